# Optimizing an MI355X kernel written in HIP

```python
import jax, jax.numpy as jnp
from jax import lax
import numpy as np

D_MODEL = 1024
BATCH = 8
SEQ = 2048
DEPTH = 1
DEC_BATCH = 128
DEC_SEQ = 8
PAST_LEN = 2048
PAGE_SIZE = 128

N_META = 16
H_RET = D_MODEL // 256
DK_RET = 256
DV_RET = 512
RET_CHUNK = 128
ROPE_BASE = 10000.0
N_HEADS = D_MODEL // 128
N_KV_HEADS = 2
D_HEAD = 128
N_IDX_HEADS = 8
D_IDX = 64
INDEX_TOPK = 256
Q_BLOCK = 128
D_FF = -(-(8 * D_MODEL) // (3 * 256)) * 256
NORM_EPS = 1e-6

RET_QK_W = H_RET * DK_RET
RET_V_W = H_RET * DV_RET
DSA_Q_W = N_HEADS * D_HEAD
DSA_KV_W = N_KV_HEADS * D_HEAD
IDX_Q_W = N_IDX_HEADS * D_IDX
IN_COLS = 2 * RET_QK_W + 2 * RET_V_W + DSA_Q_W + 2 * DSA_KV_W + IDX_Q_W + D_IDX + N_IDX_HEADS + 2 * D_MODEL
IDX_SCALE = (N_IDX_HEADS ** -0.5) * (D_IDX ** -0.5)

kernel_name = "retention_dsa_gated_hybrid_step"


def rms_norm(x, w=None):
    xf = x.astype(jnp.float32)
    y = (xf * lax.rsqrt(jnp.mean(xf * xf, axis=-1, keepdims=True) + NORM_EPS)).astype(x.dtype)
    return y if w is None else y * w


def layer_norm(x, w, b):
    xf = x.astype(jnp.float32)
    mu = jnp.mean(xf, axis=-1, keepdims=True)
    var = jnp.mean(jnp.square(xf - mu), axis=-1, keepdims=True)
    return ((xf - mu) * lax.rsqrt(var + NORM_EPS)).astype(x.dtype) * w + b


def rotary(x, pos):
    half = x.shape[-1] // 2
    inv = ROPE_BASE ** (-jnp.arange(half, dtype=jnp.float32) / half)
    ang = pos.astype(jnp.float32)[:, None] * inv[None, :]
    cos = jnp.cos(ang)[None, :, None, :]
    sin = jnp.sin(ang)[None, :, None, :]
    x1 = x[..., :half].astype(jnp.float32)
    x2 = x[..., half:].astype(jnp.float32)
    return jnp.concatenate([x1 * cos - x2 * sin, x1 * sin + x2 * cos], axis=-1).astype(x.dtype)


def retention_log_gamma():
    return jnp.log1p(-jnp.exp2(-5.0 - jnp.arange(H_RET, dtype=jnp.float32)))


def retention_chunk(S, q, k, v):
    C = q.shape[2]
    lg = retention_log_gamma()
    i = jnp.arange(C, dtype=jnp.float32)
    diff = i[:, None] - i[None, :]
    decay = jnp.where(diff >= 0, jnp.exp(lg[:, None, None] * jnp.maximum(diff, 0.0)), 0.0).astype(q.dtype)
    q_decay = jnp.exp(lg[:, None] * (i + 1.0)).astype(q.dtype)
    k_decay = jnp.exp(lg[:, None] * (C - 1.0 - i)).astype(q.dtype)
    s_decay = jnp.exp(lg * C).astype(q.dtype)
    scores = jnp.einsum("bhid,bhjd->bhij", q, k) * decay
    o = (jnp.einsum("bhij,bhjv->bhiv", scores, v)
         + jnp.einsum("bhid,bhdv->bhiv", q, S) * q_decay[None, :, :, None])
    S_new = (S * s_decay[None, :, None, None]
             + jnp.einsum("bhjd,bhjv->bhdv", k * k_decay[None, :, :, None], v))
    return S_new, o


def retention_prompt(q, k, v):
    B, H, L, _ = q.shape
    S0 = jnp.zeros((B, H, DK_RET, DV_RET), v.dtype)
    S1, o_meta = retention_chunk(S0, q[:, :, :N_META], k[:, :, :N_META], v[:, :, :N_META])
    n_c = (L - N_META) // RET_CHUNK

    def to_chunks(a):
        return a[:, :, N_META:].reshape(B, H, n_c, RET_CHUNK, a.shape[-1]).transpose(2, 0, 1, 3, 4)

    S_fin, o_c = lax.scan(lambda S, qkv: retention_chunk(S, *qkv), S1,
                          (to_chunks(q), to_chunks(k), to_chunks(v)))
    o_c = o_c.transpose(1, 2, 0, 3, 4).reshape(B, H, n_c * RET_CHUNK, DV_RET)
    return jnp.concatenate([o_meta, o_c], axis=2), S_fin


def indexer_scores(qi, wi, ki):
    s = jnp.einsum("bqhd,bsd->bqhs", qi.astype(jnp.float32), ki.astype(jnp.float32))
    return jnp.einsum("bqhs,bqh->bqs", jax.nn.relu(s), wi.astype(jnp.float32) * IDX_SCALE)


def sparse_attend(q, kg, vg, valid):
    B, Q = q.shape[:2]
    qg = q.reshape(B, Q, N_KV_HEADS, N_HEADS // N_KV_HEADS, D_HEAD)
    s = jnp.einsum("bqngd,bqknd->bqngk", qg.astype(jnp.float32), kg.astype(jnp.float32)) * (D_HEAD ** -0.5)
    s = jnp.where(valid[:, :, None, None, :], s, -jnp.inf)
    p = jax.nn.softmax(s, axis=-1).astype(vg.dtype)
    o = jnp.einsum("bqngk,bqknd->bqngd", p, vg)
    return o.reshape(B, Q, N_HEADS, D_HEAD)


def dsa_prompt(q, k, v, qi, ki, wi, n_real):
    B, L = q.shape[:2]
    topk = min(INDEX_TOPK, n_real // 4)
    nb = -(-L // Q_BLOCK)
    Lp = nb * Q_BLOCK

    def blocks(a):
        a = jnp.pad(a, [(0, 0), (0, Lp - L)] + [(0, 0)] * (a.ndim - 2))
        return jnp.swapaxes(a.reshape((B, nb, Q_BLOCK) + a.shape[2:]), 0, 1)

    q_pos = jnp.arange(Lp).reshape(nb, Q_BLOCK)
    key_pos = jnp.arange(L)
    bidx = jnp.arange(B)[:, None, None]

    def one_block(args):
        qb, qib, wib, pb = args
        score = indexer_scores(qib, wib, ki)
        score = jnp.where(key_pos[None, None, :] <= pb[None, :, None], score, -jnp.inf)
        _, sel = lax.top_k(score, topk)
        valid = sel <= pb[None, :, None]
        return sparse_attend(qb, k[bidx, sel], v[bidx, sel], valid)

    o = lax.map(one_block, (blocks(q), blocks(qi), blocks(wi), q_pos))
    return jnp.swapaxes(o, 0, 1).reshape(B, Lp, N_HEADS, D_HEAD)[:, :L]


def dsa_sample(q, k_new, v_new, qi, ki_new, wi, cache_k, cache_v, cache_kidx, page_table):
    DB, Q = q.shape[:2]
    n_pages = page_table.shape[1]
    past = n_pages * PAGE_SIZE
    L = past + Q
    topk = min(INDEX_TOPK, L // 4)
    ki_all = jnp.concatenate([cache_kidx[page_table].reshape(DB, past, D_IDX), ki_new], axis=1)
    q_pos = past + jnp.arange(Q)
    key_pos = jnp.arange(L)
    score = indexer_scores(qi, wi, ki_all)
    score = jnp.where(key_pos[None, None, :] <= q_pos[None, :, None], score, -jnp.inf)
    _, sel = lax.top_k(score, topk)
    valid = sel <= q_pos[None, :, None]
    bidx = jnp.arange(DB)[:, None, None]
    in_past = (sel < past)[..., None, None]
    ps = jnp.minimum(sel, past - 1)
    phys = page_table[bidx, ps // PAGE_SIZE]
    off = ps % PAGE_SIZE
    ns = jnp.clip(sel - past, 0, Q - 1)
    kg = jnp.where(in_past, cache_k[phys, off], k_new[bidx, ns])
    vg = jnp.where(in_past, cache_v[phys, off], v_new[bidx, ns])
    return sparse_attend(q, kg, vg, valid)


def mixer_inputs(h, pos, norm_mix_w, w_in, dsa_q_norm_w, dsa_k_norm_w, idx_k_norm_w, idx_k_norm_b):
    B, L = h.shape[:2]
    z = rms_norm(h, norm_mix_w) @ w_in
    sizes = (RET_QK_W, RET_QK_W, RET_V_W, RET_V_W, DSA_Q_W, DSA_KV_W, DSA_KV_W,
             IDX_Q_W, D_IDX, N_IDX_HEADS, 2 * D_MODEL)
    rq, rk, rv, rg, aq, ak, av, iq, ik, iw, gz = jnp.split(z, [int(c) for c in np.cumsum(sizes)[:-1]], axis=-1)
    rq = rotary(rq.reshape(B, L, H_RET, DK_RET), pos).transpose(0, 2, 1, 3)
    rk = (rotary(rk.reshape(B, L, H_RET, DK_RET), pos) * (DK_RET ** -0.5)).transpose(0, 2, 1, 3)
    rv = rv.reshape(B, L, H_RET, DV_RET).transpose(0, 2, 1, 3)
    aq = rms_norm(aq.reshape(B, L, N_HEADS, D_HEAD), dsa_q_norm_w)
    ak = rms_norm(ak.reshape(B, L, N_KV_HEADS, D_HEAD), dsa_k_norm_w)
    av = av.reshape(B, L, N_KV_HEADS, D_HEAD)
    iq = iq.reshape(B, L, N_IDX_HEADS, D_IDX)
    ik = layer_norm(ik, idx_k_norm_w, idx_k_norm_b)
    return rq, rk, rv, rg, aq, ak, av, iq, ik, iw, jax.nn.sigmoid(gz)


def merge_and_ffn(h, o_ret, rg, o_dsa, gates, w_ret_proj, w_dsa_proj, w_out, norm_ffn_w, w_ffn_in, w_ffn_out):
    B, L = h.shape[:2]
    o_ret = rms_norm(o_ret.transpose(0, 2, 1, 3)).reshape(B, L, RET_V_W) * jax.nn.silu(rg)
    br_ret = o_ret @ w_ret_proj
    br_dsa = o_dsa.reshape(B, L, DSA_Q_W) @ w_dsa_proj
    g_ret, g_dsa = jnp.split(gates, 2, axis=-1)
    h = h + (g_ret * br_ret + g_dsa * br_dsa) @ w_out
    a, b = jnp.split(rms_norm(h, norm_ffn_w) @ w_ffn_in, 2, axis=-1)
    return h + (jax.nn.silu(a) * b) @ w_ffn_out


def setup_inputs(seed: int = 0) -> dict:
    key = jax.random.key(seed)
    ks = jax.random.split(key, 20)
    f32 = jnp.float32
    n_pages = PAST_LEN // PAGE_SIZE
    n_used = DEC_BATCH * n_pages
    n_pool = (n_used * 5) // 4

    def nrm(k, shape, scale=1.0):
        return jax.random.normal(k, shape, f32) * scale

    def gain(k, shape):
        return 1.0 + 0.02 * jax.random.normal(k, shape, f32)

    return {
        "x_prompt": nrm(ks[0], (BATCH, SEQ, D_MODEL)),
        "x_sample": nrm(ks[1], (DEC_BATCH, DEC_SEQ, D_MODEL)),
        "cache_k": nrm(ks[2], (DEPTH, n_pool, PAGE_SIZE, N_KV_HEADS, D_HEAD)),
        "cache_v": nrm(ks[3], (DEPTH, n_pool, PAGE_SIZE, N_KV_HEADS, D_HEAD)),
        "cache_kidx": nrm(ks[4], (DEPTH, n_pool, PAGE_SIZE, D_IDX)),
        "state_ret": nrm(ks[5], (DEPTH, DEC_BATCH, H_RET, DK_RET, DV_RET), 0.5),
        "page_table": jax.random.permutation(ks[6], n_pool)[:n_used].reshape(DEC_BATCH, n_pages).astype(jnp.int32),
        "meta_tokens": nrm(ks[7], (N_META, D_MODEL)),
        "norm_mix_w": gain(ks[8], (DEPTH, D_MODEL)),
        "w_in": nrm(ks[9], (DEPTH, D_MODEL, IN_COLS), D_MODEL ** -0.5),
        "w_ret_proj": nrm(ks[10], (DEPTH, RET_V_W, D_MODEL), RET_V_W ** -0.5),
        "dsa_q_norm_w": gain(ks[11], (DEPTH, D_HEAD)),
        "dsa_k_norm_w": gain(ks[12], (DEPTH, D_HEAD)),
        "idx_k_norm_w": gain(ks[13], (DEPTH, D_IDX)),
        "idx_k_norm_b": nrm(ks[14], (DEPTH, D_IDX), 0.02),
        "w_dsa_proj": nrm(ks[15], (DEPTH, DSA_Q_W, D_MODEL), DSA_Q_W ** -0.5),
        "w_out": nrm(ks[16], (DEPTH, D_MODEL, D_MODEL), D_MODEL ** -0.5),
        "norm_ffn_w": gain(ks[17], (DEPTH, D_MODEL)),
        "w_ffn_in": nrm(ks[18], (DEPTH, D_MODEL, 2 * D_FF), D_MODEL ** -0.5),
        "w_ffn_out": nrm(ks[19], (DEPTH, D_FF, D_MODEL), D_FF ** -0.5),
    }


def reference(x_prompt, x_sample, cache_k, cache_v, cache_kidx, state_ret, page_table,
              meta_tokens, norm_mix_w, w_in, w_ret_proj, dsa_q_norm_w, dsa_k_norm_w,
              idx_k_norm_w, idx_k_norm_b, w_dsa_proj, w_out, norm_ffn_w, w_ffn_in, w_ffn_out):
    B, n_real = x_prompt.shape[:2]
    h_p = jnp.concatenate(
        [jnp.broadcast_to(meta_tokens.astype(x_prompt.dtype)[None], (B, N_META, D_MODEL)), x_prompt], axis=1)
    h_s = x_sample
    past = page_table.shape[1] * PAGE_SIZE
    pos_p = jnp.arange(h_p.shape[1])
    pos_s = past + jnp.arange(x_sample.shape[1])
    kp, vp, kip, sp, ks_, vs_, kis, ss = [], [], [], [], [], [], [], []
    for l in range(DEPTH):
        proj = (norm_mix_w[l], w_in[l], dsa_q_norm_w[l], dsa_k_norm_w[l], idx_k_norm_w[l], idx_k_norm_b[l])
        post = (w_ret_proj[l], w_dsa_proj[l], w_out[l], norm_ffn_w[l], w_ffn_in[l], w_ffn_out[l])
        rq, rk, rv, rg, aq, ak, av, iq, ik, iw, gates = mixer_inputs(h_p, pos_p, *proj)
        o_ret, S_p = retention_prompt(rq, rk, rv)
        o_dsa = dsa_prompt(aq, ak, av, iq, ik, iw, n_real)
        kp.append(ak); vp.append(av); kip.append(ik); sp.append(S_p)
        h_p = merge_and_ffn(h_p, o_ret, rg, o_dsa, gates, *post)
        rq, rk, rv, rg, aq, ak, av, iq, ik, iw, gates = mixer_inputs(h_s, pos_s, *proj)
        S_s, o_ret = retention_chunk(state_ret[l], rq, rk, rv)
        o_dsa = dsa_sample(aq, ak, av, iq, ik, iw, cache_k[l], cache_v[l], cache_kidx[l], page_table)
        ks_.append(ak); vs_.append(av); kis.append(ik); ss.append(S_s)
        h_s = merge_and_ffn(h_s, o_ret, rg, o_dsa, gates, *post)
    y_prompt = h_p[:, N_META:]
    return (y_prompt, h_s, jnp.stack(kp), jnp.stack(vp), jnp.stack(kip), jnp.stack(sp),
            jnp.stack(ks_), jnp.stack(vs_), jnp.stack(kis), jnp.stack(ss))
```

```cpp
#include <hip/hip_runtime.h>
#include <stdint.h>
#include <stdio.h>

#define D_MODEL 1024
#define BATCH 8
#define SEQ 2048
#define N_META 16
#define LP (N_META + SEQ)
#define DEC_BATCH 128
#define DEC_SEQ 8
#define PAST_LEN 2048
#define PAGE_SIZE 128
#define N_PAGES 16
#define H_RET 4
#define DK_RET 256
#define DV_RET 512
#define N_HEADS 8
#define N_KV 2
#define D_HEAD 128
#define N_IDXH 8
#define D_IDX 64
#define TOPK 256
#define D_FF 2816
#define IN_COLS 10312
#define NORM_EPS 1e-6f
#define IDX_SCALE 0.04419417382415922f
#define T_PROMPT (BATCH * LP)
#define T_SAMPLE (DEC_BATCH * DEC_SEQ)
#define T_ALL (T_PROMPT + T_SAMPLE)
#define T_PAD 17664
#define N1 10496
#define NFF2 5632
#define MASK_WORDS 34
#define SAMPLE_L (PAST_LEN + DEC_SEQ)

#define O_Y_P   0
#define O_Y_S   16777216
#define O_K_P   17825792
#define O_V_P   22052864
#define O_KI_P  26279936
#define O_R_P   27336704
#define O_K_S   31531008
#define O_V_S   31793152
#define O_KI_S  32055296
#define O_R_S   32120832
#define OUT_TOTAL 99229696

typedef unsigned short bf16_t;
typedef unsigned long long u64;

__device__ __forceinline__ bf16_t f2bf(float f) { unsigned u = __float_as_uint(f); u += 0x7FFFu + ((u >> 16) & 1u); return (bf16_t)(u >> 16); }
__device__ __forceinline__ float bf2f(bf16_t b) { return __uint_as_float(((unsigned)b) << 16); }
__device__ __forceinline__ float silu_f(float x) { return x / (1.0f + __expf(-x)); }
__device__ __forceinline__ float sigmoid_f(float x) { return 1.0f / (1.0f + __expf(-x)); }

__device__ __forceinline__ int row_pos(int r) { return r < T_PROMPT ? (r % LP) : (PAST_LEN + ((r - T_PROMPT) & (DEC_SEQ - 1))); }

#define WS_CTL      0ull
#define WS_W1T      (WS_CTL + 65536ull)
#define WS_WRET     (WS_W1T + (u64)N1 * 1024 * 2)
#define WS_WDSA     (WS_WRET + 1024ull * 2048 * 2)
#define WS_WOUT     (WS_WDSA + 1024ull * 1024 * 2)
#define WS_WFFI     (WS_WOUT + 1024ull * 1024 * 2)
#define WS_WFFO     (WS_WFFI + (u64)NFF2 * 1024 * 2)
#define WS_ROPE     (WS_WFFO + 1024ull * 2816 * 2)
#define WS_RSTD0    (WS_ROPE + (u64)LP * 128 * 8)
#define WS_A0       (WS_RSTD0 + (u64)T_PAD * 4)
#define WS_RQ       (WS_A0 + (u64)T_PAD * 1024 * 2)
#define WS_RK       (WS_RQ + (u64)T_PAD * 1024 * 2)
#define WS_RV       (WS_RK + (u64)T_PAD * 1024 * 2)
#define WS_G        (WS_RV + (u64)T_PAD * 2048 * 2)
#define WS_AQ       (WS_G + (u64)T_PAD * 2048 * 2)
#define WS_KB       (WS_AQ + (u64)T_PAD * 1024 * 2)
#define WS_VB       (WS_KB + (u64)T_PAD * 256 * 2)
#define WS_IQ       (WS_VB + (u64)T_PAD * 256 * 2)
#define WS_IKB      (WS_IQ + (u64)T_PAD * 512 * 2)
#define WS_IW       (WS_IKB + (u64)T_PAD * 64 * 2)
#define WS_GATES    (WS_IW + (u64)T_PAD * 8 * 4)
#define WS_MASK     (WS_GATES + (u64)T_PAD * 2048 * 2)
#define WS_SSRET    (WS_MASK + (u64)T_PAD * MASK_WORDS * 8)
#define WS_RSTD2    (WS_SSRET + (u64)T_PAD * 32 * 4)
#define WS_REGION_B (((WS_RSTD2 + (u64)T_PAD * 16 * 4) + 4095ull) & ~4095ull)
#define WS_Z        WS_REGION_B
#define WS_H2       WS_REGION_B
#define WS_A2       (WS_H2 + (u64)T_PAD * 1024 * 4)
#define WS_HID      (WS_A2 + (u64)T_PAD * 1024 * 2)
#define WS_MG       (WS_HID + (u64)T_PAD * 2816 * 2)
#define WS_OG       (WS_MG + (u64)T_PAD * 1024 * 2)
#define WS_AN       (WS_OG + (u64)T_PAD * 2048 * 2)
#define WS_ODSA     (WS_AN + (u64)T_PAD * 2048 * 2)
#define WS_M1       (WS_ODSA + (u64)T_PAD * 1024 * 2)
#define WS_M2       (WS_M1 + (u64)T_PAD * 1024 * 4)
#define WS_ZF       WS_OG
#define WS_END_B1   (WS_Z + (u64)T_PAD * N1 * 4)
#define WS_END_B2   (WS_ZF + (u64)T_PAD * NFF2 * 4)
namespace pg8 {
#define PG8_LAS __attribute__((address_space(3)))
typedef unsigned short bf16_t;
typedef short bf16x8 __attribute__((ext_vector_type(8)));
typedef float f32x4 __attribute__((ext_vector_type(4)));
typedef unsigned u32x4 __attribute__((ext_vector_type(4)));
constexpr int BM = 256, BK = 64, HALF = 128, HTB = HALF * BK * 2  , STAGE_BYTES = 8 * HTB, NXCD = 8, WGM = 8;

__host__ __device__ __forceinline__ int lds_byte(int r, int c) { const int st = (r >> 4) * 2 + (c >> 5), rr = r & 15, cc = c & 31, ob = rr * 64 + cc * 2; return st * 1024 + (ob ^ (((ob >> 9) & 1) << 5)); }
__host__ __device__ __forceinline__ void stage_rc(int b, int& R, int& C) { const int st = b / 1024, sb = b % 1024, swz = sb ^ (((sb >> 9) & 1) << 5); R = (st >> 1) * 16 + swz / 64; C = (st & 1) * 32 + (swz % 64) / 2; }
__host__ __device__ __forceinline__ int perm32(int rho) { const int n = rho >> 4, i = rho & 15; return 8 * (i >> 2) + 4 * n + (i & 3); }

struct Unit { int pm, pn; };
struct Gemm { const bf16_t* A; const bf16_t* Bt; int M, N, K; };

struct StaticOrder {
    int nM, nN, nwg, G, c;
    __host__ __device__ void init(int M, int N, int G_, int c_) { nM = M / BM; nN = N / BM; nwg = nM * nN; G = G_; c = c_; }
    __host__ __device__ bool next(int i, Unit& u) const {
        const long L = (long)i * G + c; if (L >= nwg) return false;
        int wgid = (int)L; { const int q = nwg / NXCD, r = nwg % NXCD, xcd = wgid % NXCD, off = wgid / NXCD; wgid = (xcd < r ? xcd * (q + 1) : r * (q + 1) + (xcd - r) * q) + off; }
        const int nig = WGM * nN, gid = wgid / nig, fm = gid * WGM, gsz = (nM - fm) < WGM ? (nM - fm) : WGM;
        u.pm = fm + ((wgid % nig) % gsz); u.pn = (wgid % nig) / gsz; return true;
    }
    __device__ __forceinline__ void a_ready(const Unit&) const {}
    __device__ __forceinline__ void done(const Unit&) const {}
};
struct CountedOrder : StaticOrder {
    const unsigned* ready; unsigned need; unsigned* tmo;
    __device__ __forceinline__ void a_ready(const Unit& u) const {
        if (threadIdx.x < 64) {
            const unsigned long long t0 = __builtin_amdgcn_s_memrealtime(); unsigned polls = 0;
            while ((unsigned)__builtin_amdgcn_readfirstlane(__hip_atomic_load(ready + 64 * u.pm, __ATOMIC_RELAXED, __HIP_MEMORY_SCOPE_AGENT)) < need) {
                if ((++polls & 255u) == 0u && __builtin_amdgcn_readfirstlane(__hip_atomic_load(tmo, __ATOMIC_RELAXED, __HIP_MEMORY_SCOPE_AGENT)) != 0u) break;
                if (__builtin_amdgcn_s_memrealtime() - t0 > 2000000ull) {
                    if (threadIdx.x == 0) { unsigned expect = 0u; __hip_atomic_compare_exchange_strong(tmo + 1, &expect, 0x600u | (unsigned)(u.pm & 0xff), __ATOMIC_RELAXED, __ATOMIC_RELAXED, __HIP_MEMORY_SCOPE_AGENT); __hip_atomic_store(tmo, 1u, __ATOMIC_RELAXED, __HIP_MEMORY_SCOPE_AGENT); }
                    break; }
                __builtin_amdgcn_s_sleep(2); }
            __builtin_amdgcn_fence(__ATOMIC_ACQUIRE, "agent");
            asm volatile("s_waitcnt vmcnt(0)" ::: "memory");
        }
#if !defined(BROKEN_HOOK_NO_BARRIER)
        asm volatile("" ::: "memory"); __builtin_amdgcn_s_barrier(); asm volatile("" ::: "memory");
#endif
    }
};

__device__ __forceinline__ unsigned cvt_pk_bf16(float lo, float hi) { unsigned r; asm volatile("v_cvt_pk_bf16_f32 %0, %1, %2" : "=v"(r) : "v"(lo), "v"(hi)); return r; }
typedef float f32x2 __attribute__((ext_vector_type(2)));
__device__ __forceinline__ f32x2 gelu_pk(f32x2 v) {
    const f32x2 av = __builtin_elementwise_abs(v), d = av * 0.2316418882f + 1.0f;
    f32x2 t; t.x = __builtin_amdgcn_rcpf(d.x); t.y = __builtin_amdgcn_rcpf(d.y);
    f32x2 q = t * 0.5307027145f + (-0.7265760135f); q = q * t + 0.7107068705f; q = q * t + (-0.142248368f); q = q * t + 0.127414796f; q = q * t;
    const f32x2 s = (v * v) * (-0.72134752044f);
    f32x2 e; e.x = __builtin_amdgcn_exp2f(s.x); e.y = __builtin_amdgcn_exp2f(s.y);
    const f32x2 m = v * (q * e), r = v - m;
    f32x2 o; o.x = v.x < 0.f ? m.x : r.x; o.y = v.y < 0.f ? m.y : r.y; return o;
}

struct EpiF32 {
    static constexpr bool PERM = false, AFTER_DRAIN = false;
    float* C; int ldc; const float* bias;
    __device__ __forceinline__ void operator()(const f32x4 (&acc)[2][2][4][2], const Unit& u, int wr, int wc, int fr, int fq) const {
        const int row0 = u.pm * BM + wr * 64 + fr, col0 = u.pn * BM + wc * 32 + 4 * fq;
        f32x4 bv[2][2];
#pragma unroll
        for (int bj = 0; bj < 2; ++bj)
#pragma unroll
            for (int n = 0; n < 2; ++n) bv[bj][n] = bias ? *(const f32x4*)(bias + col0 + bj * HALF + n * 16) : (f32x4){0.f, 0.f, 0.f, 0.f};
#pragma unroll
        for (int ai = 0; ai < 2; ++ai)
#pragma unroll
            for (int m = 0; m < 4; ++m) { float* rowp = C + (size_t)(row0 + ai * HALF + m * 16) * ldc + col0;
#pragma unroll
                for (int bj = 0; bj < 2; ++bj)
#pragma unroll
                    for (int n = 0; n < 2; ++n) *(f32x4*)(rowp + bj * HALF + n * 16) = acc[ai][bj][m][n] + bv[bj][n]; }
    }
};
template <int ACT  > struct EpiBf16 {
    static constexpr bool PERM = true, AFTER_DRAIN = false;
    bf16_t* O; int ldc; const float* bias; int split_cols; size_t split_stride;
    __device__ __forceinline__ void operator()(const f32x4 (&acc)[2][2][4][2], const Unit& u, int wr, int wc, int fr, int fq) const {
        const int row0 = u.pm * BM + wr * 64 + fr; int colt = u.pn * BM; bf16_t* base = O;
        if (split_cols) { const int t = colt / split_cols; base += (size_t)t * split_stride; colt -= t * split_cols; }
        const int col0 = colt + wc * 32 + 8 * fq, bcol0 = u.pn * BM + wc * 32 + 8 * fq;
        f32x4 bv[2][2];
#pragma unroll
        for (int bj = 0; bj < 2; ++bj)
#pragma unroll
            for (int n = 0; n < 2; ++n) bv[bj][n] = bias ? *(const f32x4*)(bias + bcol0 + bj * HALF + 4 * n) : (f32x4){0.f, 0.f, 0.f, 0.f};
#pragma unroll
        for (int ai = 0; ai < 2; ++ai)
#pragma unroll
            for (int m = 0; m < 4; ++m) { bf16_t* rowp = base + (size_t)(row0 + ai * HALF + m * 16) * ldc + col0;
#pragma unroll
                for (int bj = 0; bj < 2; ++bj) { f32x4 v0 = acc[ai][bj][m][0] + bv[bj][0], v1 = acc[ai][bj][m][1] + bv[bj][1];
                    if (ACT == 1) { f32x2 a = gelu_pk((f32x2){v0[0], v0[1]}), b = gelu_pk((f32x2){v0[2], v0[3]}), c = gelu_pk((f32x2){v1[0], v1[1]}), d = gelu_pk((f32x2){v1[2], v1[3]});
                        v0 = (f32x4){a.x, a.y, b.x, b.y}; v1 = (f32x4){c.x, c.y, d.x, d.y}; }
                    if (ACT == 2) {
#pragma unroll
                        for (int j = 0; j < 4; ++j) { v0[j] = 0.5f * v0[j] * (1.0f + erff(v0[j] * 0.70710678f)); v1[j] = 0.5f * v1[j] * (1.0f + erff(v1[j] * 0.70710678f)); } }
                    u32x4 w; w.x = cvt_pk_bf16(v0[0], v0[1]); w.y = cvt_pk_bf16(v0[2], v0[3]); w.z = cvt_pk_bf16(v1[0], v1[1]); w.w = cvt_pk_bf16(v1[2], v1[3]);
                    *(u32x4*)(rowp + bj * HALF) = w; } }
    }
};
template <class Epi, class Sched, bool STAMP = false>
__device__ __forceinline__ void gemm_phase(PG8_LAS unsigned char* lds, const Gemm g, const Sched& S, const Epi& E, unsigned long long* stamps) {
    const int tid = threadIdx.x, wid = __builtin_amdgcn_readfirstlane(tid >> 6), lane = tid & 63, wr = wid >> 2, wc = wid & 3, fr = lane & 15, fq = lane >> 4;
    const int K = g.K, nt = K / BK;
    int ts_lo = 0, ts_hi = 0, nts = 0; const unsigned long long rt_entry = STAMP ? (unsigned long long)wall_clock64() : 0ull;
#define PG8_STAMP() do { if (STAMP && wid == 0 && nts < 64) { const unsigned long long _c = (unsigned long long)clock64(); \
        ts_lo = (lane == nts) ? (int)(unsigned)_c : ts_lo; ts_hi = (lane == nts) ? (int)(unsigned)(_c >> 32) : ts_hi; ++nts; } } while (0)
    PG8_STAMP();
    unsigned voffA[2], voffB[2];
#pragma unroll
    for (int i = 0; i < 2; ++i) { int R, C; stage_rc(tid * 16 + i * 8192, R, C); const int Rb = Epi::PERM ? ((R & ~31) + perm32(R & 31)) : R;
        voffA[i] = (unsigned)(R * K + C) * 2u; voffB[i] = (unsigned)(Rb * K + C) * 2u; }
    const size_t kstep = (size_t)(BK * 2);
    const size_t hstep = (size_t)HALF * K * 2;
    const size_t tstep = 2 * hstep;
    const unsigned ldsw = (unsigned)wid * 1024u;
    const int aoff = lds_byte(wr * 64 + fr, fq * 8), boff = lds_byte(wc * 32 + fr, fq * 8);
#define PG8_SA(b, h) (((b) * 2 + (h)) * HTB)
#define PG8_SB(b, h) ((4 + (b) * 2 + (h)) * HTB)
#define PG8_STAGE(bufoff, gbase, voff) do { _Pragma("unroll") for (int _i = 0; _i < 2; ++_i) \
        __builtin_amdgcn_global_load_lds((const unsigned*)((const char*)(gbase) + (voff)[_i]), (PG8_LAS unsigned*)(lds + (bufoff) + ldsw + _i * 8192), 16, 0, 0); } while (0)
#define PG8_LDA(dst, b, h) do { _Pragma("unroll") for (int m = 0; m < 4; ++m) _Pragma("unroll") for (int k = 0; k < 2; ++k) dst[m][k] = *(const PG8_LAS bf16x8*)(lds + PG8_SA(b, h) + aoff + m * 2048 + k * 1024); } while (0)
#define PG8_LDB(dst, b, h) do { _Pragma("unroll") for (int n = 0; n < 2; ++n) _Pragma("unroll") for (int k = 0; k < 2; ++k) dst[n][k] = *(const PG8_LAS bf16x8*)(lds + PG8_SB(b, h) + boff + n * 2048 + k * 1024); } while (0)
#define PG8_MMA(ai, bj, At, Bt) do { __builtin_amdgcn_s_setprio(1); _Pragma("unroll") for (int m = 0; m < 4; ++m) _Pragma("unroll") for (int n = 0; n < 2; ++n) _Pragma("unroll") for (int k = 0; k < 2; ++k) \
        acc[ai][bj][m][n] = __builtin_amdgcn_mfma_f32_16x16x32_bf16(Bt[n][k], At[m][k], acc[ai][bj][m][n], 0, 0, 0); __builtin_amdgcn_s_setprio(0); } while (0)
#define PG8_WAIT_V(n) asm volatile("s_waitcnt vmcnt(" #n ")" ::: "memory")
#define PG8_WAIT_L(n) asm volatile("s_waitcnt lgkmcnt(" #n ")" ::: "memory")
#define PG8_BAR __builtin_amdgcn_s_barrier()
#define PG8_SCHED __builtin_amdgcn_sched_barrier(0)
    Unit cur, nxt; int ui = 0;
    if (!S.next(0, cur)) return;
    f32x4 acc[2][2][4][2];
#pragma unroll
    for (int a = 0; a < 2; ++a)
#pragma unroll
        for (int b = 0; b < 2; ++b)
#pragma unroll
            for (int m = 0; m < 4; ++m)
#pragma unroll
                for (int n = 0; n < 2; ++n) acc[a][b][m][n] = (f32x4){0.f, 0.f, 0.f, 0.f};
    bf16x8 At[4][2], B0[2][2], B1[2][2];
    const char* cA = (const char*)g.A + (size_t)cur.pm * tstep; const char* cB = (const char*)g.Bt + (size_t)cur.pn * tstep;
    S.a_ready(cur);
    PG8_STAGE(PG8_SB(0, 0), cB, voffB); PG8_STAGE(PG8_SA(0, 0), cA, voffA); PG8_STAGE(PG8_SB(0, 1), cB + hstep, voffB); PG8_STAGE(PG8_SA(0, 1), cA + hstep, voffA);
    if (wr == 1) PG8_BAR;
    PG8_WAIT_V(4); PG8_BAR;
    PG8_STAGE(PG8_SB(1, 0), cB + kstep, voffB); PG8_STAGE(PG8_SA(1, 0), cA + kstep, voffA); PG8_STAGE(PG8_SB(1, 1), cB + hstep + kstep, voffB);
    PG8_WAIT_V(6); PG8_BAR;
    PG8_STAMP();
    for (;;) {
        const bool has_next = S.next(ui + 1, nxt);
        const char* nA = has_next ? (const char*)g.A + (size_t)nxt.pm * tstep : cA; const char* nB = has_next ? (const char*)g.Bt + (size_t)nxt.pn * tstep : cB;
        for (int t = 0; t < nt; t += 2) {
            const bool last = (t == nt - 2);
            const char* a1 = cA + (size_t)(t + 1) * kstep;
            const char* a2 = last ? nA : cA + (size_t)(t + 2) * kstep; const char* b2 = last ? nB : cB + (size_t)(t + 2) * kstep;
            const char* a3 = a2 + kstep; const char* b3 = b2 + kstep;
            if (last && has_next) S.a_ready(nxt);
            PG8_LDB(B0, 0, 0); PG8_SCHED; PG8_LDA(At, 0, 0); PG8_STAGE(PG8_SA(1, 1), a1 + hstep, voffA);
            PG8_WAIT_L(8); PG8_BAR; PG8_WAIT_L(0); PG8_MMA(0, 0, At, B0); PG8_BAR; PG8_SCHED;
            PG8_LDB(B1, 0, 1); PG8_STAGE(PG8_SB(0, 0), b2, voffB);
            PG8_BAR; PG8_WAIT_L(0); PG8_MMA(0, 1, At, B1); PG8_BAR;
            PG8_LDA(At, 0, 1); PG8_STAGE(PG8_SA(0, 0), a2, voffA);
            PG8_BAR; PG8_WAIT_L(0); PG8_MMA(1, 0, At, B0); PG8_BAR; PG8_SCHED;
            PG8_STAGE(PG8_SB(0, 1), b2 + hstep, voffB);
            PG8_WAIT_V(6); PG8_BAR; PG8_MMA(1, 1, At, B1); PG8_BAR;
            PG8_LDB(B0, 1, 0); PG8_SCHED; PG8_LDA(At, 1, 0); PG8_STAGE(PG8_SA(0, 1), a2 + hstep, voffA);
            PG8_WAIT_L(8); PG8_BAR; PG8_WAIT_L(0); PG8_MMA(0, 0, At, B0); PG8_BAR; PG8_SCHED;
            PG8_LDB(B1, 1, 1); PG8_STAGE(PG8_SB(1, 0), b3, voffB);
            PG8_BAR; PG8_WAIT_L(0); PG8_MMA(0, 1, At, B1); PG8_BAR;
            PG8_LDA(At, 1, 1); PG8_STAGE(PG8_SA(1, 0), a3, voffA);
            PG8_BAR; PG8_WAIT_L(0); PG8_MMA(1, 0, At, B0); PG8_BAR; PG8_SCHED;
            PG8_STAGE(PG8_SB(1, 1), b3 + hstep, voffB);
            PG8_WAIT_V(6); PG8_BAR; PG8_MMA(1, 1, At, B1); PG8_BAR;
        }
        PG8_STAMP();
        if constexpr (!Epi::AFTER_DRAIN) { E(acc, cur, wr, wc, fr, fq); S.done(cur); }
        PG8_STAMP();
        if (!has_next) break;
#pragma unroll
        for (int a = 0; a < 2; ++a)
#pragma unroll
            for (int b = 0; b < 2; ++b)
#pragma unroll
                for (int m = 0; m < 4; ++m)
#pragma unroll
                    for (int n = 0; n < 2; ++n) acc[a][b][m][n] = (f32x4){0.f, 0.f, 0.f, 0.f};
        cur = nxt; cA = nA; cB = nB; ++ui;
    }
    PG8_WAIT_V(0);
    if (wr == 0) PG8_BAR;
    PG8_BAR;
    if constexpr (Epi::AFTER_DRAIN) { E.fused(acc, cur, wr, wc, fr, fq, lds, wid, lane); S.done(cur); }
    PG8_STAMP();
    if (STAMP && wid == 0) { stamps[lane] = lane < nts ? (((unsigned long long)(unsigned)ts_hi << 32) | (unsigned)ts_lo) : 0ull;
        if (lane == 62) stamps[62] = rt_entry; if (lane == 63) stamps[63] = (unsigned long long)wall_clock64(); }
#undef PG8_STAMP
#undef PG8_SA
#undef PG8_SB
#undef PG8_STAGE
#undef PG8_LDA
#undef PG8_LDB
#undef PG8_MMA
#undef PG8_WAIT_V
#undef PG8_WAIT_L
#undef PG8_BAR
#undef PG8_SCHED
}
}
__host__ __device__ __forceinline__ int ikiw_src(int c) {
    if (c < 32) return 8192 + c;
    if (c < 40) return 8256 + (c - 32);
    if (c >= 128 && c < 160) return 8192 + 32 + (c - 128);
    return -1;
}
__host__ __device__ __forceinline__ int ik_tilecol(int e) { return e < 32 ? e : 128 + (e - 32); }
__device__ __forceinline__ int src_col(int mode, int n) {
    if (mode == 0) return n;
    if (mode == 1) { if (n < 8192) return n; if (n < 8448) return ikiw_src(n - 8192); return 8264 + (n - 8448); }
    const int pn = n >> 8, c = n & 255; return c < 128 ? pn * 128 + c : D_FF + pn * 128 + (c - 128);
}
__device__ __forceinline__ void prep_weight_tile(const float* __restrict__ w, int ldw, const float* __restrict__ scale, bf16_t* __restrict__ Wt, int K, int mode, int tile, float* lds  ) {
    const int ktiles = K / 32, nt = tile / ktiles, kt = tile % ktiles, tid = threadIdx.x;
    const int n0 = nt * 64, k0 = kt * 32;
    {   const int nn = tid & 63, kk0 = tid >> 6; const int sc = src_col(mode, n0 + nn);
#pragma unroll
        for (int i = 0; i < 8; ++i) { const int kk = kk0 + i * 4; float v = 0.f; if (sc >= 0) { v = w[(size_t)(k0 + kk) * ldw + sc]; if (scale) v *= scale[k0 + kk]; } lds[kk * 65 + nn] = v; } }
    __syncthreads();
    {   const int kk = tid & 31, nn0 = tid >> 5;
#pragma unroll
        for (int i = 0; i < 8; ++i) { const int nn = nn0 + i * 8; Wt[(size_t)(n0 + nn) * K + k0 + kk] = f2bf(lds[kk * 65 + nn]); } }
    __syncthreads();
}
__device__ __forceinline__ const float* h_row_ptr(int r, const float* xp, const float* xs, const float* meta) {
    if (r < T_PROMPT) { const int b = r / LP, l = r % LP; return l < N_META ? meta + (size_t)l * D_MODEL : xp + ((size_t)b * SEQ + (l - N_META)) * D_MODEL; }
    return xs + (size_t)(r - T_PROMPT) * D_MODEL;
}
__device__ __forceinline__ void prep_row(int r, const float* xp, const float* xs, const float* meta, bf16_t* A0, float* rstd0, int lane) {
    if (r >= T_ALL) { for (int i = lane; i < D_MODEL / 2; i += 64) ((unsigned*)(A0 + (size_t)r * D_MODEL))[i] = 0u; if (lane == 0) rstd0[r] = 0.f; return; }
    const float4* src = (const float4*)h_row_ptr(r, xp, xs, meta); float ss = 0.f;
#pragma unroll
    for (int i = 0; i < 4; ++i) { const float4 v = src[lane + i * 64]; ss += v.x * v.x + v.y * v.y + v.z * v.z + v.w * v.w;
        uint2 o; o.x = (unsigned)f2bf(v.x) | ((unsigned)f2bf(v.y) << 16); o.y = (unsigned)f2bf(v.z) | ((unsigned)f2bf(v.w) << 16);
        ((uint2*)(A0 + (size_t)r * D_MODEL))[lane + i * 64] = o; }
#pragma unroll
    for (int o = 32; o >= 1; o >>= 1) ss += __shfl_xor(ss, o);
    if (lane == 0) rstd0[r] = rsqrtf(ss * (1.0f / D_MODEL) + NORM_EPS);
}
__device__ __forceinline__ void rope_entry(int idx, float2* tab) {
    const int pos = idx >> 7, i = idx & 127;
    const float inv = exp2f(-(float)i * (13.287712379549449f / 128.0f));
    const float angf = (float)pos * inv; const double a = (double)angf;
    const double kq = rint(a * 0.63661977236758134308);
    double r = fma(-kq, 1.57079632679489655800e+00, a); r = fma(-kq, 6.12323399573676603587e-17, r);
    const double r2 = r * r;
    const double sp = r * (1.0 + r2 * (-1.0 / 6 + r2 * (1.0 / 120 + r2 * (-1.0 / 5040 + r2 * (1.0 / 362880 + r2 * (-1.0 / 39916800 + r2 * (1.0 / 6227020800.0)))))));
    const double cp = 1.0 + r2 * (-0.5 + r2 * (1.0 / 24 + r2 * (-1.0 / 720 + r2 * (1.0 / 40320 + r2 * (-1.0 / 3628800 + r2 * (1.0 / 479001600 + r2 * (-1.0 / 87178291200.0)))))));
    const int q = ((int)kq) & 3;
    const double sv = (q == 0) ? sp : (q == 1) ? cp : (q == 2) ? -sp : -cp;
    const double cv = (q == 0) ? cp : (q == 1) ? -sp : (q == 2) ? -cp : sp;
    tab[idx] = make_float2((float)cv, (float)sv);
}

struct PrepArgs {
    const float *x_prompt, *x_sample, *meta, *norm_mix_w, *w_in, *w_ret, *w_dsa, *w_out, *norm_ffn_w, *w_ffi, *w_ffo;
    bf16_t *W1t, *Wret, *Wdsa, *Wout, *Wffi, *Wffo, *A0; float* rstd0; float2* rope;
};
#define PREP_J_W1   0
#define PREP_N_W1   ((N1 / 64) * (1024 / 32))
#define PREP_J_WRET (PREP_J_W1 + PREP_N_W1)
#define PREP_N_WRET ((1024 / 64) * (2048 / 32))
#define PREP_J_WDSA (PREP_J_WRET + PREP_N_WRET)
#define PREP_N_WDSA ((1024 / 64) * (1024 / 32))
#define PREP_J_WOUT (PREP_J_WDSA + PREP_N_WDSA)
#define PREP_N_WOUT ((1024 / 64) * (1024 / 32))
#define PREP_J_WFFI (PREP_J_WOUT + PREP_N_WOUT)
#define PREP_N_WFFI ((NFF2 / 64) * (1024 / 32))
#define PREP_J_WFFO (PREP_J_WFFI + PREP_N_WFFI)
#define PREP_N_WFFO ((1024 / 64) * (2816 / 32))
#define PREP_J_ROWS (PREP_J_WFFO + PREP_N_WFFO)
#define PREP_N_ROWS (T_PAD / 4)
#define PREP_J_ROPE (PREP_J_ROWS + PREP_N_ROWS)
#define PREP_N_ROPE ((LP * 128) / 256)
#define PREP_N_JOBS (PREP_J_ROPE + PREP_N_ROPE)
__device__ __forceinline__ void prep_job(const PrepArgs& a, int job, float* lds) {
    if (job < PREP_J_WRET)      prep_weight_tile(a.w_in, IN_COLS, a.norm_mix_w, a.W1t, 1024, 1, job - PREP_J_W1, lds);
    else if (job < PREP_J_WDSA) prep_weight_tile(a.w_ret, 1024, nullptr, a.Wret, 2048, 0, job - PREP_J_WRET, lds);
    else if (job < PREP_J_WOUT) prep_weight_tile(a.w_dsa, 1024, nullptr, a.Wdsa, 1024, 0, job - PREP_J_WDSA, lds);
    else if (job < PREP_J_WFFI) prep_weight_tile(a.w_out, 1024, nullptr, a.Wout, 1024, 0, job - PREP_J_WOUT, lds);
    else if (job < PREP_J_WFFO) prep_weight_tile(a.w_ffi, 2 * D_FF, a.norm_ffn_w, a.Wffi, 1024, 2, job - PREP_J_WFFI, lds);
    else if (job < PREP_J_ROWS) prep_weight_tile(a.w_ffo, 1024, nullptr, a.Wffo, 2816, 0, job - PREP_J_WFFO, lds);
    else if (job < PREP_J_ROPE) prep_row((job - PREP_J_ROWS) * 4 + (threadIdx.x >> 6), a.x_prompt, a.x_sample, a.meta, a.A0, a.rstd0, threadIdx.x & 63);
    else rope_entry((job - PREP_J_ROPE) * 256 + threadIdx.x, a.rope);
}
__global__ void __launch_bounds__(256) k_prep(PrepArgs a) {
    __shared__ float lds[32 * 65];
    for (int job = blockIdx.x; job < PREP_N_JOBS; job += gridDim.x) prep_job(a, job, lds);
}
template <class Epi> __global__ void __launch_bounds__(512, 2) k_gemm(pg8::Gemm g, Epi E) {
    extern __shared__ __attribute__((aligned(16))) unsigned char shm[];
    pg8::StaticOrder S; S.init(g.M, g.N, (int)gridDim.x, (int)blockIdx.x);
    pg8::gemm_phase<Epi, pg8::StaticOrder, false>((PG8_LAS unsigned char*)shm, g, S, E, nullptr);
}

struct Epi1Args {
    const float* Z; const float* rstd0; const float2* rope; const float *qnw, *knw, *ikw, *ikb;
    bf16_t *Rq, *Rk, *Rv, *G, *Aq, *Kb, *Vb, *Iq, *Ikb, *Gates; float* Iw; float* out;
};
__global__ void __launch_bounds__(256) k_epi1(Epi1Args a) {
    const int r = blockIdx.x, t = threadIdx.x, lane = t & 63;
    const float* z = a.Z + (size_t)r * N1; const float rs = a.rstd0[r]; const int pos = row_pos(r);
    for (int which = 0; which < 2; ++which) {
        bf16_t* dst = (which ? a.Rk : a.Rq) + (size_t)r * 1024; const float post = which ? 0.0625f : 1.0f; const int zo = which * 1024;
        for (int e = t; e < 512; e += 256) { const int hh = e >> 7, i = e & 127; const float2 cs = a.rope[pos * 128 + i];
            const float x1 = z[zo + hh * 256 + i] * rs, x2 = z[zo + hh * 256 + 128 + i] * rs;
            dst[hh * 256 + i] = f2bf((x1 * cs.x - x2 * cs.y) * post); dst[hh * 256 + 128 + i] = f2bf((x1 * cs.y + x2 * cs.x) * post); }
    }
    for (int c = t; c < 2048; c += 256) { a.Rv[(size_t)r * 2048 + c] = f2bf(z[2048 + c] * rs); a.G[(size_t)r * 2048 + c] = f2bf(silu_f(z[4096 + c] * rs)); }
    {   const int c0 = t * 4; float v[4]; float ss = 0.f;
#pragma unroll
        for (int j = 0; j < 4; ++j) { v[j] = z[6144 + c0 + j] * rs; ss += v[j] * v[j]; }
#pragma unroll
        for (int o = 16; o >= 1; o >>= 1) ss += __shfl_xor(ss, o);
        const float rn = rsqrtf(ss * (1.0f / 128.0f) + NORM_EPS);
#pragma unroll
        for (int j = 0; j < 4; ++j) a.Aq[(size_t)r * 1024 + c0 + j] = f2bf(v[j] * rn * a.qnw[(c0 + j) & 127]); }
    float* kout = a.out + (r < T_PROMPT ? (size_t)O_K_P + (size_t)r * 256 : (size_t)O_K_S + (size_t)(r - T_PROMPT) * 256);
    float* vout = a.out + (r < T_PROMPT ? (size_t)O_V_P + (size_t)r * 256 : (size_t)O_V_S + (size_t)(r - T_PROMPT) * 256);
    float* kiout = a.out + (r < T_PROMPT ? (size_t)O_KI_P + (size_t)r * 64 : (size_t)O_KI_S + (size_t)(r - T_PROMPT) * 64);
    if (t < 64) { const int c0 = t * 4; float v[4]; float ss = 0.f;
#pragma unroll
        for (int j = 0; j < 4; ++j) { v[j] = z[7168 + c0 + j] * rs; ss += v[j] * v[j]; }
#pragma unroll
        for (int o = 16; o >= 1; o >>= 1) ss += __shfl_xor(ss, o);
        const float rn = rsqrtf(ss * (1.0f / 128.0f) + NORM_EPS);
#pragma unroll
        for (int j = 0; j < 4; ++j) { const float y = v[j] * rn * a.knw[(c0 + j) & 127]; kout[c0 + j] = y; a.Kb[(size_t)r * 256 + c0 + j] = f2bf(y); }
#pragma unroll
        for (int j = 0; j < 4; ++j) { const float y = z[7424 + c0 + j] * rs; vout[c0 + j] = y; a.Vb[(size_t)r * 256 + c0 + j] = f2bf(y); } }
    for (int c = t; c < 512; c += 256) a.Iq[(size_t)r * 512 + c] = f2bf(z[7680 + c] * rs);
    if (t >= 64 && t < 128) { const float x = z[8192 + ik_tilecol(lane)] * rs; float s = x;
#pragma unroll
        for (int o = 32; o >= 1; o >>= 1) s += __shfl_xor(s, o);
        const float mu = s * (1.0f / 64.0f), d = x - mu; float q = d * d;
#pragma unroll
        for (int o = 32; o >= 1; o >>= 1) q += __shfl_xor(q, o);
        const float y = d * rsqrtf(q * (1.0f / 64.0f) + NORM_EPS) * a.ikw[lane] + a.ikb[lane];
        kiout[lane] = y; a.Ikb[(size_t)r * 64 + lane] = f2bf(y); }
    if (t >= 128 && t < 136) a.Iw[(size_t)r * 8 + (t - 128)] = z[8192 + 32 + (t - 128)] * rs * IDX_SCALE;
    for (int c = t; c < 2048; c += 256) a.Gates[(size_t)r * 2048 + c] = f2bf(sigmoid_f(z[8448 + c] * rs));
}

struct RetArgs { const bf16_t *Rq, *Rk, *Rv, *G; bf16_t* OG; float* ssret; const float* state_in; float* out; };
__global__ void __launch_bounds__(256) k_ret_naive(RetArgs a, int sample) {
    __shared__ float qk[512]; __shared__ float part[4][64];
    const int unit = blockIdx.x >> 3, slice = blockIdx.x & 7, t = threadIdx.x, dkq = t >> 6, dv = t & 63;
    const int bb = unit >> 2, h = unit & 3;
    const int row0 = sample ? T_PROMPT + bb * DEC_SEQ : bb * LP, ntok = sample ? DEC_SEQ : LP;
    const float gamma = 1.0f - exp2f(-5.0f - (float)h);
    float S[64];
    const size_t sbase = ((size_t)bb * H_RET + h) * (DK_RET * DV_RET) + slice * 64 + dv;
    const float* sin_ = sample ? a.state_in + sbase : nullptr;
#pragma unroll
    for (int i = 0; i < 64; ++i) S[i] = sample ? sin_[(size_t)(dkq * 64 + i) * DV_RET] : 0.f;
    for (int tok = 0; tok < ntok; ++tok) {
        const int r = row0 + tok;
        __syncthreads();
        qk[t] = bf2f(a.Rq[(size_t)r * 1024 + h * 256 + t]); qk[256 + t] = bf2f(a.Rk[(size_t)r * 1024 + h * 256 + t]);
        __syncthreads();
        const float v = bf2f(a.Rv[(size_t)r * 2048 + h * 512 + slice * 64 + dv]); float o = 0.f;
#pragma unroll
        for (int i = 0; i < 64; ++i) { const float kq_ = qk[256 + dkq * 64 + i], qq = qk[dkq * 64 + i]; S[i] = fmaf(S[i], gamma, kq_ * v); o = fmaf(qq, S[i], o); }
        part[dkq][dv] = o;
        __syncthreads();
        if (dkq == 0) { const float ot = (part[0][dv] + part[1][dv]) + (part[2][dv] + part[3][dv]); float ss = ot * ot;
#pragma unroll
            for (int of = 32; of >= 1; of >>= 1) ss += __shfl_xor(ss, of);
            const size_t ci = (size_t)r * 2048 + h * 512 + slice * 64 + dv;
            a.OG[ci] = f2bf(ot * bf2f(a.G[ci]));
            if (dv == 0) a.ssret[(size_t)r * 32 + h * 8 + slice] = ss; }
    }
    float* so = a.out + (sample ? (size_t)O_R_S : (size_t)O_R_P) + sbase;
#pragma unroll
    for (int i = 0; i < 64; ++i) so[(size_t)(dkq * 64 + i) * DV_RET] = S[i];
}

__global__ void __launch_bounds__(256) k_make_an(const bf16_t* OG, const float* ssret, bf16_t* An) {
    const int r = blockIdx.x, t = threadIdx.x;
    for (int c = t; c < 2048; c += 256) { const int h = c >> 9; float ss = 0.f;
#pragma unroll
        for (int s = 0; s < 8; ++s) ss += ssret[(size_t)r * 32 + h * 8 + s];
        An[(size_t)r * 2048 + c] = f2bf(bf2f(OG[(size_t)r * 2048 + c]) * rsqrtf(ss * (1.0f / 512.0f) + NORM_EPS)); }
}

struct IdxArgs { const bf16_t *Iq, *Ikb; const float* Iw; const float* cache_kidx; const int* page_table; u64* mask; };
__device__ __forceinline__ unsigned f2ord(float f) { const unsigned u = __float_as_uint(f); return (u & 0x80000000u) ? ~u : (u | 0x80000000u); }
__global__ void __launch_bounds__(256) k_topk_naive(IdxArgs a) {
    __shared__ float q[512]; __shared__ float w[8]; __shared__ unsigned sc[2304]; __shared__ unsigned red[256]; __shared__ unsigned mw[MASK_WORDS * 2]; __shared__ unsigned bc[2];
    const int r = blockIdx.x, t = threadIdx.x;
    const bool smp = r >= T_PROMPT; const int b = smp ? (r - T_PROMPT) >> 3 : r / LP, pos = row_pos(r);
    const int N = pos + 1;
    q[t] = bf2f(a.Iq[(size_t)r * 512 + t]); q[256 + t] = bf2f(a.Iq[(size_t)r * 512 + 256 + t]); if (t < 8) w[t] = a.Iw[(size_t)r * 8 + t];
    if (t < MASK_WORDS * 2) mw[t] = 0u;
    __syncthreads();
    for (int s = t; s < 2304; s += 256) {
        unsigned ord = 0u;
        if (s < N) { float k[64];
            if (!smp) { const bf16_t* kp = a.Ikb + ((size_t)b * LP + s) * 64;
#pragma unroll
                for (int d = 0; d < 64; ++d) k[d] = bf2f(kp[d]); }
            else if (s < PAST_LEN) { const float* kp = a.cache_kidx + ((size_t)a.page_table[b * N_PAGES + (s >> 7)] * PAGE_SIZE + (s & 127)) * 64;
#pragma unroll
                for (int d = 0; d < 64; ++d) k[d] = bf2f(f2bf(kp[d])); }
            else { const bf16_t* kp = a.Ikb + ((size_t)T_PROMPT + b * DEC_SEQ + (s - PAST_LEN)) * 64;
#pragma unroll
                for (int d = 0; d < 64; ++d) k[d] = bf2f(kp[d]); }
            float tot = 0.f;
            for (int hh = 0; hh < 8; ++hh) { float dsum = 0.f;
#pragma unroll
                for (int d = 0; d < 64; ++d) dsum = fmaf(q[hh * 64 + d], k[d], dsum);
                tot = fmaf(w[hh], fmaxf(dsum, 0.f), tot); }
            ord = f2ord(tot); }
        sc[s] = ord;
    }
    __syncthreads();
    unsigned mine[9];
#pragma unroll
    for (int i = 0; i < 9; ++i) mine[i] = sc[t * 9 + i];
    unsigned tau = 0u, r_ties = 0u;
    if (N > TOPK) {
        for (int bit = 31; bit >= 0; --bit) { const unsigned cand = tau | (1u << bit); unsigned c = 0;
#pragma unroll
            for (int i = 0; i < 9; ++i) c += (mine[i] >= cand) ? 1u : 0u;
#pragma unroll
            for (int o = 32; o >= 1; o >>= 1) c += __shfl_xor(c, o);
            __syncthreads(); if ((t & 63) == 0) red[t >> 6] = c; __syncthreads();
            const unsigned tot = red[0] + red[1] + red[2] + red[3];
            if (tot >= TOPK) tau = cand; }
        unsigned cg = 0;
#pragma unroll
        for (int i = 0; i < 9; ++i) cg += (mine[i] > tau) ? 1u : 0u;
#pragma unroll
        for (int o = 32; o >= 1; o >>= 1) cg += __shfl_xor(cg, o);
        __syncthreads(); if ((t & 63) == 0) red[t >> 6] = cg; __syncthreads();
        r_ties = TOPK - (red[0] + red[1] + red[2] + red[3]);
    }
    unsigned ce = 0;
#pragma unroll
    for (int i = 0; i < 9; ++i) ce += (mine[i] == tau) ? 1u : 0u;
    __syncthreads(); red[t] = ce; __syncthreads();
    unsigned rank = 0; for (int i = 0; i < t; ++i) rank += red[i];
#pragma unroll
    for (int i = 0; i < 9; ++i) { const int s = t * 9 + i; bool sel;
        if (N <= TOPK) sel = s < N;
        else { sel = mine[i] > tau; if (mine[i] == tau) { sel = rank < r_ties; ++rank; } }
        if (sel) atomicOr(&mw[s >> 5], 1u << (s & 31)); }
    __syncthreads();
    if (t < MASK_WORDS) a.mask[(size_t)r * MASK_WORDS + t] = (u64)mw[2 * t] | ((u64)mw[2 * t + 1] << 32);
    (void)bc;
}

struct AttnArgs { const bf16_t *Aq, *Kb, *Vb; const float *cache_k, *cache_v; const int* page_table; const u64* mask; bf16_t* Odsa; };
__global__ void __launch_bounds__(256) k_attn_naive(AttnArgs a) {
    __shared__ int list[TOPK]; __shared__ unsigned cnts[MASK_WORDS]; __shared__ float qv[128]; __shared__ float p[TOPK]; __shared__ float red[8];
    const int r = blockIdx.x, t = threadIdx.x;
    const bool smp = r >= T_PROMPT; const int b = smp ? (r - T_PROMPT) >> 3 : r / LP;
    if (t < MASK_WORDS) cnts[t] = __popcll(a.mask[(size_t)r * MASK_WORDS + t]);
    __syncthreads();
    if (t < MASK_WORDS) { unsigned off = 0; for (int i = 0; i < t; ++i) off += cnts[i]; u64 m = a.mask[(size_t)r * MASK_WORDS + t];
        while (m) { const int bpos = __ffsll((long long)m) - 1; m &= m - 1; if (off < TOPK) list[off] = t * 64 + bpos; ++off; } }
    unsigned nsel = 0; for (int i = 0; i < MASK_WORDS; ++i) nsel += cnts[i];
    if (nsel > TOPK) nsel = TOPK;
    __syncthreads();
    for (int hd = 0; hd < N_HEADS; ++hd) {
        const int n = hd >> 2;
        if (t < 128) qv[t] = bf2f(a.Aq[(size_t)r * 1024 + hd * 128 + t]);
        __syncthreads();
        float logit = -1e30f;
        if (t < (int)nsel) { const int s = list[t]; float d = 0.f;
            if (!smp || s >= PAST_LEN) { const uint4* kp = (const uint4*)(a.Kb + (smp ? ((size_t)T_PROMPT + b * DEC_SEQ + (s - PAST_LEN)) : ((size_t)b * LP + s)) * 256 + n * 128);
                for (int e = 0; e < 16; ++e) { const uint4 kk = kp[e]; const unsigned wv[4] = {kk.x, kk.y, kk.z, kk.w};
#pragma unroll
                    for (int j = 0; j < 4; ++j) { d = fmaf(qv[e * 8 + 2 * j], __uint_as_float(wv[j] << 16), d); d = fmaf(qv[e * 8 + 2 * j + 1], __uint_as_float(wv[j] & 0xffff0000u), d); } } }
            else { const float4* kp = (const float4*)(a.cache_k + (((size_t)a.page_table[b * N_PAGES + (s >> 7)] * PAGE_SIZE + (s & 127)) * N_KV + n) * 128);
                for (int e = 0; e < 32; ++e) { const float4 kk = kp[e]; d = fmaf(qv[e * 4], kk.x, d); d = fmaf(qv[e * 4 + 1], kk.y, d); d = fmaf(qv[e * 4 + 2], kk.z, d); d = fmaf(qv[e * 4 + 3], kk.w, d); } }
            logit = d * 0.08838834764831845f; }
        float mx = logit;
#pragma unroll
        for (int o = 32; o >= 1; o >>= 1) mx = fmaxf(mx, __shfl_xor(mx, o));
        if ((t & 63) == 0) red[t >> 6] = mx; __syncthreads();
        mx = fmaxf(fmaxf(red[0], red[1]), fmaxf(red[2], red[3]));
        const float e_ = t < (int)nsel ? __expf(logit - mx) : 0.f; float sm = e_;
#pragma unroll
        for (int o = 32; o >= 1; o >>= 1) sm += __shfl_xor(sm, o);
        if ((t & 63) == 0) red[4 + (t >> 6)] = sm; p[t] = e_; __syncthreads();
        const float inv = 1.0f / ((red[4] + red[5]) + (red[6] + red[7]));
        if (t < 128) { float acc = 0.f;
            for (unsigned j = 0; j < nsel; ++j) { const int s = list[j]; float vv;
                if (!smp || s >= PAST_LEN) vv = bf2f(a.Vb[(smp ? ((size_t)T_PROMPT + b * DEC_SEQ + (s - PAST_LEN)) : ((size_t)b * LP + s)) * 256 + n * 128 + t]);
                else vv = a.cache_v[(((size_t)a.page_table[b * N_PAGES + (s >> 7)] * PAGE_SIZE + (s & 127)) * N_KV + n) * 128 + t];
                acc = fmaf(p[j], vv, acc); }
            a.Odsa[(size_t)r * 1024 + hd * 128 + t] = f2bf(acc * inv); }
        __syncthreads();
    }
}

__global__ void __launch_bounds__(256) k_merge(const float* M1, const float* M2, const bf16_t* Gates, bf16_t* Mg) {
    const int r = blockIdx.x;
    for (int c = threadIdx.x; c < 1024; c += 256) Mg[(size_t)r * 1024 + c] = f2bf(bf2f(Gates[(size_t)r * 2048 + c]) * M1[(size_t)r * 1024 + c] + bf2f(Gates[(size_t)r * 2048 + 1024 + c]) * M2[(size_t)r * 1024 + c]);
}
__global__ void __launch_bounds__(256) k_h2(const float* Zo, const float* xp, const float* xs, const float* meta, float* H2, bf16_t* A2, float* rstd2) {
    __shared__ float red[4];
    const int r = blockIdx.x, t = threadIdx.x; const float* h = h_row_ptr(r, xp, xs, meta); float ss = 0.f;
    for (int c = t; c < 1024; c += 256) { const float v = h[c] + Zo[(size_t)r * 1024 + c]; H2[(size_t)r * 1024 + c] = v; A2[(size_t)r * 1024 + c] = f2bf(v); ss += v * v; }
#pragma unroll
    for (int o = 32; o >= 1; o >>= 1) ss += __shfl_xor(ss, o);
    if ((t & 63) == 0) red[t >> 6] = ss; __syncthreads();
    if (t == 0) rstd2[r] = rsqrtf(((red[0] + red[1]) + (red[2] + red[3])) * (1.0f / 1024.0f) + NORM_EPS);
}
__global__ void __launch_bounds__(256) k_hid(const float* Zf, const float* rstd2, bf16_t* Hid) {
    const int r = blockIdx.x; const float rs = rstd2[r];
    for (int u = threadIdx.x; u < D_FF; u += 256) { const int pn = u >> 7, c = u & 127; const float av = Zf[(size_t)r * NFF2 + pn * 256 + c] * rs, bv = Zf[(size_t)r * NFF2 + pn * 256 + 128 + c] * rs;
        Hid[(size_t)r * D_FF + u] = f2bf(silu_f(av) * bv); }
}
__global__ void __launch_bounds__(256) k_yout(const float* Zy, const float* H2, float* out) {
    const int r = blockIdx.x; float* dst;
    if (r < T_PROMPT) { const int b = r / LP, l = r % LP; if (l < N_META) return; dst = out + O_Y_P + ((size_t)b * SEQ + (l - N_META)) * 1024; }
    else dst = out + O_Y_S + (size_t)(r - T_PROMPT) * 1024;
    for (int c = threadIdx.x; c < 1024; c += 256) dst[c] = H2[(size_t)r * 1024 + c] + Zy[(size_t)r * 1024 + c];
}
template <class Epi> static void launch_gemm(const bf16_t* A, const bf16_t* Bt, int M, int N, int K, const Epi& E, hipStream_t st) {
    static bool attr = false;
    if (!attr) { hipFuncSetAttribute((const void*)k_gemm<Epi>, hipFuncAttributeMaxDynamicSharedMemorySize, pg8::STAGE_BYTES); attr = true; }
    pg8::Gemm g{A, Bt, M, N, K};
    hipLaunchKernelGGL((k_gemm<Epi>), dim3(256), dim3(512), pg8::STAGE_BYTES, st, g, E);
}
extern "C" void kernel_launch(void* const* d_in, const int* in_sizes, int n_in, void* d_out, int out_size, void* d_ws, size_t ws_size, hipStream_t stream) {
    if (n_in != 20 || out_size != OUT_TOTAL || ws_size < WS_END_B1 || ws_size < WS_END_B2) { fprintf(stderr, "kernel_launch: unexpected shapes (n_in %d out %d ws %zu need %llu)\n", n_in, out_size, ws_size, (unsigned long long)WS_END_B1); return; }
    char* ws = (char*)d_ws; float* out = (float*)d_out;
    const float* x_prompt = (const float*)d_in[0]; const float* x_sample = (const float*)d_in[1]; const float* cache_k = (const float*)d_in[2]; const float* cache_v = (const float*)d_in[3];
    const float* cache_kidx = (const float*)d_in[4]; const float* state_ret = (const float*)d_in[5]; const int* page_table = (const int*)d_in[6]; const float* meta = (const float*)d_in[7];
    bf16_t *W1t = (bf16_t*)(ws + WS_W1T), *Wret = (bf16_t*)(ws + WS_WRET), *Wdsa = (bf16_t*)(ws + WS_WDSA), *Wout = (bf16_t*)(ws + WS_WOUT), *Wffi = (bf16_t*)(ws + WS_WFFI), *Wffo = (bf16_t*)(ws + WS_WFFO);
    bf16_t *A0 = (bf16_t*)(ws + WS_A0), *Rq = (bf16_t*)(ws + WS_RQ), *Rk = (bf16_t*)(ws + WS_RK), *Rv = (bf16_t*)(ws + WS_RV), *G = (bf16_t*)(ws + WS_G), *Aq = (bf16_t*)(ws + WS_AQ), *Kb = (bf16_t*)(ws + WS_KB), *Vb = (bf16_t*)(ws + WS_VB);
    bf16_t *Iq = (bf16_t*)(ws + WS_IQ), *Ikb = (bf16_t*)(ws + WS_IKB), *Gates = (bf16_t*)(ws + WS_GATES), *OG = (bf16_t*)(ws + WS_OG), *An = (bf16_t*)(ws + WS_AN), *Odsa = (bf16_t*)(ws + WS_ODSA), *Mg = (bf16_t*)(ws + WS_MG), *A2 = (bf16_t*)(ws + WS_A2), *Hid = (bf16_t*)(ws + WS_HID);
    float *rstd0 = (float*)(ws + WS_RSTD0), *Iw = (float*)(ws + WS_IW), *ssret = (float*)(ws + WS_SSRET), *rstd2 = (float*)(ws + WS_RSTD2), *Z = (float*)(ws + WS_Z), *M1 = (float*)(ws + WS_M1), *M2 = (float*)(ws + WS_M2), *H2 = (float*)(ws + WS_H2), *Zf = (float*)(ws + WS_ZF);
    float2* rope = (float2*)(ws + WS_ROPE); u64* mask = (u64*)(ws + WS_MASK);
    PrepArgs pa{x_prompt, x_sample, meta, (const float*)d_in[8], (const float*)d_in[9], (const float*)d_in[10], (const float*)d_in[15], (const float*)d_in[16], (const float*)d_in[17], (const float*)d_in[18], (const float*)d_in[19],
                W1t, Wret, Wdsa, Wout, Wffi, Wffo, A0, rstd0, rope};
    hipLaunchKernelGGL(k_prep, dim3(2048), dim3(256), 0, stream, pa);
    launch_gemm(A0, W1t, T_PAD, N1, 1024, pg8::EpiF32{Z, N1, nullptr}, stream);
    Epi1Args ea{Z, rstd0, rope, (const float*)d_in[11], (const float*)d_in[12], (const float*)d_in[13], (const float*)d_in[14], Rq, Rk, Rv, G, Aq, Kb, Vb, Iq, Ikb, Gates, Iw, out};
    hipLaunchKernelGGL(k_epi1, dim3(T_ALL), dim3(256), 0, stream, ea);
    RetArgs ra{Rq, Rk, Rv, G, OG, ssret, state_ret, out};
    hipLaunchKernelGGL(k_ret_naive, dim3(BATCH * H_RET * 8), dim3(256), 0, stream, ra, 0);
    hipLaunchKernelGGL(k_ret_naive, dim3(DEC_BATCH * H_RET * 8), dim3(256), 0, stream, ra, 1);
    IdxArgs ia{Iq, Ikb, Iw, cache_kidx, page_table, mask};
    hipLaunchKernelGGL(k_topk_naive, dim3(T_ALL), dim3(256), 0, stream, ia);
    AttnArgs aa{Aq, Kb, Vb, cache_k, cache_v, page_table, mask, Odsa};
    hipLaunchKernelGGL(k_attn_naive, dim3(T_ALL), dim3(256), 0, stream, aa);
    hipLaunchKernelGGL(k_make_an, dim3(T_ALL), dim3(256), 0, stream, OG, ssret, An);
    launch_gemm(An, Wret, T_PAD, 1024, 2048, pg8::EpiF32{M1, 1024, nullptr}, stream);
    launch_gemm(Odsa, Wdsa, T_PAD, 1024, 1024, pg8::EpiF32{M2, 1024, nullptr}, stream);
    hipLaunchKernelGGL(k_merge, dim3(T_ALL), dim3(256), 0, stream, M1, M2, Gates, Mg);
    launch_gemm(Mg, Wout, T_PAD, 1024, 1024, pg8::EpiF32{M1, 1024, nullptr}, stream);
    hipLaunchKernelGGL(k_h2, dim3(T_ALL), dim3(256), 0, stream, M1, x_prompt, x_sample, meta, H2, A2, rstd2);
    launch_gemm(A2, Wffi, T_PAD, NFF2, 1024, pg8::EpiF32{Zf, NFF2, nullptr}, stream);
    hipLaunchKernelGGL(k_hid, dim3(T_ALL), dim3(256), 0, stream, Zf, rstd2, Hid);
    launch_gemm(Hid, Wffo, T_PAD, 1024, 2816, pg8::EpiF32{M1, 1024, nullptr}, stream);
    hipLaunchKernelGGL(k_yout, dim3(T_ALL), dim3(256), 0, stream, M1, H2, out);
}
```

```cpp
#include <hip/hip_runtime.h>
#include <stdint.h>
#include <stdio.h>

#define D_MODEL 1024
#define BATCH 8
#define SEQ 2048
#define N_META 16
#define LP (N_META + SEQ)
#define DEC_BATCH 128
#define DEC_SEQ 8
#define PAST_LEN 2048
#define PAGE_SIZE 128
#define N_PAGES 16
#define H_RET 4
#define DK_RET 256
#define DV_RET 512
#define N_HEADS 8
#define N_KV 2
#define D_HEAD 128
#define N_IDXH 8
#define D_IDX 64
#define TOPK 256
#define D_FF 2816
#define IN_COLS 10312
#define NORM_EPS 1e-6f
#define IDX_SCALE 0.04419417382415922f
#define T_PROMPT (BATCH * LP)
#define T_SAMPLE (DEC_BATCH * DEC_SEQ)
#define T_ALL (T_PROMPT + T_SAMPLE)
#define T_PAD 17664
#define N1 10496
#define NFF2 5632
#define MASK_WORDS 34
#define SAMPLE_L (PAST_LEN + DEC_SEQ)

#define O_Y_P   0
#define O_Y_S   16777216
#define O_K_P   17825792
#define O_V_P   22052864
#define O_KI_P  26279936
#define O_R_P   27336704
#define O_K_S   31531008
#define O_V_S   31793152
#define O_KI_S  32055296
#define O_R_S   32120832
#define OUT_TOTAL 99229696

typedef unsigned short bf16_t;
typedef unsigned long long u64;

__device__ __forceinline__ bf16_t f2bf(float f) { unsigned u = __float_as_uint(f); u += 0x7FFFu + ((u >> 16) & 1u); return (bf16_t)(u >> 16); }
__device__ __forceinline__ float bf2f(bf16_t b) { return __uint_as_float(((unsigned)b) << 16); }
__device__ __forceinline__ float silu_f(float x) { return x / (1.0f + __expf(-x)); }
__device__ __forceinline__ float sigmoid_f(float x) { return 1.0f / (1.0f + __expf(-x)); }

__device__ __forceinline__ int row_pos(int r) { return r < T_PROMPT ? (r % LP) : (PAST_LEN + ((r - T_PROMPT) & (DEC_SEQ - 1))); }

#define WS_CTL      0ull
#define WS_W1T      (WS_CTL + 65536ull)
#define WS_WRET     (WS_W1T + (u64)N1 * 1024 * 2)
#define WS_WDSA     (WS_WRET + 1024ull * 2048 * 2)
#define WS_WOUT     (WS_WDSA + 1024ull * 1024 * 2)
#define WS_WFFI     (WS_WOUT + 1024ull * 1024 * 2)
#define WS_WFFO     (WS_WFFI + (u64)NFF2 * 1024 * 2)
#define WS_ROPE     (WS_WFFO + 1024ull * 2816 * 2)
#define WS_RSTD0    (WS_ROPE + (u64)LP * 128 * 8)
#define WS_A0       (WS_RSTD0 + (u64)T_PAD * 4)
#define WS_RQ       (WS_A0 + (u64)T_PAD * 1024 * 2)
#define WS_RK       (WS_RQ + (u64)T_PAD * 1024 * 2)
#define WS_RV       (WS_RK + (u64)T_PAD * 1024 * 2)
#define WS_G        (WS_RV + (u64)T_PAD * 2048 * 2)
#define WS_AQ       (WS_G + (u64)T_PAD * 2048 * 2)
#define WS_KB       (WS_AQ + (u64)T_PAD * 1024 * 2)
#define WS_VB       (WS_KB + (u64)T_PAD * 256 * 2)
#define WS_IQ       (WS_VB + (u64)T_PAD * 256 * 2)
#define WS_IKB      (WS_IQ + (u64)T_PAD * 512 * 2)
#define WS_IW       (WS_IKB + (u64)T_PAD * 64 * 2)
#define WS_GATES    (WS_IW + (u64)T_PAD * 8 * 4)
#define WS_MASK     (WS_GATES + (u64)T_PAD * 2048 * 2)
#define WS_SSRET    (WS_MASK + (u64)T_PAD * MASK_WORDS * 8)
#define WS_RSTD2    (WS_SSRET + (u64)T_PAD * 32 * 4)
#define WS_REGION_B (((WS_RSTD2 + (u64)T_PAD * 16 * 4) + 4095ull) & ~4095ull)
#define WS_Z        WS_REGION_B
#define WS_H2       WS_REGION_B
#define WS_A2       (WS_H2 + (u64)T_PAD * 1024 * 4)
#define WS_HID      (WS_A2 + (u64)T_PAD * 1024 * 2)
#define WS_MG       (WS_HID + (u64)T_PAD * 2816 * 2)
#define WS_OG       (WS_MG + (u64)T_PAD * 1024 * 2)
#define WS_AN       (WS_OG + (u64)T_PAD * 2048 * 2)
#define WS_ODSA     (WS_AN + (u64)T_PAD * 2048 * 2)
#define WS_M1       (WS_ODSA + (u64)T_PAD * 1024 * 2)
#define WS_M2       (WS_M1 + (u64)T_PAD * 1024 * 4)
#define WS_ZF       WS_OG
#define WS_END_B1   (WS_Z + (u64)T_PAD * N1 * 4)
#define WS_END_B2   (WS_ZF + (u64)T_PAD * NFF2 * 4)
namespace pg8 {
#define PG8_LAS __attribute__((address_space(3)))
typedef unsigned short bf16_t;
typedef short bf16x8 __attribute__((ext_vector_type(8)));
typedef float f32x4 __attribute__((ext_vector_type(4)));
typedef unsigned u32x4 __attribute__((ext_vector_type(4)));
constexpr int BM = 256, BK = 64, HALF = 128, HTB = HALF * BK * 2  , STAGE_BYTES = 8 * HTB, NXCD = 8, WGM = 8;

__host__ __device__ __forceinline__ int lds_byte(int r, int c) { const int st = (r >> 4) * 2 + (c >> 5), rr = r & 15, cc = c & 31, ob = rr * 64 + cc * 2; return st * 1024 + (ob ^ (((ob >> 9) & 1) << 5)); }
__host__ __device__ __forceinline__ void stage_rc(int b, int& R, int& C) { const int st = b / 1024, sb = b % 1024, swz = sb ^ (((sb >> 9) & 1) << 5); R = (st >> 1) * 16 + swz / 64; C = (st & 1) * 32 + (swz % 64) / 2; }
__host__ __device__ __forceinline__ int perm32(int rho) { const int n = rho >> 4, i = rho & 15; return 8 * (i >> 2) + 4 * n + (i & 3); }

struct Unit { int pm, pn; };
struct Gemm { const bf16_t* A; const bf16_t* Bt; int M, N, K; };

struct StaticOrder {
    int nM, nN, nwg, G, c;
    __host__ __device__ void init(int M, int N, int G_, int c_) { nM = M / BM; nN = N / BM; nwg = nM * nN; G = G_; c = c_; }
    __host__ __device__ bool next(int i, Unit& u) const {
        const long L = (long)i * G + c; if (L >= nwg) return false;
        int wgid = (int)L; { const int q = nwg / NXCD, r = nwg % NXCD, xcd = wgid % NXCD, off = wgid / NXCD; wgid = (xcd < r ? xcd * (q + 1) : r * (q + 1) + (xcd - r) * q) + off; }
        const int nig = WGM * nN, gid = wgid / nig, fm = gid * WGM, gsz = (nM - fm) < WGM ? (nM - fm) : WGM;
        u.pm = fm + ((wgid % nig) % gsz); u.pn = (wgid % nig) / gsz; return true;
    }
    __device__ __forceinline__ void a_ready(const Unit&) const {}
    __device__ __forceinline__ void done(const Unit&) const {}
};
struct CountedOrder : StaticOrder {
    const unsigned* ready; unsigned need; unsigned* tmo;
    __device__ __forceinline__ void a_ready(const Unit& u) const {
        if (threadIdx.x < 64) {
            const unsigned long long t0 = __builtin_amdgcn_s_memrealtime(); unsigned polls = 0;
            while ((unsigned)__builtin_amdgcn_readfirstlane(__hip_atomic_load(ready + 64 * u.pm, __ATOMIC_RELAXED, __HIP_MEMORY_SCOPE_AGENT)) < need) {
                if ((++polls & 255u) == 0u && __builtin_amdgcn_readfirstlane(__hip_atomic_load(tmo, __ATOMIC_RELAXED, __HIP_MEMORY_SCOPE_AGENT)) != 0u) break;
                if (__builtin_amdgcn_s_memrealtime() - t0 > 2000000ull) {
                    if (threadIdx.x == 0) { unsigned expect = 0u; __hip_atomic_compare_exchange_strong(tmo + 1, &expect, 0x600u | (unsigned)(u.pm & 0xff), __ATOMIC_RELAXED, __ATOMIC_RELAXED, __HIP_MEMORY_SCOPE_AGENT); __hip_atomic_store(tmo, 1u, __ATOMIC_RELAXED, __HIP_MEMORY_SCOPE_AGENT); }
                    break; }
                __builtin_amdgcn_s_sleep(2); }
            __builtin_amdgcn_fence(__ATOMIC_ACQUIRE, "agent");
            asm volatile("s_waitcnt vmcnt(0)" ::: "memory");
        }
#if !defined(BROKEN_HOOK_NO_BARRIER)
        asm volatile("" ::: "memory"); __builtin_amdgcn_s_barrier(); asm volatile("" ::: "memory");
#endif
    }
};

__device__ __forceinline__ unsigned cvt_pk_bf16(float lo, float hi) { unsigned r; asm volatile("v_cvt_pk_bf16_f32 %0, %1, %2" : "=v"(r) : "v"(lo), "v"(hi)); return r; }
typedef float f32x2 __attribute__((ext_vector_type(2)));
__device__ __forceinline__ f32x2 gelu_pk(f32x2 v) {
    const f32x2 av = __builtin_elementwise_abs(v), d = av * 0.2316418882f + 1.0f;
    f32x2 t; t.x = __builtin_amdgcn_rcpf(d.x); t.y = __builtin_amdgcn_rcpf(d.y);
    f32x2 q = t * 0.5307027145f + (-0.7265760135f); q = q * t + 0.7107068705f; q = q * t + (-0.142248368f); q = q * t + 0.127414796f; q = q * t;
    const f32x2 s = (v * v) * (-0.72134752044f);
    f32x2 e; e.x = __builtin_amdgcn_exp2f(s.x); e.y = __builtin_amdgcn_exp2f(s.y);
    const f32x2 m = v * (q * e), r = v - m;
    f32x2 o; o.x = v.x < 0.f ? m.x : r.x; o.y = v.y < 0.f ? m.y : r.y; return o;
}

struct EpiF32 {
    static constexpr bool PERM = false, AFTER_DRAIN = false;
    float* C; int ldc; const float* bias;
    __device__ __forceinline__ void operator()(const f32x4 (&acc)[2][2][4][2], const Unit& u, int wr, int wc, int fr, int fq) const {
        const int row0 = u.pm * BM + wr * 64 + fr, col0 = u.pn * BM + wc * 32 + 4 * fq;
        f32x4 bv[2][2];
#pragma unroll
        for (int bj = 0; bj < 2; ++bj)
#pragma unroll
            for (int n = 0; n < 2; ++n) bv[bj][n] = bias ? *(const f32x4*)(bias + col0 + bj * HALF + n * 16) : (f32x4){0.f, 0.f, 0.f, 0.f};
#pragma unroll
        for (int ai = 0; ai < 2; ++ai)
#pragma unroll
            for (int m = 0; m < 4; ++m) { float* rowp = C + (size_t)(row0 + ai * HALF + m * 16) * ldc + col0;
#pragma unroll
                for (int bj = 0; bj < 2; ++bj)
#pragma unroll
                    for (int n = 0; n < 2; ++n) *(f32x4*)(rowp + bj * HALF + n * 16) = acc[ai][bj][m][n] + bv[bj][n]; }
    }
};
template <int ACT  > struct EpiBf16 {
    static constexpr bool PERM = true, AFTER_DRAIN = false;
    bf16_t* O; int ldc; const float* bias; int split_cols; size_t split_stride;
    __device__ __forceinline__ void operator()(const f32x4 (&acc)[2][2][4][2], const Unit& u, int wr, int wc, int fr, int fq) const {
        const int row0 = u.pm * BM + wr * 64 + fr; int colt = u.pn * BM; bf16_t* base = O;
        if (split_cols) { const int t = colt / split_cols; base += (size_t)t * split_stride; colt -= t * split_cols; }
        const int col0 = colt + wc * 32 + 8 * fq, bcol0 = u.pn * BM + wc * 32 + 8 * fq;
        f32x4 bv[2][2];
#pragma unroll
        for (int bj = 0; bj < 2; ++bj)
#pragma unroll
            for (int n = 0; n < 2; ++n) bv[bj][n] = bias ? *(const f32x4*)(bias + bcol0 + bj * HALF + 4 * n) : (f32x4){0.f, 0.f, 0.f, 0.f};
#pragma unroll
        for (int ai = 0; ai < 2; ++ai)
#pragma unroll
            for (int m = 0; m < 4; ++m) { bf16_t* rowp = base + (size_t)(row0 + ai * HALF + m * 16) * ldc + col0;
#pragma unroll
                for (int bj = 0; bj < 2; ++bj) { f32x4 v0 = acc[ai][bj][m][0] + bv[bj][0], v1 = acc[ai][bj][m][1] + bv[bj][1];
                    if (ACT == 1) { f32x2 a = gelu_pk((f32x2){v0[0], v0[1]}), b = gelu_pk((f32x2){v0[2], v0[3]}), c = gelu_pk((f32x2){v1[0], v1[1]}), d = gelu_pk((f32x2){v1[2], v1[3]});
                        v0 = (f32x4){a.x, a.y, b.x, b.y}; v1 = (f32x4){c.x, c.y, d.x, d.y}; }
                    if (ACT == 2) {
#pragma unroll
                        for (int j = 0; j < 4; ++j) { v0[j] = 0.5f * v0[j] * (1.0f + erff(v0[j] * 0.70710678f)); v1[j] = 0.5f * v1[j] * (1.0f + erff(v1[j] * 0.70710678f)); } }
                    u32x4 w; w.x = cvt_pk_bf16(v0[0], v0[1]); w.y = cvt_pk_bf16(v0[2], v0[3]); w.z = cvt_pk_bf16(v1[0], v1[1]); w.w = cvt_pk_bf16(v1[2], v1[3]);
                    *(u32x4*)(rowp + bj * HALF) = w; } }
    }
};
template <class Epi, class Sched, bool STAMP = false>
__device__ __forceinline__ void gemm_phase(PG8_LAS unsigned char* lds, const Gemm g, const Sched& S, const Epi& E, unsigned long long* stamps) {
    const int tid = threadIdx.x, wid = __builtin_amdgcn_readfirstlane(tid >> 6), lane = tid & 63, wr = wid >> 2, wc = wid & 3, fr = lane & 15, fq = lane >> 4;
    const int K = g.K, nt = K / BK;
    int ts_lo = 0, ts_hi = 0, nts = 0; const unsigned long long rt_entry = STAMP ? (unsigned long long)wall_clock64() : 0ull;
#define PG8_STAMP() do { if (STAMP && wid == 0 && nts < 64) { const unsigned long long _c = (unsigned long long)clock64(); \
        ts_lo = (lane == nts) ? (int)(unsigned)_c : ts_lo; ts_hi = (lane == nts) ? (int)(unsigned)(_c >> 32) : ts_hi; ++nts; } } while (0)
    PG8_STAMP();
    unsigned voffA[2], voffB[2];
#pragma unroll
    for (int i = 0; i < 2; ++i) { int R, C; stage_rc(tid * 16 + i * 8192, R, C); const int Rb = Epi::PERM ? ((R & ~31) + perm32(R & 31)) : R;
        voffA[i] = (unsigned)(R * K + C) * 2u; voffB[i] = (unsigned)(Rb * K + C) * 2u; }
    const size_t kstep = (size_t)(BK * 2);
    const size_t hstep = (size_t)HALF * K * 2;
    const size_t tstep = 2 * hstep;
    const unsigned ldsw = (unsigned)wid * 1024u;
    const int aoff = lds_byte(wr * 64 + fr, fq * 8), boff = lds_byte(wc * 32 + fr, fq * 8);
#define PG8_SA(b, h) (((b) * 2 + (h)) * HTB)
#define PG8_SB(b, h) ((4 + (b) * 2 + (h)) * HTB)
#define PG8_STAGE(bufoff, gbase, voff) do { _Pragma("unroll") for (int _i = 0; _i < 2; ++_i) \
        __builtin_amdgcn_global_load_lds((const unsigned*)((const char*)(gbase) + (voff)[_i]), (PG8_LAS unsigned*)(lds + (bufoff) + ldsw + _i * 8192), 16, 0, 0); } while (0)
#define PG8_LDA(dst, b, h) do { _Pragma("unroll") for (int m = 0; m < 4; ++m) _Pragma("unroll") for (int k = 0; k < 2; ++k) dst[m][k] = *(const PG8_LAS bf16x8*)(lds + PG8_SA(b, h) + aoff + m * 2048 + k * 1024); } while (0)
#define PG8_LDB(dst, b, h) do { _Pragma("unroll") for (int n = 0; n < 2; ++n) _Pragma("unroll") for (int k = 0; k < 2; ++k) dst[n][k] = *(const PG8_LAS bf16x8*)(lds + PG8_SB(b, h) + boff + n * 2048 + k * 1024); } while (0)
#define PG8_MMA(ai, bj, At, Bt) do { __builtin_amdgcn_s_setprio(1); _Pragma("unroll") for (int m = 0; m < 4; ++m) _Pragma("unroll") for (int n = 0; n < 2; ++n) _Pragma("unroll") for (int k = 0; k < 2; ++k) \
        acc[ai][bj][m][n] = __builtin_amdgcn_mfma_f32_16x16x32_bf16(Bt[n][k], At[m][k], acc[ai][bj][m][n], 0, 0, 0); __builtin_amdgcn_s_setprio(0); } while (0)
#define PG8_WAIT_V(n) asm volatile("s_waitcnt vmcnt(" #n ")" ::: "memory")
#define PG8_WAIT_L(n) asm volatile("s_waitcnt lgkmcnt(" #n ")" ::: "memory")
#define PG8_BAR __builtin_amdgcn_s_barrier()
#define PG8_SCHED __builtin_amdgcn_sched_barrier(0)
    Unit cur, nxt; int ui = 0;
    if (!S.next(0, cur)) return;
    f32x4 acc[2][2][4][2];
#pragma unroll
    for (int a = 0; a < 2; ++a)
#pragma unroll
        for (int b = 0; b < 2; ++b)
#pragma unroll
            for (int m = 0; m < 4; ++m)
#pragma unroll
                for (int n = 0; n < 2; ++n) acc[a][b][m][n] = (f32x4){0.f, 0.f, 0.f, 0.f};
    bf16x8 At[4][2], B0[2][2], B1[2][2];
    const char* cA = (const char*)g.A + (size_t)cur.pm * tstep; const char* cB = (const char*)g.Bt + (size_t)cur.pn * tstep;
    S.a_ready(cur);
    PG8_STAGE(PG8_SB(0, 0), cB, voffB); PG8_STAGE(PG8_SA(0, 0), cA, voffA); PG8_STAGE(PG8_SB(0, 1), cB + hstep, voffB); PG8_STAGE(PG8_SA(0, 1), cA + hstep, voffA);
    if (wr == 1) PG8_BAR;
    PG8_WAIT_V(4); PG8_BAR;
    PG8_STAGE(PG8_SB(1, 0), cB + kstep, voffB); PG8_STAGE(PG8_SA(1, 0), cA + kstep, voffA); PG8_STAGE(PG8_SB(1, 1), cB + hstep + kstep, voffB);
    PG8_WAIT_V(6); PG8_BAR;
    PG8_STAMP();
    for (;;) {
        const bool has_next = S.next(ui + 1, nxt);
        const char* nA = has_next ? (const char*)g.A + (size_t)nxt.pm * tstep : cA; const char* nB = has_next ? (const char*)g.Bt + (size_t)nxt.pn * tstep : cB;
        for (int t = 0; t < nt; t += 2) {
            const bool last = (t == nt - 2);
            const char* a1 = cA + (size_t)(t + 1) * kstep;
            const char* a2 = last ? nA : cA + (size_t)(t + 2) * kstep; const char* b2 = last ? nB : cB + (size_t)(t + 2) * kstep;
            const char* a3 = a2 + kstep; const char* b3 = b2 + kstep;
            if (last && has_next) S.a_ready(nxt);
            PG8_LDB(B0, 0, 0); PG8_SCHED; PG8_LDA(At, 0, 0); PG8_STAGE(PG8_SA(1, 1), a1 + hstep, voffA);
            PG8_WAIT_L(8); PG8_BAR; PG8_WAIT_L(0); PG8_MMA(0, 0, At, B0); PG8_BAR; PG8_SCHED;
            PG8_LDB(B1, 0, 1); PG8_STAGE(PG8_SB(0, 0), b2, voffB);
            PG8_BAR; PG8_WAIT_L(0); PG8_MMA(0, 1, At, B1); PG8_BAR;
            PG8_LDA(At, 0, 1); PG8_STAGE(PG8_SA(0, 0), a2, voffA);
            PG8_BAR; PG8_WAIT_L(0); PG8_MMA(1, 0, At, B0); PG8_BAR; PG8_SCHED;
            PG8_STAGE(PG8_SB(0, 1), b2 + hstep, voffB);
            PG8_WAIT_V(6); PG8_BAR; PG8_MMA(1, 1, At, B1); PG8_BAR;
            PG8_LDB(B0, 1, 0); PG8_SCHED; PG8_LDA(At, 1, 0); PG8_STAGE(PG8_SA(0, 1), a2 + hstep, voffA);
            PG8_WAIT_L(8); PG8_BAR; PG8_WAIT_L(0); PG8_MMA(0, 0, At, B0); PG8_BAR; PG8_SCHED;
            PG8_LDB(B1, 1, 1); PG8_STAGE(PG8_SB(1, 0), b3, voffB);
            PG8_BAR; PG8_WAIT_L(0); PG8_MMA(0, 1, At, B1); PG8_BAR;
            PG8_LDA(At, 1, 1); PG8_STAGE(PG8_SA(1, 0), a3, voffA);
            PG8_BAR; PG8_WAIT_L(0); PG8_MMA(1, 0, At, B0); PG8_BAR; PG8_SCHED;
            PG8_STAGE(PG8_SB(1, 1), b3 + hstep, voffB);
            PG8_WAIT_V(6); PG8_BAR; PG8_MMA(1, 1, At, B1); PG8_BAR;
        }
        PG8_STAMP();
        if constexpr (!Epi::AFTER_DRAIN) { E(acc, cur, wr, wc, fr, fq); S.done(cur); }
        PG8_STAMP();
        if (!has_next) break;
#pragma unroll
        for (int a = 0; a < 2; ++a)
#pragma unroll
            for (int b = 0; b < 2; ++b)
#pragma unroll
                for (int m = 0; m < 4; ++m)
#pragma unroll
                    for (int n = 0; n < 2; ++n) acc[a][b][m][n] = (f32x4){0.f, 0.f, 0.f, 0.f};
        cur = nxt; cA = nA; cB = nB; ++ui;
    }
    PG8_WAIT_V(0);
    if (wr == 0) PG8_BAR;
    PG8_BAR;
    if constexpr (Epi::AFTER_DRAIN) { E.fused(acc, cur, wr, wc, fr, fq, lds, wid, lane); S.done(cur); }
    PG8_STAMP();
    if (STAMP && wid == 0) { stamps[lane] = lane < nts ? (((unsigned long long)(unsigned)ts_hi << 32) | (unsigned)ts_lo) : 0ull;
        if (lane == 62) stamps[62] = rt_entry; if (lane == 63) stamps[63] = (unsigned long long)wall_clock64(); }
#undef PG8_STAMP
#undef PG8_SA
#undef PG8_SB
#undef PG8_STAGE
#undef PG8_LDA
#undef PG8_LDB
#undef PG8_MMA
#undef PG8_WAIT_V
#undef PG8_WAIT_L
#undef PG8_BAR
#undef PG8_SCHED
}
}
#define XB_TMO      128
#define XB_XCNT(j)  (256  + 64 * (j))
#define XB_XSUB(j)  (1280 + 64 * (j))
#define XB_XGEN(j)  (2304 + 64 * (j))
#define XB_TOP      3328
#define XB_TOPGEN   3392
#define XCD_BAR_WORDS 3456
#define XB_SPIN_CAP (1u << 18)
#define LAS __attribute__((address_space(3)))

__device__ __forceinline__ unsigned xb_ld(unsigned* p)              { return __hip_atomic_load(p, __ATOMIC_RELAXED, __HIP_MEMORY_SCOPE_AGENT); }
__device__ __forceinline__ unsigned xb_add(unsigned* p, unsigned v) { return __hip_atomic_fetch_add(p, v, __ATOMIC_RELAXED, __HIP_MEMORY_SCOPE_AGENT); }
__device__ __forceinline__ unsigned xb_xcc_id() { return (unsigned)__builtin_amdgcn_s_getreg((3 << 11) | 20) & 0xFu; }
#define XB_SPIN(cond, bar) do { unsigned _sp = 0; while (cond) { __builtin_amdgcn_s_sleep(1); \
    if ((++_sp & 255u) == 0u) { if (xb_ld(&(bar)[XB_TMO])) break; if (_sp > XB_SPIN_CAP) { atomicAdd(&(bar)[XB_TMO], 1u); break; } } } } while (0)

struct XcdBarrier {
    unsigned* bar; unsigned x;
    volatile LAS unsigned* st;
};

__device__ __forceinline__ XcdBarrier xcd_barrier_post(unsigned* bar, volatile LAS unsigned* st) {
    XcdBarrier b; b.bar = bar; b.x = xb_xcc_id(); b.st = st;
    if (threadIdx.x == 0) (void)xb_add(&bar[XB_XCNT(b.x)], 1u);
    return b;
}
__device__ __forceinline__ void xcd_barrier_complete(unsigned* bar, unsigned x, unsigned& nloc, unsigned& nx) {
    const unsigned G = gridDim.x * gridDim.y * gridDim.z;
    unsigned sum, cnt, mine, sp = 0u;
    for (;;) {
        sum = 0u; cnt = 0u; mine = 0u;
#pragma unroll
        for (unsigned j = 0; j < 16; ++j) { const unsigned c = xb_ld(&bar[XB_XCNT(j)]); sum += c; cnt += (c > 0u) ? 1u : 0u; mine = (j == x) ? c : mine; }
        if (sum == G) break;
        __builtin_amdgcn_s_sleep(1);
        if ((++sp & 255u) == 0u) { if (xb_ld(&bar[XB_TMO])) break; if (sp > XB_SPIN_CAP) { atomicAdd(&bar[XB_TMO], 1u); break; } }
    }
    nloc = mine > 0u ? mine : 1u; nx = cnt > 0u ? cnt : 1u;
}

__device__ __forceinline__ void xcd_barrier(const XcdBarrier& b) {
    asm volatile("s_waitcnt vmcnt(0)" ::: "memory");
    __syncthreads();
    if (threadIdx.x == 0) {
        unsigned* bar = b.bar;
        __builtin_amdgcn_s_waitcnt(0);
        unsigned nloc = b.st[0], nx = b.st[1];
        if (nloc == 0u) { xcd_barrier_complete(bar, b.x, nloc, nx); b.st[0] = nloc; b.st[1] = nx; }
        const unsigned old = xb_add(&bar[XB_XSUB(b.x)], 1u);
        const unsigned gen = old / nloc;
        if (old + 1u == (gen + 1u) * nloc) {
            __builtin_amdgcn_fence(__ATOMIC_RELEASE, "agent");
            asm volatile("s_waitcnt vmcnt(0)" ::: "memory");
            const unsigned og = xb_add(&bar[XB_TOP], 1u);
            const unsigned tg = og / nx;
            if (og + 1u == (tg + 1u) * nx) xb_add(&bar[XB_TOPGEN], 1u);
            else XB_SPIN(xb_ld(&bar[XB_TOPGEN]) == tg, bar);
            __builtin_amdgcn_fence(__ATOMIC_ACQUIRE, "agent");
            xb_add(&bar[XB_XGEN(b.x)], 1u);
            asm volatile("s_waitcnt vmcnt(0)" ::: "memory");
        } else {
            XB_SPIN(xb_ld(&bar[XB_XGEN(b.x)]) == gen, bar);
            __builtin_amdgcn_fence(__ATOMIC_ACQUIRE, "agent");
            asm volatile("s_waitcnt vmcnt(0)" ::: "memory");
        }
    }
    __syncthreads();
}
__host__ __device__ __forceinline__ int ikiw_src(int c) {
    if (c < 32) return 8192 + c;
    if (c < 40) return 8256 + (c - 32);
    if (c >= 128 && c < 160) return 8192 + 32 + (c - 128);
    return -1;
}
__host__ __device__ __forceinline__ int ik_tilecol(int e) { return e < 32 ? e : 128 + (e - 32); }
__device__ __forceinline__ int src_col(int mode, int n) {
    if (mode == 0) return n;
    if (mode == 1) { if (n < 8192) return n; if (n < 8448) return ikiw_src(n - 8192); return 8264 + (n - 8448); }
    const int pn = n >> 8, c = n & 255; return c < 128 ? pn * 128 + c : D_FF + pn * 128 + (c - 128);
}
__device__ __forceinline__ void prep_weight_tile(const float* __restrict__ w, int ldw, const float* __restrict__ scale, bf16_t* __restrict__ Wt, int K, int mode, int tile, float* lds  ) {
    const int ktiles = K / 32, nt = tile / ktiles, kt = tile % ktiles, tid = threadIdx.x & 255;
    const int n0 = nt * 64, k0 = kt * 32;
    {   const int nn = tid & 63, kk0 = tid >> 6; const int sc = src_col(mode, n0 + nn);
#pragma unroll
        for (int i = 0; i < 8; ++i) { const int kk = kk0 + i * 4; float v = 0.f; if (sc >= 0) { v = w[(size_t)(k0 + kk) * ldw + sc]; if (scale) v *= scale[k0 + kk]; } lds[kk * 65 + nn] = v; } }
    __syncthreads();
    {   const int kk = tid & 31, nn0 = tid >> 5;
#pragma unroll
        for (int i = 0; i < 8; ++i) { const int nn = nn0 + i * 8; Wt[(size_t)(n0 + nn) * K + k0 + kk] = f2bf(lds[kk * 65 + nn]); } }
    __syncthreads();
}
__device__ __forceinline__ const float* h_row_ptr(int r, const float* xp, const float* xs, const float* meta) {
    if (r < T_PROMPT) { const int b = r / LP, l = r % LP; return l < N_META ? meta + (size_t)l * D_MODEL : xp + ((size_t)b * SEQ + (l - N_META)) * D_MODEL; }
    return xs + (size_t)(r - T_PROMPT) * D_MODEL;
}
__device__ __forceinline__ void prep_row(int r, const float* xp, const float* xs, const float* meta, bf16_t* A0, float* rstd0, int lane) {
    if (r >= T_ALL) { for (int i = lane; i < D_MODEL / 2; i += 64) ((unsigned*)(A0 + (size_t)r * D_MODEL))[i] = 0u; if (lane == 0) rstd0[r] = 0.f; return; }
    const float4* src = (const float4*)h_row_ptr(r, xp, xs, meta); float ss = 0.f;
#pragma unroll
    for (int i = 0; i < 4; ++i) { const float4 v = src[lane + i * 64]; ss += v.x * v.x + v.y * v.y + v.z * v.z + v.w * v.w;
        uint2 o; o.x = (unsigned)f2bf(v.x) | ((unsigned)f2bf(v.y) << 16); o.y = (unsigned)f2bf(v.z) | ((unsigned)f2bf(v.w) << 16);
        ((uint2*)(A0 + (size_t)r * D_MODEL))[lane + i * 64] = o; }
#pragma unroll
    for (int o = 32; o >= 1; o >>= 1) ss += __shfl_xor(ss, o);
    if (lane == 0) rstd0[r] = rsqrtf(ss * (1.0f / D_MODEL) + NORM_EPS);
}
__device__ __forceinline__ void rope_entry(int idx, float2* tab) {
    const int pos = idx >> 7, i = idx & 127;
    const float inv = exp2f(-(float)i * (13.287712379549449f / 128.0f));
    const float angf = (float)pos * inv; const double a = (double)angf;
    const double kq = rint(a * 0.63661977236758134308);
    double r = fma(-kq, 1.57079632679489655800e+00, a); r = fma(-kq, 6.12323399573676603587e-17, r);
    const double r2 = r * r;
    const double sp = r * (1.0 + r2 * (-1.0 / 6 + r2 * (1.0 / 120 + r2 * (-1.0 / 5040 + r2 * (1.0 / 362880 + r2 * (-1.0 / 39916800 + r2 * (1.0 / 6227020800.0)))))));
    const double cp = 1.0 + r2 * (-0.5 + r2 * (1.0 / 24 + r2 * (-1.0 / 720 + r2 * (1.0 / 40320 + r2 * (-1.0 / 3628800 + r2 * (1.0 / 479001600 + r2 * (-1.0 / 87178291200.0)))))));
    const int q = ((int)kq) & 3;
    const double sv = (q == 0) ? sp : (q == 1) ? cp : (q == 2) ? -sp : -cp;
    const double cv = (q == 0) ? cp : (q == 1) ? -sp : (q == 2) ? -cp : sp;
    tab[idx] = make_float2((float)cv, (float)sv);
}

struct PrepArgs {
    const float *x_prompt, *x_sample, *meta, *norm_mix_w, *w_in, *w_ret, *w_dsa, *w_out, *norm_ffn_w, *w_ffi, *w_ffo;
    bf16_t *W1t, *Wret, *Wdsa, *Wout, *Wffi, *Wffo, *A0; float* rstd0; float2* rope;
};
#define PREP_J_W1   0
#define PREP_N_W1   ((N1 / 64) * (1024 / 32))
#define PREP_J_WRET (PREP_J_W1 + PREP_N_W1)
#define PREP_N_WRET ((1024 / 64) * (2048 / 32))
#define PREP_J_WDSA (PREP_J_WRET + PREP_N_WRET)
#define PREP_N_WDSA ((1024 / 64) * (1024 / 32))
#define PREP_J_WOUT (PREP_J_WDSA + PREP_N_WDSA)
#define PREP_N_WOUT ((1024 / 64) * (1024 / 32))
#define PREP_J_WFFI (PREP_J_WOUT + PREP_N_WOUT)
#define PREP_N_WFFI ((NFF2 / 64) * (1024 / 32))
#define PREP_J_WFFO (PREP_J_WFFI + PREP_N_WFFI)
#define PREP_N_WFFO ((1024 / 64) * (2816 / 32))
#define PREP_J_ROWS (PREP_J_WFFO + PREP_N_WFFO)
#define PREP_N_ROWS (T_PAD / 4)
#define PREP_J_ROPE (PREP_J_ROWS + PREP_N_ROWS)
#define PREP_N_ROPE ((LP * 128) / 256)
#define PREP_N_JOBS (PREP_J_ROPE + PREP_N_ROPE)
__device__ __forceinline__ void prep_job(const PrepArgs& a, int job, float* lds) {
    if (job < PREP_J_WRET)      prep_weight_tile(a.w_in, IN_COLS, a.norm_mix_w, a.W1t, 1024, 1, job - PREP_J_W1, lds);
    else if (job < PREP_J_WDSA) prep_weight_tile(a.w_ret, 1024, nullptr, a.Wret, 2048, 0, job - PREP_J_WRET, lds);
    else if (job < PREP_J_WOUT) prep_weight_tile(a.w_dsa, 1024, nullptr, a.Wdsa, 1024, 0, job - PREP_J_WDSA, lds);
    else if (job < PREP_J_WFFI) prep_weight_tile(a.w_out, 1024, nullptr, a.Wout, 1024, 0, job - PREP_J_WOUT, lds);
    else if (job < PREP_J_WFFO) prep_weight_tile(a.w_ffi, 2 * D_FF, a.norm_ffn_w, a.Wffi, 1024, 2, job - PREP_J_WFFI, lds);
    else if (job < PREP_J_ROWS) prep_weight_tile(a.w_ffo, 1024, nullptr, a.Wffo, 2816, 0, job - PREP_J_WFFO, lds);
    else if (job < PREP_J_ROPE) prep_row((job - PREP_J_ROWS) * 4 + ((threadIdx.x & 255) >> 6), a.x_prompt, a.x_sample, a.meta, a.A0, a.rstd0, threadIdx.x & 63);
    else rope_entry((job - PREP_J_ROPE) * 256 + (threadIdx.x & 255), a.rope);
}
struct MegaArgs {
    PrepArgs prep;
    const float *cache_k, *cache_v, *cache_kidx, *state_ret; const int* page_table;
    const float *qnw, *knw, *ikw, *ikb;
    bf16_t *Rq, *Rk, *Rv, *G, *Aq, *Kb, *Vb, *Iq, *Ikb, *Gates, *OG, *An, *Odsa, *Mg, *A2, *Hid;
    float *Iw, *ssret, *rstd2, *Z, *M1, *M2, *H2, *Zf, *out;
    u64* mask; unsigned* bar;
};

__device__ __forceinline__ void epi1_row(const MegaArgs& a, int r, int t) {
    const int lane = t & 63;
    const float* z = a.Z + (size_t)r * N1; const float rs = a.prep.rstd0[r]; const int pos = row_pos(r); const float2* rope = a.prep.rope;
    for (int which = 0; which < 2; ++which) {
        bf16_t* dst = (which ? a.Rk : a.Rq) + (size_t)r * 1024; const float post = which ? 0.0625f : 1.0f; const int zo = which * 1024;
        for (int e = t; e < 512; e += 256) { const int hh = e >> 7, i = e & 127; const float2 cs = rope[pos * 128 + i];
            const float x1 = z[zo + hh * 256 + i] * rs, x2 = z[zo + hh * 256 + 128 + i] * rs;
            dst[hh * 256 + i] = f2bf((x1 * cs.x - x2 * cs.y) * post); dst[hh * 256 + 128 + i] = f2bf((x1 * cs.y + x2 * cs.x) * post); }
    }
    for (int c = t; c < 2048; c += 256) { a.Rv[(size_t)r * 2048 + c] = f2bf(z[2048 + c] * rs); a.G[(size_t)r * 2048 + c] = f2bf(silu_f(z[4096 + c] * rs)); }
    {   const int c0 = t * 4; float v[4]; float ss = 0.f;
#pragma unroll
        for (int j = 0; j < 4; ++j) { v[j] = z[6144 + c0 + j] * rs; ss += v[j] * v[j]; }
#pragma unroll
        for (int o = 16; o >= 1; o >>= 1) ss += __shfl_xor(ss, o);
        const float rn = rsqrtf(ss * (1.0f / 128.0f) + NORM_EPS);
#pragma unroll
        for (int j = 0; j < 4; ++j) a.Aq[(size_t)r * 1024 + c0 + j] = f2bf(v[j] * rn * a.qnw[(c0 + j) & 127]); }
    float* kout = a.out + (r < T_PROMPT ? (size_t)O_K_P + (size_t)r * 256 : (size_t)O_K_S + (size_t)(r - T_PROMPT) * 256);
    float* vout = a.out + (r < T_PROMPT ? (size_t)O_V_P + (size_t)r * 256 : (size_t)O_V_S + (size_t)(r - T_PROMPT) * 256);
    float* kiout = a.out + (r < T_PROMPT ? (size_t)O_KI_P + (size_t)r * 64 : (size_t)O_KI_S + (size_t)(r - T_PROMPT) * 64);
    if (t < 64) { const int c0 = t * 4; float v[4]; float ss = 0.f;
#pragma unroll
        for (int j = 0; j < 4; ++j) { v[j] = z[7168 + c0 + j] * rs; ss += v[j] * v[j]; }
#pragma unroll
        for (int o = 16; o >= 1; o >>= 1) ss += __shfl_xor(ss, o);
        const float rn = rsqrtf(ss * (1.0f / 128.0f) + NORM_EPS);
#pragma unroll
        for (int j = 0; j < 4; ++j) { const float y = v[j] * rn * a.knw[(c0 + j) & 127]; kout[c0 + j] = y; a.Kb[(size_t)r * 256 + c0 + j] = f2bf(y); }
#pragma unroll
        for (int j = 0; j < 4; ++j) { const float y = z[7424 + c0 + j] * rs; vout[c0 + j] = y; a.Vb[(size_t)r * 256 + c0 + j] = f2bf(y); } }
    for (int c = t; c < 512; c += 256) a.Iq[(size_t)r * 512 + c] = f2bf(z[7680 + c] * rs);
    if (t >= 64 && t < 128) { const float x = z[8192 + ik_tilecol(lane)] * rs; float s = x;
#pragma unroll
        for (int o = 32; o >= 1; o >>= 1) s += __shfl_xor(s, o);
        const float mu = s * (1.0f / 64.0f), d = x - mu; float q = d * d;
#pragma unroll
        for (int o = 32; o >= 1; o >>= 1) q += __shfl_xor(q, o);
        const float y = d * rsqrtf(q * (1.0f / 64.0f) + NORM_EPS) * a.ikw[lane] + a.ikb[lane];
        kiout[lane] = y; a.Ikb[(size_t)r * 64 + lane] = f2bf(y); }
    if (t >= 128 && t < 136) a.Iw[(size_t)r * 8 + (t - 128)] = z[8192 + 32 + (t - 128)] * rs * IDX_SCALE;
    for (int c = t; c < 2048; c += 256) a.Gates[(size_t)r * 2048 + c] = f2bf(sigmoid_f(z[8448 + c] * rs));
}

__device__ __forceinline__ void ret_naive_unit(const MegaArgs& a, int unit8, int sample, float* lds) {
    float* qk = lds; float* part = lds + 512;
    const int unit = unit8 >> 3, slice = unit8 & 7, t = threadIdx.x, dke = t >> 6, dv = t & 63;
    const int bb = unit >> 2, h = unit & 3;
    const int row0 = sample ? T_PROMPT + bb * DEC_SEQ : bb * LP, ntok = sample ? DEC_SEQ : LP;
    const float gamma = 1.0f - exp2f(-5.0f - (float)h);
    float S[32];
    const size_t sbase = ((size_t)bb * H_RET + h) * (DK_RET * DV_RET) + slice * 64 + dv;
#pragma unroll
    for (int i = 0; i < 32; ++i) S[i] = sample ? a.state_ret[sbase + (size_t)(dke * 32 + i) * DV_RET] : 0.f;
    for (int tok = 0; tok < ntok; ++tok) {
        const int r = row0 + tok;
        __syncthreads();
        qk[t] = bf2f(t < 256 ? a.Rq[(size_t)r * 1024 + h * 256 + t] : a.Rk[(size_t)r * 1024 + h * 256 + (t - 256)]);
        __syncthreads();
        const float v = bf2f(a.Rv[(size_t)r * 2048 + h * 512 + slice * 64 + dv]); float o = 0.f;
#pragma unroll
        for (int i = 0; i < 32; ++i) { const float kq_ = qk[256 + dke * 32 + i], qq = qk[dke * 32 + i]; S[i] = fmaf(S[i], gamma, kq_ * v); o = fmaf(qq, S[i], o); }
        part[dke * 64 + dv] = o;
        __syncthreads();
        if (dke == 0) { float ot = 0.f;
#pragma unroll
            for (int e = 0; e < 8; ++e) ot += part[e * 64 + dv];
            float ss = ot * ot;
#pragma unroll
            for (int of = 32; of >= 1; of >>= 1) ss += __shfl_xor(ss, of);
            const size_t ci = (size_t)r * 2048 + h * 512 + slice * 64 + dv;
            a.OG[ci] = f2bf(ot * bf2f(a.G[ci]));
            if (dv == 0) a.ssret[(size_t)r * 32 + h * 8 + slice] = ss; }
    }
    float* so = a.out + (sample ? (size_t)O_R_S : (size_t)O_R_P) + sbase;
#pragma unroll
    for (int i = 0; i < 32; ++i) so[(size_t)(dke * 32 + i) * DV_RET] = S[i];
    __syncthreads();
}

__device__ __forceinline__ unsigned f2ord(float f) { const unsigned u = __float_as_uint(f); return (u & 0x80000000u) ? ~u : (u | 0x80000000u); }
__device__ __forceinline__ void topk_naive_row(const MegaArgs& a, int r, float* lds) {
    float* q = lds; float* w = lds + 512; unsigned* sc = (unsigned*)(lds + 520); unsigned* red = sc + 2560; unsigned* mw = red + 512;
    const int t = threadIdx.x;
    const bool smp = r >= T_PROMPT; const int b = smp ? (r - T_PROMPT) >> 3 : r / LP, pos = row_pos(r);
    const int N = pos + 1;
    __syncthreads();
    q[t] = bf2f(a.Iq[(size_t)r * 512 + t]); if (t < 8) w[t] = a.Iw[(size_t)r * 8 + t];
    if (t < MASK_WORDS * 2) mw[t] = 0u;
    __syncthreads();
    for (int s = t; s < 2560; s += 512) {
        unsigned ord = 0u;
        if (s < N) { float k[64];
            if (!smp) { const bf16_t* kp = a.Ikb + ((size_t)b * LP + s) * 64;
#pragma unroll
                for (int d = 0; d < 64; ++d) k[d] = bf2f(kp[d]); }
            else if (s < PAST_LEN) { const float* kp = a.cache_kidx + ((size_t)a.page_table[b * N_PAGES + (s >> 7)] * PAGE_SIZE + (s & 127)) * 64;
#pragma unroll
                for (int d = 0; d < 64; ++d) k[d] = bf2f(f2bf(kp[d])); }
            else { const bf16_t* kp = a.Ikb + ((size_t)T_PROMPT + b * DEC_SEQ + (s - PAST_LEN)) * 64;
#pragma unroll
                for (int d = 0; d < 64; ++d) k[d] = bf2f(kp[d]); }
            float tot = 0.f;
            for (int hh = 0; hh < 8; ++hh) { float dsum = 0.f;
#pragma unroll
                for (int d = 0; d < 64; ++d) dsum = fmaf(q[hh * 64 + d], k[d], dsum);
                tot = fmaf(w[hh], fmaxf(dsum, 0.f), tot); }
            ord = f2ord(tot); }
        sc[s] = ord;
    }
    __syncthreads();
    unsigned mine[5];
#pragma unroll
    for (int i = 0; i < 5; ++i) mine[i] = sc[t * 5 + i];
    unsigned tau = 0u, r_ties = 0u;
    if (N > TOPK) {
        for (int bit = 31; bit >= 0; --bit) { const unsigned cand = tau | (1u << bit); unsigned c = 0;
#pragma unroll
            for (int i = 0; i < 5; ++i) c += (mine[i] >= cand) ? 1u : 0u;
#pragma unroll
            for (int o = 32; o >= 1; o >>= 1) c += __shfl_xor(c, o);
            __syncthreads(); if ((t & 63) == 0) red[t >> 6] = c; __syncthreads();
            unsigned tot = 0;
#pragma unroll
            for (int e = 0; e < 8; ++e) tot += red[e];
            if (tot >= TOPK) tau = cand; }
        unsigned cg = 0;
#pragma unroll
        for (int i = 0; i < 5; ++i) cg += (mine[i] > tau) ? 1u : 0u;
#pragma unroll
        for (int o = 32; o >= 1; o >>= 1) cg += __shfl_xor(cg, o);
        __syncthreads(); if ((t & 63) == 0) red[t >> 6] = cg; __syncthreads();
        unsigned tot = 0;
#pragma unroll
        for (int e = 0; e < 8; ++e) tot += red[e];
        r_ties = TOPK - tot;
    }
    unsigned ce = 0;
#pragma unroll
    for (int i = 0; i < 5; ++i) ce += (mine[i] == tau) ? 1u : 0u;
    __syncthreads(); red[t] = ce; __syncthreads();
    unsigned rank = 0; for (int i = 0; i < t; ++i) rank += red[i];
#pragma unroll
    for (int i = 0; i < 5; ++i) { const int s = t * 5 + i; bool sel;
        if (N <= TOPK) sel = s < N;
        else { sel = mine[i] > tau; if (mine[i] == tau) { sel = rank < r_ties; ++rank; } }
        if (sel) atomicOr(&mw[s >> 5], 1u << (s & 31)); }
    __syncthreads();
    if (t < MASK_WORDS) a.mask[(size_t)r * MASK_WORDS + t] = (u64)mw[2 * t] | ((u64)mw[2 * t + 1] << 32);
}

__device__ __forceinline__ void attn_naive_row(const MegaArgs& a, int r, float* lds) {
    int* list = (int*)lds; unsigned* cnts = (unsigned*)(lds + 256); float* qv = lds + 320; float* p = lds + 576; float* red = lds + 1088;
    const int tt = threadIdx.x, half = tt >> 8, t = tt & 255;
    const bool smp = r >= T_PROMPT; const int b = smp ? (r - T_PROMPT) >> 3 : r / LP;
    __syncthreads();
    if (tt < MASK_WORDS) cnts[tt] = __popcll(a.mask[(size_t)r * MASK_WORDS + tt]);
    __syncthreads();
    if (tt < MASK_WORDS) { unsigned off = 0; for (int i = 0; i < tt; ++i) off += cnts[i]; u64 m = a.mask[(size_t)r * MASK_WORDS + tt];
        while (m) { const int bpos = __ffsll((long long)m) - 1; m &= m - 1; if (off < TOPK) list[off] = tt * 64 + bpos; ++off; } }
    unsigned nsel = 0; for (int i = 0; i < MASK_WORDS; ++i) nsel += cnts[i];
    if (nsel > TOPK) nsel = TOPK;
    __syncthreads();
    for (int hq = 0; hq < 4; ++hq) {
        const int hd = hq + 4 * half, n = half;
        if (t < 128) qv[half * 128 + t] = bf2f(a.Aq[(size_t)r * 1024 + hd * 128 + t]);
        __syncthreads();
        const float* qh = qv + half * 128;
        float logit = -1e30f;
        if (t < (int)nsel) { const int s = list[t]; float d = 0.f;
            if (!smp || s >= PAST_LEN) { const uint4* kp = (const uint4*)(a.Kb + (smp ? ((size_t)T_PROMPT + b * DEC_SEQ + (s - PAST_LEN)) : ((size_t)b * LP + s)) * 256 + n * 128);
                for (int e = 0; e < 16; ++e) { const uint4 kk = kp[e]; const unsigned wv[4] = {kk.x, kk.y, kk.z, kk.w};
#pragma unroll
                    for (int j = 0; j < 4; ++j) { d = fmaf(qh[e * 8 + 2 * j], __uint_as_float(wv[j] << 16), d); d = fmaf(qh[e * 8 + 2 * j + 1], __uint_as_float(wv[j] & 0xffff0000u), d); } } }
            else { const float4* kp = (const float4*)(a.cache_k + (((size_t)a.page_table[b * N_PAGES + (s >> 7)] * PAGE_SIZE + (s & 127)) * N_KV + n) * 128);
                for (int e = 0; e < 32; ++e) { const float4 kk = kp[e]; d = fmaf(qh[e * 4], kk.x, d); d = fmaf(qh[e * 4 + 1], kk.y, d); d = fmaf(qh[e * 4 + 2], kk.z, d); d = fmaf(qh[e * 4 + 3], kk.w, d); } }
            logit = d * 0.08838834764831845f; }
        float mx = logit;
#pragma unroll
        for (int o = 32; o >= 1; o >>= 1) mx = fmaxf(mx, __shfl_xor(mx, o));
        if ((t & 63) == 0) red[half * 8 + (t >> 6)] = mx;
        __syncthreads();
        mx = fmaxf(fmaxf(red[half * 8 + 0], red[half * 8 + 1]), fmaxf(red[half * 8 + 2], red[half * 8 + 3]));
        const float e_ = t < (int)nsel ? __expf(logit - mx) : 0.f; float sm = e_;
#pragma unroll
        for (int o = 32; o >= 1; o >>= 1) sm += __shfl_xor(sm, o);
        if ((t & 63) == 0) red[half * 8 + 4 + (t >> 6)] = sm; p[half * 256 + t] = e_;
        __syncthreads();
        const float inv = 1.0f / ((red[half * 8 + 4] + red[half * 8 + 5]) + (red[half * 8 + 6] + red[half * 8 + 7]));
        if (t < 128) { float acc = 0.f; const float* ph = p + half * 256;
            for (unsigned j = 0; j < nsel; ++j) { const int s = list[j]; float vv;
                if (!smp || s >= PAST_LEN) vv = bf2f(a.Vb[(smp ? ((size_t)T_PROMPT + b * DEC_SEQ + (s - PAST_LEN)) : ((size_t)b * LP + s)) * 256 + n * 128 + t]);
                else vv = a.cache_v[(((size_t)a.page_table[b * N_PAGES + (s >> 7)] * PAGE_SIZE + (s & 127)) * N_KV + n) * 128 + t];
                acc = fmaf(ph[j], vv, acc); }
            a.Odsa[(size_t)r * 1024 + hd * 128 + t] = f2bf(acc * inv); }
        __syncthreads();
    }
}

__device__ __forceinline__ void make_an_row(const MegaArgs& a, int r, int lane) {
    for (int c = lane; c < 2048; c += 64) { const int h = c >> 9; float ss = 0.f;
#pragma unroll
        for (int s = 0; s < 8; ++s) ss += a.ssret[(size_t)r * 32 + h * 8 + s];
        a.An[(size_t)r * 2048 + c] = f2bf(bf2f(a.OG[(size_t)r * 2048 + c]) * rsqrtf(ss * (1.0f / 512.0f) + NORM_EPS)); }
}
__device__ __forceinline__ void merge_row(const MegaArgs& a, int r, int lane) {
    for (int c = lane; c < 1024; c += 64) a.Mg[(size_t)r * 1024 + c] = f2bf(bf2f(a.Gates[(size_t)r * 2048 + c]) * a.M1[(size_t)r * 1024 + c] + bf2f(a.Gates[(size_t)r * 2048 + 1024 + c]) * a.M2[(size_t)r * 1024 + c]);
}
__device__ __forceinline__ void h2_row(const MegaArgs& a, int r, int lane) {
    const float* h = h_row_ptr(r, a.prep.x_prompt, a.prep.x_sample, a.prep.meta); float ss = 0.f;
    for (int c = lane; c < 1024; c += 64) { const float v = h[c] + a.M1[(size_t)r * 1024 + c]; a.H2[(size_t)r * 1024 + c] = v; a.A2[(size_t)r * 1024 + c] = f2bf(v); ss += v * v; }
#pragma unroll
    for (int o = 32; o >= 1; o >>= 1) ss += __shfl_xor(ss, o);
    if (lane == 0) a.rstd2[r] = rsqrtf(ss * (1.0f / 1024.0f) + NORM_EPS);
}
__device__ __forceinline__ void hid_row(const MegaArgs& a, int r, int lane) {
    const float rs = a.rstd2[r];
    for (int u = lane; u < D_FF; u += 64) { const int pn = u >> 7, c = u & 127; const float av = a.Zf[(size_t)r * NFF2 + pn * 256 + c] * rs, bv = a.Zf[(size_t)r * NFF2 + pn * 256 + 128 + c] * rs;
        a.Hid[(size_t)r * D_FF + u] = f2bf(silu_f(av) * bv); }
}
__device__ __forceinline__ void yout_row(const MegaArgs& a, int r, int lane) {
    float* dst;
    if (r < T_PROMPT) { const int b = r / LP, l = r % LP; if (l < N_META) return; dst = a.out + O_Y_P + ((size_t)b * SEQ + (l - N_META)) * 1024; }
    else dst = a.out + O_Y_S + (size_t)(r - T_PROMPT) * 1024;
    for (int c = lane; c < 1024; c += 64) dst[c] = a.H2[(size_t)r * 1024 + c] + a.M1[(size_t)r * 1024 + c];
}

#define LDS_TOTAL (pg8::STAGE_BYTES + 1024)
__global__ void __launch_bounds__(512, 2) mega(MegaArgs a) {
    extern __shared__ __attribute__((aligned(16))) unsigned char shm[];
    float* lds = (float*)shm;
    volatile LAS unsigned* xbw = (volatile LAS unsigned*)(PG8_LAS unsigned char*)(shm + pg8::STAGE_BYTES);
    const int tid = threadIdx.x, wave = tid >> 6, lane = tid & 63, half = tid >> 8, G = gridDim.x, bid = blockIdx.x;
    if (tid == 0) { xbw[0] = 0u; xbw[1] = 0u; xbw[2] = 0u; xbw[3] = 0u; }
    __syncthreads();
    XcdBarrier bar = xcd_barrier_post(a.bar, xbw);
    for (int jp = bid; jp < PREP_J_ROWS / 2; jp += G) prep_job(a.prep, 2 * jp + half, lds + half * (32 * 65));
    for (int j = PREP_J_ROWS + bid * 2 + half; j < PREP_N_JOBS; j += 2 * G) prep_job(a.prep, j, lds);
    xcd_barrier(bar);
    { pg8::StaticOrder S; S.init(T_PAD, N1, G, bid); pg8::gemm_phase<pg8::EpiF32, pg8::StaticOrder, false>((PG8_LAS unsigned char*)shm, pg8::Gemm{a.prep.A0, a.prep.W1t, T_PAD, N1, 1024}, S, pg8::EpiF32{a.Z, N1, nullptr}, nullptr); }
    xcd_barrier(bar);
    for (int rp = bid; rp < T_ALL / 2; rp += G) epi1_row(a, 2 * rp + half, tid & 255);
    xcd_barrier(bar);
    for (int u = bid; u < BATCH * H_RET * 8; u += G) ret_naive_unit(a, u, 0, lds);
    for (int u = bid; u < DEC_BATCH * H_RET * 8; u += G) ret_naive_unit(a, u, 1, lds);
    for (int r = bid; r < T_ALL; r += G) topk_naive_row(a, r, lds);
    xcd_barrier(bar);
    for (int r = bid; r < T_ALL; r += G) attn_naive_row(a, r, lds);
    for (int r = bid * 8 + wave; r < T_ALL; r += 8 * G) make_an_row(a, r, lane);
    xcd_barrier(bar);
    { pg8::StaticOrder S; S.init(T_PAD, 1024, G, bid); pg8::gemm_phase<pg8::EpiF32, pg8::StaticOrder, false>((PG8_LAS unsigned char*)shm, pg8::Gemm{a.An, a.prep.Wret, T_PAD, 1024, 2048}, S, pg8::EpiF32{a.M1, 1024, nullptr}, nullptr); }
    { pg8::StaticOrder S; S.init(T_PAD, 1024, G, bid); pg8::gemm_phase<pg8::EpiF32, pg8::StaticOrder, false>((PG8_LAS unsigned char*)shm, pg8::Gemm{a.Odsa, a.prep.Wdsa, T_PAD, 1024, 1024}, S, pg8::EpiF32{a.M2, 1024, nullptr}, nullptr); }
    xcd_barrier(bar);
    for (int r = bid * 8 + wave; r < T_ALL; r += 8 * G) merge_row(a, r, lane);
    xcd_barrier(bar);
    { pg8::StaticOrder S; S.init(T_PAD, 1024, G, bid); pg8::gemm_phase<pg8::EpiF32, pg8::StaticOrder, false>((PG8_LAS unsigned char*)shm, pg8::Gemm{a.Mg, a.prep.Wout, T_PAD, 1024, 1024}, S, pg8::EpiF32{a.M1, 1024, nullptr}, nullptr); }
    xcd_barrier(bar);
    for (int r = bid * 8 + wave; r < T_ALL; r += 8 * G) h2_row(a, r, lane);
    xcd_barrier(bar);
    { pg8::StaticOrder S; S.init(T_PAD, NFF2, G, bid); pg8::gemm_phase<pg8::EpiF32, pg8::StaticOrder, false>((PG8_LAS unsigned char*)shm, pg8::Gemm{a.A2, a.prep.Wffi, T_PAD, NFF2, 1024}, S, pg8::EpiF32{a.Zf, NFF2, nullptr}, nullptr); }
    xcd_barrier(bar);
    for (int r = bid * 8 + wave; r < T_ALL; r += 8 * G) hid_row(a, r, lane);
    xcd_barrier(bar);
    { pg8::StaticOrder S; S.init(T_PAD, 1024, G, bid); pg8::gemm_phase<pg8::EpiF32, pg8::StaticOrder, false>((PG8_LAS unsigned char*)shm, pg8::Gemm{a.Hid, a.prep.Wffo, T_PAD, 1024, 2816}, S, pg8::EpiF32{a.M1, 1024, nullptr}, nullptr); }
    xcd_barrier(bar);
    for (int r = bid * 8 + wave; r < T_ALL; r += 8 * G) yout_row(a, r, lane);
}
extern "C" void kernel_launch(void* const* d_in, const int* in_sizes, int n_in, void* d_out, int out_size, void* d_ws, size_t ws_size, hipStream_t stream) {
    static int grid = 0;
    if (grid == 0) {
        if (n_in != 20 || out_size != OUT_TOTAL || ws_size < WS_END_B1 || ws_size < WS_END_B2) { fprintf(stderr, "kernel_launch: unexpected shapes (n_in %d out %d ws %zu need %llu)\n", n_in, out_size, ws_size, (unsigned long long)WS_END_B1); grid = -1; return; }
        int dev = 0, cus = 0, per_cu = 0;
        if (hipGetDevice(&dev) != hipSuccess || hipDeviceGetAttribute(&cus, hipDeviceAttributeMultiprocessorCount, dev) != hipSuccess) { grid = -1; return; }
        if (hipFuncSetAttribute((const void*)mega, hipFuncAttributeMaxDynamicSharedMemorySize, LDS_TOTAL) != hipSuccess) { fprintf(stderr, "kernel_launch: hipFuncSetAttribute failed\n"); grid = -1; return; }
        if (hipOccupancyMaxActiveBlocksPerMultiprocessor(&per_cu, (const void*)mega, 512, LDS_TOTAL) != hipSuccess || per_cu < 1) { fprintf(stderr, "kernel_launch: occupancy query says %d blocks per CU\n", per_cu); grid = -1; return; }
        grid = cus;
    }
    if (grid < 0) return;
    char* ws = (char*)d_ws;
    MegaArgs a{};
    a.prep.x_prompt = (const float*)d_in[0]; a.prep.x_sample = (const float*)d_in[1]; a.prep.meta = (const float*)d_in[7]; a.prep.norm_mix_w = (const float*)d_in[8]; a.prep.w_in = (const float*)d_in[9];
    a.prep.w_ret = (const float*)d_in[10]; a.prep.w_dsa = (const float*)d_in[15]; a.prep.w_out = (const float*)d_in[16]; a.prep.norm_ffn_w = (const float*)d_in[17]; a.prep.w_ffi = (const float*)d_in[18]; a.prep.w_ffo = (const float*)d_in[19];
    a.prep.W1t = (bf16_t*)(ws + WS_W1T); a.prep.Wret = (bf16_t*)(ws + WS_WRET); a.prep.Wdsa = (bf16_t*)(ws + WS_WDSA); a.prep.Wout = (bf16_t*)(ws + WS_WOUT); a.prep.Wffi = (bf16_t*)(ws + WS_WFFI); a.prep.Wffo = (bf16_t*)(ws + WS_WFFO);
    a.prep.A0 = (bf16_t*)(ws + WS_A0); a.prep.rstd0 = (float*)(ws + WS_RSTD0); a.prep.rope = (float2*)(ws + WS_ROPE);
    a.cache_k = (const float*)d_in[2]; a.cache_v = (const float*)d_in[3]; a.cache_kidx = (const float*)d_in[4]; a.state_ret = (const float*)d_in[5]; a.page_table = (const int*)d_in[6];
    a.qnw = (const float*)d_in[11]; a.knw = (const float*)d_in[12]; a.ikw = (const float*)d_in[13]; a.ikb = (const float*)d_in[14];
    a.Rq = (bf16_t*)(ws + WS_RQ); a.Rk = (bf16_t*)(ws + WS_RK); a.Rv = (bf16_t*)(ws + WS_RV); a.G = (bf16_t*)(ws + WS_G); a.Aq = (bf16_t*)(ws + WS_AQ); a.Kb = (bf16_t*)(ws + WS_KB); a.Vb = (bf16_t*)(ws + WS_VB);
    a.Iq = (bf16_t*)(ws + WS_IQ); a.Ikb = (bf16_t*)(ws + WS_IKB); a.Gates = (bf16_t*)(ws + WS_GATES); a.OG = (bf16_t*)(ws + WS_OG); a.An = (bf16_t*)(ws + WS_AN); a.Odsa = (bf16_t*)(ws + WS_ODSA); a.Mg = (bf16_t*)(ws + WS_MG);
    a.A2 = (bf16_t*)(ws + WS_A2); a.Hid = (bf16_t*)(ws + WS_HID);
    a.Iw = (float*)(ws + WS_IW); a.ssret = (float*)(ws + WS_SSRET); a.rstd2 = (float*)(ws + WS_RSTD2); a.Z = (float*)(ws + WS_Z); a.M1 = (float*)(ws + WS_M1); a.M2 = (float*)(ws + WS_M2); a.H2 = (float*)(ws + WS_H2); a.Zf = (float*)(ws + WS_ZF);
    a.out = (float*)d_out; a.mask = (u64*)(ws + WS_MASK); a.bar = (unsigned*)(ws + WS_CTL);
    if (hipMemsetAsync(ws + WS_CTL, 0, 65536, stream) != hipSuccess) return;
    hipLaunchKernelGGL(mega, dim3(grid), dim3(512), LDS_TOTAL, stream, a);
}
```

```cpp
#include <hip/hip_runtime.h>
#include <stdint.h>
#include <stdio.h>

#define D_MODEL 1024
#define BATCH 8
#define SEQ 2048
#define N_META 16
#define LP (N_META + SEQ)
#define DEC_BATCH 128
#define DEC_SEQ 8
#define PAST_LEN 2048
#define PAGE_SIZE 128
#define N_PAGES 16
#define H_RET 4
#define DK_RET 256
#define DV_RET 512
#define N_HEADS 8
#define N_KV 2
#define D_HEAD 128
#define N_IDXH 8
#define D_IDX 64
#define TOPK 256
#define D_FF 2816
#define IN_COLS 10312
#define NORM_EPS 1e-6f
#define IDX_SCALE 0.04419417382415922f
#define T_PROMPT (BATCH * LP)
#define T_SAMPLE (DEC_BATCH * DEC_SEQ)
#define T_ALL (T_PROMPT + T_SAMPLE)
#define T_PAD 17664
#define N1 10496
#define NFF2 5632
#define MASK_WORDS 34
#define SAMPLE_L (PAST_LEN + DEC_SEQ)

#define O_Y_P   0
#define O_Y_S   16777216
#define O_K_P   17825792
#define O_V_P   22052864
#define O_KI_P  26279936
#define O_R_P   27336704
#define O_K_S   31531008
#define O_V_S   31793152
#define O_KI_S  32055296
#define O_R_S   32120832
#define OUT_TOTAL 99229696

typedef unsigned short bf16_t;
typedef unsigned long long u64;

__device__ __forceinline__ bf16_t f2bf(float f) { unsigned u = __float_as_uint(f); u += 0x7FFFu + ((u >> 16) & 1u); return (bf16_t)(u >> 16); }
__device__ __forceinline__ float bf2f(bf16_t b) { return __uint_as_float(((unsigned)b) << 16); }
__device__ __forceinline__ float silu_f(float x) { return x / (1.0f + __expf(-x)); }
__device__ __forceinline__ float sigmoid_f(float x) { return 1.0f / (1.0f + __expf(-x)); }

__device__ __forceinline__ int row_pos(int r) { return r < T_PROMPT ? (r % LP) : (PAST_LEN + ((r - T_PROMPT) & (DEC_SEQ - 1))); }

#define WS_CTL      0ull
#define WS_W1T      (WS_CTL + 65536ull)
#define WS_WRET     (WS_W1T + (u64)N1 * 1024 * 2)
#define WS_WDSA     (WS_WRET + 1024ull * 2048 * 2)
#define WS_WOUT     (WS_WDSA + 1024ull * 1024 * 2)
#define WS_WFFI     (WS_WOUT + 1024ull * 1024 * 2)
#define WS_WFFO     (WS_WFFI + (u64)NFF2 * 1024 * 2)
#define WS_ROPE     (WS_WFFO + 1024ull * 2816 * 2)
#define WS_RSTD0    (WS_ROPE + (u64)LP * 128 * 8)
#define WS_A0       (WS_RSTD0 + (u64)T_PAD * 4)
#define WS_RQ       (WS_A0 + (u64)T_PAD * 1024 * 2)
#define WS_RK       (WS_RQ + (u64)T_PAD * 1024 * 2)
#define WS_RV       (WS_RK + (u64)T_PAD * 1024 * 2)
#define WS_G        (WS_RV + (u64)T_PAD * 2048 * 2)
#define WS_AQ       (WS_G + (u64)T_PAD * 2048 * 2)
#define WS_KB       (WS_AQ + (u64)T_PAD * 1024 * 2)
#define WS_VB       (WS_KB + (u64)T_PAD * 256 * 2)
#define WS_IQ       (WS_VB + (u64)T_PAD * 256 * 2)
#define WS_IKB      (WS_IQ + (u64)T_PAD * 512 * 2)
#define WS_IW       (WS_IKB + (u64)T_PAD * 64 * 2)
#define WS_GATES    (WS_IW + (u64)T_PAD * 8 * 4)
#define WS_MASK     (WS_GATES + (u64)T_PAD * 2048 * 2)
#define WS_SSRET    (WS_MASK + (u64)T_PAD * MASK_WORDS * 8)
#define WS_RSTD2    (WS_SSRET + (u64)T_PAD * 32 * 4)
#define WS_REGION_B (((WS_RSTD2 + (u64)T_PAD * 16 * 4) + 4095ull) & ~4095ull)
#define WS_Z        WS_REGION_B
#define WS_H2       WS_REGION_B
#define WS_A2       (WS_H2 + (u64)T_PAD * 1024 * 4)
#define WS_HID      (WS_A2 + (u64)T_PAD * 1024 * 2)
#define WS_MG       (WS_HID + (u64)T_PAD * 2816 * 2)
#define WS_OG       (WS_MG + (u64)T_PAD * 1024 * 2)
#define WS_AN       (WS_OG + (u64)T_PAD * 2048 * 2)
#define WS_ODSA     (WS_AN + (u64)T_PAD * 2048 * 2)
#define WS_M1       (WS_ODSA + (u64)T_PAD * 1024 * 2)
#define WS_M2       (WS_M1 + (u64)T_PAD * 1024 * 4)
#define WS_ZF       WS_OG
#define WS_END_B1   (WS_Z + (u64)T_PAD * N1 * 4)
#define WS_END_B2   (WS_ZF + (u64)T_PAD * NFF2 * 4)
namespace pg8 {
#define PG8_LAS __attribute__((address_space(3)))
typedef unsigned short bf16_t;
typedef short bf16x8 __attribute__((ext_vector_type(8)));
typedef float f32x4 __attribute__((ext_vector_type(4)));
typedef unsigned u32x4 __attribute__((ext_vector_type(4)));
constexpr int BM = 256, BK = 64, HALF = 128, HTB = HALF * BK * 2  , STAGE_BYTES = 8 * HTB, NXCD = 8, WGM = 8;

__host__ __device__ __forceinline__ int lds_byte(int r, int c) { const int st = (r >> 4) * 2 + (c >> 5), rr = r & 15, cc = c & 31, ob = rr * 64 + cc * 2; return st * 1024 + (ob ^ (((ob >> 9) & 1) << 5)); }
__host__ __device__ __forceinline__ void stage_rc(int b, int& R, int& C) { const int st = b / 1024, sb = b % 1024, swz = sb ^ (((sb >> 9) & 1) << 5); R = (st >> 1) * 16 + swz / 64; C = (st & 1) * 32 + (swz % 64) / 2; }
__host__ __device__ __forceinline__ int perm32(int rho) { const int n = rho >> 4, i = rho & 15; return 8 * (i >> 2) + 4 * n + (i & 3); }

struct Unit { int pm, pn; };
struct Gemm { const bf16_t* A; const bf16_t* Bt; int M, N, K; };

struct StaticOrder {
    int nM, nN, nwg, G, c;
    __host__ __device__ void init(int M, int N, int G_, int c_) { nM = M / BM; nN = N / BM; nwg = nM * nN; G = G_; c = c_; }
    __host__ __device__ bool next(int i, Unit& u) const {
        const long L = (long)i * G + c; if (L >= nwg) return false;
        int wgid = (int)L; { const int q = nwg / NXCD, r = nwg % NXCD, xcd = wgid % NXCD, off = wgid / NXCD; wgid = (xcd < r ? xcd * (q + 1) : r * (q + 1) + (xcd - r) * q) + off; }
        const int nig = WGM * nN, gid = wgid / nig, fm = gid * WGM, gsz = (nM - fm) < WGM ? (nM - fm) : WGM;
        u.pm = fm + ((wgid % nig) % gsz); u.pn = (wgid % nig) / gsz; return true;
    }
    __device__ __forceinline__ void a_ready(const Unit&) const {}
    __device__ __forceinline__ void done(const Unit&) const {}
};
struct CountedOrder : StaticOrder {
    const unsigned* ready; unsigned need; unsigned* tmo;
    __device__ __forceinline__ void a_ready(const Unit& u) const {
        if (threadIdx.x < 64) {
            const unsigned long long t0 = __builtin_amdgcn_s_memrealtime(); unsigned polls = 0;
            while ((unsigned)__builtin_amdgcn_readfirstlane(__hip_atomic_load(ready + 64 * u.pm, __ATOMIC_RELAXED, __HIP_MEMORY_SCOPE_AGENT)) < need) {
                if ((++polls & 255u) == 0u && __builtin_amdgcn_readfirstlane(__hip_atomic_load(tmo, __ATOMIC_RELAXED, __HIP_MEMORY_SCOPE_AGENT)) != 0u) break;
                if (__builtin_amdgcn_s_memrealtime() - t0 > 2000000ull) {
                    if (threadIdx.x == 0) { unsigned expect = 0u; __hip_atomic_compare_exchange_strong(tmo + 1, &expect, 0x600u | (unsigned)(u.pm & 0xff), __ATOMIC_RELAXED, __ATOMIC_RELAXED, __HIP_MEMORY_SCOPE_AGENT); __hip_atomic_store(tmo, 1u, __ATOMIC_RELAXED, __HIP_MEMORY_SCOPE_AGENT); }
                    break; }
                __builtin_amdgcn_s_sleep(2); }
            __builtin_amdgcn_fence(__ATOMIC_ACQUIRE, "agent");
            asm volatile("s_waitcnt vmcnt(0)" ::: "memory");
        }
#if !defined(BROKEN_HOOK_NO_BARRIER)
        asm volatile("" ::: "memory"); __builtin_amdgcn_s_barrier(); asm volatile("" ::: "memory");
#endif
    }
};

__device__ __forceinline__ unsigned cvt_pk_bf16(float lo, float hi) { unsigned r; asm volatile("v_cvt_pk_bf16_f32 %0, %1, %2" : "=v"(r) : "v"(lo), "v"(hi)); return r; }
typedef float f32x2 __attribute__((ext_vector_type(2)));
__device__ __forceinline__ f32x2 gelu_pk(f32x2 v) {
    const f32x2 av = __builtin_elementwise_abs(v), d = av * 0.2316418882f + 1.0f;
    f32x2 t; t.x = __builtin_amdgcn_rcpf(d.x); t.y = __builtin_amdgcn_rcpf(d.y);
    f32x2 q = t * 0.5307027145f + (-0.7265760135f); q = q * t + 0.7107068705f; q = q * t + (-0.142248368f); q = q * t + 0.127414796f; q = q * t;
    const f32x2 s = (v * v) * (-0.72134752044f);
    f32x2 e; e.x = __builtin_amdgcn_exp2f(s.x); e.y = __builtin_amdgcn_exp2f(s.y);
    const f32x2 m = v * (q * e), r = v - m;
    f32x2 o; o.x = v.x < 0.f ? m.x : r.x; o.y = v.y < 0.f ? m.y : r.y; return o;
}

struct EpiF32 {
    static constexpr bool PERM = false, AFTER_DRAIN = false;
    float* C; int ldc; const float* bias;
    __device__ __forceinline__ void operator()(const f32x4 (&acc)[2][2][4][2], const Unit& u, int wr, int wc, int fr, int fq) const {
        const int row0 = u.pm * BM + wr * 64 + fr, col0 = u.pn * BM + wc * 32 + 4 * fq;
        f32x4 bv[2][2];
#pragma unroll
        for (int bj = 0; bj < 2; ++bj)
#pragma unroll
            for (int n = 0; n < 2; ++n) bv[bj][n] = bias ? *(const f32x4*)(bias + col0 + bj * HALF + n * 16) : (f32x4){0.f, 0.f, 0.f, 0.f};
#pragma unroll
        for (int ai = 0; ai < 2; ++ai)
#pragma unroll
            for (int m = 0; m < 4; ++m) { float* rowp = C + (size_t)(row0 + ai * HALF + m * 16) * ldc + col0;
#pragma unroll
                for (int bj = 0; bj < 2; ++bj)
#pragma unroll
                    for (int n = 0; n < 2; ++n) *(f32x4*)(rowp + bj * HALF + n * 16) = acc[ai][bj][m][n] + bv[bj][n]; }
    }
};
template <int ACT  > struct EpiBf16 {
    static constexpr bool PERM = true, AFTER_DRAIN = false;
    bf16_t* O; int ldc; const float* bias; int split_cols; size_t split_stride;
    __device__ __forceinline__ void operator()(const f32x4 (&acc)[2][2][4][2], const Unit& u, int wr, int wc, int fr, int fq) const {
        const int row0 = u.pm * BM + wr * 64 + fr; int colt = u.pn * BM; bf16_t* base = O;
        if (split_cols) { const int t = colt / split_cols; base += (size_t)t * split_stride; colt -= t * split_cols; }
        const int col0 = colt + wc * 32 + 8 * fq, bcol0 = u.pn * BM + wc * 32 + 8 * fq;
        f32x4 bv[2][2];
#pragma unroll
        for (int bj = 0; bj < 2; ++bj)
#pragma unroll
            for (int n = 0; n < 2; ++n) bv[bj][n] = bias ? *(const f32x4*)(bias + bcol0 + bj * HALF + 4 * n) : (f32x4){0.f, 0.f, 0.f, 0.f};
#pragma unroll
        for (int ai = 0; ai < 2; ++ai)
#pragma unroll
            for (int m = 0; m < 4; ++m) { bf16_t* rowp = base + (size_t)(row0 + ai * HALF + m * 16) * ldc + col0;
#pragma unroll
                for (int bj = 0; bj < 2; ++bj) { f32x4 v0 = acc[ai][bj][m][0] + bv[bj][0], v1 = acc[ai][bj][m][1] + bv[bj][1];
                    if (ACT == 1) { f32x2 a = gelu_pk((f32x2){v0[0], v0[1]}), b = gelu_pk((f32x2){v0[2], v0[3]}), c = gelu_pk((f32x2){v1[0], v1[1]}), d = gelu_pk((f32x2){v1[2], v1[3]});
                        v0 = (f32x4){a.x, a.y, b.x, b.y}; v1 = (f32x4){c.x, c.y, d.x, d.y}; }
                    if (ACT == 2) {
#pragma unroll
                        for (int j = 0; j < 4; ++j) { v0[j] = 0.5f * v0[j] * (1.0f + erff(v0[j] * 0.70710678f)); v1[j] = 0.5f * v1[j] * (1.0f + erff(v1[j] * 0.70710678f)); } }
                    u32x4 w; w.x = cvt_pk_bf16(v0[0], v0[1]); w.y = cvt_pk_bf16(v0[2], v0[3]); w.z = cvt_pk_bf16(v1[0], v1[1]); w.w = cvt_pk_bf16(v1[2], v1[3]);
                    *(u32x4*)(rowp + bj * HALF) = w; } }
    }
};
template <class Epi, class Sched, bool STAMP = false>
__device__ __forceinline__ void gemm_phase(PG8_LAS unsigned char* lds, const Gemm g, const Sched& S, const Epi& E, unsigned long long* stamps) {
    int tid_l = threadIdx.x; asm volatile("" : "+v"(tid_l));
    const int tid = tid_l, wid = __builtin_amdgcn_readfirstlane(tid >> 6), lane = tid & 63, wr = wid >> 2, wc = wid & 3, fr = lane & 15, fq = lane >> 4;
    const int K = g.K, nt = K / BK;
    int ts_lo = 0, ts_hi = 0, nts = 0; const unsigned long long rt_entry = STAMP ? (unsigned long long)wall_clock64() : 0ull;
#define PG8_STAMP() do { if (STAMP && wid == 0 && nts < 64) { const unsigned long long _c = (unsigned long long)clock64(); \
        ts_lo = (lane == nts) ? (int)(unsigned)_c : ts_lo; ts_hi = (lane == nts) ? (int)(unsigned)(_c >> 32) : ts_hi; ++nts; } } while (0)
    PG8_STAMP();
    unsigned voffA[2], voffB[2];
#pragma unroll
    for (int i = 0; i < 2; ++i) { int R, C; stage_rc(tid * 16 + i * 8192, R, C); const int Rb = Epi::PERM ? ((R & ~31) + perm32(R & 31)) : R;
        voffA[i] = (unsigned)(R * K + C) * 2u; voffB[i] = (unsigned)(Rb * K + C) * 2u; }
    const size_t kstep = (size_t)(BK * 2);
    const size_t hstep = (size_t)HALF * K * 2;
    const size_t tstep = 2 * hstep;
    const unsigned ldsw = (unsigned)wid * 1024u;
    const int aoff = lds_byte(wr * 64 + fr, fq * 8), boff = lds_byte(wc * 32 + fr, fq * 8);
#define PG8_SA(b, h) (((b) * 2 + (h)) * HTB)
#define PG8_SB(b, h) ((4 + (b) * 2 + (h)) * HTB)
#define PG8_STAGE(bufoff, gbase, voff) do { _Pragma("unroll") for (int _i = 0; _i < 2; ++_i) \
        __builtin_amdgcn_global_load_lds((const unsigned*)((const char*)(gbase) + (voff)[_i]), (PG8_LAS unsigned*)(lds + (bufoff) + ldsw + _i * 8192), 16, 0, 0); } while (0)
#define PG8_LDA(dst, b, h) do { _Pragma("unroll") for (int m = 0; m < 4; ++m) _Pragma("unroll") for (int k = 0; k < 2; ++k) dst[m][k] = *(const PG8_LAS bf16x8*)(lds + PG8_SA(b, h) + aoff + m * 2048 + k * 1024); } while (0)
#define PG8_LDB(dst, b, h) do { _Pragma("unroll") for (int n = 0; n < 2; ++n) _Pragma("unroll") for (int k = 0; k < 2; ++k) dst[n][k] = *(const PG8_LAS bf16x8*)(lds + PG8_SB(b, h) + boff + n * 2048 + k * 1024); } while (0)
#define PG8_MMA(ai, bj, At, Bt) do { __builtin_amdgcn_s_setprio(1); _Pragma("unroll") for (int m = 0; m < 4; ++m) _Pragma("unroll") for (int n = 0; n < 2; ++n) _Pragma("unroll") for (int k = 0; k < 2; ++k) \
        acc[ai][bj][m][n] = __builtin_amdgcn_mfma_f32_16x16x32_bf16(Bt[n][k], At[m][k], acc[ai][bj][m][n], 0, 0, 0); __builtin_amdgcn_s_setprio(0); } while (0)
#define PG8_WAIT_V(n) asm volatile("s_waitcnt vmcnt(" #n ")" ::: "memory")
#define PG8_WAIT_L(n) asm volatile("s_waitcnt lgkmcnt(" #n ")" ::: "memory")
#define PG8_BAR __builtin_amdgcn_s_barrier()
#define PG8_SCHED __builtin_amdgcn_sched_barrier(0)
    Unit cur, nxt; int ui = 0;
    if (!S.next(0, cur)) return;
    f32x4 acc[2][2][4][2];
#pragma unroll
    for (int a = 0; a < 2; ++a)
#pragma unroll
        for (int b = 0; b < 2; ++b)
#pragma unroll
            for (int m = 0; m < 4; ++m)
#pragma unroll
                for (int n = 0; n < 2; ++n) acc[a][b][m][n] = (f32x4){0.f, 0.f, 0.f, 0.f};
    bf16x8 At[4][2], B0[2][2], B1[2][2];
    const char* cA = (const char*)g.A + (size_t)cur.pm * tstep; const char* cB = (const char*)g.Bt + (size_t)cur.pn * tstep;
    S.a_ready(cur);
    PG8_STAGE(PG8_SB(0, 0), cB, voffB); PG8_STAGE(PG8_SA(0, 0), cA, voffA); PG8_STAGE(PG8_SB(0, 1), cB + hstep, voffB); PG8_STAGE(PG8_SA(0, 1), cA + hstep, voffA);
    if (wr == 1) PG8_BAR;
    PG8_WAIT_V(4); PG8_BAR;
    PG8_STAGE(PG8_SB(1, 0), cB + kstep, voffB); PG8_STAGE(PG8_SA(1, 0), cA + kstep, voffA); PG8_STAGE(PG8_SB(1, 1), cB + hstep + kstep, voffB);
    PG8_WAIT_V(6); PG8_BAR;
    PG8_STAMP();
    for (;;) {
        const bool has_next = S.next(ui + 1, nxt);
        const char* nA = has_next ? (const char*)g.A + (size_t)nxt.pm * tstep : cA; const char* nB = has_next ? (const char*)g.Bt + (size_t)nxt.pn * tstep : cB;
        for (int t = 0; t < nt; t += 2) {
            const bool last = (t == nt - 2);
            const char* a1 = cA + (size_t)(t + 1) * kstep;
            const char* a2 = last ? nA : cA + (size_t)(t + 2) * kstep; const char* b2 = last ? nB : cB + (size_t)(t + 2) * kstep;
            const char* a3 = a2 + kstep; const char* b3 = b2 + kstep;
            if (last && has_next) S.a_ready(nxt);
            PG8_LDB(B0, 0, 0); PG8_SCHED; PG8_LDA(At, 0, 0); PG8_STAGE(PG8_SA(1, 1), a1 + hstep, voffA);
            PG8_WAIT_L(8); PG8_BAR; PG8_WAIT_L(0); PG8_MMA(0, 0, At, B0); PG8_BAR; PG8_SCHED;
            PG8_LDB(B1, 0, 1); PG8_STAGE(PG8_SB(0, 0), b2, voffB);
            PG8_BAR; PG8_WAIT_L(0); PG8_MMA(0, 1, At, B1); PG8_BAR;
            PG8_LDA(At, 0, 1); PG8_STAGE(PG8_SA(0, 0), a2, voffA);
            PG8_BAR; PG8_WAIT_L(0); PG8_MMA(1, 0, At, B0); PG8_BAR; PG8_SCHED;
            PG8_STAGE(PG8_SB(0, 1), b2 + hstep, voffB);
            PG8_WAIT_V(6); PG8_BAR; PG8_MMA(1, 1, At, B1); PG8_BAR;
            PG8_LDB(B0, 1, 0); PG8_SCHED; PG8_LDA(At, 1, 0); PG8_STAGE(PG8_SA(0, 1), a2 + hstep, voffA);
            PG8_WAIT_L(8); PG8_BAR; PG8_WAIT_L(0); PG8_MMA(0, 0, At, B0); PG8_BAR; PG8_SCHED;
            PG8_LDB(B1, 1, 1); PG8_STAGE(PG8_SB(1, 0), b3, voffB);
            PG8_BAR; PG8_WAIT_L(0); PG8_MMA(0, 1, At, B1); PG8_BAR;
            PG8_LDA(At, 1, 1); PG8_STAGE(PG8_SA(1, 0), a3, voffA);
            PG8_BAR; PG8_WAIT_L(0); PG8_MMA(1, 0, At, B0); PG8_BAR; PG8_SCHED;
            PG8_STAGE(PG8_SB(1, 1), b3 + hstep, voffB);
            PG8_WAIT_V(6); PG8_BAR; PG8_MMA(1, 1, At, B1); PG8_BAR;
        }
        PG8_STAMP();
        if constexpr (!Epi::AFTER_DRAIN) { E(acc, cur, wr, wc, fr, fq); S.done(cur); }
        PG8_STAMP();
        if (!has_next) break;
#pragma unroll
        for (int a = 0; a < 2; ++a)
#pragma unroll
            for (int b = 0; b < 2; ++b)
#pragma unroll
                for (int m = 0; m < 4; ++m)
#pragma unroll
                    for (int n = 0; n < 2; ++n) acc[a][b][m][n] = (f32x4){0.f, 0.f, 0.f, 0.f};
        cur = nxt; cA = nA; cB = nB; ++ui;
    }
    PG8_WAIT_V(0);
    if (wr == 0) PG8_BAR;
    PG8_BAR;
    if constexpr (Epi::AFTER_DRAIN) { E.fused(acc, cur, wr, wc, fr, fq, lds, wid, lane); S.done(cur); }
    PG8_STAMP();
    if (STAMP && wid == 0) { stamps[lane] = lane < nts ? (((unsigned long long)(unsigned)ts_hi << 32) | (unsigned)ts_lo) : 0ull;
        if (lane == 62) stamps[62] = rt_entry; if (lane == 63) stamps[63] = (unsigned long long)wall_clock64(); }
#undef PG8_STAMP
#undef PG8_SA
#undef PG8_SB
#undef PG8_STAGE
#undef PG8_LDA
#undef PG8_LDB
#undef PG8_MMA
#undef PG8_WAIT_V
#undef PG8_WAIT_L
#undef PG8_BAR
#undef PG8_SCHED
}
}
#define XB_TMO      128
#define XB_XCNT(j)  (256  + 64 * (j))
#define XB_XSUB(j)  (1280 + 64 * (j))
#define XB_XGEN(j)  (2304 + 64 * (j))
#define XB_TOP      3328
#define XB_TOPGEN   3392
#define XCD_BAR_WORDS 3456
#define XB_SPIN_CAP (1u << 18)
#define LAS __attribute__((address_space(3)))

__device__ __forceinline__ unsigned xb_ld(unsigned* p)              { return __hip_atomic_load(p, __ATOMIC_RELAXED, __HIP_MEMORY_SCOPE_AGENT); }
__device__ __forceinline__ unsigned xb_add(unsigned* p, unsigned v) { return __hip_atomic_fetch_add(p, v, __ATOMIC_RELAXED, __HIP_MEMORY_SCOPE_AGENT); }
__device__ __forceinline__ unsigned xb_xcc_id() { return (unsigned)__builtin_amdgcn_s_getreg((3 << 11) | 20) & 0xFu; }
#define XB_SPIN(cond, bar) do { unsigned _sp = 0; while (cond) { __builtin_amdgcn_s_sleep(1); \
    if ((++_sp & 255u) == 0u) { if (xb_ld(&(bar)[XB_TMO])) break; if (_sp > XB_SPIN_CAP) { atomicAdd(&(bar)[XB_TMO], 1u); break; } } } } while (0)

struct XcdBarrier {
    unsigned* bar; unsigned x;
    volatile LAS unsigned* st;
};

__device__ __forceinline__ XcdBarrier xcd_barrier_post(unsigned* bar, volatile LAS unsigned* st) {
    XcdBarrier b; b.bar = bar; b.x = xb_xcc_id(); b.st = st;
    if (threadIdx.x == 0) (void)xb_add(&bar[XB_XCNT(b.x)], 1u);
    return b;
}
__device__ __forceinline__ void xcd_barrier_complete(unsigned* bar, unsigned x, unsigned& nloc, unsigned& nx) {
    const unsigned G = gridDim.x * gridDim.y * gridDim.z;
    unsigned sum, cnt, mine, sp = 0u;
    for (;;) {
        sum = 0u; cnt = 0u; mine = 0u;
#pragma unroll
        for (unsigned j = 0; j < 16; ++j) { const unsigned c = xb_ld(&bar[XB_XCNT(j)]); sum += c; cnt += (c > 0u) ? 1u : 0u; mine = (j == x) ? c : mine; }
        if (sum == G) break;
        __builtin_amdgcn_s_sleep(1);
        if ((++sp & 255u) == 0u) { if (xb_ld(&bar[XB_TMO])) break; if (sp > XB_SPIN_CAP) { atomicAdd(&bar[XB_TMO], 1u); break; } }
    }
    nloc = mine > 0u ? mine : 1u; nx = cnt > 0u ? cnt : 1u;
}

__device__ __forceinline__ void xcd_barrier(const XcdBarrier& b) {
    asm volatile("s_waitcnt vmcnt(0)" ::: "memory");
    __syncthreads();
    if (threadIdx.x == 0) {
        unsigned* bar = b.bar;
        __builtin_amdgcn_s_waitcnt(0);
        unsigned nloc = b.st[0], nx = b.st[1];
        if (nloc == 0u) { xcd_barrier_complete(bar, b.x, nloc, nx); b.st[0] = nloc; b.st[1] = nx; }
        const unsigned old = xb_add(&bar[XB_XSUB(b.x)], 1u);
        const unsigned gen = old / nloc;
        if (old + 1u == (gen + 1u) * nloc) {
            __builtin_amdgcn_fence(__ATOMIC_RELEASE, "agent");
            asm volatile("s_waitcnt vmcnt(0)" ::: "memory");
            const unsigned og = xb_add(&bar[XB_TOP], 1u);
            const unsigned tg = og / nx;
            if (og + 1u == (tg + 1u) * nx) xb_add(&bar[XB_TOPGEN], 1u);
            else XB_SPIN(xb_ld(&bar[XB_TOPGEN]) == tg, bar);
            __builtin_amdgcn_fence(__ATOMIC_ACQUIRE, "agent");
            xb_add(&bar[XB_XGEN(b.x)], 1u);
            asm volatile("s_waitcnt vmcnt(0)" ::: "memory");
        } else {
            XB_SPIN(xb_ld(&bar[XB_XGEN(b.x)]) == gen, bar);
            __builtin_amdgcn_fence(__ATOMIC_ACQUIRE, "agent");
            asm volatile("s_waitcnt vmcnt(0)" ::: "memory");
        }
    }
    __syncthreads();
}
__host__ __device__ __forceinline__ int ikiw_src(int c) {
    if (c < 32) return 8192 + c;
    if (c < 40) return 8256 + (c - 32);
    if (c >= 128 && c < 160) return 8192 + 32 + (c - 128);
    return -1;
}
__host__ __device__ __forceinline__ int ik_tilecol(int e) { return e < 32 ? e : 128 + (e - 32); }
__device__ __forceinline__ int src_col(int mode, int n) {
    if (mode == 0) return n;
    if (mode == 1) { if (n < 8192) return n; if (n < 8448) return ikiw_src(n - 8192); return 8264 + (n - 8448); }
    const int pn = n >> 8, c = n & 255; return c < 128 ? pn * 128 + c : D_FF + pn * 128 + (c - 128);
}
__device__ __forceinline__ void prep_weight_tile(const float* __restrict__ w, int ldw, const float* __restrict__ scale, bf16_t* __restrict__ Wt, int K, int mode, int tile, float* lds  ) {
    const int ktiles = K / 32, nt = tile / ktiles, kt = tile % ktiles, tid = threadIdx.x & 255;
    const int n0 = nt * 64, k0 = kt * 32;
    {   const int nn = tid & 63, kk0 = tid >> 6; const int sc = src_col(mode, n0 + nn);
#pragma unroll
        for (int i = 0; i < 8; ++i) { const int kk = kk0 + i * 4; float v = 0.f; if (sc >= 0) { v = w[(size_t)(k0 + kk) * ldw + sc]; if (scale) v *= scale[k0 + kk]; } lds[kk * 65 + nn] = v; } }
    __syncthreads();
    {   const int kk = tid & 31, nn0 = tid >> 5;
#pragma unroll
        for (int i = 0; i < 8; ++i) { const int nn = nn0 + i * 8; Wt[(size_t)(n0 + nn) * K + k0 + kk] = f2bf(lds[kk * 65 + nn]); } }
    __syncthreads();
}
__device__ __forceinline__ const float* h_row_ptr(int r, const float* xp, const float* xs, const float* meta) {
    if (r < T_PROMPT) { const int b = r / LP, l = r % LP; return l < N_META ? meta + (size_t)l * D_MODEL : xp + ((size_t)b * SEQ + (l - N_META)) * D_MODEL; }
    return xs + (size_t)(r - T_PROMPT) * D_MODEL;
}
__device__ __forceinline__ void prep_row(int r, const float* xp, const float* xs, const float* meta, bf16_t* A0, float* rstd0, int lane) {
    if (r >= T_ALL) { for (int i = lane; i < D_MODEL / 2; i += 64) ((unsigned*)(A0 + (size_t)r * D_MODEL))[i] = 0u; if (lane == 0) rstd0[r] = 0.f; return; }
    const float4* src = (const float4*)h_row_ptr(r, xp, xs, meta); float ss = 0.f;
#pragma unroll
    for (int i = 0; i < 4; ++i) { const float4 v = src[lane + i * 64]; ss += v.x * v.x + v.y * v.y + v.z * v.z + v.w * v.w;
        uint2 o; o.x = (unsigned)f2bf(v.x) | ((unsigned)f2bf(v.y) << 16); o.y = (unsigned)f2bf(v.z) | ((unsigned)f2bf(v.w) << 16);
        ((uint2*)(A0 + (size_t)r * D_MODEL))[lane + i * 64] = o; }
#pragma unroll
    for (int o = 32; o >= 1; o >>= 1) ss += __shfl_xor(ss, o);
    if (lane == 0) rstd0[r] = rsqrtf(ss * (1.0f / D_MODEL) + NORM_EPS);
}
__device__ __forceinline__ void rope_entry(int idx, float2* tab) {
    const int pos = idx >> 7, i = idx & 127;
    const float inv = exp2f(-(float)i * (13.287712379549449f / 128.0f));
    const float angf = (float)pos * inv; const double a = (double)angf;
    const double kq = rint(a * 0.63661977236758134308);
    double r = fma(-kq, 1.57079632679489655800e+00, a); r = fma(-kq, 6.12323399573676603587e-17, r);
    const double r2 = r * r;
    const double sp = r * (1.0 + r2 * (-1.0 / 6 + r2 * (1.0 / 120 + r2 * (-1.0 / 5040 + r2 * (1.0 / 362880 + r2 * (-1.0 / 39916800 + r2 * (1.0 / 6227020800.0)))))));
    const double cp = 1.0 + r2 * (-0.5 + r2 * (1.0 / 24 + r2 * (-1.0 / 720 + r2 * (1.0 / 40320 + r2 * (-1.0 / 3628800 + r2 * (1.0 / 479001600 + r2 * (-1.0 / 87178291200.0)))))));
    const int q = ((int)kq) & 3;
    const double sv = (q == 0) ? sp : (q == 1) ? cp : (q == 2) ? -sp : -cp;
    const double cv = (q == 0) ? cp : (q == 1) ? -sp : (q == 2) ? -cp : sp;
    tab[idx] = make_float2((float)cv, (float)sv);
}

struct PrepArgs {
    const float *x_prompt, *x_sample, *meta, *norm_mix_w, *w_in, *w_ret, *w_dsa, *w_out, *norm_ffn_w, *w_ffi, *w_ffo;
    bf16_t *W1t, *Wret, *Wdsa, *Wout, *Wffi, *Wffo, *A0; float* rstd0; float2* rope;
};
#define PREP_J_W1   0
#define PREP_N_W1   ((N1 / 64) * (1024 / 32))
#define PREP_J_WRET (PREP_J_W1 + PREP_N_W1)
#define PREP_N_WRET ((1024 / 64) * (2048 / 32))
#define PREP_J_WDSA (PREP_J_WRET + PREP_N_WRET)
#define PREP_N_WDSA ((1024 / 64) * (1024 / 32))
#define PREP_J_WOUT (PREP_J_WDSA + PREP_N_WDSA)
#define PREP_N_WOUT ((1024 / 64) * (1024 / 32))
#define PREP_J_WFFI (PREP_J_WOUT + PREP_N_WOUT)
#define PREP_N_WFFI ((NFF2 / 64) * (1024 / 32))
#define PREP_J_WFFO (PREP_J_WFFI + PREP_N_WFFI)
#define PREP_N_WFFO ((1024 / 64) * (2816 / 32))
#define PREP_J_ROWS (PREP_J_WFFO + PREP_N_WFFO)
#define PREP_N_ROWS (T_PAD / 4)
#define PREP_J_ROPE (PREP_J_ROWS + PREP_N_ROWS)
#define PREP_N_ROPE ((LP * 128) / 256)
#define PREP_N_JOBS (PREP_J_ROPE + PREP_N_ROPE)
__device__ __forceinline__ void prep_job(const PrepArgs& a, int job, float* lds) {
    if (job < PREP_J_WRET)      prep_weight_tile(a.w_in, IN_COLS, a.norm_mix_w, a.W1t, 1024, 1, job - PREP_J_W1, lds);
    else if (job < PREP_J_WDSA) prep_weight_tile(a.w_ret, 1024, nullptr, a.Wret, 2048, 0, job - PREP_J_WRET, lds);
    else if (job < PREP_J_WOUT) prep_weight_tile(a.w_dsa, 1024, nullptr, a.Wdsa, 1024, 0, job - PREP_J_WDSA, lds);
    else if (job < PREP_J_WFFI) prep_weight_tile(a.w_out, 1024, nullptr, a.Wout, 1024, 0, job - PREP_J_WOUT, lds);
    else if (job < PREP_J_WFFO) prep_weight_tile(a.w_ffi, 2 * D_FF, a.norm_ffn_w, a.Wffi, 1024, 2, job - PREP_J_WFFI, lds);
    else if (job < PREP_J_ROWS) prep_weight_tile(a.w_ffo, 1024, nullptr, a.Wffo, 2816, 0, job - PREP_J_WFFO, lds);
    else if (job < PREP_J_ROPE) prep_row((job - PREP_J_ROWS) * 4 + ((threadIdx.x & 255) >> 6), a.x_prompt, a.x_sample, a.meta, a.A0, a.rstd0, threadIdx.x & 63);
    else rope_entry((job - PREP_J_ROPE) * 256 + (threadIdx.x & 255), a.rope);
}
namespace att {
using bf16x8 = __attribute__((ext_vector_type(8))) short;
using s16x4  = __attribute__((ext_vector_type(4))) short;
using f32x16 = __attribute__((ext_vector_type(16))) float;
using f32x8  = __attribute__((ext_vector_type(8))) float;
using u32x4  = __attribute__((ext_vector_type(4))) unsigned;
constexpr float SCALE = 0.088388347648318440f;
constexpr float THR = 8.f;
constexpr float NEG = -3.0e38f;
constexpr int SHM_V = 64 * 128 * 2, SHM_K = 64 * 128 * 2;
#define ATT_KSWZ(row, colB) ((row) * 256 + ((colB) ^ (((row) & 7) << 4)))
#define ATT_SBAR() __builtin_amdgcn_sched_barrier(0)
__device__ __forceinline__ int crow(int r, int hi) { return (r & 3) + 8 * (r >> 2) + 4 * hi; }
__device__ __forceinline__ unsigned cvtpk(float lo, float hi) { unsigned r; asm volatile("v_cvt_pk_bf16_f32 %0, %1, %2" : "=v"(r) : "v"(lo), "v"(hi)); return r; }
__device__ __forceinline__ bf16x8 tobf(f32x8 x) { u32x4 w = {cvtpk(x[0], x[1]), cvtpk(x[2], x[3]), cvtpk(x[4], x[5]), cvtpk(x[6], x[7])}; return *reinterpret_cast<bf16x8*>(&w); }
__device__ __forceinline__ bf16x8 tobf(bf16x8 x) { return x; }

__device__ __forceinline__ void apply_mask(f32x16& p0, f32x16& p1, u64 mk, int hi) {
    const unsigned lo = (unsigned)mk >> (4 * hi), hw = (unsigned)(mk >> 32) >> (4 * hi);
#pragma unroll
    for (int r = 0; r < 16; ++r) { const unsigned bit = 1u << ((r & 3) + 8 * (r >> 2)); p0[r] = (lo & bit) ? p0[r] : NEG; p1[r] = (hw & bit) ? p1[r] : NEG; }
}
__device__ __forceinline__ void partialSM(f32x16& p0, f32x16& p1, float& m_reg, float& mn, float& alpha) {
    constexpr float C = SCALE * 1.4426950408889634f;
    float pmax = p0[0];
#pragma unroll
    for (int r = 1; r < 16; ++r) pmax = fmaxf(pmax, p0[r]);
#pragma unroll
    for (int r = 0; r < 16; ++r) pmax = fmaxf(pmax, p1[r]);
    { auto rr = __builtin_amdgcn_permlane32_swap(__float_as_uint(pmax), __float_as_uint(pmax), false, false);
      pmax = fmaxf(__uint_as_float(rr[0]), __uint_as_float(rr[1])); }
    if (__builtin_expect(__all(pmax - m_reg <= THR / SCALE), 1)) { mn = m_reg; alpha = 1.f; }
    else { mn = fmaxf(m_reg, pmax); alpha = __builtin_amdgcn_exp2f((m_reg - mn) * C); m_reg = mn; }
    const float mnC = -mn * C;
#pragma unroll
    for (int r = 0; r < 16; ++r) p0[r] = fmaf(p0[r], C, mnC);
#pragma unroll
    for (int r = 0; r < 16; ++r) p1[r] = fmaf(p1[r], C, mnC);
#pragma unroll
    for (int r = 0; r < 16; ++r) p0[r] = __builtin_amdgcn_exp2f(p0[r]);
}
__device__ __forceinline__ void finishSM(f32x16& p0, f32x16& p1, float alpha, float& l_reg, bf16x8& pa0, bf16x8& pa1, bf16x8& pa2, bf16x8& pa3) {
#pragma unroll
    for (int r = 0; r < 16; ++r) p1[r] = __builtin_amdgcn_exp2f(p1[r]);
    float ps = 0;
#pragma unroll
    for (int r = 0; r < 16; ++r) ps += p0[r];
#pragma unroll
    for (int r = 0; r < 16; ++r) ps += p1[r];
    { auto rr = __builtin_amdgcn_permlane32_swap(__float_as_uint(ps), __float_as_uint(ps), false, false);
      ps = __uint_as_float(rr[0]) + __uint_as_float(rr[1]); }
    l_reg = l_reg * alpha + ps;
#define ATT_PK4(P, BASE, OUT) do { unsigned a0 = cvtpk(P[BASE + 0], P[BASE + 1]), a1 = cvtpk(P[BASE + 2], P[BASE + 3]);   \
    unsigned b0 = cvtpk(P[BASE + 4], P[BASE + 5]), b1 = cvtpk(P[BASE + 6], P[BASE + 7]);                              \
    auto r0 = __builtin_amdgcn_permlane32_swap(a0, b0, false, false); auto r1 = __builtin_amdgcn_permlane32_swap(a1, b1, false, false); \
    u32x4 w = {r0[0], r1[0], r0[1], r1[1]}; OUT = *reinterpret_cast<bf16x8*>(&w); } while (0)
    ATT_PK4(p0, 0, pa0); ATT_PK4(p0, 8, pa1); ATT_PK4(p1, 0, pa2); ATT_PK4(p1, 8, pa3);
#undef ATT_PK4
}
__device__ __forceinline__ void qkt(f32x16& p0, f32x16& p1, const char* Ks, const bf16x8* qr, int r32, int hi) {
    p0 = f32x16{}; p1 = f32x16{};
#pragma unroll
    for (int d0 = 0; d0 < 8; ++d0) { const int cb = (d0 * 16 + hi * 8) * 2;
        const bf16x8 b0 = *reinterpret_cast<const bf16x8*>(Ks + ATT_KSWZ(r32, cb));
        const bf16x8 b1 = *reinterpret_cast<const bf16x8*>(Ks + ATT_KSWZ(32 + r32, cb));
        p0 = __builtin_amdgcn_mfma_f32_32x32x16_bf16(b0, qr[d0], p0, 0, 0, 0);
        p1 = __builtin_amdgcn_mfma_f32_32x32x16_bf16(b1, qr[d0], p1, 0, 0, 0); }
}
__device__ __forceinline__ int v_st(int k, int c) { const int kk = (k & ~0xC) | ((k & 4) << 1) | ((k & 8) >> 1); return ((kk >> 3) * 4 + (c >> 5)) * 512 + ((kk & 7) * 32 + (c & 31)) * 2; }
__device__ __forceinline__ int v_rd_base(int lane) { return ((lane & 3) << 3) | (((lane >> 2) & 3) << 6) | (((lane >> 4) & 1) << 5) | (((lane >> 5) & 1) << 8); }
constexpr int v_rd_off(int d0, int ks, int half) { return d0 * 512 + ks * 4096 + half * 2048; }
template <int OFF> __device__ __forceinline__ s16x4 tr_read(int vb) { s16x4 r; asm volatile("ds_read_b64_tr_b16 %0, %1 offset:%2" : "=&v"(r) : "v"(vb), "i"(OFF) : "memory"); return r; }
template <int D0> __device__ __forceinline__ void pv_one(f32x16& od, int vb, bf16x8 pa0, bf16x8 pa1, bf16x8 pa2, bf16x8 pa3) {
    const s16x4 l0 = tr_read<v_rd_off(D0, 0, 0)>(vb), h0 = tr_read<v_rd_off(D0, 0, 1)>(vb), l1 = tr_read<v_rd_off(D0, 1, 0)>(vb), h1 = tr_read<v_rd_off(D0, 1, 1)>(vb);
    const s16x4 l2 = tr_read<v_rd_off(D0, 2, 0)>(vb), h2 = tr_read<v_rd_off(D0, 2, 1)>(vb), l3 = tr_read<v_rd_off(D0, 3, 0)>(vb), h3 = tr_read<v_rd_off(D0, 3, 1)>(vb);
    asm volatile("s_waitcnt lgkmcnt(0)" ::: "memory"); ATT_SBAR();
#define ATT_PK(L, H) (bf16x8){L[0], L[1], L[2], L[3], H[0], H[1], H[2], H[3]}
    od = __builtin_amdgcn_mfma_f32_32x32x16_bf16(pa0, ATT_PK(l0, h0), od, 0, 0, 0);
    od = __builtin_amdgcn_mfma_f32_32x32x16_bf16(pa1, ATT_PK(l1, h1), od, 0, 0, 0);
    od = __builtin_amdgcn_mfma_f32_32x32x16_bf16(pa2, ATT_PK(l2, h2), od, 0, 0, 0);
    od = __builtin_amdgcn_mfma_f32_32x32x16_bf16(pa3, ATT_PK(l3, h3), od, 0, 0, 0);
#undef ATT_PK
}
__device__ __forceinline__ void pv_d0(f32x16* o, int vb, bf16x8 pa0, bf16x8 pa1, bf16x8 pa2, bf16x8 pa3) {
    pv_one<0>(o[0], vb, pa0, pa1, pa2, pa3); pv_one<1>(o[1], vb, pa0, pa1, pa2, pa3); pv_one<2>(o[2], vb, pa0, pa1, pa2, pa3); pv_one<3>(o[3], vb, pa0, pa1, pa2, pa3);
}

struct KvPrompt {
    using T = bf16x8; const bf16_t* K; const bf16_t* V;
    __device__ __forceinline__ T ldk(int key, int col) const { return *reinterpret_cast<const bf16x8*>(K + (size_t)key * 256 + col); }
    __device__ __forceinline__ T ldv(int key, int col) const { return *reinterpret_cast<const bf16x8*>(V + (size_t)key * 256 + col); }
};
struct KvSample {
    using T = f32x8; const float* ck; const float* cv; const float* kn; const float* vn; const int* pages  ; int n;
    __device__ __forceinline__ size_t roff(int key) const { return (((size_t)pages[key >> 7] * PAGE_SIZE + (key & 127)) * N_KV + n) * 128; }
    __device__ __forceinline__ T ldk(int key, int col) const { const float* p = key < PAST_LEN ? ck + roff(key) : kn + (size_t)min(key - PAST_LEN, DEC_SEQ - 1) * 256; return *reinterpret_cast<const f32x8*>(p + col); }
    __device__ __forceinline__ T ldv(int key, int col) const { const float* p = key < PAST_LEN ? cv + roff(key) : vn + (size_t)min(key - PAST_LEN, DEC_SEQ - 1) * 256; return *reinterpret_cast<const f32x8*>(p + col); }
};

template <class KV>
__device__ __forceinline__ void attn_unit(const KV kv, const bf16_t* __restrict__ Aq, const u64* __restrict__ mask, bf16_t* __restrict__ Odsa, int tok0, int nq_valid, int hd0, int NT, char* lds) {
    int tid_l = threadIdx.x; asm volatile("" : "+v"(tid_l));
    const int tid = tid_l, wid = tid >> 6, lane = tid & 63, r32 = lane & 31, hi = lane >> 5;
    char* V_lds = lds; char* K_lds = lds + 2 * SHM_V;
    float* wsx = (float*)(lds + 2 * SHM_V + 2 * SHM_K) + wid * 64; float* li_l = wsx; float* al_l = wsx + 32;
    float m_reg = -1e30f, l_reg = 0; f32x16 o[4] = {}; bf16x8 qr[8];
    const int mytok = tok0 + 8 * wid + (r32 >> 2);
    { const bf16_t* Qw = Aq + (size_t)mytok * 1024 + (hd0 + (r32 & 3)) * 128 + hi * 8;
#pragma unroll
      for (int d0 = 0; d0 < 8; ++d0) qr[d0] = *reinterpret_cast<const bf16x8*>(Qw + d0 * 16); }
    const u64* mrow = mask + (size_t)mytok * MASK_WORDS;
    const int sr = tid >> 4, sc = (tid & 15) * 8, vst0 = v_st(sr, sc), vst1 = v_st(32 + sr, sc);
    const int vbase = (int)(uintptr_t)(PG8_LAS char*)V_lds + v_rd_base(lane);
    typename KV::T vs0, vs1, ks0, ks1;
#define ATT_SLOAD(k0) do { vs0 = kv.ldv((k0) + sr, sc); vs1 = kv.ldv((k0) + 32 + sr, sc); ks0 = kv.ldk((k0) + sr, sc); ks1 = kv.ldk((k0) + 32 + sr, sc); } while (0)
#define ATT_SWRITE(b) do { *(bf16x8*)(V_lds + (b) * SHM_V + vst0) = tobf(vs0); *(bf16x8*)(V_lds + (b) * SHM_V + vst1) = tobf(vs1); const int kc = sc * 2; \
    *(bf16x8*)(K_lds + (b) * SHM_K + ATT_KSWZ(sr, kc)) = tobf(ks0); *(bf16x8*)(K_lds + (b) * SHM_K + ATT_KSWZ(32 + sr, kc)) = tobf(ks1); } while (0)
    __syncthreads();
    ATT_SLOAD(0); ATT_SWRITE(0); __syncthreads();
    for (int j = 0; j < NT; ++j) {
        const int b = j & 1;
        const u64 mk = mrow[j];
        if (j + 1 < NT) ATT_SLOAD((j + 1) * 64);
        f32x16 p0, p1; float mn, alpha; bf16x8 pa0, pa1, pa2, pa3;
        ATT_SBAR(); qkt(p0, p1, K_lds + b * SHM_K, qr, r32, hi); apply_mask(p0, p1, mk, hi);
        partialSM(p0, p1, m_reg, mn, alpha);
        if (__any(alpha < 1.f)) { if (hi == 0) al_l[r32] = alpha; asm volatile("s_waitcnt lgkmcnt(0)" ::: "memory");
#pragma unroll
            for (int d = 0; d < 4; ++d)
#pragma unroll
                for (int r = 0; r < 16; ++r) o[d][r] *= al_l[crow(r, hi)]; }
        finishSM(p0, p1, alpha, l_reg, pa0, pa1, pa2, pa3); ATT_SBAR();
        pv_d0(o, vbase + b * SHM_V, pa0, pa1, pa2, pa3);
        if (j + 1 < NT) ATT_SWRITE(b ^ 1);
        __syncthreads();
    }
    if (hi == 0) li_l[r32] = l_reg; asm volatile("s_waitcnt lgkmcnt(0)" ::: "memory");
#pragma unroll
    for (int r = 0; r < 16; ++r) { const int orow = crow(r, hi); const float rli = __builtin_amdgcn_rcpf(li_l[orow]);
        const int q = 8 * wid + (orow >> 2);
        if (q < nq_valid) { bf16_t* Ow = Odsa + (size_t)(tok0 + q) * 1024 + (hd0 + (orow & 3)) * 128 + r32;
#pragma unroll
            for (int d0 = 0; d0 < 4; ++d0) Ow[d0 * 32] = f2bf(o[d0][r] * rli); } }
#undef ATT_SLOAD
#undef ATT_SWRITE
}
}
struct MegaArgs {
    PrepArgs prep;
    const float *cache_k, *cache_v, *cache_kidx, *state_ret; const int* page_table;
    const float *qnw, *knw, *ikw, *ikb;
    bf16_t *Rq, *Rk, *Rv, *G, *Aq, *Kb, *Vb, *Iq, *Ikb, *Gates, *OG, *An, *Odsa, *Mg, *A2, *Hid;
    float *Iw, *ssret, *rstd2, *Z, *M1, *M2, *H2, *Zf, *out;
    u64* mask; unsigned* bar;
};

__device__ __forceinline__ void epi1_row(const MegaArgs& a, int r, int t) {
    const int lane = t & 63;
    const float* z = a.Z + (size_t)r * N1; const float rs = a.prep.rstd0[r]; const int pos = row_pos(r); const float2* rope = a.prep.rope;
    for (int which = 0; which < 2; ++which) {
        bf16_t* dst = (which ? a.Rk : a.Rq) + (size_t)r * 1024; const float post = which ? 0.0625f : 1.0f; const int zo = which * 1024;
        for (int e = t; e < 512; e += 256) { const int hh = e >> 7, i = e & 127; const float2 cs = rope[pos * 128 + i];
            const float x1 = z[zo + hh * 256 + i] * rs, x2 = z[zo + hh * 256 + 128 + i] * rs;
            dst[hh * 256 + i] = f2bf((x1 * cs.x - x2 * cs.y) * post); dst[hh * 256 + 128 + i] = f2bf((x1 * cs.y + x2 * cs.x) * post); }
    }
    for (int c = t; c < 2048; c += 256) { a.Rv[(size_t)r * 2048 + c] = f2bf(z[2048 + c] * rs); a.G[(size_t)r * 2048 + c] = f2bf(silu_f(z[4096 + c] * rs)); }
    {   const int c0 = t * 4; float v[4]; float ss = 0.f;
#pragma unroll
        for (int j = 0; j < 4; ++j) { v[j] = z[6144 + c0 + j] * rs; ss += v[j] * v[j]; }
#pragma unroll
        for (int o = 16; o >= 1; o >>= 1) ss += __shfl_xor(ss, o);
        const float rn = rsqrtf(ss * (1.0f / 128.0f) + NORM_EPS);
#pragma unroll
        for (int j = 0; j < 4; ++j) a.Aq[(size_t)r * 1024 + c0 + j] = f2bf(v[j] * rn * a.qnw[(c0 + j) & 127]); }
    float* kout = a.out + (r < T_PROMPT ? (size_t)O_K_P + (size_t)r * 256 : (size_t)O_K_S + (size_t)(r - T_PROMPT) * 256);
    float* vout = a.out + (r < T_PROMPT ? (size_t)O_V_P + (size_t)r * 256 : (size_t)O_V_S + (size_t)(r - T_PROMPT) * 256);
    float* kiout = a.out + (r < T_PROMPT ? (size_t)O_KI_P + (size_t)r * 64 : (size_t)O_KI_S + (size_t)(r - T_PROMPT) * 64);
    if (t < 64) { const int c0 = t * 4; float v[4]; float ss = 0.f;
#pragma unroll
        for (int j = 0; j < 4; ++j) { v[j] = z[7168 + c0 + j] * rs; ss += v[j] * v[j]; }
#pragma unroll
        for (int o = 16; o >= 1; o >>= 1) ss += __shfl_xor(ss, o);
        const float rn = rsqrtf(ss * (1.0f / 128.0f) + NORM_EPS);
#pragma unroll
        for (int j = 0; j < 4; ++j) { const float y = v[j] * rn * a.knw[(c0 + j) & 127]; kout[c0 + j] = y; a.Kb[(size_t)r * 256 + c0 + j] = f2bf(y); }
#pragma unroll
        for (int j = 0; j < 4; ++j) { const float y = z[7424 + c0 + j] * rs; vout[c0 + j] = y; a.Vb[(size_t)r * 256 + c0 + j] = f2bf(y); } }
    for (int c = t; c < 512; c += 256) a.Iq[(size_t)r * 512 + c] = f2bf(z[7680 + c] * rs);
    if (t >= 64 && t < 128) { const float x = z[8192 + ik_tilecol(lane)] * rs; float s = x;
#pragma unroll
        for (int o = 32; o >= 1; o >>= 1) s += __shfl_xor(s, o);
        const float mu = s * (1.0f / 64.0f), d = x - mu; float q = d * d;
#pragma unroll
        for (int o = 32; o >= 1; o >>= 1) q += __shfl_xor(q, o);
        const float y = d * rsqrtf(q * (1.0f / 64.0f) + NORM_EPS) * a.ikw[lane] + a.ikb[lane];
        kiout[lane] = y; a.Ikb[(size_t)r * 64 + lane] = f2bf(y); }
    if (t >= 128 && t < 136) a.Iw[(size_t)r * 8 + (t - 128)] = z[8192 + 32 + (t - 128)] * rs * IDX_SCALE;
    for (int c = t; c < 2048; c += 256) a.Gates[(size_t)r * 2048 + c] = f2bf(sigmoid_f(z[8448 + c] * rs));
}

__device__ __forceinline__ void ret_naive_unit(const MegaArgs& a, int unit8, int sample, float* lds) {
    float* qk = lds; float* part = lds + 512;
    const int unit = unit8 >> 3, slice = unit8 & 7, t = threadIdx.x, dke = t >> 6, dv = t & 63;
    const int bb = unit >> 2, h = unit & 3;
    const int row0 = sample ? T_PROMPT + bb * DEC_SEQ : bb * LP, ntok = sample ? DEC_SEQ : LP;
    const float gamma = 1.0f - exp2f(-5.0f - (float)h);
    float S[32];
    const size_t sbase = ((size_t)bb * H_RET + h) * (DK_RET * DV_RET) + slice * 64 + dv;
#pragma unroll
    for (int i = 0; i < 32; ++i) S[i] = sample ? a.state_ret[sbase + (size_t)(dke * 32 + i) * DV_RET] : 0.f;
    for (int tok = 0; tok < ntok; ++tok) {
        const int r = row0 + tok;
        __syncthreads();
        qk[t] = bf2f(t < 256 ? a.Rq[(size_t)r * 1024 + h * 256 + t] : a.Rk[(size_t)r * 1024 + h * 256 + (t - 256)]);
        __syncthreads();
        const float v = bf2f(a.Rv[(size_t)r * 2048 + h * 512 + slice * 64 + dv]); float o = 0.f;
#pragma unroll
        for (int i = 0; i < 32; ++i) { const float kq_ = qk[256 + dke * 32 + i], qq = qk[dke * 32 + i]; S[i] = fmaf(S[i], gamma, kq_ * v); o = fmaf(qq, S[i], o); }
        part[dke * 64 + dv] = o;
        __syncthreads();
        if (dke == 0) { float ot = 0.f;
#pragma unroll
            for (int e = 0; e < 8; ++e) ot += part[e * 64 + dv];
            float ss = ot * ot;
#pragma unroll
            for (int of = 32; of >= 1; of >>= 1) ss += __shfl_xor(ss, of);
            const size_t ci = (size_t)r * 2048 + h * 512 + slice * 64 + dv;
            a.OG[ci] = f2bf(ot * bf2f(a.G[ci]));
            if (dv == 0) a.ssret[(size_t)r * 32 + h * 8 + slice] = ss; }
    }
    float* so = a.out + (sample ? (size_t)O_R_S : (size_t)O_R_P) + sbase;
#pragma unroll
    for (int i = 0; i < 32; ++i) so[(size_t)(dke * 32 + i) * DV_RET] = S[i];
    __syncthreads();
}

__device__ __forceinline__ unsigned f2ord(float f) { const unsigned u = __float_as_uint(f); return (u & 0x80000000u) ? ~u : (u | 0x80000000u); }
__device__ __forceinline__ void topk_naive_row(const MegaArgs& a, int r, float* lds) {
    float* q = lds; float* w = lds + 512; unsigned* sc = (unsigned*)(lds + 520); unsigned* red = sc + 2560; unsigned* mw = red + 512;
    const int t = threadIdx.x;
    const bool smp = r >= T_PROMPT; const int b = smp ? (r - T_PROMPT) >> 3 : r / LP, pos = row_pos(r);
    const int N = pos + 1;
    __syncthreads();
    q[t] = bf2f(a.Iq[(size_t)r * 512 + t]); if (t < 8) w[t] = a.Iw[(size_t)r * 8 + t];
    if (t < MASK_WORDS * 2) mw[t] = 0u;
    __syncthreads();
    for (int s = t; s < 2560; s += 512) {
        unsigned ord = 0u;
        if (s < N) { float k[64];
            if (!smp) { const bf16_t* kp = a.Ikb + ((size_t)b * LP + s) * 64;
#pragma unroll
                for (int d = 0; d < 64; ++d) k[d] = bf2f(kp[d]); }
            else if (s < PAST_LEN) { const float* kp = a.cache_kidx + ((size_t)a.page_table[b * N_PAGES + (s >> 7)] * PAGE_SIZE + (s & 127)) * 64;
#pragma unroll
                for (int d = 0; d < 64; ++d) k[d] = bf2f(f2bf(kp[d])); }
            else { const bf16_t* kp = a.Ikb + ((size_t)T_PROMPT + b * DEC_SEQ + (s - PAST_LEN)) * 64;
#pragma unroll
                for (int d = 0; d < 64; ++d) k[d] = bf2f(kp[d]); }
            float tot = 0.f;
            for (int hh = 0; hh < 8; ++hh) { float dsum = 0.f;
#pragma unroll
                for (int d = 0; d < 64; ++d) dsum = fmaf(q[hh * 64 + d], k[d], dsum);
                tot = fmaf(w[hh], fmaxf(dsum, 0.f), tot); }
            ord = f2ord(tot); }
        sc[s] = ord;
    }
    __syncthreads();
    unsigned mine[5];
#pragma unroll
    for (int i = 0; i < 5; ++i) mine[i] = sc[t * 5 + i];
    unsigned tau = 0u, r_ties = 0u;
    if (N > TOPK) {
        for (int bit = 31; bit >= 0; --bit) { const unsigned cand = tau | (1u << bit); unsigned c = 0;
#pragma unroll
            for (int i = 0; i < 5; ++i) c += (mine[i] >= cand) ? 1u : 0u;
#pragma unroll
            for (int o = 32; o >= 1; o >>= 1) c += __shfl_xor(c, o);
            __syncthreads(); if ((t & 63) == 0) red[t >> 6] = c; __syncthreads();
            unsigned tot = 0;
#pragma unroll
            for (int e = 0; e < 8; ++e) tot += red[e];
            if (tot >= TOPK) tau = cand; }
        unsigned cg = 0;
#pragma unroll
        for (int i = 0; i < 5; ++i) cg += (mine[i] > tau) ? 1u : 0u;
#pragma unroll
        for (int o = 32; o >= 1; o >>= 1) cg += __shfl_xor(cg, o);
        __syncthreads(); if ((t & 63) == 0) red[t >> 6] = cg; __syncthreads();
        unsigned tot = 0;
#pragma unroll
        for (int e = 0; e < 8; ++e) tot += red[e];
        r_ties = TOPK - tot;
    }
    unsigned ce = 0;
#pragma unroll
    for (int i = 0; i < 5; ++i) ce += (mine[i] == tau) ? 1u : 0u;
    __syncthreads(); red[t] = ce; __syncthreads();
    unsigned rank = 0; for (int i = 0; i < t; ++i) rank += red[i];
#pragma unroll
    for (int i = 0; i < 5; ++i) { const int s = t * 5 + i; bool sel;
        if (N <= TOPK) sel = s < N;
        else { sel = mine[i] > tau; if (mine[i] == tau) { sel = rank < r_ties; ++rank; } }
        if (sel) atomicOr(&mw[s >> 5], 1u << (s & 31)); }
    __syncthreads();
    if (t < MASK_WORDS) a.mask[(size_t)r * MASK_WORDS + t] = (u64)mw[2 * t] | ((u64)mw[2 * t + 1] << 32);
}

__device__ __forceinline__ void make_an_row(const MegaArgs& a, int r, int lane) {
    for (int c = lane; c < 2048; c += 64) { const int h = c >> 9; float ss = 0.f;
#pragma unroll
        for (int s = 0; s < 8; ++s) ss += a.ssret[(size_t)r * 32 + h * 8 + s];
        a.An[(size_t)r * 2048 + c] = f2bf(bf2f(a.OG[(size_t)r * 2048 + c]) * rsqrtf(ss * (1.0f / 512.0f) + NORM_EPS)); }
}
__device__ __forceinline__ void merge_row(const MegaArgs& a, int r, int lane) {
    for (int c = lane; c < 1024; c += 64) a.Mg[(size_t)r * 1024 + c] = f2bf(bf2f(a.Gates[(size_t)r * 2048 + c]) * a.M1[(size_t)r * 1024 + c] + bf2f(a.Gates[(size_t)r * 2048 + 1024 + c]) * a.M2[(size_t)r * 1024 + c]);
}
__device__ __forceinline__ void h2_row(const MegaArgs& a, int r, int lane) {
    const float* h = h_row_ptr(r, a.prep.x_prompt, a.prep.x_sample, a.prep.meta); float ss = 0.f;
    for (int c = lane; c < 1024; c += 64) { const float v = h[c] + a.M1[(size_t)r * 1024 + c]; a.H2[(size_t)r * 1024 + c] = v; a.A2[(size_t)r * 1024 + c] = f2bf(v); ss += v * v; }
#pragma unroll
    for (int o = 32; o >= 1; o >>= 1) ss += __shfl_xor(ss, o);
    if (lane == 0) a.rstd2[r] = rsqrtf(ss * (1.0f / 1024.0f) + NORM_EPS);
}
__device__ __forceinline__ void hid_row(const MegaArgs& a, int r, int lane) {
    const float rs = a.rstd2[r];
    for (int u = lane; u < D_FF; u += 64) { const int pn = u >> 7, c = u & 127; const float av = a.Zf[(size_t)r * NFF2 + pn * 256 + c] * rs, bv = a.Zf[(size_t)r * NFF2 + pn * 256 + 128 + c] * rs;
        a.Hid[(size_t)r * D_FF + u] = f2bf(silu_f(av) * bv); }
}
__device__ __forceinline__ void yout_row(const MegaArgs& a, int r, int lane) {
    float* dst;
    if (r < T_PROMPT) { const int b = r / LP, l = r % LP; if (l < N_META) return; dst = a.out + O_Y_P + ((size_t)b * SEQ + (l - N_META)) * 1024; }
    else dst = a.out + O_Y_S + (size_t)(r - T_PROMPT) * 1024;
    for (int c = lane; c < 1024; c += 64) dst[c] = a.H2[(size_t)r * 1024 + c] + a.M1[(size_t)r * 1024 + c];
}

#define ATT_N_PROMPT_UNITS (BATCH * N_KV * 33)
__device__ __forceinline__ void attn_prompt_unit(const MegaArgs& a, int idx, char* lds) {
    const int qb = 32 - idx / 16, bn = idx % 16, b = bn >> 1, n = bn & 1;
    const int tok0 = b * LP + 64 * qb, nq = (LP - 64 * qb) < 64 ? (LP - 64 * qb) : 64;
    const int NT = qb + 1;
    att::KvPrompt kv{a.Kb + (size_t)b * LP * 256 + n * 128, a.Vb + (size_t)b * LP * 256 + n * 128};
    att::attn_unit<att::KvPrompt>(kv, a.Aq, a.mask, a.Odsa, tok0, nq, 4 * n, NT, lds);
}
__device__ __forceinline__ void attn_sample_unit(const MegaArgs& a, int u, char* lds) {
    const int db = u >> 1, n = u & 1;
    int* pages = (int*)(lds + 2 * att::SHM_V + 2 * att::SHM_K + 2048);
    __syncthreads();
    if (threadIdx.x < N_PAGES) pages[threadIdx.x] = a.page_table[db * N_PAGES + threadIdx.x];
    __syncthreads();
    att::KvSample kv{a.cache_k, a.cache_v, a.out + O_K_S + (size_t)db * DEC_SEQ * 256 + n * 128, a.out + O_V_S + (size_t)db * DEC_SEQ * 256 + n * 128, pages, n};
    att::attn_unit<att::KvSample>(kv, a.Aq, a.mask, a.Odsa, T_PROMPT + db * DEC_SEQ, DEC_SEQ, 4 * n, 33, lds);
}

#define LDS_TOTAL (pg8::STAGE_BYTES + 1024)
__global__ void __launch_bounds__(512, 2) mega(MegaArgs a) {
    extern __shared__ __attribute__((aligned(16))) unsigned char shm[];
    float* lds = (float*)shm;
    volatile LAS unsigned* xbw = (volatile LAS unsigned*)(PG8_LAS unsigned char*)(shm + pg8::STAGE_BYTES);
    const int tid = threadIdx.x, wave = tid >> 6, lane = tid & 63, half = tid >> 8, G = gridDim.x, bid = blockIdx.x;
    if (tid == 0) { xbw[0] = 0u; xbw[1] = 0u; xbw[2] = 0u; xbw[3] = 0u; }
    __syncthreads();
    XcdBarrier bar = xcd_barrier_post(a.bar, xbw);
    for (int jp = bid; jp < PREP_J_ROWS / 2; jp += G) prep_job(a.prep, 2 * jp + half, lds + half * (32 * 65));
    for (int j = PREP_J_ROWS + bid * 2 + half; j < PREP_N_JOBS; j += 2 * G) prep_job(a.prep, j, lds);
    xcd_barrier(bar);
    { pg8::StaticOrder S; S.init(T_PAD, N1, G, bid); pg8::gemm_phase<pg8::EpiF32, pg8::StaticOrder, false>((PG8_LAS unsigned char*)shm, pg8::Gemm{a.prep.A0, a.prep.W1t, T_PAD, N1, 1024}, S, pg8::EpiF32{a.Z, N1, nullptr}, nullptr); }
    xcd_barrier(bar);
    for (int rp = bid; rp < T_ALL / 2; rp += G) epi1_row(a, 2 * rp + half, tid & 255);
    xcd_barrier(bar);
    for (int u = bid; u < BATCH * H_RET * 8; u += G) ret_naive_unit(a, u, 0, lds);
    for (int u = bid; u < DEC_BATCH * H_RET * 8; u += G) ret_naive_unit(a, u, 1, lds);
    for (int r = bid; r < T_ALL; r += G) topk_naive_row(a, r, lds);
    xcd_barrier(bar);
    for (int i = 0; ; ++i) { const long p = (long)i * G + ((i & 1) ? (G - 1 - bid) : bid); if (p >= ATT_N_PROMPT_UNITS) { if ((long)i * G >= ATT_N_PROMPT_UNITS) break; else continue; } attn_prompt_unit(a, (int)p, (char*)shm); }
    for (int u = bid; u < DEC_BATCH * N_KV; u += G) attn_sample_unit(a, u, (char*)shm);
    for (int r = bid * 8 + wave; r < T_ALL; r += 8 * G) make_an_row(a, r, lane);
    xcd_barrier(bar);
    { pg8::StaticOrder S; S.init(T_PAD, 1024, G, bid); pg8::gemm_phase<pg8::EpiF32, pg8::StaticOrder, false>((PG8_LAS unsigned char*)shm, pg8::Gemm{a.An, a.prep.Wret, T_PAD, 1024, 2048}, S, pg8::EpiF32{a.M1, 1024, nullptr}, nullptr); }
    { pg8::StaticOrder S; S.init(T_PAD, 1024, G, bid); pg8::gemm_phase<pg8::EpiF32, pg8::StaticOrder, false>((PG8_LAS unsigned char*)shm, pg8::Gemm{a.Odsa, a.prep.Wdsa, T_PAD, 1024, 1024}, S, pg8::EpiF32{a.M2, 1024, nullptr}, nullptr); }
    xcd_barrier(bar);
    for (int r = bid * 8 + wave; r < T_ALL; r += 8 * G) merge_row(a, r, lane);
    xcd_barrier(bar);
    { pg8::StaticOrder S; S.init(T_PAD, 1024, G, bid); pg8::gemm_phase<pg8::EpiF32, pg8::StaticOrder, false>((PG8_LAS unsigned char*)shm, pg8::Gemm{a.Mg, a.prep.Wout, T_PAD, 1024, 1024}, S, pg8::EpiF32{a.M1, 1024, nullptr}, nullptr); }
    xcd_barrier(bar);
    for (int r = bid * 8 + wave; r < T_ALL; r += 8 * G) h2_row(a, r, lane);
    xcd_barrier(bar);
    { pg8::StaticOrder S; S.init(T_PAD, NFF2, G, bid); pg8::gemm_phase<pg8::EpiF32, pg8::StaticOrder, false>((PG8_LAS unsigned char*)shm, pg8::Gemm{a.A2, a.prep.Wffi, T_PAD, NFF2, 1024}, S, pg8::EpiF32{a.Zf, NFF2, nullptr}, nullptr); }
    xcd_barrier(bar);
    for (int r = bid * 8 + wave; r < T_ALL; r += 8 * G) hid_row(a, r, lane);
    xcd_barrier(bar);
    { pg8::StaticOrder S; S.init(T_PAD, 1024, G, bid); pg8::gemm_phase<pg8::EpiF32, pg8::StaticOrder, false>((PG8_LAS unsigned char*)shm, pg8::Gemm{a.Hid, a.prep.Wffo, T_PAD, 1024, 2816}, S, pg8::EpiF32{a.M1, 1024, nullptr}, nullptr); }
    xcd_barrier(bar);
    for (int r = bid * 8 + wave; r < T_ALL; r += 8 * G) yout_row(a, r, lane);
}
extern "C" void kernel_launch(void* const* d_in, const int* in_sizes, int n_in, void* d_out, int out_size, void* d_ws, size_t ws_size, hipStream_t stream) {
    static int grid = 0;
    if (grid == 0) {
        if (n_in != 20 || out_size != OUT_TOTAL || ws_size < WS_END_B1 || ws_size < WS_END_B2) { fprintf(stderr, "kernel_launch: unexpected shapes (n_in %d out %d ws %zu need %llu)\n", n_in, out_size, ws_size, (unsigned long long)WS_END_B1); grid = -1; return; }
        int dev = 0, cus = 0, per_cu = 0;
        if (hipGetDevice(&dev) != hipSuccess || hipDeviceGetAttribute(&cus, hipDeviceAttributeMultiprocessorCount, dev) != hipSuccess) { grid = -1; return; }
        if (hipFuncSetAttribute((const void*)mega, hipFuncAttributeMaxDynamicSharedMemorySize, LDS_TOTAL) != hipSuccess) { fprintf(stderr, "kernel_launch: hipFuncSetAttribute failed\n"); grid = -1; return; }
        if (hipOccupancyMaxActiveBlocksPerMultiprocessor(&per_cu, (const void*)mega, 512, LDS_TOTAL) != hipSuccess || per_cu < 1) { fprintf(stderr, "kernel_launch: occupancy query says %d blocks per CU\n", per_cu); grid = -1; return; }
        grid = cus;
    }
    if (grid < 0) return;
    char* ws = (char*)d_ws;
    MegaArgs a{};
    a.prep.x_prompt = (const float*)d_in[0]; a.prep.x_sample = (const float*)d_in[1]; a.prep.meta = (const float*)d_in[7]; a.prep.norm_mix_w = (const float*)d_in[8]; a.prep.w_in = (const float*)d_in[9];
    a.prep.w_ret = (const float*)d_in[10]; a.prep.w_dsa = (const float*)d_in[15]; a.prep.w_out = (const float*)d_in[16]; a.prep.norm_ffn_w = (const float*)d_in[17]; a.prep.w_ffi = (const float*)d_in[18]; a.prep.w_ffo = (const float*)d_in[19];
    a.prep.W1t = (bf16_t*)(ws + WS_W1T); a.prep.Wret = (bf16_t*)(ws + WS_WRET); a.prep.Wdsa = (bf16_t*)(ws + WS_WDSA); a.prep.Wout = (bf16_t*)(ws + WS_WOUT); a.prep.Wffi = (bf16_t*)(ws + WS_WFFI); a.prep.Wffo = (bf16_t*)(ws + WS_WFFO);
    a.prep.A0 = (bf16_t*)(ws + WS_A0); a.prep.rstd0 = (float*)(ws + WS_RSTD0); a.prep.rope = (float2*)(ws + WS_ROPE);
    a.cache_k = (const float*)d_in[2]; a.cache_v = (const float*)d_in[3]; a.cache_kidx = (const float*)d_in[4]; a.state_ret = (const float*)d_in[5]; a.page_table = (const int*)d_in[6];
    a.qnw = (const float*)d_in[11]; a.knw = (const float*)d_in[12]; a.ikw = (const float*)d_in[13]; a.ikb = (const float*)d_in[14];
    a.Rq = (bf16_t*)(ws + WS_RQ); a.Rk = (bf16_t*)(ws + WS_RK); a.Rv = (bf16_t*)(ws + WS_RV); a.G = (bf16_t*)(ws + WS_G); a.Aq = (bf16_t*)(ws + WS_AQ); a.Kb = (bf16_t*)(ws + WS_KB); a.Vb = (bf16_t*)(ws + WS_VB);
    a.Iq = (bf16_t*)(ws + WS_IQ); a.Ikb = (bf16_t*)(ws + WS_IKB); a.Gates = (bf16_t*)(ws + WS_GATES); a.OG = (bf16_t*)(ws + WS_OG); a.An = (bf16_t*)(ws + WS_AN); a.Odsa = (bf16_t*)(ws + WS_ODSA); a.Mg = (bf16_t*)(ws + WS_MG);
    a.A2 = (bf16_t*)(ws + WS_A2); a.Hid = (bf16_t*)(ws + WS_HID);
    a.Iw = (float*)(ws + WS_IW); a.ssret = (float*)(ws + WS_SSRET); a.rstd2 = (float*)(ws + WS_RSTD2); a.Z = (float*)(ws + WS_Z); a.M1 = (float*)(ws + WS_M1); a.M2 = (float*)(ws + WS_M2); a.H2 = (float*)(ws + WS_H2); a.Zf = (float*)(ws + WS_ZF);
    a.out = (float*)d_out; a.mask = (u64*)(ws + WS_MASK); a.bar = (unsigned*)(ws + WS_CTL);
    if (hipMemsetAsync(ws + WS_CTL, 0, 65536, stream) != hipSuccess) return;
    hipLaunchKernelGGL(mega, dim3(grid), dim3(512), LDS_TOTAL, stream, a);
}
```

```cpp
#include <hip/hip_runtime.h>
#include <stdint.h>
#include <stdio.h>

#define D_MODEL 1024
#define BATCH 8
#define SEQ 2048
#define N_META 16
#define LP (N_META + SEQ)
#define DEC_BATCH 128
#define DEC_SEQ 8
#define PAST_LEN 2048
#define PAGE_SIZE 128
#define N_PAGES 16
#define H_RET 4
#define DK_RET 256
#define DV_RET 512
#define N_HEADS 8
#define N_KV 2
#define D_HEAD 128
#define N_IDXH 8
#define D_IDX 64
#define TOPK 256
#define D_FF 2816
#define IN_COLS 10312
#define NORM_EPS 1e-6f
#define IDX_SCALE 0.04419417382415922f
#define T_PROMPT (BATCH * LP)
#define T_SAMPLE (DEC_BATCH * DEC_SEQ)
#define T_ALL (T_PROMPT + T_SAMPLE)
#define T_PAD 17664
#define N1 10496
#define NFF2 5632
#define MASK_WORDS 34
#define SAMPLE_L (PAST_LEN + DEC_SEQ)

#define O_Y_P   0
#define O_Y_S   16777216
#define O_K_P   17825792
#define O_V_P   22052864
#define O_KI_P  26279936
#define O_R_P   27336704
#define O_K_S   31531008
#define O_V_S   31793152
#define O_KI_S  32055296
#define O_R_S   32120832
#define OUT_TOTAL 99229696

typedef unsigned short bf16_t;
typedef unsigned long long u64;

__device__ __forceinline__ bf16_t f2bf(float f) { unsigned u = __float_as_uint(f); u += 0x7FFFu + ((u >> 16) & 1u); return (bf16_t)(u >> 16); }
__device__ __forceinline__ float bf2f(bf16_t b) { return __uint_as_float(((unsigned)b) << 16); }
__device__ __forceinline__ float silu_f(float x) { return x / (1.0f + __expf(-x)); }
__device__ __forceinline__ float sigmoid_f(float x) { return 1.0f / (1.0f + __expf(-x)); }

__device__ __forceinline__ int row_pos(int r) { return r < T_PROMPT ? (r % LP) : (PAST_LEN + ((r - T_PROMPT) & (DEC_SEQ - 1))); }

#define WS_CTL      0ull
#define WS_W1T      (WS_CTL + 65536ull)
#define WS_WRET     (WS_W1T + (u64)N1 * 1024 * 2)
#define WS_WDSA     (WS_WRET + 1024ull * 2048 * 2)
#define WS_WOUT     (WS_WDSA + 1024ull * 1024 * 2)
#define WS_WFFI     (WS_WOUT + 1024ull * 1024 * 2)
#define WS_WFFO     (WS_WFFI + (u64)NFF2 * 1024 * 2)
#define WS_ROPE     (WS_WFFO + 1024ull * 2816 * 2)
#define WS_RSTD0    (WS_ROPE + (u64)LP * 128 * 8)
#define WS_A0       (WS_RSTD0 + (u64)T_PAD * 4)
#define WS_RQ       (WS_A0 + (u64)T_PAD * 1024 * 2)
#define WS_RK       (WS_RQ + (u64)T_PAD * 1024 * 2)
#define WS_RV       (WS_RK + (u64)T_PAD * 1024 * 2)
#define WS_G        (WS_RV + (u64)T_PAD * 2048 * 2)
#define WS_AQ       (WS_G + (u64)T_PAD * 2048 * 2)
#define WS_KB       (WS_AQ + (u64)T_PAD * 1024 * 2)
#define WS_VB       (WS_KB + (u64)T_PAD * 256 * 2)
#define WS_IQ       (WS_VB + (u64)T_PAD * 256 * 2)
#define WS_IKB      (WS_IQ + (u64)T_PAD * 512 * 2)
#define WS_IW       (WS_IKB + (u64)T_PAD * 64 * 2)
#define WS_GATES    (WS_IW + (u64)T_PAD * 8 * 4)
#define WS_MASK     (WS_GATES + (u64)T_PAD * 2048 * 2)
#define WS_SSRET    (WS_MASK + (u64)T_PAD * MASK_WORDS * 8)
#define WS_RSTD2    (WS_SSRET + (u64)T_PAD * 32 * 4)
#define WS_REGION_B (((WS_RSTD2 + (u64)T_PAD * 16 * 4) + 4095ull) & ~4095ull)
#define WS_Z        WS_REGION_B
#define WS_H2       WS_REGION_B
#define WS_A2       (WS_H2 + (u64)T_PAD * 1024 * 4)
#define WS_HID      (WS_A2 + (u64)T_PAD * 1024 * 2)
#define WS_MG       (WS_HID + (u64)T_PAD * 2816 * 2)
#define WS_OG       (WS_MG + (u64)T_PAD * 1024 * 2)
#define WS_AN       (WS_OG + (u64)T_PAD * 2048 * 2)
#define WS_ODSA     (WS_AN + (u64)T_PAD * 2048 * 2)
#define WS_M1       (WS_ODSA + (u64)T_PAD * 1024 * 2)
#define WS_M2       (WS_M1 + (u64)T_PAD * 1024 * 4)
#define WS_ZF       WS_OG
#define WS_END_B1   (WS_Z + (u64)T_PAD * N1 * 4)
#define WS_END_B2   (WS_ZF + (u64)T_PAD * NFF2 * 4)
namespace pg8 {
#define PG8_LAS __attribute__((address_space(3)))
typedef unsigned short bf16_t;
typedef short bf16x8 __attribute__((ext_vector_type(8)));
typedef float f32x4 __attribute__((ext_vector_type(4)));
typedef unsigned u32x4 __attribute__((ext_vector_type(4)));
constexpr int BM = 256, BK = 64, HALF = 128, HTB = HALF * BK * 2  , STAGE_BYTES = 8 * HTB, NXCD = 8, WGM = 8;

__host__ __device__ __forceinline__ int lds_byte(int r, int c) { const int st = (r >> 4) * 2 + (c >> 5), rr = r & 15, cc = c & 31, ob = rr * 64 + cc * 2; return st * 1024 + (ob ^ (((ob >> 9) & 1) << 5)); }
__host__ __device__ __forceinline__ void stage_rc(int b, int& R, int& C) { const int st = b / 1024, sb = b % 1024, swz = sb ^ (((sb >> 9) & 1) << 5); R = (st >> 1) * 16 + swz / 64; C = (st & 1) * 32 + (swz % 64) / 2; }
__host__ __device__ __forceinline__ int perm32(int rho) { const int n = rho >> 4, i = rho & 15; return 8 * (i >> 2) + 4 * n + (i & 3); }

struct Unit { int pm, pn; };
struct Gemm { const bf16_t* A; const bf16_t* Bt; int M, N, K; };

struct StaticOrder {
    int nM, nN, nwg, G, c;
    __host__ __device__ void init(int M, int N, int G_, int c_) { nM = M / BM; nN = N / BM; nwg = nM * nN; G = G_; c = c_; }
    __host__ __device__ bool next(int i, Unit& u) const {
        const long L = (long)i * G + c; if (L >= nwg) return false;
        int wgid = (int)L; { const int q = nwg / NXCD, r = nwg % NXCD, xcd = wgid % NXCD, off = wgid / NXCD; wgid = (xcd < r ? xcd * (q + 1) : r * (q + 1) + (xcd - r) * q) + off; }
        const int nig = WGM * nN, gid = wgid / nig, fm = gid * WGM, gsz = (nM - fm) < WGM ? (nM - fm) : WGM;
        u.pm = fm + ((wgid % nig) % gsz); u.pn = (wgid % nig) / gsz; return true;
    }
    __device__ __forceinline__ void a_ready(const Unit&) const {}
    __device__ __forceinline__ void done(const Unit&) const {}
};
struct CountedOrder : StaticOrder {
    const unsigned* ready; unsigned need; unsigned* tmo;
    __device__ __forceinline__ void a_ready(const Unit& u) const {
        if (threadIdx.x < 64) {
            const unsigned long long t0 = __builtin_amdgcn_s_memrealtime(); unsigned polls = 0;
            while ((unsigned)__builtin_amdgcn_readfirstlane(__hip_atomic_load(ready + 64 * u.pm, __ATOMIC_RELAXED, __HIP_MEMORY_SCOPE_AGENT)) < need) {
                if ((++polls & 255u) == 0u && __builtin_amdgcn_readfirstlane(__hip_atomic_load(tmo, __ATOMIC_RELAXED, __HIP_MEMORY_SCOPE_AGENT)) != 0u) break;
                if (__builtin_amdgcn_s_memrealtime() - t0 > 2000000ull) {
                    if (threadIdx.x == 0) { unsigned expect = 0u; __hip_atomic_compare_exchange_strong(tmo + 1, &expect, 0x600u | (unsigned)(u.pm & 0xff), __ATOMIC_RELAXED, __ATOMIC_RELAXED, __HIP_MEMORY_SCOPE_AGENT); __hip_atomic_store(tmo, 1u, __ATOMIC_RELAXED, __HIP_MEMORY_SCOPE_AGENT); }
                    break; }
                __builtin_amdgcn_s_sleep(2); }
            __builtin_amdgcn_fence(__ATOMIC_ACQUIRE, "agent");
            asm volatile("s_waitcnt vmcnt(0)" ::: "memory");
        }
#if !defined(BROKEN_HOOK_NO_BARRIER)
        asm volatile("" ::: "memory"); __builtin_amdgcn_s_barrier(); asm volatile("" ::: "memory");
#endif
    }
};

__device__ __forceinline__ unsigned cvt_pk_bf16(float lo, float hi) { unsigned r; asm volatile("v_cvt_pk_bf16_f32 %0, %1, %2" : "=v"(r) : "v"(lo), "v"(hi)); return r; }
typedef float f32x2 __attribute__((ext_vector_type(2)));
__device__ __forceinline__ f32x2 gelu_pk(f32x2 v) {
    const f32x2 av = __builtin_elementwise_abs(v), d = av * 0.2316418882f + 1.0f;
    f32x2 t; t.x = __builtin_amdgcn_rcpf(d.x); t.y = __builtin_amdgcn_rcpf(d.y);
    f32x2 q = t * 0.5307027145f + (-0.7265760135f); q = q * t + 0.7107068705f; q = q * t + (-0.142248368f); q = q * t + 0.127414796f; q = q * t;
    const f32x2 s = (v * v) * (-0.72134752044f);
    f32x2 e; e.x = __builtin_amdgcn_exp2f(s.x); e.y = __builtin_amdgcn_exp2f(s.y);
    const f32x2 m = v * (q * e), r = v - m;
    f32x2 o; o.x = v.x < 0.f ? m.x : r.x; o.y = v.y < 0.f ? m.y : r.y; return o;
}

struct EpiF32 {
    static constexpr bool PERM = false, AFTER_DRAIN = false;
    float* C; int ldc; const float* bias;
    __device__ __forceinline__ void operator()(const f32x4 (&acc)[2][2][4][2], const Unit& u, int wr, int wc, int fr, int fq) const {
        const int row0 = u.pm * BM + wr * 64 + fr, col0 = u.pn * BM + wc * 32 + 4 * fq;
        f32x4 bv[2][2];
#pragma unroll
        for (int bj = 0; bj < 2; ++bj)
#pragma unroll
            for (int n = 0; n < 2; ++n) bv[bj][n] = bias ? *(const f32x4*)(bias + col0 + bj * HALF + n * 16) : (f32x4){0.f, 0.f, 0.f, 0.f};
#pragma unroll
        for (int ai = 0; ai < 2; ++ai)
#pragma unroll
            for (int m = 0; m < 4; ++m) { float* rowp = C + (size_t)(row0 + ai * HALF + m * 16) * ldc + col0;
#pragma unroll
                for (int bj = 0; bj < 2; ++bj)
#pragma unroll
                    for (int n = 0; n < 2; ++n) *(f32x4*)(rowp + bj * HALF + n * 16) = acc[ai][bj][m][n] + bv[bj][n]; }
    }
};
template <int ACT  > struct EpiBf16 {
    static constexpr bool PERM = true, AFTER_DRAIN = false;
    bf16_t* O; int ldc; const float* bias; int split_cols; size_t split_stride;
    __device__ __forceinline__ void operator()(const f32x4 (&acc)[2][2][4][2], const Unit& u, int wr, int wc, int fr, int fq) const {
        const int row0 = u.pm * BM + wr * 64 + fr; int colt = u.pn * BM; bf16_t* base = O;
        if (split_cols) { const int t = colt / split_cols; base += (size_t)t * split_stride; colt -= t * split_cols; }
        const int col0 = colt + wc * 32 + 8 * fq, bcol0 = u.pn * BM + wc * 32 + 8 * fq;
        f32x4 bv[2][2];
#pragma unroll
        for (int bj = 0; bj < 2; ++bj)
#pragma unroll
            for (int n = 0; n < 2; ++n) bv[bj][n] = bias ? *(const f32x4*)(bias + bcol0 + bj * HALF + 4 * n) : (f32x4){0.f, 0.f, 0.f, 0.f};
#pragma unroll
        for (int ai = 0; ai < 2; ++ai)
#pragma unroll
            for (int m = 0; m < 4; ++m) { bf16_t* rowp = base + (size_t)(row0 + ai * HALF + m * 16) * ldc + col0;
#pragma unroll
                for (int bj = 0; bj < 2; ++bj) { f32x4 v0 = acc[ai][bj][m][0] + bv[bj][0], v1 = acc[ai][bj][m][1] + bv[bj][1];
                    if (ACT == 1) { f32x2 a = gelu_pk((f32x2){v0[0], v0[1]}), b = gelu_pk((f32x2){v0[2], v0[3]}), c = gelu_pk((f32x2){v1[0], v1[1]}), d = gelu_pk((f32x2){v1[2], v1[3]});
                        v0 = (f32x4){a.x, a.y, b.x, b.y}; v1 = (f32x4){c.x, c.y, d.x, d.y}; }
                    if (ACT == 2) {
#pragma unroll
                        for (int j = 0; j < 4; ++j) { v0[j] = 0.5f * v0[j] * (1.0f + erff(v0[j] * 0.70710678f)); v1[j] = 0.5f * v1[j] * (1.0f + erff(v1[j] * 0.70710678f)); } }
                    u32x4 w; w.x = cvt_pk_bf16(v0[0], v0[1]); w.y = cvt_pk_bf16(v0[2], v0[3]); w.z = cvt_pk_bf16(v1[0], v1[1]); w.w = cvt_pk_bf16(v1[2], v1[3]);
                    *(u32x4*)(rowp + bj * HALF) = w; } }
    }
};
template <class Epi, class Sched, bool STAMP = false>
__device__ __forceinline__ void gemm_phase(PG8_LAS unsigned char* lds, const Gemm g, const Sched& S, const Epi& E, unsigned long long* stamps) {
    int tid_l = threadIdx.x; asm volatile("" : "+v"(tid_l));
    const int tid = tid_l, wid = __builtin_amdgcn_readfirstlane(tid >> 6), lane = tid & 63, wr = wid >> 2, wc = wid & 3, fr = lane & 15, fq = lane >> 4;
    const int K = g.K, nt = K / BK;
    int ts_lo = 0, ts_hi = 0, nts = 0; const unsigned long long rt_entry = STAMP ? (unsigned long long)wall_clock64() : 0ull;
#define PG8_STAMP() do { if (STAMP && wid == 0 && nts < 64) { const unsigned long long _c = (unsigned long long)clock64(); \
        ts_lo = (lane == nts) ? (int)(unsigned)_c : ts_lo; ts_hi = (lane == nts) ? (int)(unsigned)(_c >> 32) : ts_hi; ++nts; } } while (0)
    PG8_STAMP();
    unsigned voffA[2], voffB[2];
#pragma unroll
    for (int i = 0; i < 2; ++i) { int R, C; stage_rc(tid * 16 + i * 8192, R, C); const int Rb = Epi::PERM ? ((R & ~31) + perm32(R & 31)) : R;
        voffA[i] = (unsigned)(R * K + C) * 2u; voffB[i] = (unsigned)(Rb * K + C) * 2u; }
    const size_t kstep = (size_t)(BK * 2);
    const size_t hstep = (size_t)HALF * K * 2;
    const size_t tstep = 2 * hstep;
    const unsigned ldsw = (unsigned)wid * 1024u;
    const int aoff = lds_byte(wr * 64 + fr, fq * 8), boff = lds_byte(wc * 32 + fr, fq * 8);
#define PG8_SA(b, h) (((b) * 2 + (h)) * HTB)
#define PG8_SB(b, h) ((4 + (b) * 2 + (h)) * HTB)
#define PG8_STAGE(bufoff, gbase, voff) do { _Pragma("unroll") for (int _i = 0; _i < 2; ++_i) \
        __builtin_amdgcn_global_load_lds((const unsigned*)((const char*)(gbase) + (voff)[_i]), (PG8_LAS unsigned*)(lds + (bufoff) + ldsw + _i * 8192), 16, 0, 0); } while (0)
#define PG8_LDA(dst, b, h) do { _Pragma("unroll") for (int m = 0; m < 4; ++m) _Pragma("unroll") for (int k = 0; k < 2; ++k) dst[m][k] = *(const PG8_LAS bf16x8*)(lds + PG8_SA(b, h) + aoff + m * 2048 + k * 1024); } while (0)
#define PG8_LDB(dst, b, h) do { _Pragma("unroll") for (int n = 0; n < 2; ++n) _Pragma("unroll") for (int k = 0; k < 2; ++k) dst[n][k] = *(const PG8_LAS bf16x8*)(lds + PG8_SB(b, h) + boff + n * 2048 + k * 1024); } while (0)
#define PG8_MMA(ai, bj, At, Bt) do { __builtin_amdgcn_s_setprio(1); _Pragma("unroll") for (int m = 0; m < 4; ++m) _Pragma("unroll") for (int n = 0; n < 2; ++n) _Pragma("unroll") for (int k = 0; k < 2; ++k) \
        acc[ai][bj][m][n] = __builtin_amdgcn_mfma_f32_16x16x32_bf16(Bt[n][k], At[m][k], acc[ai][bj][m][n], 0, 0, 0); __builtin_amdgcn_s_setprio(0); } while (0)
#define PG8_WAIT_V(n) asm volatile("s_waitcnt vmcnt(" #n ")" ::: "memory")
#define PG8_WAIT_L(n) asm volatile("s_waitcnt lgkmcnt(" #n ")" ::: "memory")
#define PG8_BAR __builtin_amdgcn_s_barrier()
#define PG8_SCHED __builtin_amdgcn_sched_barrier(0)
    Unit cur, nxt; int ui = 0;
    if (!S.next(0, cur)) return;
    f32x4 acc[2][2][4][2];
#pragma unroll
    for (int a = 0; a < 2; ++a)
#pragma unroll
        for (int b = 0; b < 2; ++b)
#pragma unroll
            for (int m = 0; m < 4; ++m)
#pragma unroll
                for (int n = 0; n < 2; ++n) acc[a][b][m][n] = (f32x4){0.f, 0.f, 0.f, 0.f};
    bf16x8 At[4][2], B0[2][2], B1[2][2];
    const char* cA = (const char*)g.A + (size_t)cur.pm * tstep; const char* cB = (const char*)g.Bt + (size_t)cur.pn * tstep;
    S.a_ready(cur);
    PG8_STAGE(PG8_SB(0, 0), cB, voffB); PG8_STAGE(PG8_SA(0, 0), cA, voffA); PG8_STAGE(PG8_SB(0, 1), cB + hstep, voffB); PG8_STAGE(PG8_SA(0, 1), cA + hstep, voffA);
    if (wr == 1) PG8_BAR;
    PG8_WAIT_V(4); PG8_BAR;
    PG8_STAGE(PG8_SB(1, 0), cB + kstep, voffB); PG8_STAGE(PG8_SA(1, 0), cA + kstep, voffA); PG8_STAGE(PG8_SB(1, 1), cB + hstep + kstep, voffB);
    PG8_WAIT_V(6); PG8_BAR;
    PG8_STAMP();
    for (;;) {
        const bool has_next = S.next(ui + 1, nxt);
        const char* nA = has_next ? (const char*)g.A + (size_t)nxt.pm * tstep : cA; const char* nB = has_next ? (const char*)g.Bt + (size_t)nxt.pn * tstep : cB;
        for (int t = 0; t < nt; t += 2) {
            const bool last = (t == nt - 2);
            const char* a1 = cA + (size_t)(t + 1) * kstep;
            const char* a2 = last ? nA : cA + (size_t)(t + 2) * kstep; const char* b2 = last ? nB : cB + (size_t)(t + 2) * kstep;
            const char* a3 = a2 + kstep; const char* b3 = b2 + kstep;
            if (last && has_next) S.a_ready(nxt);
            PG8_LDB(B0, 0, 0); PG8_SCHED; PG8_LDA(At, 0, 0); PG8_STAGE(PG8_SA(1, 1), a1 + hstep, voffA);
            PG8_WAIT_L(8); PG8_BAR; PG8_WAIT_L(0); PG8_MMA(0, 0, At, B0); PG8_BAR; PG8_SCHED;
            PG8_LDB(B1, 0, 1); PG8_STAGE(PG8_SB(0, 0), b2, voffB);
            PG8_BAR; PG8_WAIT_L(0); PG8_MMA(0, 1, At, B1); PG8_BAR;
            PG8_LDA(At, 0, 1); PG8_STAGE(PG8_SA(0, 0), a2, voffA);
            PG8_BAR; PG8_WAIT_L(0); PG8_MMA(1, 0, At, B0); PG8_BAR; PG8_SCHED;
            PG8_STAGE(PG8_SB(0, 1), b2 + hstep, voffB);
            PG8_WAIT_V(6); PG8_BAR; PG8_MMA(1, 1, At, B1); PG8_BAR;
            PG8_LDB(B0, 1, 0); PG8_SCHED; PG8_LDA(At, 1, 0); PG8_STAGE(PG8_SA(0, 1), a2 + hstep, voffA);
            PG8_WAIT_L(8); PG8_BAR; PG8_WAIT_L(0); PG8_MMA(0, 0, At, B0); PG8_BAR; PG8_SCHED;
            PG8_LDB(B1, 1, 1); PG8_STAGE(PG8_SB(1, 0), b3, voffB);
            PG8_BAR; PG8_WAIT_L(0); PG8_MMA(0, 1, At, B1); PG8_BAR;
            PG8_LDA(At, 1, 1); PG8_STAGE(PG8_SA(1, 0), a3, voffA);
            PG8_BAR; PG8_WAIT_L(0); PG8_MMA(1, 0, At, B0); PG8_BAR; PG8_SCHED;
            PG8_STAGE(PG8_SB(1, 1), b3 + hstep, voffB);
            PG8_WAIT_V(6); PG8_BAR; PG8_MMA(1, 1, At, B1); PG8_BAR;
        }
        PG8_STAMP();
        if constexpr (!Epi::AFTER_DRAIN) { E(acc, cur, wr, wc, fr, fq); S.done(cur); }
        PG8_STAMP();
        if (!has_next) break;
#pragma unroll
        for (int a = 0; a < 2; ++a)
#pragma unroll
            for (int b = 0; b < 2; ++b)
#pragma unroll
                for (int m = 0; m < 4; ++m)
#pragma unroll
                    for (int n = 0; n < 2; ++n) acc[a][b][m][n] = (f32x4){0.f, 0.f, 0.f, 0.f};
        cur = nxt; cA = nA; cB = nB; ++ui;
    }
    PG8_WAIT_V(0);
    if (wr == 0) PG8_BAR;
    PG8_BAR;
    if constexpr (Epi::AFTER_DRAIN) { E.fused(acc, cur, wr, wc, fr, fq, lds, wid, lane); S.done(cur); }
    PG8_STAMP();
    if (STAMP && wid == 0) { stamps[lane] = lane < nts ? (((unsigned long long)(unsigned)ts_hi << 32) | (unsigned)ts_lo) : 0ull;
        if (lane == 62) stamps[62] = rt_entry; if (lane == 63) stamps[63] = (unsigned long long)wall_clock64(); }
#undef PG8_STAMP
#undef PG8_SA
#undef PG8_SB
#undef PG8_STAGE
#undef PG8_LDA
#undef PG8_LDB
#undef PG8_MMA
#undef PG8_WAIT_V
#undef PG8_WAIT_L
#undef PG8_BAR
#undef PG8_SCHED
}
}
#define XB_TMO      128
#define XB_XCNT(j)  (256  + 64 * (j))
#define XB_XSUB(j)  (1280 + 64 * (j))
#define XB_XGEN(j)  (2304 + 64 * (j))
#define XB_TOP      3328
#define XB_TOPGEN   3392
#define XCD_BAR_WORDS 3456
#define XB_SPIN_CAP (1u << 18)
#define LAS __attribute__((address_space(3)))

__device__ __forceinline__ unsigned xb_ld(unsigned* p)              { return __hip_atomic_load(p, __ATOMIC_RELAXED, __HIP_MEMORY_SCOPE_AGENT); }
__device__ __forceinline__ unsigned xb_add(unsigned* p, unsigned v) { return __hip_atomic_fetch_add(p, v, __ATOMIC_RELAXED, __HIP_MEMORY_SCOPE_AGENT); }
__device__ __forceinline__ unsigned xb_xcc_id() { return (unsigned)__builtin_amdgcn_s_getreg((3 << 11) | 20) & 0xFu; }
#define XB_SPIN(cond, bar) do { unsigned _sp = 0; while (cond) { __builtin_amdgcn_s_sleep(1); \
    if ((++_sp & 255u) == 0u) { if (xb_ld(&(bar)[XB_TMO])) break; if (_sp > XB_SPIN_CAP) { atomicAdd(&(bar)[XB_TMO], 1u); break; } } } } while (0)

struct XcdBarrier {
    unsigned* bar; unsigned x;
    volatile LAS unsigned* st;
};

__device__ __forceinline__ XcdBarrier xcd_barrier_post(unsigned* bar, volatile LAS unsigned* st) {
    XcdBarrier b; b.bar = bar; b.x = xb_xcc_id(); b.st = st;
    if (threadIdx.x == 0) (void)xb_add(&bar[XB_XCNT(b.x)], 1u);
    return b;
}
__device__ __forceinline__ void xcd_barrier_complete(unsigned* bar, unsigned x, unsigned& nloc, unsigned& nx) {
    const unsigned G = gridDim.x * gridDim.y * gridDim.z;
    unsigned sum, cnt, mine, sp = 0u;
    for (;;) {
        sum = 0u; cnt = 0u; mine = 0u;
#pragma unroll
        for (unsigned j = 0; j < 16; ++j) { const unsigned c = xb_ld(&bar[XB_XCNT(j)]); sum += c; cnt += (c > 0u) ? 1u : 0u; mine = (j == x) ? c : mine; }
        if (sum == G) break;
        __builtin_amdgcn_s_sleep(1);
        if ((++sp & 255u) == 0u) { if (xb_ld(&bar[XB_TMO])) break; if (sp > XB_SPIN_CAP) { atomicAdd(&bar[XB_TMO], 1u); break; } }
    }
    nloc = mine > 0u ? mine : 1u; nx = cnt > 0u ? cnt : 1u;
}

__device__ __forceinline__ void xcd_barrier(const XcdBarrier& b) {
    asm volatile("s_waitcnt vmcnt(0)" ::: "memory");
    __syncthreads();
    if (threadIdx.x == 0) {
        unsigned* bar = b.bar;
        __builtin_amdgcn_s_waitcnt(0);
        unsigned nloc = b.st[0], nx = b.st[1];
        if (nloc == 0u) { xcd_barrier_complete(bar, b.x, nloc, nx); b.st[0] = nloc; b.st[1] = nx; }
        const unsigned old = xb_add(&bar[XB_XSUB(b.x)], 1u);
        const unsigned gen = old / nloc;
        if (old + 1u == (gen + 1u) * nloc) {
            __builtin_amdgcn_fence(__ATOMIC_RELEASE, "agent");
            asm volatile("s_waitcnt vmcnt(0)" ::: "memory");
            const unsigned og = xb_add(&bar[XB_TOP], 1u);
            const unsigned tg = og / nx;
            if (og + 1u == (tg + 1u) * nx) xb_add(&bar[XB_TOPGEN], 1u);
            else XB_SPIN(xb_ld(&bar[XB_TOPGEN]) == tg, bar);
            __builtin_amdgcn_fence(__ATOMIC_ACQUIRE, "agent");
            xb_add(&bar[XB_XGEN(b.x)], 1u);
            asm volatile("s_waitcnt vmcnt(0)" ::: "memory");
        } else {
            XB_SPIN(xb_ld(&bar[XB_XGEN(b.x)]) == gen, bar);
            __builtin_amdgcn_fence(__ATOMIC_ACQUIRE, "agent");
            asm volatile("s_waitcnt vmcnt(0)" ::: "memory");
        }
    }
    __syncthreads();
}
__host__ __device__ __forceinline__ int ikiw_src(int c) {
    if (c < 32) return 8192 + c;
    if (c < 40) return 8256 + (c - 32);
    if (c >= 128 && c < 160) return 8192 + 32 + (c - 128);
    return -1;
}
__host__ __device__ __forceinline__ int ik_tilecol(int e) { return e < 32 ? e : 128 + (e - 32); }
__device__ __forceinline__ int src_col(int mode, int n) {
    if (mode == 0) return n;
    if (mode == 1) { if (n < 8192) return n; if (n < 8448) return ikiw_src(n - 8192); return 8264 + (n - 8448); }
    const int pn = n >> 8, c = n & 255; return c < 128 ? pn * 128 + c : D_FF + pn * 128 + (c - 128);
}
__device__ __forceinline__ void prep_weight_tile(const float* __restrict__ w, int ldw, const float* __restrict__ scale, bf16_t* __restrict__ Wt, int K, int mode, int tile, float* lds  ) {
    const int ktiles = K / 32, nt = tile / ktiles, kt = tile % ktiles, tid = threadIdx.x & 255;
    const int n0 = nt * 64, k0 = kt * 32;
    {   const int nn = tid & 63, kk0 = tid >> 6; const int sc = src_col(mode, n0 + nn);
#pragma unroll
        for (int i = 0; i < 8; ++i) { const int kk = kk0 + i * 4; float v = 0.f; if (sc >= 0) { v = w[(size_t)(k0 + kk) * ldw + sc]; if (scale) v *= scale[k0 + kk]; } lds[kk * 65 + nn] = v; } }
    __syncthreads();
    {   const int kk = tid & 31, nn0 = tid >> 5;
#pragma unroll
        for (int i = 0; i < 8; ++i) { const int nn = nn0 + i * 8; Wt[(size_t)(n0 + nn) * K + k0 + kk] = f2bf(lds[kk * 65 + nn]); } }
    __syncthreads();
}
__device__ __forceinline__ const float* h_row_ptr(int r, const float* xp, const float* xs, const float* meta) {
    if (r < T_PROMPT) { const int b = r / LP, l = r % LP; return l < N_META ? meta + (size_t)l * D_MODEL : xp + ((size_t)b * SEQ + (l - N_META)) * D_MODEL; }
    return xs + (size_t)(r - T_PROMPT) * D_MODEL;
}
__device__ __forceinline__ void prep_row(int r, const float* xp, const float* xs, const float* meta, bf16_t* A0, float* rstd0, int lane) {
    if (r >= T_ALL) { for (int i = lane; i < D_MODEL / 2; i += 64) ((unsigned*)(A0 + (size_t)r * D_MODEL))[i] = 0u; if (lane == 0) rstd0[r] = 0.f; return; }
    const float4* src = (const float4*)h_row_ptr(r, xp, xs, meta); float ss = 0.f;
#pragma unroll
    for (int i = 0; i < 4; ++i) { const float4 v = src[lane + i * 64]; ss += v.x * v.x + v.y * v.y + v.z * v.z + v.w * v.w;
        uint2 o; o.x = (unsigned)f2bf(v.x) | ((unsigned)f2bf(v.y) << 16); o.y = (unsigned)f2bf(v.z) | ((unsigned)f2bf(v.w) << 16);
        ((uint2*)(A0 + (size_t)r * D_MODEL))[lane + i * 64] = o; }
#pragma unroll
    for (int o = 32; o >= 1; o >>= 1) ss += __shfl_xor(ss, o);
    if (lane == 0) rstd0[r] = rsqrtf(ss * (1.0f / D_MODEL) + NORM_EPS);
}
__device__ __forceinline__ void rope_entry(int idx, float2* tab) {
    const int pos = idx >> 7, i = idx & 127;
    const float inv = exp2f(-(float)i * (13.287712379549449f / 128.0f));
    const float angf = (float)pos * inv; const double a = (double)angf;
    const double kq = rint(a * 0.63661977236758134308);
    double r = fma(-kq, 1.57079632679489655800e+00, a); r = fma(-kq, 6.12323399573676603587e-17, r);
    const double r2 = r * r;
    const double sp = r * (1.0 + r2 * (-1.0 / 6 + r2 * (1.0 / 120 + r2 * (-1.0 / 5040 + r2 * (1.0 / 362880 + r2 * (-1.0 / 39916800 + r2 * (1.0 / 6227020800.0)))))));
    const double cp = 1.0 + r2 * (-0.5 + r2 * (1.0 / 24 + r2 * (-1.0 / 720 + r2 * (1.0 / 40320 + r2 * (-1.0 / 3628800 + r2 * (1.0 / 479001600 + r2 * (-1.0 / 87178291200.0)))))));
    const int q = ((int)kq) & 3;
    const double sv = (q == 0) ? sp : (q == 1) ? cp : (q == 2) ? -sp : -cp;
    const double cv = (q == 0) ? cp : (q == 1) ? -sp : (q == 2) ? -cp : sp;
    tab[idx] = make_float2((float)cv, (float)sv);
}

struct PrepArgs {
    const float *x_prompt, *x_sample, *meta, *norm_mix_w, *w_in, *w_ret, *w_dsa, *w_out, *norm_ffn_w, *w_ffi, *w_ffo;
    bf16_t *W1t, *Wret, *Wdsa, *Wout, *Wffi, *Wffo, *A0; float* rstd0; float2* rope;
};
#define PREP_J_W1   0
#define PREP_N_W1   ((N1 / 64) * (1024 / 32))
#define PREP_J_WRET (PREP_J_W1 + PREP_N_W1)
#define PREP_N_WRET ((1024 / 64) * (2048 / 32))
#define PREP_J_WDSA (PREP_J_WRET + PREP_N_WRET)
#define PREP_N_WDSA ((1024 / 64) * (1024 / 32))
#define PREP_J_WOUT (PREP_J_WDSA + PREP_N_WDSA)
#define PREP_N_WOUT ((1024 / 64) * (1024 / 32))
#define PREP_J_WFFI (PREP_J_WOUT + PREP_N_WOUT)
#define PREP_N_WFFI ((NFF2 / 64) * (1024 / 32))
#define PREP_J_WFFO (PREP_J_WFFI + PREP_N_WFFI)
#define PREP_N_WFFO ((1024 / 64) * (2816 / 32))
#define PREP_J_ROWS (PREP_J_WFFO + PREP_N_WFFO)
#define PREP_N_ROWS (T_PAD / 4)
#define PREP_J_ROPE (PREP_J_ROWS + PREP_N_ROWS)
#define PREP_N_ROPE ((LP * 128) / 256)
#define PREP_N_JOBS (PREP_J_ROPE + PREP_N_ROPE)
__device__ __forceinline__ void prep_job(const PrepArgs& a, int job, float* lds) {
    if (job < PREP_J_WRET)      prep_weight_tile(a.w_in, IN_COLS, a.norm_mix_w, a.W1t, 1024, 1, job - PREP_J_W1, lds);
    else if (job < PREP_J_WDSA) prep_weight_tile(a.w_ret, 1024, nullptr, a.Wret, 2048, 0, job - PREP_J_WRET, lds);
    else if (job < PREP_J_WOUT) prep_weight_tile(a.w_dsa, 1024, nullptr, a.Wdsa, 1024, 0, job - PREP_J_WDSA, lds);
    else if (job < PREP_J_WFFI) prep_weight_tile(a.w_out, 1024, nullptr, a.Wout, 1024, 0, job - PREP_J_WOUT, lds);
    else if (job < PREP_J_WFFO) prep_weight_tile(a.w_ffi, 2 * D_FF, a.norm_ffn_w, a.Wffi, 1024, 2, job - PREP_J_WFFI, lds);
    else if (job < PREP_J_ROWS) prep_weight_tile(a.w_ffo, 1024, nullptr, a.Wffo, 2816, 0, job - PREP_J_WFFO, lds);
    else if (job < PREP_J_ROPE) prep_row((job - PREP_J_ROWS) * 4 + ((threadIdx.x & 255) >> 6), a.x_prompt, a.x_sample, a.meta, a.A0, a.rstd0, threadIdx.x & 63);
    else rope_entry((job - PREP_J_ROPE) * 256 + (threadIdx.x & 255), a.rope);
}
namespace att {
using bf16x8 = __attribute__((ext_vector_type(8))) short;
using s16x4  = __attribute__((ext_vector_type(4))) short;
using f32x16 = __attribute__((ext_vector_type(16))) float;
using f32x8  = __attribute__((ext_vector_type(8))) float;
using u32x4  = __attribute__((ext_vector_type(4))) unsigned;
constexpr float SCALE = 0.088388347648318440f;
constexpr float THR = 8.f;
constexpr float NEG = -3.0e38f;
constexpr int SHM_V = 64 * 128 * 2, SHM_K = 64 * 128 * 2;
#define ATT_KSWZ(row, colB) ((row) * 256 + ((colB) ^ (((row) & 7) << 4)))
#define ATT_SBAR() __builtin_amdgcn_sched_barrier(0)
__device__ __forceinline__ int crow(int r, int hi) { return (r & 3) + 8 * (r >> 2) + 4 * hi; }
__device__ __forceinline__ unsigned cvtpk(float lo, float hi) { unsigned r; asm volatile("v_cvt_pk_bf16_f32 %0, %1, %2" : "=v"(r) : "v"(lo), "v"(hi)); return r; }
__device__ __forceinline__ bf16x8 tobf(f32x8 x) { u32x4 w = {cvtpk(x[0], x[1]), cvtpk(x[2], x[3]), cvtpk(x[4], x[5]), cvtpk(x[6], x[7])}; return *reinterpret_cast<bf16x8*>(&w); }
__device__ __forceinline__ bf16x8 tobf(bf16x8 x) { return x; }

__device__ __forceinline__ void apply_mask(f32x16& p0, f32x16& p1, u64 mk, int hi) {
    const unsigned lo = (unsigned)mk >> (4 * hi), hw = (unsigned)(mk >> 32) >> (4 * hi);
#pragma unroll
    for (int r = 0; r < 16; ++r) { const unsigned bit = 1u << ((r & 3) + 8 * (r >> 2)); p0[r] = (lo & bit) ? p0[r] : NEG; p1[r] = (hw & bit) ? p1[r] : NEG; }
}
__device__ __forceinline__ void partialSM(f32x16& p0, f32x16& p1, float& m_reg, float& mn, float& alpha) {
    constexpr float C = SCALE * 1.4426950408889634f;
    float pmax = p0[0];
#pragma unroll
    for (int r = 1; r < 16; ++r) pmax = fmaxf(pmax, p0[r]);
#pragma unroll
    for (int r = 0; r < 16; ++r) pmax = fmaxf(pmax, p1[r]);
    { auto rr = __builtin_amdgcn_permlane32_swap(__float_as_uint(pmax), __float_as_uint(pmax), false, false);
      pmax = fmaxf(__uint_as_float(rr[0]), __uint_as_float(rr[1])); }
    if (__builtin_expect(__all(pmax - m_reg <= THR / SCALE), 1)) { mn = m_reg; alpha = 1.f; }
    else { mn = fmaxf(m_reg, pmax); alpha = __builtin_amdgcn_exp2f((m_reg - mn) * C); m_reg = mn; }
    const float mnC = -mn * C;
#pragma unroll
    for (int r = 0; r < 16; ++r) p0[r] = fmaf(p0[r], C, mnC);
#pragma unroll
    for (int r = 0; r < 16; ++r) p1[r] = fmaf(p1[r], C, mnC);
#pragma unroll
    for (int r = 0; r < 16; ++r) p0[r] = __builtin_amdgcn_exp2f(p0[r]);
}
__device__ __forceinline__ void finishSM(f32x16& p0, f32x16& p1, float alpha, float& l_reg, bf16x8& pa0, bf16x8& pa1, bf16x8& pa2, bf16x8& pa3) {
#pragma unroll
    for (int r = 0; r < 16; ++r) p1[r] = __builtin_amdgcn_exp2f(p1[r]);
    float ps = 0;
#pragma unroll
    for (int r = 0; r < 16; ++r) ps += p0[r];
#pragma unroll
    for (int r = 0; r < 16; ++r) ps += p1[r];
    { auto rr = __builtin_amdgcn_permlane32_swap(__float_as_uint(ps), __float_as_uint(ps), false, false);
      ps = __uint_as_float(rr[0]) + __uint_as_float(rr[1]); }
    l_reg = l_reg * alpha + ps;
#define ATT_PK4(P, BASE, OUT) do { unsigned a0 = cvtpk(P[BASE + 0], P[BASE + 1]), a1 = cvtpk(P[BASE + 2], P[BASE + 3]);   \
    unsigned b0 = cvtpk(P[BASE + 4], P[BASE + 5]), b1 = cvtpk(P[BASE + 6], P[BASE + 7]);                              \
    auto r0 = __builtin_amdgcn_permlane32_swap(a0, b0, false, false); auto r1 = __builtin_amdgcn_permlane32_swap(a1, b1, false, false); \
    u32x4 w = {r0[0], r1[0], r0[1], r1[1]}; OUT = *reinterpret_cast<bf16x8*>(&w); } while (0)
    ATT_PK4(p0, 0, pa0); ATT_PK4(p0, 8, pa1); ATT_PK4(p1, 0, pa2); ATT_PK4(p1, 8, pa3);
#undef ATT_PK4
}
__device__ __forceinline__ void qkt(f32x16& p0, f32x16& p1, const char* Ks, const bf16x8* qr, int r32, int hi) {
    p0 = f32x16{}; p1 = f32x16{};
#pragma unroll
    for (int d0 = 0; d0 < 8; ++d0) { const int cb = (d0 * 16 + hi * 8) * 2;
        const bf16x8 b0 = *reinterpret_cast<const bf16x8*>(Ks + ATT_KSWZ(r32, cb));
        const bf16x8 b1 = *reinterpret_cast<const bf16x8*>(Ks + ATT_KSWZ(32 + r32, cb));
        p0 = __builtin_amdgcn_mfma_f32_32x32x16_bf16(b0, qr[d0], p0, 0, 0, 0);
        p1 = __builtin_amdgcn_mfma_f32_32x32x16_bf16(b1, qr[d0], p1, 0, 0, 0); }
}
__device__ __forceinline__ int v_st(int k, int c) { const int kk = (k & ~0xC) | ((k & 4) << 1) | ((k & 8) >> 1); return ((kk >> 3) * 4 + (c >> 5)) * 512 + ((kk & 7) * 32 + (c & 31)) * 2; }
__device__ __forceinline__ int v_rd_base(int lane) { return ((lane & 3) << 3) | (((lane >> 2) & 3) << 6) | (((lane >> 4) & 1) << 5) | (((lane >> 5) & 1) << 8); }
constexpr int v_rd_off(int d0, int ks, int half) { return d0 * 512 + ks * 4096 + half * 2048; }
template <int OFF> __device__ __forceinline__ s16x4 tr_read(int vb) { s16x4 r; asm volatile("ds_read_b64_tr_b16 %0, %1 offset:%2" : "=&v"(r) : "v"(vb), "i"(OFF) : "memory"); return r; }
template <int D0> __device__ __forceinline__ void pv_one(f32x16& od, int vb, bf16x8 pa0, bf16x8 pa1, bf16x8 pa2, bf16x8 pa3) {
    const s16x4 l0 = tr_read<v_rd_off(D0, 0, 0)>(vb), h0 = tr_read<v_rd_off(D0, 0, 1)>(vb), l1 = tr_read<v_rd_off(D0, 1, 0)>(vb), h1 = tr_read<v_rd_off(D0, 1, 1)>(vb);
    const s16x4 l2 = tr_read<v_rd_off(D0, 2, 0)>(vb), h2 = tr_read<v_rd_off(D0, 2, 1)>(vb), l3 = tr_read<v_rd_off(D0, 3, 0)>(vb), h3 = tr_read<v_rd_off(D0, 3, 1)>(vb);
    asm volatile("s_waitcnt lgkmcnt(0)" ::: "memory"); ATT_SBAR();
#define ATT_PK(L, H) (bf16x8){L[0], L[1], L[2], L[3], H[0], H[1], H[2], H[3]}
    od = __builtin_amdgcn_mfma_f32_32x32x16_bf16(pa0, ATT_PK(l0, h0), od, 0, 0, 0);
    od = __builtin_amdgcn_mfma_f32_32x32x16_bf16(pa1, ATT_PK(l1, h1), od, 0, 0, 0);
    od = __builtin_amdgcn_mfma_f32_32x32x16_bf16(pa2, ATT_PK(l2, h2), od, 0, 0, 0);
    od = __builtin_amdgcn_mfma_f32_32x32x16_bf16(pa3, ATT_PK(l3, h3), od, 0, 0, 0);
#undef ATT_PK
}
__device__ __forceinline__ void pv_d0(f32x16* o, int vb, bf16x8 pa0, bf16x8 pa1, bf16x8 pa2, bf16x8 pa3) {
    pv_one<0>(o[0], vb, pa0, pa1, pa2, pa3); pv_one<1>(o[1], vb, pa0, pa1, pa2, pa3); pv_one<2>(o[2], vb, pa0, pa1, pa2, pa3); pv_one<3>(o[3], vb, pa0, pa1, pa2, pa3);
}

struct KvPrompt {
    using T = bf16x8; const bf16_t* K; const bf16_t* V;
    __device__ __forceinline__ T ldk(int key, int col) const { return *reinterpret_cast<const bf16x8*>(K + (size_t)key * 256 + col); }
    __device__ __forceinline__ T ldv(int key, int col) const { return *reinterpret_cast<const bf16x8*>(V + (size_t)key * 256 + col); }
};
struct KvSample {
    using T = f32x8; const float* ck; const float* cv; const float* kn; const float* vn; const int* pages  ; int n;
    __device__ __forceinline__ size_t roff(int key) const { return (((size_t)pages[key >> 7] * PAGE_SIZE + (key & 127)) * N_KV + n) * 128; }
    __device__ __forceinline__ T ldk(int key, int col) const { const float* p = key < PAST_LEN ? ck + roff(key) : kn + (size_t)min(key - PAST_LEN, DEC_SEQ - 1) * 256; return *reinterpret_cast<const f32x8*>(p + col); }
    __device__ __forceinline__ T ldv(int key, int col) const { const float* p = key < PAST_LEN ? cv + roff(key) : vn + (size_t)min(key - PAST_LEN, DEC_SEQ - 1) * 256; return *reinterpret_cast<const f32x8*>(p + col); }
};

template <class KV>
__device__ __forceinline__ void attn_unit(const KV kv, const bf16_t* __restrict__ Aq, const u64* __restrict__ mask, bf16_t* __restrict__ Odsa, int tok0, int nq_valid, int hd0, int NT, char* lds) {
    int tid_l = threadIdx.x; asm volatile("" : "+v"(tid_l));
    const int tid = tid_l, wid = tid >> 6, lane = tid & 63, r32 = lane & 31, hi = lane >> 5;
    char* V_lds = lds; char* K_lds = lds + 2 * SHM_V;
    float* wsx = (float*)(lds + 2 * SHM_V + 2 * SHM_K) + wid * 64; float* li_l = wsx; float* al_l = wsx + 32;
    float m_reg = -1e30f, l_reg = 0; f32x16 o[4] = {}; bf16x8 qr[8];
    const int mytok = tok0 + 8 * wid + (r32 >> 2);
    { const bf16_t* Qw = Aq + (size_t)mytok * 1024 + (hd0 + (r32 & 3)) * 128 + hi * 8;
#pragma unroll
      for (int d0 = 0; d0 < 8; ++d0) qr[d0] = *reinterpret_cast<const bf16x8*>(Qw + d0 * 16); }
    const u64* mrow = mask + (size_t)mytok * MASK_WORDS;
    const int sr = tid >> 4, sc = (tid & 15) * 8, vst0 = v_st(sr, sc), vst1 = v_st(32 + sr, sc);
    const int vbase = (int)(uintptr_t)(PG8_LAS char*)V_lds + v_rd_base(lane);
    typename KV::T vs0, vs1, ks0, ks1;
#define ATT_SLOAD(k0) do { vs0 = kv.ldv((k0) + sr, sc); vs1 = kv.ldv((k0) + 32 + sr, sc); ks0 = kv.ldk((k0) + sr, sc); ks1 = kv.ldk((k0) + 32 + sr, sc); } while (0)
#define ATT_SWRITE(b) do { *(bf16x8*)(V_lds + (b) * SHM_V + vst0) = tobf(vs0); *(bf16x8*)(V_lds + (b) * SHM_V + vst1) = tobf(vs1); const int kc = sc * 2; \
    *(bf16x8*)(K_lds + (b) * SHM_K + ATT_KSWZ(sr, kc)) = tobf(ks0); *(bf16x8*)(K_lds + (b) * SHM_K + ATT_KSWZ(32 + sr, kc)) = tobf(ks1); } while (0)
    __syncthreads();
    ATT_SLOAD(0); ATT_SWRITE(0); __syncthreads();
    for (int j = 0; j < NT; ++j) {
        const int b = j & 1;
        const u64 mk = mrow[j];
        if (j + 1 < NT) ATT_SLOAD((j + 1) * 64);
        f32x16 p0, p1; float mn, alpha; bf16x8 pa0, pa1, pa2, pa3;
        ATT_SBAR(); qkt(p0, p1, K_lds + b * SHM_K, qr, r32, hi); apply_mask(p0, p1, mk, hi);
        partialSM(p0, p1, m_reg, mn, alpha);
        if (__any(alpha < 1.f)) { if (hi == 0) al_l[r32] = alpha; asm volatile("s_waitcnt lgkmcnt(0)" ::: "memory");
#pragma unroll
            for (int d = 0; d < 4; ++d)
#pragma unroll
                for (int r = 0; r < 16; ++r) o[d][r] *= al_l[crow(r, hi)]; }
        finishSM(p0, p1, alpha, l_reg, pa0, pa1, pa2, pa3); ATT_SBAR();
        pv_d0(o, vbase + b * SHM_V, pa0, pa1, pa2, pa3);
        if (j + 1 < NT) ATT_SWRITE(b ^ 1);
        __syncthreads();
    }
    if (hi == 0) li_l[r32] = l_reg; asm volatile("s_waitcnt lgkmcnt(0)" ::: "memory");
#pragma unroll
    for (int r = 0; r < 16; ++r) { const int orow = crow(r, hi); const float rli = __builtin_amdgcn_rcpf(li_l[orow]);
        const int q = 8 * wid + (orow >> 2);
        if (q < nq_valid) { bf16_t* Ow = Odsa + (size_t)(tok0 + q) * 1024 + (hd0 + (orow & 3)) * 128 + r32;
#pragma unroll
            for (int d0 = 0; d0 < 4; ++d0) Ow[d0 * 32] = f2bf(o[d0][r] * rli); } }
#undef ATT_SLOAD
#undef ATT_SWRITE
}
}
namespace idx {
using bf16x8 = __attribute__((ext_vector_type(8))) short;
using f32x16 = __attribute__((ext_vector_type(16))) float;
using f32x8  = __attribute__((ext_vector_type(8))) float;
constexpr int NTILE = 65;
constexpr int WAVE_LDS = NTILE * 64 * 4;
__device__ __forceinline__ unsigned ord_of(float f) { const unsigned u = __float_as_uint(f); return (u & 0x80000000u) ? ~u : (u | 0x80000000u); }
__device__ __forceinline__ int half_sum(int v) {
#pragma unroll
    for (int o = 16; o >= 1; o >>= 1) v += __shfl_xor(v, o);
    return v;
}
template <bool SAMPLE> struct KeySrc {
    const bf16_t* ikb; const float* ck; const int* pt;
    __device__ __forceinline__ void load(int t, int c, int hi, bf16x8 (&B)[4]) const {
        if (!SAMPLE) { const bf16_t* p = ikb + (size_t)(32 * t + c) * 64 + hi * 8;
#pragma unroll
            for (int s = 0; s < 4; ++s) B[s] = *reinterpret_cast<const bf16x8*>(p + 16 * s); }
        else if (t < 64) { const int page = __builtin_amdgcn_readfirstlane(pt[t >> 2]);
            const float* p = ck + ((size_t)page * PAGE_SIZE + ((32 * t) & 127) + c) * 64 + hi * 8;
#pragma unroll
            for (int s = 0; s < 4; ++s) B[s] = att::tobf(*reinterpret_cast<const f32x8*>(p + 16 * s)); }
        else { const bf16_t* p = ikb + (size_t)(c < DEC_SEQ ? c : DEC_SEQ - 1) * 64 + hi * 8;
#pragma unroll
            for (int s = 0; s < 4; ++s) B[s] = *reinterpret_cast<const bf16x8*>(p + 16 * s); }
    }
};
template <int A_> __device__ __forceinline__ float head_sum(const f32x16& acc, const float (&w)[8]) {
    float s = 0.f;
#pragma unroll
    for (int h = 0; h < 8; ++h) s = fmaf(w[h], fmaxf(acc[8 * A_ + h], 0.f), s);
    return s;
}
template <bool SAMPLE, int A_>
__device__ __forceinline__ void pass(const KeySrc<SAMPLE>& ks, const bf16x8 (&A)[4], const float* Iw, int tokbase, int pos0, int nvalid, int ntiles, unsigned* strip, unsigned* mask32, int lane) {
    const int c = lane & 31, hi = lane >> 5, myq = 2 * hi + A_, mypos = pos0 + myq; const bool qvalid = myq < nvalid;
    float w[8];
    { const float* wp = Iw + (size_t)(tokbase + (qvalid ? myq : nvalid - 1)) * 8;
#pragma unroll
      for (int h = 0; h < 8; ++h) w[h] = wp[h]; }
    bf16x8 B[4], Bn[4];
    ks.load(0, c, hi, B);
    for (int t = 0; t < ntiles; ++t) {
        if (t + 1 < ntiles) ks.load(t + 1, c, hi, Bn);
        f32x16 acc = {};
#pragma unroll
        for (int s = 0; s < 4; ++s) acc = __builtin_amdgcn_mfma_f32_32x32x16_bf16(A[s], B[s], acc, 0, 0, 0);
        const float sc = head_sum<A_>(acc, w);
        strip[t * 64 + lane] = (32 * t + c <= mypos) ? ord_of(sc) : 0u;
#pragma unroll
        for (int s = 0; s < 4; ++s) B[s] = Bn[s];
    }
    unsigned x[NTILE];
#pragma unroll
    for (int t = 0; t < NTILE; ++t) x[t] = (t < ntiles) ? strip[t * 64 + lane] : 0u;
    unsigned tau = 0u; int r_ties = 0;
    if (__any(mypos + 1 > TOPK)) {
        for (int bit = 31; bit >= 0; --bit) { const unsigned cand = tau | (1u << bit); int cnt = 0;
#pragma unroll
            for (int t = 0; t < NTILE; ++t) cnt += (x[t] >= cand) ? 1 : 0;
            cnt = half_sum(cnt);
            if (cnt >= TOPK) tau = cand; }
        int cg = 0;
#pragma unroll
        for (int t = 0; t < NTILE; ++t) cg += (x[t] > tau) ? 1 : 0;
        cg = half_sum(cg);
        r_ties = TOPK - cg;
    }
    if (mypos + 1 <= TOPK) { tau = 0u; r_ties = 0; }
    int eq_before = 0; unsigned* mrow = mask32 + (size_t)(tokbase + myq) * (2 * MASK_WORDS);
#pragma unroll
    for (int t = 0; t < NTILE; ++t) {
        const bool eq = x[t] == tau, gt = x[t] > tau;
        const u64 eqm = __ballot(eq); const unsigned my_eqm = hi ? (unsigned)(eqm >> 32) : (unsigned)eqm;
        const int rank = eq_before + __popc(my_eqm & ((1u << c) - 1u));
        const bool sel = gt || (eq && rank < r_ties);
        eq_before += __popc(my_eqm);
        const u64 sm = __ballot(sel); const unsigned my_sm = hi ? (unsigned)(sm >> 32) : (unsigned)sm;
        if (c == 0 && qvalid) mrow[t] = my_sm;
    }
    if (c < 2 * MASK_WORDS - NTILE && qvalid) mrow[NTILE + c] = 0u;
}
template <bool SAMPLE>
__device__ __forceinline__ void wave_task(const KeySrc<SAMPLE>& ks, const bf16_t* Iq, const float* Iw, int tokbase, int pos0, int nvalid, unsigned* strip, unsigned* mask32, int lane) {
    const int c = lane & 31, hi = lane >> 5;
    const int aq_ = 2 * ((c >> 2) & 1) + (c >> 4), ah = 4 * ((c >> 3) & 1) + (c & 3);
    bf16x8 A[4];
    { const bf16_t* ap = Iq + (size_t)(tokbase + (aq_ < nvalid ? aq_ : nvalid - 1)) * 512 + ah * 64 + hi * 8;
#pragma unroll
      for (int s = 0; s < 4; ++s) A[s] = *reinterpret_cast<const bf16x8*>(ap + 16 * s); }
    const int pmax = pos0 + nvalid - 1; int ntiles = (pmax + 32) >> 5; if (ntiles > NTILE) ntiles = NTILE;
    pass<SAMPLE, 0>(ks, A, Iw, tokbase, pos0, nvalid, ntiles, strip, mask32, lane);
    pass<SAMPLE, 1>(ks, A, Iw, tokbase, pos0, nvalid, ntiles, strip, mask32, lane);
}
}
struct MegaArgs {
    PrepArgs prep;
    const float *cache_k, *cache_v, *cache_kidx, *state_ret; const int* page_table;
    const float *qnw, *knw, *ikw, *ikb;
    bf16_t *Rq, *Rk, *Rv, *G, *Aq, *Kb, *Vb, *Iq, *Ikb, *Gates, *OG, *An, *Odsa, *Mg, *A2, *Hid;
    float *Iw, *ssret, *rstd2, *Z, *M1, *M2, *H2, *Zf, *out;
    u64* mask; unsigned* bar;
};

namespace ret {
using bf16x8 = __attribute__((ext_vector_type(8))) short;
using s16x4  = __attribute__((ext_vector_type(4))) short;
using f32x4  = __attribute__((ext_vector_type(4))) float;
using u32x4  = __attribute__((ext_vector_type(4))) unsigned;
using u32x2  = __attribute__((ext_vector_type(2))) unsigned;
constexpr int QS = 528, VS = 144, PS = 80;
constexpr int OFF_Q = 0, OFF_K = OFF_Q + 32 * QS, OFF_V = OFF_K + 32 * QS, OFF_P = OFF_V + 32 * VS, OFF_ST = OFF_P + 32 * PS, OFF_SS = OFF_ST + 64 * QS, LDS_BYTES = OFF_SS + 32 * 4 * 4;
__device__ __forceinline__ s16x4 trr(int addr) { s16x4 r; asm volatile("ds_read_b64_tr_b16 %0, %1" : "=&v"(r) : "v"(addr) : "memory"); return r; }
__device__ __forceinline__ bf16x8 cat(s16x4 l, s16x4 h) { return (bf16x8){l[0], l[1], l[2], l[3], h[0], h[1], h[2], h[3]}; }
__device__ __forceinline__ u32x4 scale8(u32x4 v, float f) {
    u32x4 o;
#pragma unroll
    for (int i = 0; i < 4; ++i) o[i] = att::cvtpk(__uint_as_float(v[i] << 16) * f, __uint_as_float(v[i] & 0xffff0000u) * f);
    return o;
}
__device__ __forceinline__ void unit(const MegaArgs& a, int unit8, char* lds) {
    int tid_l = threadIdx.x; asm volatile("" : "+v"(tid_l));
    const int tid = tid_l, w = __builtin_amdgcn_readfirstlane(tid >> 6), lane = tid & 63, g = lane >> 4, c15 = lane & 15, q4 = c15 >> 2, p4 = c15 & 3;
    const int bh = unit8 >> 3, sl = unit8 & 7, b = bh >> 2, h = bh & 3;
    const int ldsb = (int)(uintptr_t)(PG8_LAS char*)lds;
    const float lg2 = log2f(1.0f - exp2f(-5.0f - (float)h));
    const int st_tok = tid >> 4, st_seg = tid & 15;
    const float fq = exp2f(lg2 * (float)(st_tok + 1)), fk = exp2f(-lg2 * (float)(st_tok + 1));
    f32x4 S[2][4];
#pragma unroll
    for (int i = 0; i < 2; ++i)
#pragma unroll
        for (int u = 0; u < 4; ++u) S[i][u] = (f32x4){0.f, 0.f, 0.f, 0.f};
    u32x4 rq0, rq1, rk0, rk1; u32x2 rv;
#define RET_LOAD(tok0_, len_) do { const bool ok_ = st_tok < (len_); const size_t r_ = (size_t)((tok0_) + (ok_ ? st_tok : 0)); \
        const u32x4* qp_ = (const u32x4*)(a.Rq + r_ * 1024 + h * 256 + st_seg * 16); const u32x4* kp_ = (const u32x4*)(a.Rk + r_ * 1024 + h * 256 + st_seg * 16); \
        rq0 = qp_[0]; rq1 = qp_[1]; rk0 = kp_[0]; rk1 = kp_[1]; rv = *(const u32x2*)(a.Rv + r_ * 2048 + h * 512 + sl * 64 + st_seg * 4); \
        if (!ok_) { rq0 = rq1 = rk0 = rk1 = (u32x4){0u, 0u, 0u, 0u}; rv = (u32x2){0u, 0u}; } } while (0)
    const int row0 = b * LP;
    RET_LOAD(row0, 16);
    __syncthreads();
    for (int c = 0; c < 65; ++c) {
        const int len = c == 0 ? 16 : 32, tok0 = c == 0 ? row0 : row0 + 16 + 32 * (c - 1);
        *(u32x4*)(lds + OFF_Q + st_tok * QS + st_seg * 32) = scale8(rq0, fq); *(u32x4*)(lds + OFF_Q + st_tok * QS + st_seg * 32 + 16) = scale8(rq1, fq);
        *(u32x4*)(lds + OFF_K + st_tok * QS + st_seg * 32) = scale8(rk0, fk); *(u32x4*)(lds + OFF_K + st_tok * QS + st_seg * 32 + 16) = scale8(rk1, fk);
        *(u32x2*)(lds + OFF_V + st_tok * VS + st_seg * 8) = rv;
#pragma unroll
        for (int i = 0; i < 2; ++i)
#pragma unroll
            for (int u = 0; u < 4; ++u) { u32x2 pk; pk.x = att::cvtpk(S[i][u][0], S[i][u][1]); pk.y = att::cvtpk(S[i][u][2], S[i][u][3]);
                *(u32x2*)(lds + OFF_ST + (16 * u + c15) * QS + (32 * w + 16 * i + 4 * g) * 2) = pk; }
        __syncthreads();
        if (c + 1 < 65) RET_LOAD(row0 + 16 + 32 * c, 32);
        if (w < 3) { const int jt = w >> 1, it = (w + 1) >> 1; f32x4 pacc = {0.f, 0.f, 0.f, 0.f};
#pragma unroll
            for (int s = 0; s < 8; ++s) { const bf16x8 A = *(const bf16x8*)(lds + OFF_K + (16 * jt + c15) * QS + (32 * s + 8 * g) * 2), B = *(const bf16x8*)(lds + OFF_Q + (16 * it + c15) * QS + (32 * s + 8 * g) * 2);
                pacc = __builtin_amdgcn_mfma_f32_16x16x32_bf16(A, B, pacc, 0, 0, 0); }
            const int ig = 16 * it + c15, jg0 = 16 * jt + 4 * g; float pv[4];
#pragma unroll
            for (int r = 0; r < 4; ++r) pv[r] = (jg0 + r <= ig) ? pacc[r] : 0.f;
            u32x2 pk; pk.x = att::cvtpk(pv[0], pv[1]); pk.y = att::cvtpk(pv[2], pv[3]);
            *(u32x2*)(lds + OFF_P + ig * PS + jg0 * 2) = pk; }
        else if (w == 3) { if (lane < 32) *(u32x4*)(lds + OFF_P + (lane >> 1) * PS + 32 + 16 * (lane & 1)) = (u32x4){0u, 0u, 0u, 0u}; }
        { s16x4 vl[4], vh[4], kl[2], kh[2];
#pragma unroll
          for (int u = 0; u < 4; ++u) { const int ad = ldsb + OFF_V + (8 * g + q4) * VS + (16 * u + 4 * p4) * 2; vl[u] = trr(ad); vh[u] = trr(ad + 4 * VS); }
#pragma unroll
          for (int i = 0; i < 2; ++i) { const int ad = ldsb + OFF_K + (8 * g + q4) * QS + (32 * w + 16 * i + 4 * p4) * 2; kl[i] = trr(ad); kh[i] = trr(ad + 4 * QS); }
          asm volatile("s_waitcnt lgkmcnt(0)" ::: "memory"); __builtin_amdgcn_sched_barrier(0);
          const float gl = exp2f(lg2 * (float)len);
#pragma unroll
          for (int i = 0; i < 2; ++i)
#pragma unroll
              for (int u = 0; u < 4; ++u) { S[i][u] = __builtin_amdgcn_mfma_f32_16x16x32_bf16(cat(kl[i], kh[i]), cat(vl[u], vh[u]), S[i][u], 0, 0, 0); S[i][u] *= gl; } }
        __syncthreads();
        { const int dt = w & 3, it = w >> 2; f32x4 o = {0.f, 0.f, 0.f, 0.f};
          { const int ad = ldsb + OFF_V + (8 * g + q4) * VS + (16 * dt + 4 * p4) * 2; const s16x4 lo = trr(ad), hi = trr(ad + 4 * VS);
            const bf16x8 Bp = *(const bf16x8*)(lds + OFF_P + (16 * it + c15) * PS + (8 * g) * 2);
            asm volatile("s_waitcnt lgkmcnt(0)" ::: "memory"); __builtin_amdgcn_sched_barrier(0);
            o = __builtin_amdgcn_mfma_f32_16x16x32_bf16(cat(lo, hi), Bp, o, 0, 0, 0); }
#pragma unroll
          for (int s = 0; s < 8; ++s) { const bf16x8 A = *(const bf16x8*)(lds + OFF_ST + (16 * dt + c15) * QS + (32 * s + 8 * g) * 2), B = *(const bf16x8*)(lds + OFF_Q + (16 * it + c15) * QS + (32 * s + 8 * g) * 2);
              o = __builtin_amdgcn_mfma_f32_16x16x32_bf16(A, B, o, 0, 0, 0); }
          const int i = 16 * it + c15; float ss = o[0] * o[0] + o[1] * o[1] + o[2] * o[2] + o[3] * o[3];
          ss += __shfl_xor(ss, 16); ss += __shfl_xor(ss, 32);
          if (g == 0) ((float*)(lds + OFF_SS))[i * 4 + dt] = ss;
          if (i < len) { const size_t ci = (size_t)(tok0 + i) * 2048 + h * 512 + sl * 64 + 16 * dt + 4 * g; const u32x2 gg = *(const u32x2*)(a.G + ci);
              u32x2 pk; pk.x = att::cvtpk(o[0] * __uint_as_float(gg.x << 16), o[1] * __uint_as_float(gg.x & 0xffff0000u)); pk.y = att::cvtpk(o[2] * __uint_as_float(gg.y << 16), o[3] * __uint_as_float(gg.y & 0xffff0000u));
              *(u32x2*)(a.OG + ci) = pk; } }
        __syncthreads();
        if (tid < len) { const float* sp = (const float*)(lds + OFF_SS) + tid * 4; a.ssret[(size_t)(tok0 + tid) * 32 + h * 8 + sl] = (sp[0] + sp[1]) + (sp[2] + sp[3]); }
    }
    float* so = a.out + (size_t)O_R_P + ((size_t)b * H_RET + h) * (DK_RET * DV_RET) + sl * 64;
#pragma unroll
    for (int i = 0; i < 2; ++i)
#pragma unroll
        for (int u = 0; u < 4; ++u)
#pragma unroll
            for (int r = 0; r < 4; ++r) so[(size_t)(32 * w + 16 * i + 4 * g + r) * DV_RET + 16 * u + c15] = S[i][u][r];
    __syncthreads();
#undef RET_LOAD
}
}
__device__ __forceinline__ void epi1_row(const MegaArgs& a, int r, int t) {
    const int lane = t & 63;
    const float* z = a.Z + (size_t)r * N1; const float rs = a.prep.rstd0[r]; const int pos = row_pos(r); const float2* rope = a.prep.rope;
    for (int which = 0; which < 2; ++which) {
        bf16_t* dst = (which ? a.Rk : a.Rq) + (size_t)r * 1024; const float post = which ? 0.0625f : 1.0f; const int zo = which * 1024;
        for (int e = t; e < 512; e += 256) { const int hh = e >> 7, i = e & 127; const float2 cs = rope[pos * 128 + i];
            const float x1 = z[zo + hh * 256 + i] * rs, x2 = z[zo + hh * 256 + 128 + i] * rs;
            dst[hh * 256 + i] = f2bf((x1 * cs.x - x2 * cs.y) * post); dst[hh * 256 + 128 + i] = f2bf((x1 * cs.y + x2 * cs.x) * post); }
    }
    for (int c = t; c < 2048; c += 256) { a.Rv[(size_t)r * 2048 + c] = f2bf(z[2048 + c] * rs); a.G[(size_t)r * 2048 + c] = f2bf(silu_f(z[4096 + c] * rs)); }
    {   const int c0 = t * 4; float v[4]; float ss = 0.f;
#pragma unroll
        for (int j = 0; j < 4; ++j) { v[j] = z[6144 + c0 + j] * rs; ss += v[j] * v[j]; }
#pragma unroll
        for (int o = 16; o >= 1; o >>= 1) ss += __shfl_xor(ss, o);
        const float rn = rsqrtf(ss * (1.0f / 128.0f) + NORM_EPS);
#pragma unroll
        for (int j = 0; j < 4; ++j) a.Aq[(size_t)r * 1024 + c0 + j] = f2bf(v[j] * rn * a.qnw[(c0 + j) & 127]); }
    float* kout = a.out + (r < T_PROMPT ? (size_t)O_K_P + (size_t)r * 256 : (size_t)O_K_S + (size_t)(r - T_PROMPT) * 256);
    float* vout = a.out + (r < T_PROMPT ? (size_t)O_V_P + (size_t)r * 256 : (size_t)O_V_S + (size_t)(r - T_PROMPT) * 256);
    float* kiout = a.out + (r < T_PROMPT ? (size_t)O_KI_P + (size_t)r * 64 : (size_t)O_KI_S + (size_t)(r - T_PROMPT) * 64);
    if (t < 64) { const int c0 = t * 4; float v[4]; float ss = 0.f;
#pragma unroll
        for (int j = 0; j < 4; ++j) { v[j] = z[7168 + c0 + j] * rs; ss += v[j] * v[j]; }
#pragma unroll
        for (int o = 16; o >= 1; o >>= 1) ss += __shfl_xor(ss, o);
        const float rn = rsqrtf(ss * (1.0f / 128.0f) + NORM_EPS);
#pragma unroll
        for (int j = 0; j < 4; ++j) { const float y = v[j] * rn * a.knw[(c0 + j) & 127]; kout[c0 + j] = y; a.Kb[(size_t)r * 256 + c0 + j] = f2bf(y); }
#pragma unroll
        for (int j = 0; j < 4; ++j) { const float y = z[7424 + c0 + j] * rs; vout[c0 + j] = y; a.Vb[(size_t)r * 256 + c0 + j] = f2bf(y); } }
    for (int c = t; c < 512; c += 256) a.Iq[(size_t)r * 512 + c] = f2bf(z[7680 + c] * rs);
    if (t >= 64 && t < 128) { const float x = z[8192 + ik_tilecol(lane)] * rs; float s = x;
#pragma unroll
        for (int o = 32; o >= 1; o >>= 1) s += __shfl_xor(s, o);
        const float mu = s * (1.0f / 64.0f), d = x - mu; float q = d * d;
#pragma unroll
        for (int o = 32; o >= 1; o >>= 1) q += __shfl_xor(q, o);
        const float y = d * rsqrtf(q * (1.0f / 64.0f) + NORM_EPS) * a.ikw[lane] + a.ikb[lane];
        kiout[lane] = y; a.Ikb[(size_t)r * 64 + lane] = f2bf(y); }
    if (t >= 128 && t < 136) a.Iw[(size_t)r * 8 + (t - 128)] = z[8192 + 32 + (t - 128)] * rs * IDX_SCALE;
    for (int c = t; c < 2048; c += 256) a.Gates[(size_t)r * 2048 + c] = f2bf(sigmoid_f(z[8448 + c] * rs));
}

__device__ __forceinline__ void ret_naive_unit(const MegaArgs& a, int unit8, int sample, float* lds) {
    float* qk = lds; float* part = lds + 512;
    const int unit = unit8 >> 3, slice = unit8 & 7, t = threadIdx.x, dke = t >> 6, dv = t & 63;
    const int bb = unit >> 2, h = unit & 3;
    const int row0 = sample ? T_PROMPT + bb * DEC_SEQ : bb * LP, ntok = sample ? DEC_SEQ : LP;
    const float gamma = 1.0f - exp2f(-5.0f - (float)h);
    float S[32];
    const size_t sbase = ((size_t)bb * H_RET + h) * (DK_RET * DV_RET) + slice * 64 + dv;
#pragma unroll
    for (int i = 0; i < 32; ++i) S[i] = sample ? a.state_ret[sbase + (size_t)(dke * 32 + i) * DV_RET] : 0.f;
    for (int tok = 0; tok < ntok; ++tok) {
        const int r = row0 + tok;
        __syncthreads();
        qk[t] = bf2f(t < 256 ? a.Rq[(size_t)r * 1024 + h * 256 + t] : a.Rk[(size_t)r * 1024 + h * 256 + (t - 256)]);
        __syncthreads();
        const float v = bf2f(a.Rv[(size_t)r * 2048 + h * 512 + slice * 64 + dv]); float o = 0.f;
#pragma unroll
        for (int i = 0; i < 32; ++i) { const float kq_ = qk[256 + dke * 32 + i], qq = qk[dke * 32 + i]; S[i] = fmaf(S[i], gamma, kq_ * v); o = fmaf(qq, S[i], o); }
        part[dke * 64 + dv] = o;
        __syncthreads();
        if (dke == 0) { float ot = 0.f;
#pragma unroll
            for (int e = 0; e < 8; ++e) ot += part[e * 64 + dv];
            float ss = ot * ot;
#pragma unroll
            for (int of = 32; of >= 1; of >>= 1) ss += __shfl_xor(ss, of);
            const size_t ci = (size_t)r * 2048 + h * 512 + slice * 64 + dv;
            a.OG[ci] = f2bf(ot * bf2f(a.G[ci]));
            if (dv == 0) a.ssret[(size_t)r * 32 + h * 8 + slice] = ss; }
    }
    float* so = a.out + (sample ? (size_t)O_R_S : (size_t)O_R_P) + sbase;
#pragma unroll
    for (int i = 0; i < 32; ++i) so[(size_t)(dke * 32 + i) * DV_RET] = S[i];
    __syncthreads();
}

__device__ __forceinline__ void make_an_row(const MegaArgs& a, int r, int lane) {
    for (int c = lane; c < 2048; c += 64) { const int h = c >> 9; float ss = 0.f;
#pragma unroll
        for (int s = 0; s < 8; ++s) ss += a.ssret[(size_t)r * 32 + h * 8 + s];
        a.An[(size_t)r * 2048 + c] = f2bf(bf2f(a.OG[(size_t)r * 2048 + c]) * rsqrtf(ss * (1.0f / 512.0f) + NORM_EPS)); }
}
__device__ __forceinline__ void merge_row(const MegaArgs& a, int r, int lane) {
    for (int c = lane; c < 1024; c += 64) a.Mg[(size_t)r * 1024 + c] = f2bf(bf2f(a.Gates[(size_t)r * 2048 + c]) * a.M1[(size_t)r * 1024 + c] + bf2f(a.Gates[(size_t)r * 2048 + 1024 + c]) * a.M2[(size_t)r * 1024 + c]);
}
__device__ __forceinline__ void h2_row(const MegaArgs& a, int r, int lane) {
    const float* h = h_row_ptr(r, a.prep.x_prompt, a.prep.x_sample, a.prep.meta); float ss = 0.f;
    for (int c = lane; c < 1024; c += 64) { const float v = h[c] + a.M1[(size_t)r * 1024 + c]; a.H2[(size_t)r * 1024 + c] = v; a.A2[(size_t)r * 1024 + c] = f2bf(v); ss += v * v; }
#pragma unroll
    for (int o = 32; o >= 1; o >>= 1) ss += __shfl_xor(ss, o);
    if (lane == 0) a.rstd2[r] = rsqrtf(ss * (1.0f / 1024.0f) + NORM_EPS);
}
__device__ __forceinline__ void hid_row(const MegaArgs& a, int r, int lane) {
    const float rs = a.rstd2[r];
    for (int u = lane; u < D_FF; u += 64) { const int pn = u >> 7, c = u & 127; const float av = a.Zf[(size_t)r * NFF2 + pn * 256 + c] * rs, bv = a.Zf[(size_t)r * NFF2 + pn * 256 + 128 + c] * rs;
        a.Hid[(size_t)r * D_FF + u] = f2bf(silu_f(av) * bv); }
}
__device__ __forceinline__ void yout_row(const MegaArgs& a, int r, int lane) {
    float* dst;
    if (r < T_PROMPT) { const int b = r / LP, l = r % LP; if (l < N_META) return; dst = a.out + O_Y_P + ((size_t)b * SEQ + (l - N_META)) * 1024; }
    else dst = a.out + O_Y_S + (size_t)(r - T_PROMPT) * 1024;
    for (int c = lane; c < 1024; c += 64) dst[c] = a.H2[(size_t)r * 1024 + c] + a.M1[(size_t)r * 1024 + c];
}

#define IDX_N_SAMPLE_UNITS (DEC_BATCH / 4)
#define IDX_N_PROMPT_UNITS (BATCH * 65)
#define IDX_N_UNITS (IDX_N_SAMPLE_UNITS + IDX_N_PROMPT_UNITS)
__device__ __forceinline__ void idx_unit(const MegaArgs& a, int idxu, unsigned char* shm) {
    int lane_l = threadIdx.x; asm volatile("" : "+v"(lane_l));
    const int wave = __builtin_amdgcn_readfirstlane(lane_l >> 6), lane = lane_l & 63;
    unsigned* strip = (unsigned*)(shm + (size_t)wave * idx::WAVE_LDS); unsigned* mask32 = (unsigned*)a.mask;
    if (idxu < IDX_N_SAMPLE_UNITS) {
        const int db = 4 * idxu + (wave >> 1), q0 = 4 * (wave & 1);
        idx::KeySrc<true> ks{a.Ikb + (size_t)(T_PROMPT + db * DEC_SEQ) * 64, a.cache_kidx, a.page_table + db * N_PAGES};
        idx::wave_task<true>(ks, a.Iq, a.Iw, T_PROMPT + db * DEC_SEQ + q0, PAST_LEN + q0, 4, strip, mask32, lane);
    } else {
        const int pi = idxu - IDX_N_SAMPLE_UNITS, u = 64 - pi / 8, b = pi % 8, l0 = 32 * u + 4 * wave;
        if (l0 < LP) {
            idx::KeySrc<false> ks{a.Ikb + (size_t)b * LP * 64, nullptr, nullptr};
            idx::wave_task<false>(ks, a.Iq, a.Iw, b * LP + l0, l0, (LP - l0) < 4 ? (LP - l0) : 4, strip, mask32, lane);
        }
    }
}
#define ATT_N_PROMPT_UNITS (BATCH * N_KV * 33)
__device__ __forceinline__ void attn_prompt_unit(const MegaArgs& a, int idx, char* lds) {
    const int qb = 32 - idx / 16, bn = idx % 16, b = bn >> 1, n = bn & 1;
    const int tok0 = b * LP + 64 * qb, nq = (LP - 64 * qb) < 64 ? (LP - 64 * qb) : 64;
    const int NT = qb + 1;
    att::KvPrompt kv{a.Kb + (size_t)b * LP * 256 + n * 128, a.Vb + (size_t)b * LP * 256 + n * 128};
    att::attn_unit<att::KvPrompt>(kv, a.Aq, a.mask, a.Odsa, tok0, nq, 4 * n, NT, lds);
}
__device__ __forceinline__ void attn_sample_unit(const MegaArgs& a, int u, char* lds) {
    const int db = u >> 1, n = u & 1;
    int* pages = (int*)(lds + 2 * att::SHM_V + 2 * att::SHM_K + 2048);
    __syncthreads();
    if (threadIdx.x < N_PAGES) pages[threadIdx.x] = a.page_table[db * N_PAGES + threadIdx.x];
    __syncthreads();
    att::KvSample kv{a.cache_k, a.cache_v, a.out + O_K_S + (size_t)db * DEC_SEQ * 256 + n * 128, a.out + O_V_S + (size_t)db * DEC_SEQ * 256 + n * 128, pages, n};
    att::attn_unit<att::KvSample>(kv, a.Aq, a.mask, a.Odsa, T_PROMPT + db * DEC_SEQ, DEC_SEQ, 4 * n, 33, lds);
}

#define LDS_TOTAL (8 * idx::WAVE_LDS + 2048)
__global__ void __launch_bounds__(512, 2) mega(MegaArgs a) {
    extern __shared__ __attribute__((aligned(16))) unsigned char shm[];
    float* lds = (float*)shm;
    volatile LAS unsigned* xbw = (volatile LAS unsigned*)(PG8_LAS unsigned char*)(shm + LDS_TOTAL - 16);
    const int tid = threadIdx.x, wave = tid >> 6, lane = tid & 63, half = tid >> 8, G = gridDim.x, bid = blockIdx.x;
    if (tid == 0) { xbw[0] = 0u; xbw[1] = 0u; xbw[2] = 0u; xbw[3] = 0u; }
    __syncthreads();
    XcdBarrier bar = xcd_barrier_post(a.bar, xbw);
    for (int jp = bid; jp < PREP_J_ROWS / 2; jp += G) prep_job(a.prep, 2 * jp + half, lds + half * (32 * 65));
    for (int j = PREP_J_ROWS + bid * 2 + half; j < PREP_N_JOBS; j += 2 * G) prep_job(a.prep, j, lds);
    xcd_barrier(bar);
    { pg8::StaticOrder S; S.init(T_PAD, N1, G, bid); pg8::gemm_phase<pg8::EpiF32, pg8::StaticOrder, false>((PG8_LAS unsigned char*)shm, pg8::Gemm{a.prep.A0, a.prep.W1t, T_PAD, N1, 1024}, S, pg8::EpiF32{a.Z, N1, nullptr}, nullptr); }
    xcd_barrier(bar);
    for (int rp = bid; rp < T_ALL / 2; rp += G) epi1_row(a, 2 * rp + half, tid & 255);
    xcd_barrier(bar);
    for (int u = bid; u < BATCH * H_RET * 8; u += G) ret::unit(a, u, (char*)shm);
    for (int u = bid; u < DEC_BATCH * H_RET * 8; u += G) ret_naive_unit(a, u, 1, lds);
    for (int i = 0; (long)i * G < IDX_N_UNITS; ++i) { const long p = (long)i * G + ((i & 1) ? (G - 1 - bid) : bid); if (p < IDX_N_UNITS) idx_unit(a, (int)p, shm); }
    xcd_barrier(bar);
    for (int i = 0; ; ++i) { const long p = (long)i * G + ((i & 1) ? (G - 1 - bid) : bid); if (p >= ATT_N_PROMPT_UNITS) { if ((long)i * G >= ATT_N_PROMPT_UNITS) break; else continue; } attn_prompt_unit(a, (int)p, (char*)shm); }
    for (int u = bid; u < DEC_BATCH * N_KV; u += G) attn_sample_unit(a, u, (char*)shm);
    for (int r = bid * 8 + wave; r < T_ALL; r += 8 * G) make_an_row(a, r, lane);
    xcd_barrier(bar);
    { pg8::StaticOrder S; S.init(T_PAD, 1024, G, bid); pg8::gemm_phase<pg8::EpiF32, pg8::StaticOrder, false>((PG8_LAS unsigned char*)shm, pg8::Gemm{a.An, a.prep.Wret, T_PAD, 1024, 2048}, S, pg8::EpiF32{a.M1, 1024, nullptr}, nullptr); }
    { pg8::StaticOrder S; S.init(T_PAD, 1024, G, bid); pg8::gemm_phase<pg8::EpiF32, pg8::StaticOrder, false>((PG8_LAS unsigned char*)shm, pg8::Gemm{a.Odsa, a.prep.Wdsa, T_PAD, 1024, 1024}, S, pg8::EpiF32{a.M2, 1024, nullptr}, nullptr); }
    xcd_barrier(bar);
    for (int r = bid * 8 + wave; r < T_ALL; r += 8 * G) merge_row(a, r, lane);
    xcd_barrier(bar);
    { pg8::StaticOrder S; S.init(T_PAD, 1024, G, bid); pg8::gemm_phase<pg8::EpiF32, pg8::StaticOrder, false>((PG8_LAS unsigned char*)shm, pg8::Gemm{a.Mg, a.prep.Wout, T_PAD, 1024, 1024}, S, pg8::EpiF32{a.M1, 1024, nullptr}, nullptr); }
    xcd_barrier(bar);
    for (int r = bid * 8 + wave; r < T_ALL; r += 8 * G) h2_row(a, r, lane);
    xcd_barrier(bar);
    { pg8::StaticOrder S; S.init(T_PAD, NFF2, G, bid); pg8::gemm_phase<pg8::EpiF32, pg8::StaticOrder, false>((PG8_LAS unsigned char*)shm, pg8::Gemm{a.A2, a.prep.Wffi, T_PAD, NFF2, 1024}, S, pg8::EpiF32{a.Zf, NFF2, nullptr}, nullptr); }
    xcd_barrier(bar);
    for (int r = bid * 8 + wave; r < T_ALL; r += 8 * G) hid_row(a, r, lane);
    xcd_barrier(bar);
    { pg8::StaticOrder S; S.init(T_PAD, 1024, G, bid); pg8::gemm_phase<pg8::EpiF32, pg8::StaticOrder, false>((PG8_LAS unsigned char*)shm, pg8::Gemm{a.Hid, a.prep.Wffo, T_PAD, 1024, 2816}, S, pg8::EpiF32{a.M1, 1024, nullptr}, nullptr); }
    xcd_barrier(bar);
    for (int r = bid * 8 + wave; r < T_ALL; r += 8 * G) yout_row(a, r, lane);
}
extern "C" void kernel_launch(void* const* d_in, const int* in_sizes, int n_in, void* d_out, int out_size, void* d_ws, size_t ws_size, hipStream_t stream) {
    static int grid = 0;
    if (grid == 0) {
        if (n_in != 20 || out_size != OUT_TOTAL || ws_size < WS_END_B1 || ws_size < WS_END_B2) { fprintf(stderr, "kernel_launch: unexpected shapes (n_in %d out %d ws %zu need %llu)\n", n_in, out_size, ws_size, (unsigned long long)WS_END_B1); grid = -1; return; }
        int dev = 0, cus = 0, per_cu = 0;
        if (hipGetDevice(&dev) != hipSuccess || hipDeviceGetAttribute(&cus, hipDeviceAttributeMultiprocessorCount, dev) != hipSuccess) { grid = -1; return; }
        if (hipFuncSetAttribute((const void*)mega, hipFuncAttributeMaxDynamicSharedMemorySize, LDS_TOTAL) != hipSuccess) { fprintf(stderr, "kernel_launch: hipFuncSetAttribute failed\n"); grid = -1; return; }
        if (hipOccupancyMaxActiveBlocksPerMultiprocessor(&per_cu, (const void*)mega, 512, LDS_TOTAL) != hipSuccess || per_cu < 1) { fprintf(stderr, "kernel_launch: occupancy query says %d blocks per CU\n", per_cu); grid = -1; return; }
        grid = cus;
    }
    if (grid < 0) return;
    char* ws = (char*)d_ws;
    MegaArgs a{};
    a.prep.x_prompt = (const float*)d_in[0]; a.prep.x_sample = (const float*)d_in[1]; a.prep.meta = (const float*)d_in[7]; a.prep.norm_mix_w = (const float*)d_in[8]; a.prep.w_in = (const float*)d_in[9];
    a.prep.w_ret = (const float*)d_in[10]; a.prep.w_dsa = (const float*)d_in[15]; a.prep.w_out = (const float*)d_in[16]; a.prep.norm_ffn_w = (const float*)d_in[17]; a.prep.w_ffi = (const float*)d_in[18]; a.prep.w_ffo = (const float*)d_in[19];
    a.prep.W1t = (bf16_t*)(ws + WS_W1T); a.prep.Wret = (bf16_t*)(ws + WS_WRET); a.prep.Wdsa = (bf16_t*)(ws + WS_WDSA); a.prep.Wout = (bf16_t*)(ws + WS_WOUT); a.prep.Wffi = (bf16_t*)(ws + WS_WFFI); a.prep.Wffo = (bf16_t*)(ws + WS_WFFO);
    a.prep.A0 = (bf16_t*)(ws + WS_A0); a.prep.rstd0 = (float*)(ws + WS_RSTD0); a.prep.rope = (float2*)(ws + WS_ROPE);
    a.cache_k = (const float*)d_in[2]; a.cache_v = (const float*)d_in[3]; a.cache_kidx = (const float*)d_in[4]; a.state_ret = (const float*)d_in[5]; a.page_table = (const int*)d_in[6];
    a.qnw = (const float*)d_in[11]; a.knw = (const float*)d_in[12]; a.ikw = (const float*)d_in[13]; a.ikb = (const float*)d_in[14];
    a.Rq = (bf16_t*)(ws + WS_RQ); a.Rk = (bf16_t*)(ws + WS_RK); a.Rv = (bf16_t*)(ws + WS_RV); a.G = (bf16_t*)(ws + WS_G); a.Aq = (bf16_t*)(ws + WS_AQ); a.Kb = (bf16_t*)(ws + WS_KB); a.Vb = (bf16_t*)(ws + WS_VB);
    a.Iq = (bf16_t*)(ws + WS_IQ); a.Ikb = (bf16_t*)(ws + WS_IKB); a.Gates = (bf16_t*)(ws + WS_GATES); a.OG = (bf16_t*)(ws + WS_OG); a.An = (bf16_t*)(ws + WS_AN); a.Odsa = (bf16_t*)(ws + WS_ODSA); a.Mg = (bf16_t*)(ws + WS_MG);
    a.A2 = (bf16_t*)(ws + WS_A2); a.Hid = (bf16_t*)(ws + WS_HID);
    a.Iw = (float*)(ws + WS_IW); a.ssret = (float*)(ws + WS_SSRET); a.rstd2 = (float*)(ws + WS_RSTD2); a.Z = (float*)(ws + WS_Z); a.M1 = (float*)(ws + WS_M1); a.M2 = (float*)(ws + WS_M2); a.H2 = (float*)(ws + WS_H2); a.Zf = (float*)(ws + WS_ZF);
    a.out = (float*)d_out; a.mask = (u64*)(ws + WS_MASK); a.bar = (unsigned*)(ws + WS_CTL);
    if (hipMemsetAsync(ws + WS_CTL, 0, 65536, stream) != hipSuccess) return;
    hipLaunchKernelGGL(mega, dim3(grid), dim3(512), LDS_TOTAL, stream, a);
}
```

```cpp
#include <hip/hip_runtime.h>
#include <stdint.h>
#include <stdio.h>

#define D_MODEL 1024
#define BATCH 8
#define SEQ 2048
#define N_META 16
#define LP (N_META + SEQ)
#define DEC_BATCH 128
#define DEC_SEQ 8
#define PAST_LEN 2048
#define PAGE_SIZE 128
#define N_PAGES 16
#define H_RET 4
#define DK_RET 256
#define DV_RET 512
#define N_HEADS 8
#define N_KV 2
#define D_HEAD 128
#define N_IDXH 8
#define D_IDX 64
#define TOPK 256
#define D_FF 2816
#define IN_COLS 10312
#define NORM_EPS 1e-6f
#define IDX_SCALE 0.04419417382415922f
#define T_PROMPT (BATCH * LP)
#define T_SAMPLE (DEC_BATCH * DEC_SEQ)
#define T_ALL (T_PROMPT + T_SAMPLE)
#define T_PAD 17664
#define N1 10496
#define NFF2 5632
#define MASK_WORDS 34
#define SAMPLE_L (PAST_LEN + DEC_SEQ)

#define O_Y_P   0
#define O_Y_S   16777216
#define O_K_P   17825792
#define O_V_P   22052864
#define O_KI_P  26279936
#define O_R_P   27336704
#define O_K_S   31531008
#define O_V_S   31793152
#define O_KI_S  32055296
#define O_R_S   32120832
#define OUT_TOTAL 99229696

typedef unsigned short bf16_t;
typedef unsigned long long u64;

__device__ __forceinline__ bf16_t f2bf(float f) { unsigned u = __float_as_uint(f); u += 0x7FFFu + ((u >> 16) & 1u); return (bf16_t)(u >> 16); }
__device__ __forceinline__ float bf2f(bf16_t b) { return __uint_as_float(((unsigned)b) << 16); }
__device__ __forceinline__ float silu_f(float x) { return x / (1.0f + __expf(-x)); }
__device__ __forceinline__ float sigmoid_f(float x) { return 1.0f / (1.0f + __expf(-x)); }

__device__ __forceinline__ int row_pos(int r) { return r < T_PROMPT ? (r % LP) : (PAST_LEN + ((r - T_PROMPT) & (DEC_SEQ - 1))); }

#define WS_CTL      0ull
#define WS_W1T      (WS_CTL + 65536ull)
#define WS_WRET     (WS_W1T + (u64)N1 * 1024 * 2)
#define WS_WDSA     (WS_WRET + 1024ull * 2048 * 2)
#define WS_WOUT     (WS_WDSA + 1024ull * 1024 * 2)
#define WS_WFFI     (WS_WOUT + 1024ull * 1024 * 2)
#define WS_WFFO     (WS_WFFI + (u64)NFF2 * 1024 * 2)
#define WS_ROPE     (WS_WFFO + 1024ull * 2816 * 2)
#define WS_RSTD0    (WS_ROPE + (u64)LP * 128 * 8)
#define WS_A0       (WS_RSTD0 + (u64)T_PAD * 4)
#define WS_RQ       (WS_A0 + (u64)T_PAD * 1024 * 2)
#define WS_RK       (WS_RQ + (u64)T_PAD * 1024 * 2)
#define WS_RV       (WS_RK + (u64)T_PAD * 1024 * 2)
#define WS_G        (WS_RV + (u64)T_PAD * 2048 * 2)
#define WS_AQ       (WS_G + (u64)T_PAD * 2048 * 2)
#define WS_KB       (WS_AQ + (u64)T_PAD * 1024 * 2)
#define WS_VB       (WS_KB + (u64)T_PAD * 256 * 2)
#define WS_IQ       (WS_VB + (u64)T_PAD * 256 * 2)
#define WS_IKB      (WS_IQ + (u64)T_PAD * 512 * 2)
#define WS_IW       (WS_IKB + (u64)T_PAD * 64 * 2)
#define WS_GATES    (WS_IW + (u64)T_PAD * 8 * 4)
#define WS_MASK     (WS_GATES + (u64)T_PAD * 2048 * 2)
#define WS_SSRET    (WS_MASK + (u64)T_PAD * MASK_WORDS * 8)
#define WS_RSTD2    (WS_SSRET + (u64)T_PAD * 32 * 4)
#define WS_REGION_B (((WS_RSTD2 + (u64)T_PAD * 16 * 4) + 4095ull) & ~4095ull)
#define WS_Z        WS_REGION_B
#define WS_H2       WS_REGION_B
#define WS_A2       (WS_H2 + (u64)T_PAD * 1024 * 4)
#define WS_HID      (WS_A2 + (u64)T_PAD * 1024 * 2)
#define WS_MG       (WS_HID + (u64)T_PAD * 2816 * 2)
#define WS_OG       (WS_MG + (u64)T_PAD * 1024 * 2)
#define WS_AN       (WS_OG + (u64)T_PAD * 2048 * 2)
#define WS_ODSA     (WS_AN + (u64)T_PAD * 2048 * 2)
#define WS_M1       (WS_ODSA + (u64)T_PAD * 1024 * 2)
#define WS_M2       (WS_M1 + (u64)T_PAD * 1024 * 4)
#define WS_ZF       WS_OG
#define WS_END_B1   (WS_Z + (u64)T_PAD * N1 * 4)
#define WS_END_B2   (WS_ZF + (u64)T_PAD * NFF2 * 4)
namespace pg8 {
#define PG8_LAS __attribute__((address_space(3)))
typedef unsigned short bf16_t;
typedef short bf16x8 __attribute__((ext_vector_type(8)));
typedef float f32x4 __attribute__((ext_vector_type(4)));
typedef unsigned u32x4 __attribute__((ext_vector_type(4)));
constexpr int BM = 256, BK = 64, HALF = 128, HTB = HALF * BK * 2  , STAGE_BYTES = 8 * HTB, NXCD = 8, WGM = 8;

__host__ __device__ __forceinline__ int lds_byte(int r, int c) { const int st = (r >> 4) * 2 + (c >> 5), rr = r & 15, cc = c & 31, ob = rr * 64 + cc * 2; return st * 1024 + (ob ^ (((ob >> 9) & 1) << 5)); }
__host__ __device__ __forceinline__ void stage_rc(int b, int& R, int& C) { const int st = b / 1024, sb = b % 1024, swz = sb ^ (((sb >> 9) & 1) << 5); R = (st >> 1) * 16 + swz / 64; C = (st & 1) * 32 + (swz % 64) / 2; }
__host__ __device__ __forceinline__ int perm32(int rho) { const int n = rho >> 4, i = rho & 15; return 8 * (i >> 2) + 4 * n + (i & 3); }

struct Unit { int pm, pn; };
struct Gemm { const bf16_t* A; const bf16_t* Bt; int M, N, K; };

struct StaticOrder {
    int nM, nN, nwg, G, c;
    __host__ __device__ void init(int M, int N, int G_, int c_) { nM = M / BM; nN = N / BM; nwg = nM * nN; G = G_; c = c_; }
    __host__ __device__ bool next(int i, Unit& u) const {
        const long L = (long)i * G + c; if (L >= nwg) return false;
        int wgid = (int)L; { const int q = nwg / NXCD, r = nwg % NXCD, xcd = wgid % NXCD, off = wgid / NXCD; wgid = (xcd < r ? xcd * (q + 1) : r * (q + 1) + (xcd - r) * q) + off; }
        const int nig = WGM * nN, gid = wgid / nig, fm = gid * WGM, gsz = (nM - fm) < WGM ? (nM - fm) : WGM;
        u.pm = fm + ((wgid % nig) % gsz); u.pn = (wgid % nig) / gsz; return true;
    }
    __device__ __forceinline__ void a_ready(const Unit&) const {}
    __device__ __forceinline__ void done(const Unit&) const {}
};
struct CountedOrder : StaticOrder {
    const unsigned* ready; unsigned need; unsigned* tmo;
    __device__ __forceinline__ void a_ready(const Unit& u) const {
        if (threadIdx.x < 64) {
            const unsigned long long t0 = __builtin_amdgcn_s_memrealtime(); unsigned polls = 0;
            while ((unsigned)__builtin_amdgcn_readfirstlane(__hip_atomic_load(ready + 64 * u.pm, __ATOMIC_RELAXED, __HIP_MEMORY_SCOPE_AGENT)) < need) {
                if ((++polls & 255u) == 0u && __builtin_amdgcn_readfirstlane(__hip_atomic_load(tmo, __ATOMIC_RELAXED, __HIP_MEMORY_SCOPE_AGENT)) != 0u) break;
                if (__builtin_amdgcn_s_memrealtime() - t0 > 2000000ull) {
                    if (threadIdx.x == 0) { unsigned expect = 0u; __hip_atomic_compare_exchange_strong(tmo + 1, &expect, 0x600u | (unsigned)(u.pm & 0xff), __ATOMIC_RELAXED, __ATOMIC_RELAXED, __HIP_MEMORY_SCOPE_AGENT); __hip_atomic_store(tmo, 1u, __ATOMIC_RELAXED, __HIP_MEMORY_SCOPE_AGENT); }
                    break; }
                __builtin_amdgcn_s_sleep(2); }
            __builtin_amdgcn_fence(__ATOMIC_ACQUIRE, "agent");
            asm volatile("s_waitcnt vmcnt(0)" ::: "memory");
        }
#if !defined(BROKEN_HOOK_NO_BARRIER)
        asm volatile("" ::: "memory"); __builtin_amdgcn_s_barrier(); asm volatile("" ::: "memory");
#endif
    }
};

typedef float f32x2c __attribute__((ext_vector_type(2))); typedef __bf16 bf16x2c __attribute__((ext_vector_type(2)));
__device__ __forceinline__ unsigned cvt_pk_bf16(float lo, float hi) { const f32x2c v = {lo, hi}; return __builtin_bit_cast(unsigned, __builtin_convertvector(v, bf16x2c)); }
typedef float f32x2 __attribute__((ext_vector_type(2)));
__device__ __forceinline__ f32x2 gelu_pk(f32x2 v) {
    const f32x2 av = __builtin_elementwise_abs(v), d = av * 0.2316418882f + 1.0f;
    f32x2 t; t.x = __builtin_amdgcn_rcpf(d.x); t.y = __builtin_amdgcn_rcpf(d.y);
    f32x2 q = t * 0.5307027145f + (-0.7265760135f); q = q * t + 0.7107068705f; q = q * t + (-0.142248368f); q = q * t + 0.127414796f; q = q * t;
    const f32x2 s = (v * v) * (-0.72134752044f);
    f32x2 e; e.x = __builtin_amdgcn_exp2f(s.x); e.y = __builtin_amdgcn_exp2f(s.y);
    const f32x2 m = v * (q * e), r = v - m;
    f32x2 o; o.x = v.x < 0.f ? m.x : r.x; o.y = v.y < 0.f ? m.y : r.y; return o;
}

struct EpiF32 {
    static constexpr bool PERM = false, AFTER_DRAIN = false;
    float* C; int ldc; const float* bias;
    __device__ __forceinline__ void operator()(const f32x4 (&acc)[2][2][4][2], const Unit& u, int wr, int wc, int fr, int fq) const {
        const int row0 = u.pm * BM + wr * 64 + fr, col0 = u.pn * BM + wc * 32 + 4 * fq;
        f32x4 bv[2][2];
#pragma unroll
        for (int bj = 0; bj < 2; ++bj)
#pragma unroll
            for (int n = 0; n < 2; ++n) bv[bj][n] = bias ? *(const f32x4*)(bias + col0 + bj * HALF + n * 16) : (f32x4){0.f, 0.f, 0.f, 0.f};
#pragma unroll
        for (int ai = 0; ai < 2; ++ai)
#pragma unroll
            for (int m = 0; m < 4; ++m) { float* rowp = C + (size_t)(row0 + ai * HALF + m * 16) * ldc + col0;
#pragma unroll
                for (int bj = 0; bj < 2; ++bj)
#pragma unroll
                    for (int n = 0; n < 2; ++n) *(f32x4*)(rowp + bj * HALF + n * 16) = acc[ai][bj][m][n] + bv[bj][n]; }
    }
};
template <int ACT  > struct EpiBf16 {
    static constexpr bool PERM = true, AFTER_DRAIN = false;
    bf16_t* O; int ldc; const float* bias; int split_cols; size_t split_stride;
    __device__ __forceinline__ void operator()(const f32x4 (&acc)[2][2][4][2], const Unit& u, int wr, int wc, int fr, int fq) const {
        const int row0 = u.pm * BM + wr * 64 + fr; int colt = u.pn * BM; bf16_t* base = O;
        if (split_cols) { const int t = colt / split_cols; base += (size_t)t * split_stride; colt -= t * split_cols; }
        const int col0 = colt + wc * 32 + 8 * fq, bcol0 = u.pn * BM + wc * 32 + 8 * fq;
        f32x4 bv[2][2];
#pragma unroll
        for (int bj = 0; bj < 2; ++bj)
#pragma unroll
            for (int n = 0; n < 2; ++n) bv[bj][n] = bias ? *(const f32x4*)(bias + bcol0 + bj * HALF + 4 * n) : (f32x4){0.f, 0.f, 0.f, 0.f};
#pragma unroll
        for (int ai = 0; ai < 2; ++ai)
#pragma unroll
            for (int m = 0; m < 4; ++m) { bf16_t* rowp = base + (size_t)(row0 + ai * HALF + m * 16) * ldc + col0;
#pragma unroll
                for (int bj = 0; bj < 2; ++bj) { f32x4 v0 = acc[ai][bj][m][0] + bv[bj][0], v1 = acc[ai][bj][m][1] + bv[bj][1];
                    if (ACT == 1) { f32x2 a = gelu_pk((f32x2){v0[0], v0[1]}), b = gelu_pk((f32x2){v0[2], v0[3]}), c = gelu_pk((f32x2){v1[0], v1[1]}), d = gelu_pk((f32x2){v1[2], v1[3]});
                        v0 = (f32x4){a.x, a.y, b.x, b.y}; v1 = (f32x4){c.x, c.y, d.x, d.y}; }
                    if (ACT == 2) {
#pragma unroll
                        for (int j = 0; j < 4; ++j) { v0[j] = 0.5f * v0[j] * (1.0f + erff(v0[j] * 0.70710678f)); v1[j] = 0.5f * v1[j] * (1.0f + erff(v1[j] * 0.70710678f)); } }
                    u32x4 w; w.x = cvt_pk_bf16(v0[0], v0[1]); w.y = cvt_pk_bf16(v0[2], v0[3]); w.z = cvt_pk_bf16(v1[0], v1[1]); w.w = cvt_pk_bf16(v1[2], v1[3]);
                    *(u32x4*)(rowp + bj * HALF) = w; } }
    }
};
template <class Epi, class Sched, bool STAMP = false>
__device__ __forceinline__ void gemm_phase(PG8_LAS unsigned char* lds, const Gemm g, const Sched& S, const Epi& E, unsigned long long* stamps) {
    int tid_l = threadIdx.x; asm volatile("" : "+v"(tid_l));
    const int tid = tid_l, wid = __builtin_amdgcn_readfirstlane(tid >> 6), lane = tid & 63, wr = wid >> 2, wc = wid & 3, fr = lane & 15, fq = lane >> 4;
    const int K = g.K, nt = K / BK;
    int ts_lo = 0, ts_hi = 0, nts = 0; const unsigned long long rt_entry = STAMP ? (unsigned long long)wall_clock64() : 0ull;
#define PG8_STAMP() do { if (STAMP && wid == 0 && nts < 64) { const unsigned long long _c = (unsigned long long)clock64(); \
        ts_lo = (lane == nts) ? (int)(unsigned)_c : ts_lo; ts_hi = (lane == nts) ? (int)(unsigned)(_c >> 32) : ts_hi; ++nts; } } while (0)
    PG8_STAMP();
    unsigned voffA[2], voffB[2];
#pragma unroll
    for (int i = 0; i < 2; ++i) { int R, C; stage_rc(tid * 16 + i * 8192, R, C); const int Rb = Epi::PERM ? ((R & ~31) + perm32(R & 31)) : R;
        voffA[i] = (unsigned)(R * K + C) * 2u; voffB[i] = (unsigned)(Rb * K + C) * 2u; }
    const size_t kstep = (size_t)(BK * 2);
    const size_t hstep = (size_t)HALF * K * 2;
    const size_t tstep = 2 * hstep;
    const unsigned ldsw = (unsigned)wid * 1024u;
    const int aoff = lds_byte(wr * 64 + fr, fq * 8), boff = lds_byte(wc * 32 + fr, fq * 8);
#define PG8_SA(b, h) (((b) * 2 + (h)) * HTB)
#define PG8_SB(b, h) ((4 + (b) * 2 + (h)) * HTB)
#define PG8_STAGE(bufoff, gbase, voff) do { _Pragma("unroll") for (int _i = 0; _i < 2; ++_i) \
        __builtin_amdgcn_global_load_lds((const unsigned*)((const char*)(gbase) + (voff)[_i]), (PG8_LAS unsigned*)(lds + (bufoff) + ldsw + _i * 8192), 16, 0, 0); } while (0)
#define PG8_LDA(dst, b, h) do { _Pragma("unroll") for (int m = 0; m < 4; ++m) _Pragma("unroll") for (int k = 0; k < 2; ++k) dst[m][k] = *(const PG8_LAS bf16x8*)(lds + PG8_SA(b, h) + aoff + m * 2048 + k * 1024); } while (0)
#define PG8_LDB(dst, b, h) do { _Pragma("unroll") for (int n = 0; n < 2; ++n) _Pragma("unroll") for (int k = 0; k < 2; ++k) dst[n][k] = *(const PG8_LAS bf16x8*)(lds + PG8_SB(b, h) + boff + n * 2048 + k * 1024); } while (0)
#define PG8_MMA(ai, bj, At, Bt) do { __builtin_amdgcn_s_setprio(1); _Pragma("unroll") for (int m = 0; m < 4; ++m) _Pragma("unroll") for (int n = 0; n < 2; ++n) _Pragma("unroll") for (int k = 0; k < 2; ++k) \
        acc[ai][bj][m][n] = __builtin_amdgcn_mfma_f32_16x16x32_bf16(Bt[n][k], At[m][k], acc[ai][bj][m][n], 0, 0, 0); __builtin_amdgcn_s_setprio(0); } while (0)
#define PG8_WAIT_V(n) asm volatile("s_waitcnt vmcnt(" #n ")" ::: "memory")
#define PG8_WAIT_L(n) asm volatile("s_waitcnt lgkmcnt(" #n ")" ::: "memory")
#define PG8_BAR __builtin_amdgcn_s_barrier()
#define PG8_SCHED __builtin_amdgcn_sched_barrier(0)
    Unit cur, nxt; int ui = 0;
    if (!S.next(0, cur)) return;
    f32x4 acc[2][2][4][2];
#pragma unroll
    for (int a = 0; a < 2; ++a)
#pragma unroll
        for (int b = 0; b < 2; ++b)
#pragma unroll
            for (int m = 0; m < 4; ++m)
#pragma unroll
                for (int n = 0; n < 2; ++n) acc[a][b][m][n] = (f32x4){0.f, 0.f, 0.f, 0.f};
    bf16x8 At[4][2], B0[2][2], B1[2][2];
    const char* cA = (const char*)g.A + (size_t)cur.pm * tstep; const char* cB = (const char*)g.Bt + (size_t)cur.pn * tstep;
    S.a_ready(cur);
    PG8_STAGE(PG8_SB(0, 0), cB, voffB); PG8_STAGE(PG8_SA(0, 0), cA, voffA); PG8_STAGE(PG8_SB(0, 1), cB + hstep, voffB); PG8_STAGE(PG8_SA(0, 1), cA + hstep, voffA);
    if (wr == 1) PG8_BAR;
    PG8_WAIT_V(4); PG8_BAR;
    PG8_STAGE(PG8_SB(1, 0), cB + kstep, voffB); PG8_STAGE(PG8_SA(1, 0), cA + kstep, voffA); PG8_STAGE(PG8_SB(1, 1), cB + hstep + kstep, voffB);
    PG8_WAIT_V(6); PG8_BAR;
    PG8_STAMP();
    for (;;) {
        const bool has_next = S.next(ui + 1, nxt);
        const char* nA = has_next ? (const char*)g.A + (size_t)nxt.pm * tstep : cA; const char* nB = has_next ? (const char*)g.Bt + (size_t)nxt.pn * tstep : cB;
        for (int t = 0; t < nt; t += 2) {
            const bool last = (t == nt - 2);
            const char* a1 = cA + (size_t)(t + 1) * kstep;
            const char* a2 = last ? nA : cA + (size_t)(t + 2) * kstep; const char* b2 = last ? nB : cB + (size_t)(t + 2) * kstep;
            const char* a3 = a2 + kstep; const char* b3 = b2 + kstep;
            if (last && has_next) S.a_ready(nxt);
            PG8_LDB(B0, 0, 0); PG8_SCHED; PG8_LDA(At, 0, 0); PG8_STAGE(PG8_SA(1, 1), a1 + hstep, voffA);
            PG8_WAIT_L(8); PG8_BAR; PG8_WAIT_L(0); PG8_MMA(0, 0, At, B0); PG8_BAR; PG8_SCHED;
            PG8_LDB(B1, 0, 1); PG8_STAGE(PG8_SB(0, 0), b2, voffB);
            PG8_BAR; PG8_WAIT_L(0); PG8_MMA(0, 1, At, B1); PG8_BAR;
            PG8_LDA(At, 0, 1); PG8_STAGE(PG8_SA(0, 0), a2, voffA);
            PG8_BAR; PG8_WAIT_L(0); PG8_MMA(1, 0, At, B0); PG8_BAR; PG8_SCHED;
            PG8_STAGE(PG8_SB(0, 1), b2 + hstep, voffB);
            PG8_WAIT_V(6); PG8_BAR; PG8_MMA(1, 1, At, B1); PG8_BAR;
            PG8_LDB(B0, 1, 0); PG8_SCHED; PG8_LDA(At, 1, 0); PG8_STAGE(PG8_SA(0, 1), a2 + hstep, voffA);
            PG8_WAIT_L(8); PG8_BAR; PG8_WAIT_L(0); PG8_MMA(0, 0, At, B0); PG8_BAR; PG8_SCHED;
            PG8_LDB(B1, 1, 1); PG8_STAGE(PG8_SB(1, 0), b3, voffB);
            PG8_BAR; PG8_WAIT_L(0); PG8_MMA(0, 1, At, B1); PG8_BAR;
            PG8_LDA(At, 1, 1); PG8_STAGE(PG8_SA(1, 0), a3, voffA);
            PG8_BAR; PG8_WAIT_L(0); PG8_MMA(1, 0, At, B0); PG8_BAR; PG8_SCHED;
            PG8_STAGE(PG8_SB(1, 1), b3 + hstep, voffB);
            PG8_WAIT_V(6); PG8_BAR; PG8_MMA(1, 1, At, B1); PG8_BAR;
        }
        PG8_STAMP();
        if constexpr (!Epi::AFTER_DRAIN) { E(acc, cur, wr, wc, fr, fq); S.done(cur); }
        PG8_STAMP();
        if (!has_next) break;
#pragma unroll
        for (int a = 0; a < 2; ++a)
#pragma unroll
            for (int b = 0; b < 2; ++b)
#pragma unroll
                for (int m = 0; m < 4; ++m)
#pragma unroll
                    for (int n = 0; n < 2; ++n) acc[a][b][m][n] = (f32x4){0.f, 0.f, 0.f, 0.f};
        cur = nxt; cA = nA; cB = nB; ++ui;
    }
    PG8_WAIT_V(0);
    if (wr == 0) PG8_BAR;
    PG8_BAR;
    if constexpr (Epi::AFTER_DRAIN) { E.fused(acc, cur, wr, wc, fr, fq, lds, wid, lane); S.done(cur); }
    PG8_STAMP();
    if (STAMP && wid == 0) { stamps[lane] = lane < nts ? (((unsigned long long)(unsigned)ts_hi << 32) | (unsigned)ts_lo) : 0ull;
        if (lane == 62) stamps[62] = rt_entry; if (lane == 63) stamps[63] = (unsigned long long)wall_clock64(); }
#undef PG8_STAMP
#undef PG8_SA
#undef PG8_SB
#undef PG8_STAGE
#undef PG8_LDA
#undef PG8_LDB
#undef PG8_MMA
#undef PG8_WAIT_V
#undef PG8_WAIT_L
#undef PG8_BAR
#undef PG8_SCHED
}
}
#define XB_TMO      128
#define XB_XCNT(j)  (256  + 64 * (j))
#define XB_XSUB(j)  (1280 + 64 * (j))
#define XB_XGEN(j)  (2304 + 64 * (j))
#define XB_TOP      3328
#define XB_TOPGEN   3392
#define XCD_BAR_WORDS 3456
#define XB_SPIN_CAP (1u << 18)
#define LAS __attribute__((address_space(3)))

__device__ __forceinline__ unsigned xb_ld(unsigned* p)              { return __hip_atomic_load(p, __ATOMIC_RELAXED, __HIP_MEMORY_SCOPE_AGENT); }
__device__ __forceinline__ unsigned xb_add(unsigned* p, unsigned v) { return __hip_atomic_fetch_add(p, v, __ATOMIC_RELAXED, __HIP_MEMORY_SCOPE_AGENT); }
__device__ __forceinline__ unsigned xb_xcc_id() { return (unsigned)__builtin_amdgcn_s_getreg((3 << 11) | 20) & 0xFu; }
#define XB_SPIN(cond, bar) do { unsigned _sp = 0; while (cond) { __builtin_amdgcn_s_sleep(1); \
    if ((++_sp & 255u) == 0u) { if (xb_ld(&(bar)[XB_TMO])) break; if (_sp > XB_SPIN_CAP) { atomicAdd(&(bar)[XB_TMO], 1u); break; } } } } while (0)

struct XcdBarrier {
    unsigned* bar; unsigned x;
    volatile LAS unsigned* st;
};

__device__ __forceinline__ XcdBarrier xcd_barrier_post(unsigned* bar, volatile LAS unsigned* st) {
    XcdBarrier b; b.bar = bar; b.x = xb_xcc_id(); b.st = st;
    if (threadIdx.x == 0) (void)xb_add(&bar[XB_XCNT(b.x)], 1u);
    return b;
}
__device__ __forceinline__ void xcd_barrier_complete(unsigned* bar, unsigned x, unsigned& nloc, unsigned& nx) {
    const unsigned G = gridDim.x * gridDim.y * gridDim.z;
    unsigned sum, cnt, mine, sp = 0u;
    for (;;) {
        sum = 0u; cnt = 0u; mine = 0u;
#pragma unroll
        for (unsigned j = 0; j < 16; ++j) { const unsigned c = xb_ld(&bar[XB_XCNT(j)]); sum += c; cnt += (c > 0u) ? 1u : 0u; mine = (j == x) ? c : mine; }
        if (sum == G) break;
        __builtin_amdgcn_s_sleep(1);
        if ((++sp & 255u) == 0u) { if (xb_ld(&bar[XB_TMO])) break; if (sp > XB_SPIN_CAP) { atomicAdd(&bar[XB_TMO], 1u); break; } }
    }
    nloc = mine > 0u ? mine : 1u; nx = cnt > 0u ? cnt : 1u;
}

__device__ __forceinline__ void xcd_barrier(const XcdBarrier& b) {
    asm volatile("s_waitcnt vmcnt(0)" ::: "memory");
    __syncthreads();
    if (threadIdx.x == 0) {
        unsigned* bar = b.bar;
        __builtin_amdgcn_s_waitcnt(0);
        unsigned nloc = b.st[0], nx = b.st[1];
        if (nloc == 0u) { xcd_barrier_complete(bar, b.x, nloc, nx); b.st[0] = nloc; b.st[1] = nx; }
        const unsigned old = xb_add(&bar[XB_XSUB(b.x)], 1u);
        const unsigned gen = old / nloc;
        if (old + 1u == (gen + 1u) * nloc) {
            __builtin_amdgcn_fence(__ATOMIC_RELEASE, "agent");
            asm volatile("s_waitcnt vmcnt(0)" ::: "memory");
            const unsigned og = xb_add(&bar[XB_TOP], 1u);
            const unsigned tg = og / nx;
            if (og + 1u == (tg + 1u) * nx) xb_add(&bar[XB_TOPGEN], 1u);
            else XB_SPIN(xb_ld(&bar[XB_TOPGEN]) == tg, bar);
            __builtin_amdgcn_fence(__ATOMIC_ACQUIRE, "agent");
            xb_add(&bar[XB_XGEN(b.x)], 1u);
            asm volatile("s_waitcnt vmcnt(0)" ::: "memory");
        } else {
            XB_SPIN(xb_ld(&bar[XB_XGEN(b.x)]) == gen, bar);
            __builtin_amdgcn_fence(__ATOMIC_ACQUIRE, "agent");
            asm volatile("s_waitcnt vmcnt(0)" ::: "memory");
        }
    }
    __syncthreads();
}
__host__ __device__ __forceinline__ int ikiw_src(int c) {
    if (c < 32) return 8192 + c;
    if (c < 40) return 8256 + (c - 32);
    if (c >= 128 && c < 160) return 8192 + 32 + (c - 128);
    return -1;
}
__host__ __device__ __forceinline__ int ik_tilecol(int e) { return e < 32 ? e : 128 + (e - 32); }
__device__ __forceinline__ int src_col(int mode, int n) {
    if (mode == 0) return n;
    if (mode == 1) { if (n < 8192) return n; if (n < 8448) return ikiw_src(n - 8192); return 8264 + (n - 8448); }
    const int pn = n >> 8, c = n & 255; return c < 128 ? pn * 128 + c : D_FF + pn * 128 + (c - 128);
}
__device__ __forceinline__ void prep_weight_tile(const float* __restrict__ w, int ldw, const float* __restrict__ scale, bf16_t* __restrict__ Wt, int K, int mode, int tile, float* lds  ) {
    const int ktiles = K / 32, nt = tile / ktiles, kt = tile % ktiles, tid = threadIdx.x & 255;
    const int n0 = nt * 64, k0 = kt * 32;
    {   const int nn = tid & 63, kk0 = tid >> 6; const int sc = src_col(mode, n0 + nn);
#pragma unroll
        for (int i = 0; i < 8; ++i) { const int kk = kk0 + i * 4; float v = 0.f; if (sc >= 0) { v = w[(size_t)(k0 + kk) * ldw + sc]; if (scale) v *= scale[k0 + kk]; } lds[kk * 65 + nn] = v; } }
    __syncthreads();
    {   const int kk = tid & 31, nn0 = tid >> 5;
#pragma unroll
        for (int i = 0; i < 8; ++i) { const int nn = nn0 + i * 8; Wt[(size_t)(n0 + nn) * K + k0 + kk] = f2bf(lds[kk * 65 + nn]); } }
    __syncthreads();
}
__device__ __forceinline__ const float* h_row_ptr(int r, const float* xp, const float* xs, const float* meta) {
    if (r < T_PROMPT) { const int b = r / LP, l = r % LP; return l < N_META ? meta + (size_t)l * D_MODEL : xp + ((size_t)b * SEQ + (l - N_META)) * D_MODEL; }
    return xs + (size_t)(r - T_PROMPT) * D_MODEL;
}
__device__ __forceinline__ void prep_row(int r, const float* xp, const float* xs, const float* meta, bf16_t* A0, float* rstd0, int lane) {
    if (r >= T_ALL) { for (int i = lane; i < D_MODEL / 2; i += 64) ((unsigned*)(A0 + (size_t)r * D_MODEL))[i] = 0u; if (lane == 0) rstd0[r] = 0.f; return; }
    const float4* src = (const float4*)h_row_ptr(r, xp, xs, meta); float ss = 0.f;
#pragma unroll
    for (int i = 0; i < 4; ++i) { const float4 v = src[lane + i * 64]; ss += v.x * v.x + v.y * v.y + v.z * v.z + v.w * v.w;
        uint2 o; o.x = (unsigned)f2bf(v.x) | ((unsigned)f2bf(v.y) << 16); o.y = (unsigned)f2bf(v.z) | ((unsigned)f2bf(v.w) << 16);
        ((uint2*)(A0 + (size_t)r * D_MODEL))[lane + i * 64] = o; }
#pragma unroll
    for (int o = 32; o >= 1; o >>= 1) ss += __shfl_xor(ss, o);
    if (lane == 0) rstd0[r] = rsqrtf(ss * (1.0f / D_MODEL) + NORM_EPS);
}
__device__ __forceinline__ void rope_entry(int idx, float2* tab) {
    const int pos = idx >> 7, i = idx & 127;
    const float inv = exp2f(-(float)i * (13.287712379549449f / 128.0f));
    const float angf = (float)pos * inv; const double a = (double)angf;
    const double kq = rint(a * 0.63661977236758134308);
    double r = fma(-kq, 1.57079632679489655800e+00, a); r = fma(-kq, 6.12323399573676603587e-17, r);
    const double r2 = r * r;
    const double sp = r * (1.0 + r2 * (-1.0 / 6 + r2 * (1.0 / 120 + r2 * (-1.0 / 5040 + r2 * (1.0 / 362880 + r2 * (-1.0 / 39916800 + r2 * (1.0 / 6227020800.0)))))));
    const double cp = 1.0 + r2 * (-0.5 + r2 * (1.0 / 24 + r2 * (-1.0 / 720 + r2 * (1.0 / 40320 + r2 * (-1.0 / 3628800 + r2 * (1.0 / 479001600 + r2 * (-1.0 / 87178291200.0)))))));
    const int q = ((int)kq) & 3;
    const double sv = (q == 0) ? sp : (q == 1) ? cp : (q == 2) ? -sp : -cp;
    const double cv = (q == 0) ? cp : (q == 1) ? -sp : (q == 2) ? -cp : sp;
    tab[idx] = make_float2((float)cv, (float)sv);
}

struct PrepArgs {
    const float *x_prompt, *x_sample, *meta, *norm_mix_w, *w_in, *w_ret, *w_dsa, *w_out, *norm_ffn_w, *w_ffi, *w_ffo;
    bf16_t *W1t, *Wret, *Wdsa, *Wout, *Wffi, *Wffo, *A0; float* rstd0; float2* rope;
};
#define PREP_J_W1   0
#define PREP_N_W1   ((N1 / 64) * (1024 / 32))
#define PREP_J_WRET (PREP_J_W1 + PREP_N_W1)
#define PREP_N_WRET ((1024 / 64) * (2048 / 32))
#define PREP_J_WDSA (PREP_J_WRET + PREP_N_WRET)
#define PREP_N_WDSA ((1024 / 64) * (1024 / 32))
#define PREP_J_WOUT (PREP_J_WDSA + PREP_N_WDSA)
#define PREP_N_WOUT ((1024 / 64) * (1024 / 32))
#define PREP_J_WFFI (PREP_J_WOUT + PREP_N_WOUT)
#define PREP_N_WFFI ((NFF2 / 64) * (1024 / 32))
#define PREP_J_WFFO (PREP_J_WFFI + PREP_N_WFFI)
#define PREP_N_WFFO ((1024 / 64) * (2816 / 32))
#define PREP_J_ROWS (PREP_J_WFFO + PREP_N_WFFO)
#define PREP_N_ROWS (T_PAD / 4)
#define PREP_J_ROPE (PREP_J_ROWS + PREP_N_ROWS)
#define PREP_N_ROPE ((LP * 128) / 256)
#define PREP_N_JOBS (PREP_J_ROPE + PREP_N_ROPE)
__device__ __forceinline__ void prep_job(const PrepArgs& a, int job, float* lds) {
    if (job < PREP_J_WRET)      prep_weight_tile(a.w_in, IN_COLS, a.norm_mix_w, a.W1t, 1024, 1, job - PREP_J_W1, lds);
    else if (job < PREP_J_WDSA) prep_weight_tile(a.w_ret, 1024, nullptr, a.Wret, 2048, 0, job - PREP_J_WRET, lds);
    else if (job < PREP_J_WOUT) prep_weight_tile(a.w_dsa, 1024, nullptr, a.Wdsa, 1024, 0, job - PREP_J_WDSA, lds);
    else if (job < PREP_J_WFFI) prep_weight_tile(a.w_out, 1024, nullptr, a.Wout, 1024, 0, job - PREP_J_WOUT, lds);
    else if (job < PREP_J_WFFO) prep_weight_tile(a.w_ffi, 2 * D_FF, a.norm_ffn_w, a.Wffi, 1024, 2, job - PREP_J_WFFI, lds);
    else if (job < PREP_J_ROWS) prep_weight_tile(a.w_ffo, 1024, nullptr, a.Wffo, 2816, 0, job - PREP_J_WFFO, lds);
    else if (job < PREP_J_ROPE) prep_row((job - PREP_J_ROWS) * 4 + ((threadIdx.x & 255) >> 6), a.x_prompt, a.x_sample, a.meta, a.A0, a.rstd0, threadIdx.x & 63);
    else rope_entry((job - PREP_J_ROPE) * 256 + (threadIdx.x & 255), a.rope);
}
namespace att {
using bf16x8 = __attribute__((ext_vector_type(8))) short;
using s16x4  = __attribute__((ext_vector_type(4))) short;
using f32x16 = __attribute__((ext_vector_type(16))) float;
using f32x8  = __attribute__((ext_vector_type(8))) float;
using u32x4  = __attribute__((ext_vector_type(4))) unsigned;
constexpr float SCALE = 0.088388347648318440f;
constexpr float THR = 8.f;
constexpr float NEG = -3.0e38f;
constexpr int SHM_V = 64 * 128 * 2, SHM_K = 64 * 128 * 2;
#define ATT_KSWZ(row, colB) ((row) * 256 + ((colB) ^ (((row) & 7) << 4)))
#define ATT_SBAR() __builtin_amdgcn_sched_barrier(0)
__device__ __forceinline__ int crow(int r, int hi) { return (r & 3) + 8 * (r >> 2) + 4 * hi; }
__device__ __forceinline__ unsigned cvtpk(float lo, float hi) { return pg8::cvt_pk_bf16(lo, hi); }
__device__ __forceinline__ bf16x8 tobf(f32x8 x) { u32x4 w = {cvtpk(x[0], x[1]), cvtpk(x[2], x[3]), cvtpk(x[4], x[5]), cvtpk(x[6], x[7])}; return *reinterpret_cast<bf16x8*>(&w); }
__device__ __forceinline__ bf16x8 tobf(bf16x8 x) { return x; }

__device__ __forceinline__ void apply_mask(f32x16& p0, f32x16& p1, u64 mk, int hi) {
    const unsigned lo = (unsigned)mk >> (4 * hi), hw = (unsigned)(mk >> 32) >> (4 * hi);
#pragma unroll
    for (int r = 0; r < 16; ++r) { const unsigned bit = 1u << ((r & 3) + 8 * (r >> 2)); p0[r] = (lo & bit) ? p0[r] : NEG; p1[r] = (hw & bit) ? p1[r] : NEG; }
}
__device__ __forceinline__ void partialSM(f32x16& p0, f32x16& p1, float& m_reg, float& mn, float& alpha) {
    constexpr float C = SCALE * 1.4426950408889634f;
    float pmax = p0[0];
#pragma unroll
    for (int r = 1; r < 16; ++r) pmax = fmaxf(pmax, p0[r]);
#pragma unroll
    for (int r = 0; r < 16; ++r) pmax = fmaxf(pmax, p1[r]);
    { auto rr = __builtin_amdgcn_permlane32_swap(__float_as_uint(pmax), __float_as_uint(pmax), false, false);
      pmax = fmaxf(__uint_as_float(rr[0]), __uint_as_float(rr[1])); }
    if (__builtin_expect(__all(pmax - m_reg <= THR / SCALE), 1)) { mn = m_reg; alpha = 1.f; }
    else { mn = fmaxf(m_reg, pmax); alpha = __builtin_amdgcn_exp2f((m_reg - mn) * C); m_reg = mn; }
    const float mnC = -mn * C;
#pragma unroll
    for (int r = 0; r < 16; ++r) p0[r] = fmaf(p0[r], C, mnC);
#pragma unroll
    for (int r = 0; r < 16; ++r) p1[r] = fmaf(p1[r], C, mnC);
#pragma unroll
    for (int r = 0; r < 16; ++r) p0[r] = __builtin_amdgcn_exp2f(p0[r]);
}
__device__ __forceinline__ void finishSM(f32x16& p0, f32x16& p1, float alpha, float& l_reg, bf16x8& pa0, bf16x8& pa1, bf16x8& pa2, bf16x8& pa3) {
#pragma unroll
    for (int r = 0; r < 16; ++r) p1[r] = __builtin_amdgcn_exp2f(p1[r]);
    float ps = 0;
#pragma unroll
    for (int r = 0; r < 16; ++r) ps += p0[r];
#pragma unroll
    for (int r = 0; r < 16; ++r) ps += p1[r];
    { auto rr = __builtin_amdgcn_permlane32_swap(__float_as_uint(ps), __float_as_uint(ps), false, false);
      ps = __uint_as_float(rr[0]) + __uint_as_float(rr[1]); }
    l_reg = l_reg * alpha + ps;
#define ATT_PK4(P, BASE, OUT) do { unsigned a0 = cvtpk(P[BASE + 0], P[BASE + 1]), a1 = cvtpk(P[BASE + 2], P[BASE + 3]);   \
    unsigned b0 = cvtpk(P[BASE + 4], P[BASE + 5]), b1 = cvtpk(P[BASE + 6], P[BASE + 7]);                              \
    auto r0 = __builtin_amdgcn_permlane32_swap(a0, b0, false, false); auto r1 = __builtin_amdgcn_permlane32_swap(a1, b1, false, false); \
    u32x4 w = {r0[0], r1[0], r0[1], r1[1]}; OUT = *reinterpret_cast<bf16x8*>(&w); } while (0)
    ATT_PK4(p0, 0, pa0); ATT_PK4(p0, 8, pa1); ATT_PK4(p1, 0, pa2); ATT_PK4(p1, 8, pa3);
#undef ATT_PK4
}
__device__ __forceinline__ void qkt(f32x16& p0, f32x16& p1, const char* Ks, const bf16x8* qr, int r32, int hi) {
    p0 = f32x16{}; p1 = f32x16{};
#pragma unroll
    for (int d0 = 0; d0 < 8; ++d0) { const int cb = (d0 * 16 + hi * 8) * 2;
        const bf16x8 b0 = *reinterpret_cast<const bf16x8*>(Ks + ATT_KSWZ(r32, cb));
        const bf16x8 b1 = *reinterpret_cast<const bf16x8*>(Ks + ATT_KSWZ(32 + r32, cb));
        p0 = __builtin_amdgcn_mfma_f32_32x32x16_bf16(b0, qr[d0], p0, 0, 0, 0);
        p1 = __builtin_amdgcn_mfma_f32_32x32x16_bf16(b1, qr[d0], p1, 0, 0, 0); }
}
__device__ __forceinline__ int v_st(int k, int c) { const int kk = (k & ~0xC) | ((k & 4) << 1) | ((k & 8) >> 1); return ((kk >> 3) * 4 + (c >> 5)) * 512 + ((kk & 7) * 32 + (c & 31)) * 2; }
__device__ __forceinline__ int v_rd_base(int lane) { return ((lane & 3) << 3) | (((lane >> 2) & 3) << 6) | (((lane >> 4) & 1) << 5) | (((lane >> 5) & 1) << 8); }
constexpr int v_rd_off(int d0, int ks, int half) { return d0 * 512 + ks * 4096 + half * 2048; }
template <int OFF> __device__ __forceinline__ s16x4 tr_read(int vb) { s16x4 r; asm volatile("ds_read_b64_tr_b16 %0, %1 offset:%2" : "=&v"(r) : "v"(vb), "i"(OFF) : "memory"); return r; }
template <int D0> __device__ __forceinline__ void pv_one(f32x16& od, int vb, bf16x8 pa0, bf16x8 pa1, bf16x8 pa2, bf16x8 pa3) {
    const s16x4 l0 = tr_read<v_rd_off(D0, 0, 0)>(vb), h0 = tr_read<v_rd_off(D0, 0, 1)>(vb), l1 = tr_read<v_rd_off(D0, 1, 0)>(vb), h1 = tr_read<v_rd_off(D0, 1, 1)>(vb);
    const s16x4 l2 = tr_read<v_rd_off(D0, 2, 0)>(vb), h2 = tr_read<v_rd_off(D0, 2, 1)>(vb), l3 = tr_read<v_rd_off(D0, 3, 0)>(vb), h3 = tr_read<v_rd_off(D0, 3, 1)>(vb);
    asm volatile("s_waitcnt lgkmcnt(0)" ::: "memory"); ATT_SBAR();
#define ATT_PK(L, H) (bf16x8){L[0], L[1], L[2], L[3], H[0], H[1], H[2], H[3]}
    od = __builtin_amdgcn_mfma_f32_32x32x16_bf16(pa0, ATT_PK(l0, h0), od, 0, 0, 0);
    od = __builtin_amdgcn_mfma_f32_32x32x16_bf16(pa1, ATT_PK(l1, h1), od, 0, 0, 0);
    od = __builtin_amdgcn_mfma_f32_32x32x16_bf16(pa2, ATT_PK(l2, h2), od, 0, 0, 0);
    od = __builtin_amdgcn_mfma_f32_32x32x16_bf16(pa3, ATT_PK(l3, h3), od, 0, 0, 0);
#undef ATT_PK
}
__device__ __forceinline__ void pv_d0(f32x16* o, int vb, bf16x8 pa0, bf16x8 pa1, bf16x8 pa2, bf16x8 pa3) {
    pv_one<0>(o[0], vb, pa0, pa1, pa2, pa3); pv_one<1>(o[1], vb, pa0, pa1, pa2, pa3); pv_one<2>(o[2], vb, pa0, pa1, pa2, pa3); pv_one<3>(o[3], vb, pa0, pa1, pa2, pa3);
}

struct KvPrompt {
    using T = bf16x8; const bf16_t* K; const bf16_t* V;
    __device__ __forceinline__ T ldk(int key, int col) const { return *reinterpret_cast<const bf16x8*>(K + (size_t)key * 256 + col); }
    __device__ __forceinline__ T ldv(int key, int col) const { return *reinterpret_cast<const bf16x8*>(V + (size_t)key * 256 + col); }
};
struct KvSample {
    using T = f32x8; const float* ck; const float* cv; const float* kn; const float* vn; const int* pages  ; int n;
    __device__ __forceinline__ size_t roff(int key) const { return (((size_t)pages[key >> 7] * PAGE_SIZE + (key & 127)) * N_KV + n) * 128; }
    __device__ __forceinline__ T ldk(int key, int col) const { const float* p = key < PAST_LEN ? ck + roff(key) : kn + (size_t)min(key - PAST_LEN, DEC_SEQ - 1) * 256; return *reinterpret_cast<const f32x8*>(p + col); }
    __device__ __forceinline__ T ldv(int key, int col) const { const float* p = key < PAST_LEN ? cv + roff(key) : vn + (size_t)min(key - PAST_LEN, DEC_SEQ - 1) * 256; return *reinterpret_cast<const f32x8*>(p + col); }
};

template <class KV>
__device__ __forceinline__ void attn_unit(const KV kv, const bf16_t* __restrict__ Aq, const float* __restrict__ qnw, const u64* __restrict__ mask, bf16_t* __restrict__ Odsa, int tok0, int nq_valid, int hd0, int NT, char* lds) {
    int tid_l = threadIdx.x; asm volatile("" : "+v"(tid_l));
    const int tid = tid_l, wid = tid >> 6, lane = tid & 63, r32 = lane & 31, hi = lane >> 5;
    char* V_lds = lds; char* K_lds = lds + 2 * SHM_V;
    float* wsx = (float*)(lds + 2 * SHM_V + 2 * SHM_K) + wid * 64; float* li_l = wsx; float* al_l = wsx + 32;
    float m_reg = -1e30f, l_reg = 0; f32x16 o[4] = {}; bf16x8 qr[8];
    const int mytok = tok0 + 8 * wid + (r32 >> 2);
    { const bf16_t* Qw = Aq + (size_t)mytok * 1024 + (hd0 + (r32 & 3)) * 128 + hi * 8;
#pragma unroll
      for (int d0 = 0; d0 < 8; ++d0) qr[d0] = *reinterpret_cast<const bf16x8*>(Qw + d0 * 16);
      float ssq = 0.f;
#pragma unroll
      for (int d0 = 0; d0 < 8; ++d0) { const u32x4 w = *reinterpret_cast<const u32x4*>(&qr[d0]);
#pragma unroll
          for (int j = 0; j < 4; ++j) { const float lo = __uint_as_float(w[j] << 16), hh = __uint_as_float(w[j] & 0xffff0000u); ssq += lo * lo + hh * hh; } }
      ssq += __shfl_xor(ssq, 32);
      const float rn = rsqrtf(ssq * (1.0f / 128.0f) + NORM_EPS);
#pragma unroll
      for (int d0 = 0; d0 < 8; ++d0) { const u32x4 w = *reinterpret_cast<const u32x4*>(&qr[d0]); const float4 g0 = *(const float4*)(qnw + d0 * 16 + hi * 8), g1 = *(const float4*)(qnw + d0 * 16 + hi * 8 + 4);
          u32x4 o; o[0] = cvtpk(__uint_as_float(w[0] << 16) * rn * g0.x, __uint_as_float(w[0] & 0xffff0000u) * rn * g0.y); o[1] = cvtpk(__uint_as_float(w[1] << 16) * rn * g0.z, __uint_as_float(w[1] & 0xffff0000u) * rn * g0.w);
          o[2] = cvtpk(__uint_as_float(w[2] << 16) * rn * g1.x, __uint_as_float(w[2] & 0xffff0000u) * rn * g1.y); o[3] = cvtpk(__uint_as_float(w[3] << 16) * rn * g1.z, __uint_as_float(w[3] & 0xffff0000u) * rn * g1.w);
          qr[d0] = *reinterpret_cast<const bf16x8*>(&o); } }
    const u64* mrow = mask + (size_t)mytok * MASK_WORDS;
    const int sr = tid >> 4, sc = (tid & 15) * 8, vst0 = v_st(sr, sc), vst1 = v_st(32 + sr, sc);
    const int vbase = (int)(uintptr_t)(PG8_LAS char*)V_lds + v_rd_base(lane);
    typename KV::T vs0, vs1, ks0, ks1;
#define ATT_SLOAD(k0) do { vs0 = kv.ldv((k0) + sr, sc); vs1 = kv.ldv((k0) + 32 + sr, sc); ks0 = kv.ldk((k0) + sr, sc); ks1 = kv.ldk((k0) + 32 + sr, sc); } while (0)
#define ATT_SWRITE(b) do { *(bf16x8*)(V_lds + (b) * SHM_V + vst0) = tobf(vs0); *(bf16x8*)(V_lds + (b) * SHM_V + vst1) = tobf(vs1); const int kc = sc * 2; \
    *(bf16x8*)(K_lds + (b) * SHM_K + ATT_KSWZ(sr, kc)) = tobf(ks0); *(bf16x8*)(K_lds + (b) * SHM_K + ATT_KSWZ(32 + sr, kc)) = tobf(ks1); } while (0)
    __syncthreads();
    ATT_SLOAD(0); ATT_SWRITE(0); __syncthreads();
    for (int j = 0; j < NT; ++j) {
        const int b = j & 1;
        const u64 mk = mrow[j];
        if (j + 1 < NT) ATT_SLOAD((j + 1) * 64);
        f32x16 p0, p1; float mn, alpha; bf16x8 pa0, pa1, pa2, pa3;
        ATT_SBAR(); qkt(p0, p1, K_lds + b * SHM_K, qr, r32, hi); apply_mask(p0, p1, mk, hi);
        partialSM(p0, p1, m_reg, mn, alpha);
        if (__any(alpha < 1.f)) { if (hi == 0) al_l[r32] = alpha; asm volatile("s_waitcnt lgkmcnt(0)" ::: "memory");
#pragma unroll
            for (int d = 0; d < 4; ++d)
#pragma unroll
                for (int r = 0; r < 16; ++r) o[d][r] *= al_l[crow(r, hi)]; }
        finishSM(p0, p1, alpha, l_reg, pa0, pa1, pa2, pa3); ATT_SBAR();
        pv_d0(o, vbase + b * SHM_V, pa0, pa1, pa2, pa3);
        if (j + 1 < NT) ATT_SWRITE(b ^ 1);
        __syncthreads();
    }
    if (hi == 0) li_l[r32] = l_reg; asm volatile("s_waitcnt lgkmcnt(0)" ::: "memory");
#pragma unroll
    for (int r = 0; r < 16; ++r) { const int orow = crow(r, hi); const float rli = __builtin_amdgcn_rcpf(li_l[orow]);
        const int q = 8 * wid + (orow >> 2);
        if (q < nq_valid) { bf16_t* Ow = Odsa + (size_t)(tok0 + q) * 1024 + (hd0 + (orow & 3)) * 128 + r32;
#pragma unroll
            for (int d0 = 0; d0 < 4; ++d0) Ow[d0 * 32] = f2bf(o[d0][r] * rli); } }
#undef ATT_SLOAD
#undef ATT_SWRITE
}
}
namespace idx {
using bf16x8 = __attribute__((ext_vector_type(8))) short;
using f32x16 = __attribute__((ext_vector_type(16))) float;
using f32x8  = __attribute__((ext_vector_type(8))) float;
constexpr int NTILE = 65;
constexpr int WAVE_LDS = NTILE * 64 * 4;
__device__ __forceinline__ unsigned ord_of(float f) { const unsigned u = __float_as_uint(f); return (u & 0x80000000u) ? ~u : (u | 0x80000000u); }
__device__ __forceinline__ int half_sum(int v) {
#pragma unroll
    for (int o = 16; o >= 1; o >>= 1) v += __shfl_xor(v, o);
    return v;
}
template <bool SAMPLE> struct KeySrc {
    const bf16_t* ikb; const float* ck; const int* pt;
    __device__ __forceinline__ void load(int t, int c, int hi, bf16x8 (&B)[4]) const {
        if (!SAMPLE) { const bf16_t* p = ikb + (size_t)(32 * t + c) * 64 + hi * 8;
#pragma unroll
            for (int s = 0; s < 4; ++s) B[s] = *reinterpret_cast<const bf16x8*>(p + 16 * s); }
        else if (t < 64) { const int page = __builtin_amdgcn_readfirstlane(pt[t >> 2]);
            const float* p = ck + ((size_t)page * PAGE_SIZE + ((32 * t) & 127) + c) * 64 + hi * 8;
#pragma unroll
            for (int s = 0; s < 4; ++s) B[s] = att::tobf(*reinterpret_cast<const f32x8*>(p + 16 * s)); }
        else { const bf16_t* p = ikb + (size_t)(c < DEC_SEQ ? c : DEC_SEQ - 1) * 64 + hi * 8;
#pragma unroll
            for (int s = 0; s < 4; ++s) B[s] = *reinterpret_cast<const bf16x8*>(p + 16 * s); }
    }
};
template <int A_> __device__ __forceinline__ float head_sum(const f32x16& acc, const float (&w)[8]) {
    float s = 0.f;
#pragma unroll
    for (int h = 0; h < 8; ++h) s = fmaf(w[h], fmaxf(acc[8 * A_ + h], 0.f), s);
    return s;
}
template <bool SAMPLE, int A_>
__device__ __forceinline__ void pass(const KeySrc<SAMPLE>& ks, const bf16x8 (&A)[4], const float* Iw, int tokbase, int pos0, int nvalid, int ntiles, unsigned* strip, unsigned* mask32, int lane) {
    const int c = lane & 31, hi = lane >> 5, myq = 2 * hi + A_, mypos = pos0 + myq; const bool qvalid = myq < nvalid;
    float w[8];
    { const float* wp = Iw + (size_t)(tokbase + (qvalid ? myq : nvalid - 1)) * 8;
#pragma unroll
      for (int h = 0; h < 8; ++h) w[h] = wp[h]; }
    bf16x8 B[4], Bn[4];
    ks.load(0, c, hi, B);
    for (int t = 0; t < ntiles; ++t) {
        if (t + 1 < ntiles) ks.load(t + 1, c, hi, Bn);
        f32x16 acc = {};
#pragma unroll
        for (int s = 0; s < 4; ++s) acc = __builtin_amdgcn_mfma_f32_32x32x16_bf16(A[s], B[s], acc, 0, 0, 0);
        const float sc = head_sum<A_>(acc, w);
        strip[t * 64 + lane] = (32 * t + c <= mypos) ? ord_of(sc) : 0u;
#pragma unroll
        for (int s = 0; s < 4; ++s) B[s] = Bn[s];
    }
    unsigned x[NTILE];
#pragma unroll
    for (int t = 0; t < NTILE; ++t) x[t] = (t < ntiles) ? strip[t * 64 + lane] : 0u;
    unsigned tau = 0u; int r_ties = 0;
    if (__any(mypos + 1 > TOPK)) {
        for (int bit = 31; bit >= 0; --bit) { const unsigned cand = tau | (1u << bit); int cnt = 0;
#pragma unroll
            for (int t = 0; t < NTILE; ++t) cnt += (x[t] >= cand) ? 1 : 0;
            cnt = half_sum(cnt);
            if (cnt >= TOPK) tau = cand; }
        int cg = 0;
#pragma unroll
        for (int t = 0; t < NTILE; ++t) cg += (x[t] > tau) ? 1 : 0;
        cg = half_sum(cg);
        r_ties = TOPK - cg;
    }
    if (mypos + 1 <= TOPK) { tau = 0u; r_ties = 0; }
    int eq_before = 0; unsigned* mrow = mask32 + (size_t)(tokbase + myq) * (2 * MASK_WORDS);
#pragma unroll
    for (int t = 0; t < NTILE; ++t) {
        const bool eq = x[t] == tau, gt = x[t] > tau;
        const u64 eqm = __ballot(eq); const unsigned my_eqm = hi ? (unsigned)(eqm >> 32) : (unsigned)eqm;
        const int rank = eq_before + __popc(my_eqm & ((1u << c) - 1u));
        const bool sel = gt || (eq && rank < r_ties);
        eq_before += __popc(my_eqm);
        const u64 sm = __ballot(sel); const unsigned my_sm = hi ? (unsigned)(sm >> 32) : (unsigned)sm;
        if (c == 0 && qvalid) mrow[t] = my_sm;
    }
    if (c < 2 * MASK_WORDS - NTILE && qvalid) mrow[NTILE + c] = 0u;
}
template <bool SAMPLE>
__device__ __forceinline__ void wave_task(const KeySrc<SAMPLE>& ks, const bf16_t* Iq, const float* Iw, int tokbase, int pos0, int nvalid, unsigned* strip, unsigned* mask32, int lane) {
    const int c = lane & 31, hi = lane >> 5;
    const int aq_ = 2 * ((c >> 2) & 1) + (c >> 4), ah = 4 * ((c >> 3) & 1) + (c & 3);
    bf16x8 A[4];
    { const bf16_t* ap = Iq + (size_t)(tokbase + (aq_ < nvalid ? aq_ : nvalid - 1)) * 512 + ah * 64 + hi * 8;
#pragma unroll
      for (int s = 0; s < 4; ++s) A[s] = *reinterpret_cast<const bf16x8*>(ap + 16 * s); }
    const int pmax = pos0 + nvalid - 1; int ntiles = (pmax + 32) >> 5; if (ntiles > NTILE) ntiles = NTILE;
    pass<SAMPLE, 0>(ks, A, Iw, tokbase, pos0, nvalid, ntiles, strip, mask32, lane);
    pass<SAMPLE, 1>(ks, A, Iw, tokbase, pos0, nvalid, ntiles, strip, mask32, lane);
}
}
struct MegaArgs {
    PrepArgs prep;
    const float *cache_k, *cache_v, *cache_kidx, *state_ret; const int* page_table;
    const float *qnw, *knw, *ikw, *ikb;
    bf16_t *Rq, *Rk, *Rv, *G, *Aq, *Kb, *Vb, *Iq, *Ikb, *Gates, *OG, *An, *Odsa, *Mg, *A2, *Hid;
    float *Iw, *ssret, *rstd2, *Z, *M1, *M2, *H2, *Zf, *out;
    u64* mask; unsigned* bar;
};

namespace ret {
using bf16x8 = __attribute__((ext_vector_type(8))) short;
using s16x4  = __attribute__((ext_vector_type(4))) short;
using f32x4  = __attribute__((ext_vector_type(4))) float;
using u32x4  = __attribute__((ext_vector_type(4))) unsigned;
using u32x2  = __attribute__((ext_vector_type(2))) unsigned;
constexpr int QS = 528, VS = 144, PS = 80;
constexpr int OFF_Q = 0, OFF_K = OFF_Q + 32 * QS, OFF_V = OFF_K + 32 * QS, OFF_P = OFF_V + 32 * VS, OFF_ST = OFF_P + 32 * PS, OFF_SS = OFF_ST + 64 * QS, LDS_BYTES = OFF_SS + 32 * 4 * 4;
__device__ __forceinline__ s16x4 trr(int addr) { s16x4 r; asm volatile("ds_read_b64_tr_b16 %0, %1" : "=&v"(r) : "v"(addr) : "memory"); return r; }
__device__ __forceinline__ bf16x8 cat(s16x4 l, s16x4 h) { return (bf16x8){l[0], l[1], l[2], l[3], h[0], h[1], h[2], h[3]}; }
__device__ __forceinline__ u32x4 scale8(u32x4 v, float f) {
    u32x4 o;
#pragma unroll
    for (int i = 0; i < 4; ++i) o[i] = att::cvtpk(__uint_as_float(v[i] << 16) * f, __uint_as_float(v[i] & 0xffff0000u) * f);
    return o;
}
__device__ __forceinline__ void unit(const MegaArgs& a, int unit8, char* lds) {
    int tid_l = threadIdx.x; asm volatile("" : "+v"(tid_l));
    const int tid = tid_l, w = __builtin_amdgcn_readfirstlane(tid >> 6), lane = tid & 63, g = lane >> 4, c15 = lane & 15, q4 = c15 >> 2, p4 = c15 & 3;
    const int bh = unit8 >> 3, sl = unit8 & 7, b = bh >> 2, h = bh & 3;
    const int ldsb = (int)(uintptr_t)(PG8_LAS char*)lds;
    const float lg2 = log2f(1.0f - exp2f(-5.0f - (float)h));
    const int st_tok = tid >> 4, st_seg = tid & 15;
    const float fq = exp2f(lg2 * (float)(st_tok + 1)), fk = exp2f(-lg2 * (float)(st_tok + 1));
    f32x4 S[2][4];
#pragma unroll
    for (int i = 0; i < 2; ++i)
#pragma unroll
        for (int u = 0; u < 4; ++u) S[i][u] = (f32x4){0.f, 0.f, 0.f, 0.f};
    u32x4 rq0, rq1, rk0, rk1; u32x2 rv;
#define RET_LOAD(tok0_, len_) do { const bool ok_ = st_tok < (len_); const size_t r_ = (size_t)((tok0_) + (ok_ ? st_tok : 0)); \
        const u32x4* qp_ = (const u32x4*)(a.Rq + r_ * 1024 + h * 256 + st_seg * 16); const u32x4* kp_ = (const u32x4*)(a.Rk + r_ * 1024 + h * 256 + st_seg * 16); \
        rq0 = qp_[0]; rq1 = qp_[1]; rk0 = kp_[0]; rk1 = kp_[1]; rv = *(const u32x2*)(a.Rv + r_ * 2048 + h * 512 + sl * 64 + st_seg * 4); \
        if (!ok_) { rq0 = rq1 = rk0 = rk1 = (u32x4){0u, 0u, 0u, 0u}; rv = (u32x2){0u, 0u}; } } while (0)
    const int row0 = b * LP;
    RET_LOAD(row0, 16);
    __syncthreads();
    for (int c = 0; c < 65; ++c) {
        const int len = c == 0 ? 16 : 32, tok0 = c == 0 ? row0 : row0 + 16 + 32 * (c - 1);
        *(u32x4*)(lds + OFF_Q + st_tok * QS + st_seg * 32) = scale8(rq0, fq); *(u32x4*)(lds + OFF_Q + st_tok * QS + st_seg * 32 + 16) = scale8(rq1, fq);
        *(u32x4*)(lds + OFF_K + st_tok * QS + st_seg * 32) = scale8(rk0, fk); *(u32x4*)(lds + OFF_K + st_tok * QS + st_seg * 32 + 16) = scale8(rk1, fk);
        *(u32x2*)(lds + OFF_V + st_tok * VS + st_seg * 8) = rv;
#pragma unroll
        for (int i = 0; i < 2; ++i)
#pragma unroll
            for (int u = 0; u < 4; ++u) { u32x2 pk; pk.x = att::cvtpk(S[i][u][0], S[i][u][1]); pk.y = att::cvtpk(S[i][u][2], S[i][u][3]);
                *(u32x2*)(lds + OFF_ST + (16 * u + c15) * QS + (32 * w + 16 * i + 4 * g) * 2) = pk; }
        __syncthreads();
        if (c + 1 < 65) RET_LOAD(row0 + 16 + 32 * c, 32);
        if (w < 3) { const int jt = w >> 1, it = (w + 1) >> 1; f32x4 pacc = {0.f, 0.f, 0.f, 0.f};
#pragma unroll
            for (int s = 0; s < 8; ++s) { const bf16x8 A = *(const bf16x8*)(lds + OFF_K + (16 * jt + c15) * QS + (32 * s + 8 * g) * 2), B = *(const bf16x8*)(lds + OFF_Q + (16 * it + c15) * QS + (32 * s + 8 * g) * 2);
                pacc = __builtin_amdgcn_mfma_f32_16x16x32_bf16(A, B, pacc, 0, 0, 0); }
            const int ig = 16 * it + c15, jg0 = 16 * jt + 4 * g; float pv[4];
#pragma unroll
            for (int r = 0; r < 4; ++r) pv[r] = (jg0 + r <= ig) ? pacc[r] : 0.f;
            u32x2 pk; pk.x = att::cvtpk(pv[0], pv[1]); pk.y = att::cvtpk(pv[2], pv[3]);
            *(u32x2*)(lds + OFF_P + ig * PS + jg0 * 2) = pk; }
        else if (w == 3) { if (lane < 32) *(u32x4*)(lds + OFF_P + (lane >> 1) * PS + 32 + 16 * (lane & 1)) = (u32x4){0u, 0u, 0u, 0u}; }
        { s16x4 vl[4], vh[4], kl[2], kh[2];
#pragma unroll
          for (int u = 0; u < 4; ++u) { const int ad = ldsb + OFF_V + (8 * g + q4) * VS + (16 * u + 4 * p4) * 2; vl[u] = trr(ad); vh[u] = trr(ad + 4 * VS); }
#pragma unroll
          for (int i = 0; i < 2; ++i) { const int ad = ldsb + OFF_K + (8 * g + q4) * QS + (32 * w + 16 * i + 4 * p4) * 2; kl[i] = trr(ad); kh[i] = trr(ad + 4 * QS); }
          asm volatile("s_waitcnt lgkmcnt(0)" ::: "memory"); __builtin_amdgcn_sched_barrier(0);
          const float gl = exp2f(lg2 * (float)len);
#pragma unroll
          for (int i = 0; i < 2; ++i)
#pragma unroll
              for (int u = 0; u < 4; ++u) { S[i][u] = __builtin_amdgcn_mfma_f32_16x16x32_bf16(cat(kl[i], kh[i]), cat(vl[u], vh[u]), S[i][u], 0, 0, 0); S[i][u] *= gl; } }
        __syncthreads();
        { const int dt = w & 3, it = w >> 2; f32x4 o = {0.f, 0.f, 0.f, 0.f};
          { const int ad = ldsb + OFF_V + (8 * g + q4) * VS + (16 * dt + 4 * p4) * 2; const s16x4 lo = trr(ad), hi = trr(ad + 4 * VS);
            const bf16x8 Bp = *(const bf16x8*)(lds + OFF_P + (16 * it + c15) * PS + (8 * g) * 2);
            asm volatile("s_waitcnt lgkmcnt(0)" ::: "memory"); __builtin_amdgcn_sched_barrier(0);
            o = __builtin_amdgcn_mfma_f32_16x16x32_bf16(cat(lo, hi), Bp, o, 0, 0, 0); }
#pragma unroll
          for (int s = 0; s < 8; ++s) { const bf16x8 A = *(const bf16x8*)(lds + OFF_ST + (16 * dt + c15) * QS + (32 * s + 8 * g) * 2), B = *(const bf16x8*)(lds + OFF_Q + (16 * it + c15) * QS + (32 * s + 8 * g) * 2);
              o = __builtin_amdgcn_mfma_f32_16x16x32_bf16(A, B, o, 0, 0, 0); }
          const int i = 16 * it + c15; float ss = o[0] * o[0] + o[1] * o[1] + o[2] * o[2] + o[3] * o[3];
          ss += __shfl_xor(ss, 16); ss += __shfl_xor(ss, 32);
          if (g == 0) ((float*)(lds + OFF_SS))[i * 4 + dt] = ss;
          if (i < len) { const size_t ci = (size_t)(tok0 + i) * 2048 + h * 512 + sl * 64 + 16 * dt + 4 * g; const u32x2 gg = *(const u32x2*)(a.G + ci);
              u32x2 pk; pk.x = att::cvtpk(o[0] * __uint_as_float(gg.x << 16), o[1] * __uint_as_float(gg.x & 0xffff0000u)); pk.y = att::cvtpk(o[2] * __uint_as_float(gg.y << 16), o[3] * __uint_as_float(gg.y & 0xffff0000u));
              *(u32x2*)(a.OG + ci) = pk; } }
        __syncthreads();
        if (tid < len) { const float* sp = (const float*)(lds + OFF_SS) + tid * 4; a.ssret[(size_t)(tok0 + tid) * 32 + h * 8 + sl] = (sp[0] + sp[1]) + (sp[2] + sp[3]); }
    }
    float* so = a.out + (size_t)O_R_P + ((size_t)b * H_RET + h) * (DK_RET * DV_RET) + sl * 64;
#pragma unroll
    for (int i = 0; i < 2; ++i)
#pragma unroll
        for (int u = 0; u < 4; ++u)
#pragma unroll
            for (int r = 0; r < 4; ++r) so[(size_t)(32 * w + 16 * i + 4 * g + r) * DV_RET + 16 * u + c15] = S[i][u][r];
    __syncthreads();
#undef RET_LOAD
}
}
namespace epi {
using f32x4 = pg8::f32x4; using u32x4 = pg8::u32x4; typedef unsigned u32x2 __attribute__((ext_vector_type(2)));
__device__ __forceinline__ unsigned pk(float lo, float hi) { return pg8::cvt_pk_bf16(lo, hi); }
__device__ __forceinline__ u32x4 pack8(const f32x4& a, const f32x4& b) { u32x4 w; w.x = pk(a[0], a[1]); w.y = pk(a[2], a[3]); w.z = pk(b[0], b[1]); w.w = pk(b[2], b[3]); return w; }
__device__ __forceinline__ float bflo(unsigned w) { return __uint_as_float(w << 16); }
__device__ __forceinline__ float bfhi(unsigned w) { return __uint_as_float(w & 0xffff0000u); }
__device__ __forceinline__ f32x4 silu4(f32x4 x) { f32x4 o;
#pragma unroll
    for (int j = 0; j < 4; ++j) o[j] = x[j] * __builtin_amdgcn_rcpf(1.0f + __expf(-x[j])); return o; }
__device__ __forceinline__ f32x4 sigm4(f32x4 x) { f32x4 o;
#pragma unroll
    for (int j = 0; j < 4; ++j) o[j] = __builtin_amdgcn_rcpf(1.0f + __expf(-x[j])); return o; }

struct Epi1 {
    static constexpr bool PERM = true, AFTER_DRAIN = false;
    const float* rstd0; const float2* rope; const float *ikw, *ikb;
    bf16_t *Rq, *Rk, *Rv, *G, *Aq, *Vb, *Iq, *Ikb, *Gates; float* Iw; float* out; int gz0;
    template <int TY> __device__ __forceinline__ void run(const f32x4 (&acc)[2][2][4][2], int pm, int wr, int wc, int fr, int fq, bf16_t* dbase, int ld, float* fbase, float* fbase_s, float post, int isv) const {
        const int cl = wc * 32 + 8 * fq;
#pragma unroll
        for (int ai = 0; ai < 2; ++ai)
#pragma unroll
            for (int m = 0; m < 4; ++m) {
                const int row = pm * 256 + ai * 128 + wr * 64 + m * 16 + fr; const bool ok = row < T_ALL; const int rowc = ok ? row : T_ALL - 1;
                const float rs = rstd0[rowc];
                f32x4 v[2][2];
#pragma unroll
                for (int bj = 0; bj < 2; ++bj)
#pragma unroll
                    for (int n = 0; n < 2; ++n) v[bj][n] = acc[ai][bj][m][n] * rs;
                if constexpr (TY == 0) {
                    bf16_t* dst = dbase + (size_t)rowc * 1024 + cl;
                    const float4* rp = (const float4*)(rope + (size_t)row_pos(rowc) * 128 + cl);
                    f32x4 o1[2], o2[2];
#pragma unroll
                    for (int n = 0; n < 2; ++n) { const float4 cs0 = rp[2 * n], cs1 = rp[2 * n + 1]; const float c[4] = {cs0.x, cs0.z, cs1.x, cs1.z}, s[4] = {cs0.y, cs0.w, cs1.y, cs1.w};
#pragma unroll
                        for (int j = 0; j < 4; ++j) { o1[n][j] = (v[0][n][j] * c[j] - v[1][n][j] * s[j]) * post; o2[n][j] = (v[0][n][j] * s[j] + v[1][n][j] * c[j]) * post; } }
                    if (ok) { *(u32x4*)dst = pack8(o1[0], o1[1]); *(u32x4*)(dst + 128) = pack8(o2[0], o2[1]); }
                } else if constexpr (TY == 1 || TY == 2 || TY == 3) {
                    bf16_t* dst = dbase + (size_t)rowc * ld + cl;
                    if constexpr (TY == 2) { v[0][0] = silu4(v[0][0]); v[0][1] = silu4(v[0][1]); v[1][0] = silu4(v[1][0]); v[1][1] = silu4(v[1][1]); }
                    if constexpr (TY == 3) { v[0][0] = sigm4(v[0][0]); v[0][1] = sigm4(v[0][1]); v[1][0] = sigm4(v[1][0]); v[1][1] = sigm4(v[1][1]); }
                    if (ok) { *(u32x4*)dst = pack8(v[0][0], v[0][1]); *(u32x4*)(dst + 128) = pack8(v[1][0], v[1][1]); }
                } else if constexpr (TY == 4) {
                    float* dst = (rowc < T_PROMPT ? fbase + (size_t)rowc * 256 : fbase_s + (size_t)(rowc - T_PROMPT) * 256) + cl;
                    if (ok) { *(f32x4*)dst = v[0][0]; *(f32x4*)(dst + 4) = v[0][1]; *(f32x4*)(dst + 128) = v[1][0]; *(f32x4*)(dst + 132) = v[1][1];
                        if (isv) { bf16_t* vb = Vb + (size_t)rowc * 256 + cl; *(u32x4*)vb = pack8(v[0][0], v[0][1]); *(u32x4*)(vb + 128) = pack8(v[1][0], v[1][1]); } }
                } else {
                    if (wc == 0) {
                        float s = 0.f;
#pragma unroll
                        for (int bj = 0; bj < 2; ++bj)
#pragma unroll
                            for (int n = 0; n < 2; ++n) s += (v[bj][n][0] + v[bj][n][1]) + (v[bj][n][2] + v[bj][n][3]);
                        s += __shfl_xor(s, 16); s += __shfl_xor(s, 32);
                        const float mu = s * (1.0f / 64.0f); float q = 0.f;
#pragma unroll
                        for (int bj = 0; bj < 2; ++bj)
#pragma unroll
                            for (int n = 0; n < 2; ++n) { const f32x4 d = v[bj][n] - mu; q += (d[0] * d[0] + d[1] * d[1]) + (d[2] * d[2] + d[3] * d[3]); }
                        q += __shfl_xor(q, 16); q += __shfl_xor(q, 32);
                        const float rn = rsqrtf(q * (1.0f / 64.0f) + NORM_EPS);
                        float* ko = out + (rowc < T_PROMPT ? (size_t)O_KI_P + (size_t)rowc * 64 : (size_t)O_KI_S + (size_t)(rowc - T_PROMPT) * 64);
#pragma unroll
                        for (int bj = 0; bj < 2; ++bj) { const int e0 = 32 * bj + 8 * fq; f32x4 y[2];
#pragma unroll
                            for (int n = 0; n < 2; ++n) { const f32x4 wv = *(const f32x4*)(ikw + e0 + 4 * n), bv = *(const f32x4*)(ikb + e0 + 4 * n); y[n] = (v[bj][n] - mu) * rn * wv + bv; }
                            if (ok) { *(f32x4*)(ko + e0) = y[0]; *(f32x4*)(ko + e0 + 4) = y[1]; *(u32x4*)(Ikb + (size_t)rowc * 64 + e0) = pack8(y[0], y[1]); } }
                    } else if (wc == 1 && fq == 0) {
                        if (ok) { *(f32x4*)(Iw + (size_t)rowc * 8) = v[0][0] * IDX_SCALE; *(f32x4*)(Iw + (size_t)rowc * 8 + 4) = v[0][1] * IDX_SCALE; }
                    }
                }
            }
    }
    __device__ __forceinline__ void operator()(const f32x4 (&acc)[2][2][4][2], const pg8::Unit& u, int wr, int wc, int fr, int fq) const {
        const int pn = u.pn + gz0, pm = u.pm;
        if (pn < 4)        run<0>(acc, pm, wr, wc, fr, fq, Rq + pn * 256, 1024, nullptr, nullptr, 1.0f, 0);
        else if (pn < 8)   run<0>(acc, pm, wr, wc, fr, fq, Rk + (pn - 4) * 256, 1024, nullptr, nullptr, 0.0625f, 0);
        else if (pn < 16)  run<1>(acc, pm, wr, wc, fr, fq, Rv + (pn - 8) * 256, 2048, nullptr, nullptr, 1.0f, 0);
        else if (pn < 24)  run<2>(acc, pm, wr, wc, fr, fq, G + (pn - 16) * 256, 2048, nullptr, nullptr, 1.0f, 0);
        else if (pn < 28)  run<1>(acc, pm, wr, wc, fr, fq, Aq + (pn - 24) * 256, 1024, nullptr, nullptr, 1.0f, 0);
        else if (pn == 28) run<4>(acc, pm, wr, wc, fr, fq, nullptr, 0, out + O_K_P, out + O_K_S, 1.0f, 0);
        else if (pn == 29) run<4>(acc, pm, wr, wc, fr, fq, nullptr, 0, out + O_V_P, out + O_V_S, 1.0f, 1);
        else if (pn < 32)  run<1>(acc, pm, wr, wc, fr, fq, Iq + (pn - 30) * 256, 512, nullptr, nullptr, 1.0f, 0);
        else if (pn == 32) run<5>(acc, pm, wr, wc, fr, fq, nullptr, 0, nullptr, nullptr, 1.0f, 0);
        else               run<3>(acc, pm, wr, wc, fr, fq, Gates + (pn - 33 + gz0) * 256, 2048, nullptr, nullptr, 1.0f, 0);
    }
};
struct EpiRet {
    static constexpr bool PERM = false, AFTER_DRAIN = false;
    const bf16_t* Gates; float* M1;
    __device__ __forceinline__ void operator()(const f32x4 (&acc)[2][2][4][2], const pg8::Unit& u, int wr, int wc, int fr, int fq) const {
#pragma unroll
        for (int ai = 0; ai < 2; ++ai)
#pragma unroll
            for (int m = 0; m < 4; ++m) { const int row = u.pm * 256 + ai * 128 + wr * 64 + m * 16 + fr;
#pragma unroll
                for (int bj = 0; bj < 2; ++bj)
#pragma unroll
                    for (int n = 0; n < 2; ++n) { const int col = u.pn * 256 + bj * 128 + wc * 32 + 16 * n + 4 * fq; const u32x2 g = *(const u32x2*)(Gates + (size_t)row * 2048 + col);
                        const f32x4 gv = {bflo(g.x), bfhi(g.x), bflo(g.y), bfhi(g.y)}; *(f32x4*)(M1 + (size_t)row * 1024 + col) = acc[ai][bj][m][n] * gv; } }
    }
};
struct EpiDsa {
    static constexpr bool PERM = false, AFTER_DRAIN = false;
    const bf16_t* Gates; const float* M1; bf16_t* Mg;
    __device__ __forceinline__ void operator()(const f32x4 (&acc)[2][2][4][2], const pg8::Unit& u, int wr, int wc, int fr, int fq) const {
#pragma unroll
        for (int ai = 0; ai < 2; ++ai)
#pragma unroll
            for (int m = 0; m < 4; ++m) { const int row = u.pm * 256 + ai * 128 + wr * 64 + m * 16 + fr;
#pragma unroll
                for (int bj = 0; bj < 2; ++bj)
#pragma unroll
                    for (int n = 0; n < 2; ++n) { const int col = u.pn * 256 + bj * 128 + wc * 32 + 16 * n + 4 * fq; const u32x2 g = *(const u32x2*)(Gates + (size_t)row * 2048 + 1024 + col);
                        const f32x4 gv = {bflo(g.x), bfhi(g.x), bflo(g.y), bfhi(g.y)}; const f32x4 r = *(const f32x4*)(M1 + (size_t)row * 1024 + col) + acc[ai][bj][m][n] * gv;
                        u32x2 w; w.x = pk(r[0], r[1]); w.y = pk(r[2], r[3]); *(u32x2*)(Mg + (size_t)row * 1024 + col) = w; } }
    }
};
struct EpiOut {
    static constexpr bool PERM = false, AFTER_DRAIN = false;
    const float *xp, *xs, *meta; float* H2; bf16_t* A2; float* ss2;
    __device__ __forceinline__ void operator()(const f32x4 (&acc)[2][2][4][2], const pg8::Unit& u, int wr, int wc, int fr, int fq) const {
#pragma unroll
        for (int ai = 0; ai < 2; ++ai)
#pragma unroll
            for (int m = 0; m < 4; ++m) { const int row = u.pm * 256 + ai * 128 + wr * 64 + m * 16 + fr; const bool ok = row < T_ALL; const float* h = h_row_ptr(ok ? row : 0, xp, xs, meta); float ss = 0.f;
#pragma unroll
                for (int bj = 0; bj < 2; ++bj)
#pragma unroll
                    for (int n = 0; n < 2; ++n) { const int col = u.pn * 256 + bj * 128 + wc * 32 + 16 * n + 4 * fq; f32x4 r = acc[ai][bj][m][n]; if (ok) r += *(const f32x4*)(h + col);
                        *(f32x4*)(H2 + (size_t)row * 1024 + col) = r; u32x2 w; w.x = pk(r[0], r[1]); w.y = pk(r[2], r[3]); *(u32x2*)(A2 + (size_t)row * 1024 + col) = w;
                        ss += (r[0] * r[0] + r[1] * r[1]) + (r[2] * r[2] + r[3] * r[3]); }
                ss += __shfl_xor(ss, 16); ss += __shfl_xor(ss, 32);
                if (fq == 0) ss2[(size_t)row * 16 + u.pn * 4 + wc] = ss; }
    }
};
struct EpiFfi {
    static constexpr bool PERM = true, AFTER_DRAIN = false;
    const float* ss2; bf16_t* Hid;
    __device__ __forceinline__ void operator()(const f32x4 (&acc)[2][2][4][2], const pg8::Unit& u, int wr, int wc, int fr, int fq) const {
#pragma unroll
        for (int ai = 0; ai < 2; ++ai)
#pragma unroll
            for (int m = 0; m < 4; ++m) { const int row = u.pm * 256 + ai * 128 + wr * 64 + m * 16 + fr; const f32x4* sp = (const f32x4*)(ss2 + (size_t)row * 16);
                const f32x4 s0 = sp[0], s1 = sp[1], s2 = sp[2], s3 = sp[3]; const f32x4 st = (s0 + s1) + (s2 + s3);
                const float rs = rsqrtf(((st[0] + st[1]) + (st[2] + st[3])) * (1.0f / 1024.0f) + NORM_EPS);
                f32x4 hv[2];
#pragma unroll
                for (int n = 0; n < 2; ++n) hv[n] = silu4(acc[ai][0][m][n] * rs) * (acc[ai][1][m][n] * rs);
                *(u32x4*)(Hid + (size_t)row * D_FF + u.pn * 128 + wc * 32 + 8 * fq) = pack8(hv[0], hv[1]); }
    }
};
struct EpiFfo {
    static constexpr bool PERM = false, AFTER_DRAIN = false;
    const float* H2; float* out;
    __device__ __forceinline__ void operator()(const f32x4 (&acc)[2][2][4][2], const pg8::Unit& u, int wr, int wc, int fr, int fq) const {
#pragma unroll
        for (int ai = 0; ai < 2; ++ai)
#pragma unroll
            for (int m = 0; m < 4; ++m) { const int row = u.pm * 256 + ai * 128 + wr * 64 + m * 16 + fr; float* dst = nullptr;
                if (row < T_PROMPT) { const int b = row / LP, l = row % LP; if (l >= N_META) dst = out + O_Y_P + ((size_t)b * SEQ + (l - N_META)) * 1024; }
                else if (row < T_ALL) dst = out + O_Y_S + (size_t)(row - T_PROMPT) * 1024;
                if (dst) {
#pragma unroll
                    for (int bj = 0; bj < 2; ++bj)
#pragma unroll
                        for (int n = 0; n < 2; ++n) { const int col = u.pn * 256 + bj * 128 + wc * 32 + 16 * n + 4 * fq; *(f32x4*)(dst + col) = *(const f32x4*)(H2 + (size_t)row * 1024 + col) + acc[ai][bj][m][n]; } } }
    }
};
}
__device__ __forceinline__ void ret_naive_unit(const MegaArgs& a, int unit8, int sample, float* lds) {
    float* qk = lds; float* part = lds + 512;
    const int unit = unit8 >> 3, slice = unit8 & 7, t = threadIdx.x, dke = t >> 6, dv = t & 63;
    const int bb = unit >> 2, h = unit & 3;
    const int row0 = sample ? T_PROMPT + bb * DEC_SEQ : bb * LP, ntok = sample ? DEC_SEQ : LP;
    const float gamma = 1.0f - exp2f(-5.0f - (float)h);
    float S[32];
    const size_t sbase = ((size_t)bb * H_RET + h) * (DK_RET * DV_RET) + slice * 64 + dv;
#pragma unroll
    for (int i = 0; i < 32; ++i) S[i] = sample ? a.state_ret[sbase + (size_t)(dke * 32 + i) * DV_RET] : 0.f;
    for (int tok = 0; tok < ntok; ++tok) {
        const int r = row0 + tok;
        __syncthreads();
        qk[t] = bf2f(t < 256 ? a.Rq[(size_t)r * 1024 + h * 256 + t] : a.Rk[(size_t)r * 1024 + h * 256 + (t - 256)]);
        __syncthreads();
        const float v = bf2f(a.Rv[(size_t)r * 2048 + h * 512 + slice * 64 + dv]); float o = 0.f;
#pragma unroll
        for (int i = 0; i < 32; ++i) { const float kq_ = qk[256 + dke * 32 + i], qq = qk[dke * 32 + i]; S[i] = fmaf(S[i], gamma, kq_ * v); o = fmaf(qq, S[i], o); }
        part[dke * 64 + dv] = o;
        __syncthreads();
        if (dke == 0) { float ot = 0.f;
#pragma unroll
            for (int e = 0; e < 8; ++e) ot += part[e * 64 + dv];
            float ss = ot * ot;
#pragma unroll
            for (int of = 32; of >= 1; of >>= 1) ss += __shfl_xor(ss, of);
            const size_t ci = (size_t)r * 2048 + h * 512 + slice * 64 + dv;
            a.OG[ci] = f2bf(ot * bf2f(a.G[ci]));
            if (dv == 0) a.ssret[(size_t)r * 32 + h * 8 + slice] = ss; }
    }
    float* so = a.out + (sample ? (size_t)O_R_S : (size_t)O_R_P) + sbase;
#pragma unroll
    for (int i = 0; i < 32; ++i) so[(size_t)(dke * 32 + i) * DV_RET] = S[i];
    __syncthreads();
}

__device__ __forceinline__ void make_an_row(const MegaArgs& a, int r, int lane) {
    for (int c = lane; c < 2048; c += 64) { const int h = c >> 9; float ss = 0.f;
#pragma unroll
        for (int s = 0; s < 8; ++s) ss += a.ssret[(size_t)r * 32 + h * 8 + s];
        a.An[(size_t)r * 2048 + c] = f2bf(bf2f(a.OG[(size_t)r * 2048 + c]) * rsqrtf(ss * (1.0f / 512.0f) + NORM_EPS)); }
}
__device__ __forceinline__ void knorm_row(const MegaArgs& a, int r, int lane) {
    float* kp = a.out + (r < T_PROMPT ? (size_t)O_K_P + (size_t)r * 256 : (size_t)O_K_S + (size_t)(r - T_PROMPT) * 256) + lane * 4;
    const float4 x = *(const float4*)kp; float ss = x.x * x.x + x.y * x.y + x.z * x.z + x.w * x.w;
#pragma unroll
    for (int o = 16; o >= 1; o >>= 1) ss += __shfl_xor(ss, o);
    const float rn = rsqrtf(ss * (1.0f / 128.0f) + NORM_EPS); const float4 w = *(const float4*)(a.knw + (lane & 31) * 4);
    const float4 y = make_float4(x.x * rn * w.x, x.y * rn * w.y, x.z * rn * w.z, x.w * rn * w.w);
    *(float4*)kp = y;
    uint2 o; o.x = (unsigned)f2bf(y.x) | ((unsigned)f2bf(y.y) << 16); o.y = (unsigned)f2bf(y.z) | ((unsigned)f2bf(y.w) << 16);
    *(uint2*)(a.Kb + (size_t)r * 256 + lane * 4) = o;
}
#define IDX_N_SAMPLE_UNITS (DEC_BATCH / 4)
#define IDX_N_PROMPT_UNITS (BATCH * 65)
#define IDX_N_UNITS (IDX_N_SAMPLE_UNITS + IDX_N_PROMPT_UNITS)
__device__ __forceinline__ void idx_unit(const MegaArgs& a, int idxu, unsigned char* shm) {
    int lane_l = threadIdx.x; asm volatile("" : "+v"(lane_l));
    const int wave = __builtin_amdgcn_readfirstlane(lane_l >> 6), lane = lane_l & 63;
    unsigned* strip = (unsigned*)(shm + (size_t)wave * idx::WAVE_LDS); unsigned* mask32 = (unsigned*)a.mask;
    if (idxu < IDX_N_SAMPLE_UNITS) {
        const int db = 4 * idxu + (wave >> 1), q0 = 4 * (wave & 1);
        idx::KeySrc<true> ks{a.Ikb + (size_t)(T_PROMPT + db * DEC_SEQ) * 64, a.cache_kidx, a.page_table + db * N_PAGES};
        idx::wave_task<true>(ks, a.Iq, a.Iw, T_PROMPT + db * DEC_SEQ + q0, PAST_LEN + q0, 4, strip, mask32, lane);
    } else {
        const int pi = idxu - IDX_N_SAMPLE_UNITS, u = 64 - pi / 8, b = pi % 8, l0 = 32 * u + 4 * wave;
        if (l0 < LP) {
            idx::KeySrc<false> ks{a.Ikb + (size_t)b * LP * 64, nullptr, nullptr};
            idx::wave_task<false>(ks, a.Iq, a.Iw, b * LP + l0, l0, (LP - l0) < 4 ? (LP - l0) : 4, strip, mask32, lane);
        }
    }
}
#define ATT_N_PROMPT_UNITS (BATCH * N_KV * 33)
__device__ __forceinline__ void attn_prompt_unit(const MegaArgs& a, int idx, char* lds) {
    const int qb = 32 - idx / 16, bn = idx % 16, b = bn >> 1, n = bn & 1;
    const int tok0 = b * LP + 64 * qb, nq = (LP - 64 * qb) < 64 ? (LP - 64 * qb) : 64;
    const int NT = qb + 1;
    att::KvPrompt kv{a.Kb + (size_t)b * LP * 256 + n * 128, a.Vb + (size_t)b * LP * 256 + n * 128};
    att::attn_unit<att::KvPrompt>(kv, a.Aq, a.qnw, a.mask, a.Odsa, tok0, nq, 4 * n, NT, lds);
}
__device__ __forceinline__ void attn_sample_unit(const MegaArgs& a, int u, char* lds) {
    const int db = u >> 1, n = u & 1;
    int* pages = (int*)(lds + 2 * att::SHM_V + 2 * att::SHM_K + 2048);
    __syncthreads();
    if (threadIdx.x < N_PAGES) pages[threadIdx.x] = a.page_table[db * N_PAGES + threadIdx.x];
    __syncthreads();
    att::KvSample kv{a.cache_k, a.cache_v, a.out + O_K_S + (size_t)db * DEC_SEQ * 256 + n * 128, a.out + O_V_S + (size_t)db * DEC_SEQ * 256 + n * 128, pages, n};
    att::attn_unit<att::KvSample>(kv, a.Aq, a.qnw, a.mask, a.Odsa, T_PROMPT + db * DEC_SEQ, DEC_SEQ, 4 * n, 33, lds);
}

#define LDS_TOTAL (8 * idx::WAVE_LDS + 2048)
__global__ void __launch_bounds__(512, 2) mega(MegaArgs a) {
    extern __shared__ __attribute__((aligned(16))) unsigned char shm[];
    float* lds = (float*)shm;
    volatile LAS unsigned* xbw = (volatile LAS unsigned*)(PG8_LAS unsigned char*)(shm + LDS_TOTAL - 16);
    const int tid = threadIdx.x, wave = tid >> 6, lane = tid & 63, half = tid >> 8, G = gridDim.x, bid = blockIdx.x;
    if (tid == 0) { xbw[0] = 0u; xbw[1] = 0u; xbw[2] = 0u; xbw[3] = 0u; }
    __syncthreads();
    XcdBarrier bar = xcd_barrier_post(a.bar, xbw);
    for (int jp = bid; jp < PREP_J_ROWS / 2; jp += G) prep_job(a.prep, 2 * jp + half, lds + half * (32 * 65));
    for (int j = PREP_J_ROWS + bid * 2 + half; j < PREP_N_JOBS; j += 2 * G) prep_job(a.prep, j, lds);
    xcd_barrier(bar);
    { pg8::StaticOrder S; S.init(T_PAD, N1, G, bid);
      epi::Epi1 E{a.prep.rstd0, a.prep.rope, a.ikw, a.ikb, a.Rq, a.Rk, a.Rv, a.G, a.Aq, a.Vb, a.Iq, a.Ikb, a.Gates, a.Iw, a.out, 0};
      pg8::gemm_phase<epi::Epi1, pg8::StaticOrder, false>((PG8_LAS unsigned char*)shm, pg8::Gemm{a.prep.A0, a.prep.W1t, T_PAD, N1, 1024}, S, E, nullptr); }
    xcd_barrier(bar);
    for (int u = bid; u < BATCH * H_RET * 8; u += G) ret::unit(a, u, (char*)shm);
    for (int u = bid; u < DEC_BATCH * H_RET * 8; u += G) ret_naive_unit(a, u, 1, lds);
    for (int i = 0; (long)i * G < IDX_N_UNITS; ++i) { const long p = (long)i * G + ((i & 1) ? (G - 1 - bid) : bid); if (p < IDX_N_UNITS) idx_unit(a, (int)p, shm); }
    for (int r = bid * 8 + wave; r < T_ALL; r += 8 * G) knorm_row(a, r, lane);
    xcd_barrier(bar);
    for (int i = 0; ; ++i) { const long p = (long)i * G + ((i & 1) ? (G - 1 - bid) : bid); if (p >= ATT_N_PROMPT_UNITS) { if ((long)i * G >= ATT_N_PROMPT_UNITS) break; else continue; } attn_prompt_unit(a, (int)p, (char*)shm); }
    for (int u = bid; u < DEC_BATCH * N_KV; u += G) attn_sample_unit(a, u, (char*)shm);
    for (int r = bid * 8 + wave; r < T_ALL; r += 8 * G) make_an_row(a, r, lane);
    xcd_barrier(bar);
    const bf16_t* gates_p4 = a.Gates; asm volatile("" : "+s"(gates_p4));
    { pg8::StaticOrder S; S.init(T_PAD, 1024, G, bid); pg8::gemm_phase<epi::EpiRet, pg8::StaticOrder, false>((PG8_LAS unsigned char*)shm, pg8::Gemm{a.An, a.prep.Wret, T_PAD, 1024, 2048}, S, epi::EpiRet{gates_p4, a.M1}, nullptr); }
    { pg8::StaticOrder S; S.init(T_PAD, 1024, G, bid); pg8::gemm_phase<epi::EpiDsa, pg8::StaticOrder, false>((PG8_LAS unsigned char*)shm, pg8::Gemm{a.Odsa, a.prep.Wdsa, T_PAD, 1024, 1024}, S, epi::EpiDsa{gates_p4, a.M1, a.Mg}, nullptr); }
    xcd_barrier(bar);
    { pg8::StaticOrder S; S.init(T_PAD, 1024, G, bid); pg8::gemm_phase<epi::EpiOut, pg8::StaticOrder, false>((PG8_LAS unsigned char*)shm, pg8::Gemm{a.Mg, a.prep.Wout, T_PAD, 1024, 1024}, S, epi::EpiOut{a.prep.x_prompt, a.prep.x_sample, a.prep.meta, a.H2, a.A2, a.rstd2}, nullptr); }
    xcd_barrier(bar);
    { pg8::StaticOrder S; S.init(T_PAD, NFF2, G, bid); pg8::gemm_phase<epi::EpiFfi, pg8::StaticOrder, false>((PG8_LAS unsigned char*)shm, pg8::Gemm{a.A2, a.prep.Wffi, T_PAD, NFF2, 1024}, S, epi::EpiFfi{a.rstd2, a.Hid}, nullptr); }
    xcd_barrier(bar);
    { pg8::StaticOrder S; S.init(T_PAD, 1024, G, bid); pg8::gemm_phase<epi::EpiFfo, pg8::StaticOrder, false>((PG8_LAS unsigned char*)shm, pg8::Gemm{a.Hid, a.prep.Wffo, T_PAD, 1024, 2816}, S, epi::EpiFfo{a.H2, a.out}, nullptr); }
}
extern "C" void kernel_launch(void* const* d_in, const int* in_sizes, int n_in, void* d_out, int out_size, void* d_ws, size_t ws_size, hipStream_t stream) {
    static int grid = 0;
    if (grid == 0) {
        if (n_in != 20 || out_size != OUT_TOTAL || ws_size < WS_END_B1 || ws_size < WS_END_B2) { fprintf(stderr, "kernel_launch: unexpected shapes (n_in %d out %d ws %zu need %llu)\n", n_in, out_size, ws_size, (unsigned long long)WS_END_B1); grid = -1; return; }
        int dev = 0, cus = 0, per_cu = 0;
        if (hipGetDevice(&dev) != hipSuccess || hipDeviceGetAttribute(&cus, hipDeviceAttributeMultiprocessorCount, dev) != hipSuccess) { grid = -1; return; }
        if (hipFuncSetAttribute((const void*)mega, hipFuncAttributeMaxDynamicSharedMemorySize, LDS_TOTAL) != hipSuccess) { fprintf(stderr, "kernel_launch: hipFuncSetAttribute failed\n"); grid = -1; return; }
        if (hipOccupancyMaxActiveBlocksPerMultiprocessor(&per_cu, (const void*)mega, 512, LDS_TOTAL) != hipSuccess || per_cu < 1) { fprintf(stderr, "kernel_launch: occupancy query says %d blocks per CU\n", per_cu); grid = -1; return; }
        grid = cus;
    }
    if (grid < 0) return;
    char* ws = (char*)d_ws;
    MegaArgs a{};
    a.prep.x_prompt = (const float*)d_in[0]; a.prep.x_sample = (const float*)d_in[1]; a.prep.meta = (const float*)d_in[7]; a.prep.norm_mix_w = (const float*)d_in[8]; a.prep.w_in = (const float*)d_in[9];
    a.prep.w_ret = (const float*)d_in[10]; a.prep.w_dsa = (const float*)d_in[15]; a.prep.w_out = (const float*)d_in[16]; a.prep.norm_ffn_w = (const float*)d_in[17]; a.prep.w_ffi = (const float*)d_in[18]; a.prep.w_ffo = (const float*)d_in[19];
    a.prep.W1t = (bf16_t*)(ws + WS_W1T); a.prep.Wret = (bf16_t*)(ws + WS_WRET); a.prep.Wdsa = (bf16_t*)(ws + WS_WDSA); a.prep.Wout = (bf16_t*)(ws + WS_WOUT); a.prep.Wffi = (bf16_t*)(ws + WS_WFFI); a.prep.Wffo = (bf16_t*)(ws + WS_WFFO);
    a.prep.A0 = (bf16_t*)(ws + WS_A0); a.prep.rstd0 = (float*)(ws + WS_RSTD0); a.prep.rope = (float2*)(ws + WS_ROPE);
    a.cache_k = (const float*)d_in[2]; a.cache_v = (const float*)d_in[3]; a.cache_kidx = (const float*)d_in[4]; a.state_ret = (const float*)d_in[5]; a.page_table = (const int*)d_in[6];
    a.qnw = (const float*)d_in[11]; a.knw = (const float*)d_in[12]; a.ikw = (const float*)d_in[13]; a.ikb = (const float*)d_in[14];
    a.Rq = (bf16_t*)(ws + WS_RQ); a.Rk = (bf16_t*)(ws + WS_RK); a.Rv = (bf16_t*)(ws + WS_RV); a.G = (bf16_t*)(ws + WS_G); a.Aq = (bf16_t*)(ws + WS_AQ); a.Kb = (bf16_t*)(ws + WS_KB); a.Vb = (bf16_t*)(ws + WS_VB);
    a.Iq = (bf16_t*)(ws + WS_IQ); a.Ikb = (bf16_t*)(ws + WS_IKB); a.Gates = (bf16_t*)(ws + WS_GATES); a.OG = (bf16_t*)(ws + WS_OG); a.An = (bf16_t*)(ws + WS_AN); a.Odsa = (bf16_t*)(ws + WS_ODSA); a.Mg = (bf16_t*)(ws + WS_MG);
    a.A2 = (bf16_t*)(ws + WS_A2); a.Hid = (bf16_t*)(ws + WS_HID);
    a.Iw = (float*)(ws + WS_IW); a.ssret = (float*)(ws + WS_SSRET); a.rstd2 = (float*)(ws + WS_RSTD2); a.Z = (float*)(ws + WS_Z); a.M1 = (float*)(ws + WS_M1); a.M2 = (float*)(ws + WS_M2); a.H2 = (float*)(ws + WS_H2); a.Zf = (float*)(ws + WS_ZF);
    a.out = (float*)d_out; a.mask = (u64*)(ws + WS_MASK); a.bar = (unsigned*)(ws + WS_CTL);
    if (hipMemsetAsync(ws + WS_CTL, 0, 65536, stream) != hipSuccess) return;
    hipLaunchKernelGGL(mega, dim3(grid), dim3(512), LDS_TOTAL, stream, a);
}
```

```cpp
#include <hip/hip_runtime.h>
#include <stdint.h>
#include <stdio.h>

#define D_MODEL 1024
#define BATCH 8
#define SEQ 2048
#define N_META 16
#define LP (N_META + SEQ)
#define DEC_BATCH 128
#define DEC_SEQ 8
#define PAST_LEN 2048
#define PAGE_SIZE 128
#define N_PAGES 16
#define H_RET 4
#define DK_RET 256
#define DV_RET 512
#define N_HEADS 8
#define N_KV 2
#define D_HEAD 128
#define N_IDXH 8
#define D_IDX 64
#define TOPK 256
#define D_FF 2816
#define IN_COLS 10312
#define NORM_EPS 1e-6f
#define IDX_SCALE 0.04419417382415922f
#define T_PROMPT (BATCH * LP)
#define T_SAMPLE (DEC_BATCH * DEC_SEQ)
#define T_ALL (T_PROMPT + T_SAMPLE)
#define T_PAD 17664
#define N1 10496
#define NFF2 5632
#define MASK_WORDS 34
#define SAMPLE_L (PAST_LEN + DEC_SEQ)

#define O_Y_P   0
#define O_Y_S   16777216
#define O_K_P   17825792
#define O_V_P   22052864
#define O_KI_P  26279936
#define O_R_P   27336704
#define O_K_S   31531008
#define O_V_S   31793152
#define O_KI_S  32055296
#define O_R_S   32120832
#define OUT_TOTAL 99229696

typedef unsigned short bf16_t;
typedef unsigned long long u64;

__device__ __forceinline__ bf16_t f2bf(float f) { unsigned u = __float_as_uint(f); u += 0x7FFFu + ((u >> 16) & 1u); return (bf16_t)(u >> 16); }
__device__ __forceinline__ float bf2f(bf16_t b) { return __uint_as_float(((unsigned)b) << 16); }
__device__ __forceinline__ float silu_f(float x) { return x / (1.0f + __expf(-x)); }
__device__ __forceinline__ float sigmoid_f(float x) { return 1.0f / (1.0f + __expf(-x)); }

__device__ __forceinline__ int row_pos(int r) { return r < T_PROMPT ? (r % LP) : (PAST_LEN + ((r - T_PROMPT) & (DEC_SEQ - 1))); }

#define WS_CTL      0ull
#define WS_W1T      (WS_CTL + 65536ull)
#define WS_WRET     (WS_W1T + (u64)N1 * 1024 * 2)
#define WS_WDSA     (WS_WRET + 1024ull * 2048 * 2)
#define WS_WOUT     (WS_WDSA + 1024ull * 1024 * 2)
#define WS_WFFI     (WS_WOUT + 1024ull * 1024 * 2)
#define WS_WFFO     (WS_WFFI + (u64)NFF2 * 1024 * 2)
#define WS_ROPE     (WS_WFFO + 1024ull * 2816 * 2)
#define WS_RSTD0    (WS_ROPE + (u64)LP * 128 * 8)
#define WS_A0       (WS_RSTD0 + (u64)T_PAD * 4)
#define WS_RQ       (WS_A0 + (u64)T_PAD * 1024 * 2)
#define WS_RK       (WS_RQ + (u64)T_PAD * 1024 * 2)
#define WS_RV       (WS_RK + (u64)T_PAD * 1024 * 2)
#define WS_G        (WS_RV + (u64)T_PAD * 2048 * 2)
#define WS_AQ       (WS_G + (u64)T_PAD * 2048 * 2)
#define WS_KB       (WS_AQ + (u64)T_PAD * 1024 * 2)
#define WS_VB       (WS_KB + (u64)T_PAD * 256 * 2)
#define WS_IQ       (WS_VB + (u64)T_PAD * 256 * 2)
#define WS_IKB      (WS_IQ + (u64)T_PAD * 512 * 2)
#define WS_IW       (WS_IKB + (u64)T_PAD * 64 * 2)
#define WS_GATES    (WS_IW + (u64)T_PAD * 8 * 4)
#define WS_MASK     (WS_GATES + (u64)T_PAD * 2048 * 2)
#define WS_SSRET    (WS_MASK + (u64)T_PAD * MASK_WORDS * 8)
#define WS_RSTD2    (WS_SSRET + (u64)T_PAD * 32 * 4)
#define WS_REGION_B (((WS_RSTD2 + (u64)T_PAD * 16 * 4) + 4095ull) & ~4095ull)
#define WS_Z        WS_REGION_B
#define WS_H2       WS_REGION_B
#define WS_A2       (WS_H2 + (u64)T_PAD * 1024 * 4)
#define WS_HID      (WS_A2 + (u64)T_PAD * 1024 * 2)
#define WS_MG       (WS_HID + (u64)T_PAD * 2816 * 2)
#define WS_OG       (WS_MG + (u64)T_PAD * 1024 * 2)
#define WS_AN       (WS_OG + (u64)T_PAD * 2048 * 2)
#define WS_ODSA     (WS_AN + (u64)T_PAD * 2048 * 2)
#define WS_M1       (WS_ODSA + (u64)T_PAD * 1024 * 2)
#define WS_M2       (WS_M1 + (u64)T_PAD * 1024 * 4)
#define WS_ZF       WS_OG
#define WS_END_B1   (WS_Z + (u64)T_PAD * N1 * 4)
#define WS_END_B2   (WS_ZF + (u64)T_PAD * NFF2 * 4)
namespace pg8 {
#define PG8_LAS __attribute__((address_space(3)))
typedef unsigned short bf16_t;
typedef short bf16x8 __attribute__((ext_vector_type(8)));
typedef float f32x4 __attribute__((ext_vector_type(4)));
typedef unsigned u32x4 __attribute__((ext_vector_type(4)));
constexpr int BM = 256, BK = 64, HALF = 128, HTB = HALF * BK * 2  , STAGE_BYTES = 8 * HTB, NXCD = 8, WGM = 8;

__host__ __device__ __forceinline__ int lds_byte(int r, int c) { const int st = (r >> 4) * 2 + (c >> 5), rr = r & 15, cc = c & 31, ob = rr * 64 + cc * 2; return st * 1024 + (ob ^ (((ob >> 9) & 1) << 5)); }
__host__ __device__ __forceinline__ void stage_rc(int b, int& R, int& C) { const int st = b / 1024, sb = b % 1024, swz = sb ^ (((sb >> 9) & 1) << 5); R = (st >> 1) * 16 + swz / 64; C = (st & 1) * 32 + (swz % 64) / 2; }
__host__ __device__ __forceinline__ int perm32(int rho) { const int n = rho >> 4, i = rho & 15; return 8 * (i >> 2) + 4 * n + (i & 3); }

struct Unit { int pm, pn; };
struct Gemm { const bf16_t* A; const bf16_t* Bt; int M, N, K; };

struct StaticOrder {
    int nM, nN, nwg, G, c;
    __host__ __device__ void init(int M, int N, int G_, int c_) { nM = M / BM; nN = N / BM; nwg = nM * nN; G = G_; c = c_; }
    __host__ __device__ bool next(int i, Unit& u) const {
        const long L = (long)i * G + c; if (L >= nwg) return false;
        int wgid = (int)L; { const int q = nwg / NXCD, r = nwg % NXCD, xcd = wgid % NXCD, off = wgid / NXCD; wgid = (xcd < r ? xcd * (q + 1) : r * (q + 1) + (xcd - r) * q) + off; }
        const int nig = WGM * nN, gid = wgid / nig, fm = gid * WGM, gsz = (nM - fm) < WGM ? (nM - fm) : WGM;
        u.pm = fm + ((wgid % nig) % gsz); u.pn = (wgid % nig) / gsz; return true;
    }
    __device__ __forceinline__ void a_ready(const Unit&) const {}
    __device__ __forceinline__ void done(const Unit&) const {}
};
struct CountedOrder : StaticOrder {
    const unsigned* ready; unsigned need; unsigned* tmo;
    __device__ __forceinline__ void a_ready(const Unit& u) const {
        if (threadIdx.x < 64) {
            const unsigned long long t0 = __builtin_amdgcn_s_memrealtime(); unsigned polls = 0;
            while ((unsigned)__builtin_amdgcn_readfirstlane(__hip_atomic_load(ready + 64 * u.pm, __ATOMIC_RELAXED, __HIP_MEMORY_SCOPE_AGENT)) < need) {
                if ((++polls & 255u) == 0u && __builtin_amdgcn_readfirstlane(__hip_atomic_load(tmo, __ATOMIC_RELAXED, __HIP_MEMORY_SCOPE_AGENT)) != 0u) break;
                if (__builtin_amdgcn_s_memrealtime() - t0 > 2000000ull) {
                    if (threadIdx.x == 0) { unsigned expect = 0u; __hip_atomic_compare_exchange_strong(tmo + 1, &expect, 0x600u | (unsigned)(u.pm & 0xff), __ATOMIC_RELAXED, __ATOMIC_RELAXED, __HIP_MEMORY_SCOPE_AGENT); __hip_atomic_store(tmo, 1u, __ATOMIC_RELAXED, __HIP_MEMORY_SCOPE_AGENT); }
                    break; }
                __builtin_amdgcn_s_sleep(2); }
            __builtin_amdgcn_fence(__ATOMIC_ACQUIRE, "agent");
            asm volatile("s_waitcnt vmcnt(0)" ::: "memory");
        }
#if !defined(BROKEN_HOOK_NO_BARRIER)
        asm volatile("" ::: "memory"); __builtin_amdgcn_s_barrier(); asm volatile("" ::: "memory");
#endif
    }
};

typedef float f32x2c __attribute__((ext_vector_type(2))); typedef __bf16 bf16x2c __attribute__((ext_vector_type(2)));
__device__ __forceinline__ unsigned cvt_pk_bf16(float lo, float hi) { const f32x2c v = {lo, hi}; return __builtin_bit_cast(unsigned, __builtin_convertvector(v, bf16x2c)); }
typedef float f32x2 __attribute__((ext_vector_type(2)));
__device__ __forceinline__ f32x2 gelu_pk(f32x2 v) {
    const f32x2 av = __builtin_elementwise_abs(v), d = av * 0.2316418882f + 1.0f;
    f32x2 t; t.x = __builtin_amdgcn_rcpf(d.x); t.y = __builtin_amdgcn_rcpf(d.y);
    f32x2 q = t * 0.5307027145f + (-0.7265760135f); q = q * t + 0.7107068705f; q = q * t + (-0.142248368f); q = q * t + 0.127414796f; q = q * t;
    const f32x2 s = (v * v) * (-0.72134752044f);
    f32x2 e; e.x = __builtin_amdgcn_exp2f(s.x); e.y = __builtin_amdgcn_exp2f(s.y);
    const f32x2 m = v * (q * e), r = v - m;
    f32x2 o; o.x = v.x < 0.f ? m.x : r.x; o.y = v.y < 0.f ? m.y : r.y; return o;
}

struct EpiF32 {
    static constexpr bool PERM = false, AFTER_DRAIN = false;
    float* C; int ldc; const float* bias;
    __device__ __forceinline__ void operator()(const f32x4 (&acc)[2][2][4][2], const Unit& u, int wr, int wc, int fr, int fq) const {
        const int row0 = u.pm * BM + wr * 64 + fr, col0 = u.pn * BM + wc * 32 + 4 * fq;
        f32x4 bv[2][2];
#pragma unroll
        for (int bj = 0; bj < 2; ++bj)
#pragma unroll
            for (int n = 0; n < 2; ++n) bv[bj][n] = bias ? *(const f32x4*)(bias + col0 + bj * HALF + n * 16) : (f32x4){0.f, 0.f, 0.f, 0.f};
#pragma unroll
        for (int ai = 0; ai < 2; ++ai)
#pragma unroll
            for (int m = 0; m < 4; ++m) { float* rowp = C + (size_t)(row0 + ai * HALF + m * 16) * ldc + col0;
#pragma unroll
                for (int bj = 0; bj < 2; ++bj)
#pragma unroll
                    for (int n = 0; n < 2; ++n) *(f32x4*)(rowp + bj * HALF + n * 16) = acc[ai][bj][m][n] + bv[bj][n]; }
    }
};
template <int ACT  > struct EpiBf16 {
    static constexpr bool PERM = true, AFTER_DRAIN = false;
    bf16_t* O; int ldc; const float* bias; int split_cols; size_t split_stride;
    __device__ __forceinline__ void operator()(const f32x4 (&acc)[2][2][4][2], const Unit& u, int wr, int wc, int fr, int fq) const {
        const int row0 = u.pm * BM + wr * 64 + fr; int colt = u.pn * BM; bf16_t* base = O;
        if (split_cols) { const int t = colt / split_cols; base += (size_t)t * split_stride; colt -= t * split_cols; }
        const int col0 = colt + wc * 32 + 8 * fq, bcol0 = u.pn * BM + wc * 32 + 8 * fq;
        f32x4 bv[2][2];
#pragma unroll
        for (int bj = 0; bj < 2; ++bj)
#pragma unroll
            for (int n = 0; n < 2; ++n) bv[bj][n] = bias ? *(const f32x4*)(bias + bcol0 + bj * HALF + 4 * n) : (f32x4){0.f, 0.f, 0.f, 0.f};
#pragma unroll
        for (int ai = 0; ai < 2; ++ai)
#pragma unroll
            for (int m = 0; m < 4; ++m) { bf16_t* rowp = base + (size_t)(row0 + ai * HALF + m * 16) * ldc + col0;
#pragma unroll
                for (int bj = 0; bj < 2; ++bj) { f32x4 v0 = acc[ai][bj][m][0] + bv[bj][0], v1 = acc[ai][bj][m][1] + bv[bj][1];
                    if (ACT == 1) { f32x2 a = gelu_pk((f32x2){v0[0], v0[1]}), b = gelu_pk((f32x2){v0[2], v0[3]}), c = gelu_pk((f32x2){v1[0], v1[1]}), d = gelu_pk((f32x2){v1[2], v1[3]});
                        v0 = (f32x4){a.x, a.y, b.x, b.y}; v1 = (f32x4){c.x, c.y, d.x, d.y}; }
                    if (ACT == 2) {
#pragma unroll
                        for (int j = 0; j < 4; ++j) { v0[j] = 0.5f * v0[j] * (1.0f + erff(v0[j] * 0.70710678f)); v1[j] = 0.5f * v1[j] * (1.0f + erff(v1[j] * 0.70710678f)); } }
                    u32x4 w; w.x = cvt_pk_bf16(v0[0], v0[1]); w.y = cvt_pk_bf16(v0[2], v0[3]); w.z = cvt_pk_bf16(v1[0], v1[1]); w.w = cvt_pk_bf16(v1[2], v1[3]);
                    *(u32x4*)(rowp + bj * HALF) = w; } }
    }
};
template <class Epi, class Sched, bool STAMP = false>
__device__ __forceinline__ void gemm_phase(PG8_LAS unsigned char* lds, const Gemm g, const Sched& S, const Epi& E, unsigned long long* stamps) {
    int tid_l = threadIdx.x; asm volatile("" : "+v"(tid_l));
    const int tid = tid_l, wid = __builtin_amdgcn_readfirstlane(tid >> 6), lane = tid & 63, wr = wid >> 2, wc = wid & 3, fr = lane & 15, fq = lane >> 4;
    const int K = g.K, nt = K / BK;
    int ts_lo = 0, ts_hi = 0, nts = 0; const unsigned long long rt_entry = STAMP ? (unsigned long long)wall_clock64() : 0ull;
#define PG8_STAMP() do { if (STAMP && wid == 0 && nts < 64) { const unsigned long long _c = (unsigned long long)clock64(); \
        ts_lo = (lane == nts) ? (int)(unsigned)_c : ts_lo; ts_hi = (lane == nts) ? (int)(unsigned)(_c >> 32) : ts_hi; ++nts; } } while (0)
    PG8_STAMP();
    unsigned voffA[2], voffB[2];
#pragma unroll
    for (int i = 0; i < 2; ++i) { int R, C; stage_rc(tid * 16 + i * 8192, R, C); const int Rb = Epi::PERM ? ((R & ~31) + perm32(R & 31)) : R;
        voffA[i] = (unsigned)(R * K + C) * 2u; voffB[i] = (unsigned)(Rb * K + C) * 2u; }
    const size_t kstep = (size_t)(BK * 2);
    const size_t hstep = (size_t)HALF * K * 2;
    const size_t tstep = 2 * hstep;
    const unsigned ldsw = (unsigned)wid * 1024u;
    const int aoff = lds_byte(wr * 64 + fr, fq * 8), boff = lds_byte(wc * 32 + fr, fq * 8);
#define PG8_SA(b, h) (((b) * 2 + (h)) * HTB)
#define PG8_SB(b, h) ((4 + (b) * 2 + (h)) * HTB)
#define PG8_STAGE(bufoff, gbase, voff) do { _Pragma("unroll") for (int _i = 0; _i < 2; ++_i) \
        __builtin_amdgcn_global_load_lds((const unsigned*)((const char*)(gbase) + (voff)[_i]), (PG8_LAS unsigned*)(lds + (bufoff) + ldsw + _i * 8192), 16, 0, 0); } while (0)
#define PG8_LDA(dst, b, h) do { _Pragma("unroll") for (int m = 0; m < 4; ++m) _Pragma("unroll") for (int k = 0; k < 2; ++k) dst[m][k] = *(const PG8_LAS bf16x8*)(lds + PG8_SA(b, h) + aoff + m * 2048 + k * 1024); } while (0)
#define PG8_LDB(dst, b, h) do { _Pragma("unroll") for (int n = 0; n < 2; ++n) _Pragma("unroll") for (int k = 0; k < 2; ++k) dst[n][k] = *(const PG8_LAS bf16x8*)(lds + PG8_SB(b, h) + boff + n * 2048 + k * 1024); } while (0)
#define PG8_MMA(ai, bj, At, Bt) do { __builtin_amdgcn_s_setprio(1); _Pragma("unroll") for (int m = 0; m < 4; ++m) _Pragma("unroll") for (int n = 0; n < 2; ++n) _Pragma("unroll") for (int k = 0; k < 2; ++k) \
        acc[ai][bj][m][n] = __builtin_amdgcn_mfma_f32_16x16x32_bf16(Bt[n][k], At[m][k], acc[ai][bj][m][n], 0, 0, 0); __builtin_amdgcn_s_setprio(0); } while (0)
#define PG8_WAIT_V(n) asm volatile("s_waitcnt vmcnt(" #n ")" ::: "memory")
#define PG8_WAIT_L(n) asm volatile("s_waitcnt lgkmcnt(" #n ")" ::: "memory")
#define PG8_BAR __builtin_amdgcn_s_barrier()
#define PG8_SCHED __builtin_amdgcn_sched_barrier(0)
    Unit cur, nxt; int ui = 0;
    if (!S.next(0, cur)) return;
    f32x4 acc[2][2][4][2];
#pragma unroll
    for (int a = 0; a < 2; ++a)
#pragma unroll
        for (int b = 0; b < 2; ++b)
#pragma unroll
            for (int m = 0; m < 4; ++m)
#pragma unroll
                for (int n = 0; n < 2; ++n) acc[a][b][m][n] = (f32x4){0.f, 0.f, 0.f, 0.f};
    bf16x8 At[4][2], B0[2][2], B1[2][2];
    const char* cA = (const char*)g.A + (size_t)cur.pm * tstep; const char* cB = (const char*)g.Bt + (size_t)cur.pn * tstep;
    S.a_ready(cur);
    PG8_STAGE(PG8_SB(0, 0), cB, voffB); PG8_STAGE(PG8_SA(0, 0), cA, voffA); PG8_STAGE(PG8_SB(0, 1), cB + hstep, voffB); PG8_STAGE(PG8_SA(0, 1), cA + hstep, voffA);
    if (wr == 1) PG8_BAR;
    PG8_WAIT_V(4); PG8_BAR;
    PG8_STAGE(PG8_SB(1, 0), cB + kstep, voffB); PG8_STAGE(PG8_SA(1, 0), cA + kstep, voffA); PG8_STAGE(PG8_SB(1, 1), cB + hstep + kstep, voffB);
    PG8_WAIT_V(6); PG8_BAR;
    PG8_STAMP();
    for (;;) {
        const bool has_next = S.next(ui + 1, nxt);
        const char* nA = has_next ? (const char*)g.A + (size_t)nxt.pm * tstep : cA; const char* nB = has_next ? (const char*)g.Bt + (size_t)nxt.pn * tstep : cB;
        for (int t = 0; t < nt; t += 2) {
            const bool last = (t == nt - 2);
            const char* a1 = cA + (size_t)(t + 1) * kstep;
            const char* a2 = last ? nA : cA + (size_t)(t + 2) * kstep; const char* b2 = last ? nB : cB + (size_t)(t + 2) * kstep;
            const char* a3 = a2 + kstep; const char* b3 = b2 + kstep;
            if (last && has_next) S.a_ready(nxt);
            PG8_LDB(B0, 0, 0); PG8_SCHED; PG8_LDA(At, 0, 0); PG8_STAGE(PG8_SA(1, 1), a1 + hstep, voffA);
            PG8_WAIT_L(8); PG8_BAR; PG8_WAIT_L(0); PG8_MMA(0, 0, At, B0); PG8_BAR; PG8_SCHED;
            PG8_LDB(B1, 0, 1); PG8_STAGE(PG8_SB(0, 0), b2, voffB);
            PG8_BAR; PG8_WAIT_L(0); PG8_MMA(0, 1, At, B1); PG8_BAR;
            PG8_LDA(At, 0, 1); PG8_STAGE(PG8_SA(0, 0), a2, voffA);
            PG8_BAR; PG8_WAIT_L(0); PG8_MMA(1, 0, At, B0); PG8_BAR; PG8_SCHED;
            PG8_STAGE(PG8_SB(0, 1), b2 + hstep, voffB);
            PG8_WAIT_V(6); PG8_BAR; PG8_MMA(1, 1, At, B1); PG8_BAR;
            PG8_LDB(B0, 1, 0); PG8_SCHED; PG8_LDA(At, 1, 0); PG8_STAGE(PG8_SA(0, 1), a2 + hstep, voffA);
            PG8_WAIT_L(8); PG8_BAR; PG8_WAIT_L(0); PG8_MMA(0, 0, At, B0); PG8_BAR; PG8_SCHED;
            PG8_LDB(B1, 1, 1); PG8_STAGE(PG8_SB(1, 0), b3, voffB);
            PG8_BAR; PG8_WAIT_L(0); PG8_MMA(0, 1, At, B1); PG8_BAR;
            PG8_LDA(At, 1, 1); PG8_STAGE(PG8_SA(1, 0), a3, voffA);
            PG8_BAR; PG8_WAIT_L(0); PG8_MMA(1, 0, At, B0); PG8_BAR; PG8_SCHED;
            PG8_STAGE(PG8_SB(1, 1), b3 + hstep, voffB);
            PG8_WAIT_V(6); PG8_BAR; PG8_MMA(1, 1, At, B1); PG8_BAR;
        }
        PG8_STAMP();
        if constexpr (!Epi::AFTER_DRAIN) { E(acc, cur, wr, wc, fr, fq); S.done(cur); }
        PG8_STAMP();
        if (!has_next) break;
#pragma unroll
        for (int a = 0; a < 2; ++a)
#pragma unroll
            for (int b = 0; b < 2; ++b)
#pragma unroll
                for (int m = 0; m < 4; ++m)
#pragma unroll
                    for (int n = 0; n < 2; ++n) acc[a][b][m][n] = (f32x4){0.f, 0.f, 0.f, 0.f};
        cur = nxt; cA = nA; cB = nB; ++ui;
    }
    PG8_WAIT_V(0);
    if (wr == 0) PG8_BAR;
    PG8_BAR;
    if constexpr (Epi::AFTER_DRAIN) { E.fused(acc, cur, wr, wc, fr, fq, lds, wid, lane); S.done(cur); }
    PG8_STAMP();
    if (STAMP && wid == 0) { stamps[lane] = lane < nts ? (((unsigned long long)(unsigned)ts_hi << 32) | (unsigned)ts_lo) : 0ull;
        if (lane == 62) stamps[62] = rt_entry; if (lane == 63) stamps[63] = (unsigned long long)wall_clock64(); }
#undef PG8_STAMP
#undef PG8_SA
#undef PG8_SB
#undef PG8_STAGE
#undef PG8_LDA
#undef PG8_LDB
#undef PG8_MMA
#undef PG8_WAIT_V
#undef PG8_WAIT_L
#undef PG8_BAR
#undef PG8_SCHED
}
}
#define XB_TMO      128
#define XB_XCNT(j)  (256  + 64 * (j))
#define XB_XSUB(j)  (1280 + 64 * (j))
#define XB_XGEN(j)  (2304 + 64 * (j))
#define XB_TOP      3328
#define XB_TOPGEN   3392
#define XCD_BAR_WORDS 3456
#define XB_SPIN_CAP (1u << 18)
#define LAS __attribute__((address_space(3)))

__device__ __forceinline__ unsigned xb_ld(unsigned* p)              { return __hip_atomic_load(p, __ATOMIC_RELAXED, __HIP_MEMORY_SCOPE_AGENT); }
__device__ __forceinline__ unsigned xb_add(unsigned* p, unsigned v) { return __hip_atomic_fetch_add(p, v, __ATOMIC_RELAXED, __HIP_MEMORY_SCOPE_AGENT); }
__device__ __forceinline__ unsigned xb_xcc_id() { return (unsigned)__builtin_amdgcn_s_getreg((3 << 11) | 20) & 0xFu; }
#define XB_SPIN(cond, bar) do { unsigned _sp = 0; while (cond) { __builtin_amdgcn_s_sleep(1); \
    if ((++_sp & 255u) == 0u) { if (xb_ld(&(bar)[XB_TMO])) break; if (_sp > XB_SPIN_CAP) { atomicAdd(&(bar)[XB_TMO], 1u); break; } } } } while (0)

struct XcdBarrier {
    unsigned* bar; unsigned x;
    volatile LAS unsigned* st;
};

__device__ __forceinline__ XcdBarrier xcd_barrier_post(unsigned* bar, volatile LAS unsigned* st) {
    XcdBarrier b; b.bar = bar; b.x = xb_xcc_id(); b.st = st;
    if (threadIdx.x == 0) (void)xb_add(&bar[XB_XCNT(b.x)], 1u);
    return b;
}
__device__ __forceinline__ void xcd_barrier_complete(unsigned* bar, unsigned x, unsigned& nloc, unsigned& nx) {
    const unsigned G = gridDim.x * gridDim.y * gridDim.z;
    unsigned sum, cnt, mine, sp = 0u;
    for (;;) {
        sum = 0u; cnt = 0u; mine = 0u;
#pragma unroll
        for (unsigned j = 0; j < 16; ++j) { const unsigned c = xb_ld(&bar[XB_XCNT(j)]); sum += c; cnt += (c > 0u) ? 1u : 0u; mine = (j == x) ? c : mine; }
        if (sum == G) break;
        __builtin_amdgcn_s_sleep(1);
        if ((++sp & 255u) == 0u) { if (xb_ld(&bar[XB_TMO])) break; if (sp > XB_SPIN_CAP) { atomicAdd(&bar[XB_TMO], 1u); break; } }
    }
    nloc = mine > 0u ? mine : 1u; nx = cnt > 0u ? cnt : 1u;
}

__device__ __forceinline__ void xcd_barrier(const XcdBarrier& b) {
    asm volatile("s_waitcnt vmcnt(0)" ::: "memory");
    __syncthreads();
    if (threadIdx.x == 0) {
        unsigned* bar = b.bar;
        __builtin_amdgcn_s_waitcnt(0);
        unsigned nloc = b.st[0], nx = b.st[1];
        if (nloc == 0u) { xcd_barrier_complete(bar, b.x, nloc, nx); b.st[0] = nloc; b.st[1] = nx; }
        const unsigned old = xb_add(&bar[XB_XSUB(b.x)], 1u);
        const unsigned gen = old / nloc;
        if (old + 1u == (gen + 1u) * nloc) {
            __builtin_amdgcn_fence(__ATOMIC_RELEASE, "agent");
            asm volatile("s_waitcnt vmcnt(0)" ::: "memory");
            const unsigned og = xb_add(&bar[XB_TOP], 1u);
            const unsigned tg = og / nx;
            if (og + 1u == (tg + 1u) * nx) xb_add(&bar[XB_TOPGEN], 1u);
            else XB_SPIN(xb_ld(&bar[XB_TOPGEN]) == tg, bar);
            __builtin_amdgcn_fence(__ATOMIC_ACQUIRE, "agent");
            xb_add(&bar[XB_XGEN(b.x)], 1u);
            asm volatile("s_waitcnt vmcnt(0)" ::: "memory");
        } else {
            XB_SPIN(xb_ld(&bar[XB_XGEN(b.x)]) == gen, bar);
            __builtin_amdgcn_fence(__ATOMIC_ACQUIRE, "agent");
            asm volatile("s_waitcnt vmcnt(0)" ::: "memory");
        }
    }
    __syncthreads();
}
__host__ __device__ __forceinline__ int ikiw_src(int c) {
    if (c < 32) return 8192 + c;
    if (c < 40) return 8256 + (c - 32);
    if (c >= 128 && c < 160) return 8192 + 32 + (c - 128);
    return -1;
}
__host__ __device__ __forceinline__ int ik_tilecol(int e) { return e < 32 ? e : 128 + (e - 32); }
__device__ __forceinline__ int src_col(int mode, int n) {
    if (mode == 0) return n;
    if (mode == 1) { if (n < 8192) return n; if (n < 8448) return ikiw_src(n - 8192); return 8264 + (n - 8448); }
    const int pn = n >> 8, c = n & 255; return c < 128 ? pn * 128 + c : D_FF + pn * 128 + (c - 128);
}
__device__ __forceinline__ void prep_weight_tile(const float* __restrict__ w, int ldw, const float* __restrict__ scale, bf16_t* __restrict__ Wt, int K, int mode, int tile, float* lds  ) {
    const int ktiles = K / 32, nt = tile / ktiles, kt = tile % ktiles, tid = threadIdx.x & 255;
    const int n0 = nt * 64, k0 = kt * 32;
    {   const int nn = tid & 63, kk0 = tid >> 6; const int sc = src_col(mode, n0 + nn);
#pragma unroll
        for (int i = 0; i < 8; ++i) { const int kk = kk0 + i * 4; float v = 0.f; if (sc >= 0) { v = w[(size_t)(k0 + kk) * ldw + sc]; if (scale) v *= scale[k0 + kk]; } lds[kk * 65 + nn] = v; } }
    __syncthreads();
    {   const int kk = tid & 31, nn0 = tid >> 5;
#pragma unroll
        for (int i = 0; i < 8; ++i) { const int nn = nn0 + i * 8; Wt[(size_t)(n0 + nn) * K + k0 + kk] = f2bf(lds[kk * 65 + nn]); } }
    __syncthreads();
}
__device__ __forceinline__ const float* h_row_ptr(int r, const float* xp, const float* xs, const float* meta) {
    if (r < T_PROMPT) { const int b = r / LP, l = r % LP; return l < N_META ? meta + (size_t)l * D_MODEL : xp + ((size_t)b * SEQ + (l - N_META)) * D_MODEL; }
    return xs + (size_t)(r - T_PROMPT) * D_MODEL;
}
__device__ __forceinline__ void prep_row(int r, const float* xp, const float* xs, const float* meta, bf16_t* A0, float* rstd0, int lane) {
    if (r >= T_ALL) { for (int i = lane; i < D_MODEL / 2; i += 64) ((unsigned*)(A0 + (size_t)r * D_MODEL))[i] = 0u; if (lane == 0) rstd0[r] = 0.f; return; }
    const float4* src = (const float4*)h_row_ptr(r, xp, xs, meta); float ss = 0.f;
#pragma unroll
    for (int i = 0; i < 4; ++i) { const float4 v = src[lane + i * 64]; ss += v.x * v.x + v.y * v.y + v.z * v.z + v.w * v.w;
        uint2 o; o.x = (unsigned)f2bf(v.x) | ((unsigned)f2bf(v.y) << 16); o.y = (unsigned)f2bf(v.z) | ((unsigned)f2bf(v.w) << 16);
        ((uint2*)(A0 + (size_t)r * D_MODEL))[lane + i * 64] = o; }
#pragma unroll
    for (int o = 32; o >= 1; o >>= 1) ss += __shfl_xor(ss, o);
    if (lane == 0) rstd0[r] = rsqrtf(ss * (1.0f / D_MODEL) + NORM_EPS);
}
__device__ __forceinline__ void rope_entry(int idx, float2* tab) {
    const int pos = idx >> 7, i = idx & 127;
    const float inv = exp2f(-(float)i * (13.287712379549449f / 128.0f));
    const float angf = (float)pos * inv; const double a = (double)angf;
    const double kq = rint(a * 0.63661977236758134308);
    double r = fma(-kq, 1.57079632679489655800e+00, a); r = fma(-kq, 6.12323399573676603587e-17, r);
    const double r2 = r * r;
    const double sp = r * (1.0 + r2 * (-1.0 / 6 + r2 * (1.0 / 120 + r2 * (-1.0 / 5040 + r2 * (1.0 / 362880 + r2 * (-1.0 / 39916800 + r2 * (1.0 / 6227020800.0)))))));
    const double cp = 1.0 + r2 * (-0.5 + r2 * (1.0 / 24 + r2 * (-1.0 / 720 + r2 * (1.0 / 40320 + r2 * (-1.0 / 3628800 + r2 * (1.0 / 479001600 + r2 * (-1.0 / 87178291200.0)))))));
    const int q = ((int)kq) & 3;
    const double sv = (q == 0) ? sp : (q == 1) ? cp : (q == 2) ? -sp : -cp;
    const double cv = (q == 0) ? cp : (q == 1) ? -sp : (q == 2) ? -cp : sp;
    tab[idx] = make_float2((float)cv, (float)sv);
}

struct PrepArgs {
    const float *x_prompt, *x_sample, *meta, *norm_mix_w, *w_in, *w_ret, *w_dsa, *w_out, *norm_ffn_w, *w_ffi, *w_ffo;
    bf16_t *W1t, *Wret, *Wdsa, *Wout, *Wffi, *Wffo, *A0; float* rstd0; float2* rope;
};
#define PREP_J_W1   0
#define PREP_N_W1   ((N1 / 64) * (1024 / 32))
#define PREP_J_WRET (PREP_J_W1 + PREP_N_W1)
#define PREP_N_WRET ((1024 / 64) * (2048 / 32))
#define PREP_J_WDSA (PREP_J_WRET + PREP_N_WRET)
#define PREP_N_WDSA ((1024 / 64) * (1024 / 32))
#define PREP_J_WOUT (PREP_J_WDSA + PREP_N_WDSA)
#define PREP_N_WOUT ((1024 / 64) * (1024 / 32))
#define PREP_J_WFFI (PREP_J_WOUT + PREP_N_WOUT)
#define PREP_N_WFFI ((NFF2 / 64) * (1024 / 32))
#define PREP_J_WFFO (PREP_J_WFFI + PREP_N_WFFI)
#define PREP_N_WFFO ((1024 / 64) * (2816 / 32))
#define PREP_J_ROWS (PREP_J_WFFO + PREP_N_WFFO)
#define PREP_N_ROWS (T_PAD / 4)
#define PREP_J_ROPE (PREP_J_ROWS + PREP_N_ROWS)
#define PREP_N_ROPE ((LP * 128) / 256)
#define PREP_N_JOBS (PREP_J_ROPE + PREP_N_ROPE)
__device__ __forceinline__ void prep_job(const PrepArgs& a, int job, float* lds) {
    if (job < PREP_J_WRET)      prep_weight_tile(a.w_in, IN_COLS, a.norm_mix_w, a.W1t, 1024, 1, job - PREP_J_W1, lds);
    else if (job < PREP_J_WDSA) prep_weight_tile(a.w_ret, 1024, nullptr, a.Wret, 2048, 0, job - PREP_J_WRET, lds);
    else if (job < PREP_J_WOUT) prep_weight_tile(a.w_dsa, 1024, nullptr, a.Wdsa, 1024, 0, job - PREP_J_WDSA, lds);
    else if (job < PREP_J_WFFI) prep_weight_tile(a.w_out, 1024, nullptr, a.Wout, 1024, 0, job - PREP_J_WOUT, lds);
    else if (job < PREP_J_WFFO) prep_weight_tile(a.w_ffi, 2 * D_FF, a.norm_ffn_w, a.Wffi, 1024, 2, job - PREP_J_WFFI, lds);
    else if (job < PREP_J_ROWS) prep_weight_tile(a.w_ffo, 1024, nullptr, a.Wffo, 2816, 0, job - PREP_J_WFFO, lds);
    else if (job < PREP_J_ROPE) prep_row((job - PREP_J_ROWS) * 4 + ((threadIdx.x & 255) >> 6), a.x_prompt, a.x_sample, a.meta, a.A0, a.rstd0, threadIdx.x & 63);
    else rope_entry((job - PREP_J_ROPE) * 256 + (threadIdx.x & 255), a.rope);
}
namespace att {
using bf16x8 = __attribute__((ext_vector_type(8))) short;
using s16x4  = __attribute__((ext_vector_type(4))) short;
using f32x16 = __attribute__((ext_vector_type(16))) float;
using f32x8  = __attribute__((ext_vector_type(8))) float;
using u32x4  = __attribute__((ext_vector_type(4))) unsigned;
constexpr float SCALE = 0.088388347648318440f;
constexpr float THR = 8.f;
constexpr float NEG = -3.0e38f;
constexpr int SHM_V = 64 * 128 * 2, SHM_K = 64 * 128 * 2;
#define ATT_KSWZ(row, colB) ((row) * 256 + ((colB) ^ (((row) & 7) << 4)))
#define ATT_SBAR() __builtin_amdgcn_sched_barrier(0)
__device__ __forceinline__ int crow(int r, int hi) { return (r & 3) + 8 * (r >> 2) + 4 * hi; }
__device__ __forceinline__ unsigned cvtpk(float lo, float hi) { return pg8::cvt_pk_bf16(lo, hi); }
__device__ __forceinline__ bf16x8 tobf(f32x8 x) { u32x4 w = {cvtpk(x[0], x[1]), cvtpk(x[2], x[3]), cvtpk(x[4], x[5]), cvtpk(x[6], x[7])}; return *reinterpret_cast<bf16x8*>(&w); }
__device__ __forceinline__ bf16x8 tobf(bf16x8 x) { return x; }

__device__ __forceinline__ void apply_mask(f32x16& p0, f32x16& p1, u64 mk, int hi) {
    const unsigned lo = (unsigned)mk >> (4 * hi), hw = (unsigned)(mk >> 32) >> (4 * hi);
#pragma unroll
    for (int r = 0; r < 16; ++r) { const unsigned bit = 1u << ((r & 3) + 8 * (r >> 2)); p0[r] = (lo & bit) ? p0[r] : NEG; p1[r] = (hw & bit) ? p1[r] : NEG; }
}
__device__ __forceinline__ void partialSM(f32x16& p0, f32x16& p1, float& m_reg, float& mn, float& alpha) {
    constexpr float C = SCALE * 1.4426950408889634f;
    float pmax = p0[0];
#pragma unroll
    for (int r = 1; r < 16; ++r) pmax = fmaxf(pmax, p0[r]);
#pragma unroll
    for (int r = 0; r < 16; ++r) pmax = fmaxf(pmax, p1[r]);
    { auto rr = __builtin_amdgcn_permlane32_swap(__float_as_uint(pmax), __float_as_uint(pmax), false, false);
      pmax = fmaxf(__uint_as_float(rr[0]), __uint_as_float(rr[1])); }
    if (__builtin_expect(__all(pmax - m_reg <= THR / SCALE), 1)) { mn = m_reg; alpha = 1.f; }
    else { mn = fmaxf(m_reg, pmax); alpha = __builtin_amdgcn_exp2f((m_reg - mn) * C); m_reg = mn; }
    const float mnC = -mn * C;
#pragma unroll
    for (int r = 0; r < 16; ++r) p0[r] = fmaf(p0[r], C, mnC);
#pragma unroll
    for (int r = 0; r < 16; ++r) p1[r] = fmaf(p1[r], C, mnC);
#pragma unroll
    for (int r = 0; r < 16; ++r) p0[r] = __builtin_amdgcn_exp2f(p0[r]);
}
__device__ __forceinline__ void finishSM(f32x16& p0, f32x16& p1, float alpha, float& l_reg, bf16x8& pa0, bf16x8& pa1, bf16x8& pa2, bf16x8& pa3) {
#pragma unroll
    for (int r = 0; r < 16; ++r) p1[r] = __builtin_amdgcn_exp2f(p1[r]);
    float ps = 0;
#pragma unroll
    for (int r = 0; r < 16; ++r) ps += p0[r];
#pragma unroll
    for (int r = 0; r < 16; ++r) ps += p1[r];
    { auto rr = __builtin_amdgcn_permlane32_swap(__float_as_uint(ps), __float_as_uint(ps), false, false);
      ps = __uint_as_float(rr[0]) + __uint_as_float(rr[1]); }
    l_reg = l_reg * alpha + ps;
#define ATT_PK4(P, BASE, OUT) do { unsigned a0 = cvtpk(P[BASE + 0], P[BASE + 1]), a1 = cvtpk(P[BASE + 2], P[BASE + 3]);   \
    unsigned b0 = cvtpk(P[BASE + 4], P[BASE + 5]), b1 = cvtpk(P[BASE + 6], P[BASE + 7]);                              \
    auto r0 = __builtin_amdgcn_permlane32_swap(a0, b0, false, false); auto r1 = __builtin_amdgcn_permlane32_swap(a1, b1, false, false); \
    u32x4 w = {r0[0], r1[0], r0[1], r1[1]}; OUT = *reinterpret_cast<bf16x8*>(&w); } while (0)
    ATT_PK4(p0, 0, pa0); ATT_PK4(p0, 8, pa1); ATT_PK4(p1, 0, pa2); ATT_PK4(p1, 8, pa3);
#undef ATT_PK4
}
__device__ __forceinline__ void qkt(f32x16& p0, f32x16& p1, const char* Ks, const bf16x8* qr, int r32, int hi) {
    p0 = f32x16{}; p1 = f32x16{};
#pragma unroll
    for (int d0 = 0; d0 < 8; ++d0) { const int cb = (d0 * 16 + hi * 8) * 2;
        const bf16x8 b0 = *reinterpret_cast<const bf16x8*>(Ks + ATT_KSWZ(r32, cb));
        const bf16x8 b1 = *reinterpret_cast<const bf16x8*>(Ks + ATT_KSWZ(32 + r32, cb));
        p0 = __builtin_amdgcn_mfma_f32_32x32x16_bf16(b0, qr[d0], p0, 0, 0, 0);
        p1 = __builtin_amdgcn_mfma_f32_32x32x16_bf16(b1, qr[d0], p1, 0, 0, 0); }
}
__device__ __forceinline__ int v_st(int k, int c) { const int kk = (k & ~0xC) | ((k & 4) << 1) | ((k & 8) >> 1); return ((kk >> 3) * 4 + (c >> 5)) * 512 + ((kk & 7) * 32 + (c & 31)) * 2; }
__device__ __forceinline__ int v_rd_base(int lane) { return ((lane & 3) << 3) | (((lane >> 2) & 3) << 6) | (((lane >> 4) & 1) << 5) | (((lane >> 5) & 1) << 8); }
constexpr int v_rd_off(int d0, int ks, int half) { return d0 * 512 + ks * 4096 + half * 2048; }
template <int OFF> __device__ __forceinline__ s16x4 tr_read(int vb) { s16x4 r; asm volatile("ds_read_b64_tr_b16 %0, %1 offset:%2" : "=&v"(r) : "v"(vb), "i"(OFF) : "memory"); return r; }
template <int D0> __device__ __forceinline__ void pv_one(f32x16& od, int vb, bf16x8 pa0, bf16x8 pa1, bf16x8 pa2, bf16x8 pa3) {
    const s16x4 l0 = tr_read<v_rd_off(D0, 0, 0)>(vb), h0 = tr_read<v_rd_off(D0, 0, 1)>(vb), l1 = tr_read<v_rd_off(D0, 1, 0)>(vb), h1 = tr_read<v_rd_off(D0, 1, 1)>(vb);
    const s16x4 l2 = tr_read<v_rd_off(D0, 2, 0)>(vb), h2 = tr_read<v_rd_off(D0, 2, 1)>(vb), l3 = tr_read<v_rd_off(D0, 3, 0)>(vb), h3 = tr_read<v_rd_off(D0, 3, 1)>(vb);
    asm volatile("s_waitcnt lgkmcnt(0)" ::: "memory"); ATT_SBAR();
#define ATT_PK(L, H) (bf16x8){L[0], L[1], L[2], L[3], H[0], H[1], H[2], H[3]}
    od = __builtin_amdgcn_mfma_f32_32x32x16_bf16(pa0, ATT_PK(l0, h0), od, 0, 0, 0);
    od = __builtin_amdgcn_mfma_f32_32x32x16_bf16(pa1, ATT_PK(l1, h1), od, 0, 0, 0);
    od = __builtin_amdgcn_mfma_f32_32x32x16_bf16(pa2, ATT_PK(l2, h2), od, 0, 0, 0);
    od = __builtin_amdgcn_mfma_f32_32x32x16_bf16(pa3, ATT_PK(l3, h3), od, 0, 0, 0);
#undef ATT_PK
}
__device__ __forceinline__ void pv_d0(f32x16* o, int vb, bf16x8 pa0, bf16x8 pa1, bf16x8 pa2, bf16x8 pa3) {
    pv_one<0>(o[0], vb, pa0, pa1, pa2, pa3); pv_one<1>(o[1], vb, pa0, pa1, pa2, pa3); pv_one<2>(o[2], vb, pa0, pa1, pa2, pa3); pv_one<3>(o[3], vb, pa0, pa1, pa2, pa3);
}

struct KvPrompt {
    using T = bf16x8; const bf16_t* K; const bf16_t* V;
    __device__ __forceinline__ T ldk(int key, int col) const { return *reinterpret_cast<const bf16x8*>(K + (size_t)key * 256 + col); }
    __device__ __forceinline__ T ldv(int key, int col) const { return *reinterpret_cast<const bf16x8*>(V + (size_t)key * 256 + col); }
};
struct KvSample {
    using T = f32x8; const float* ck; const float* cv; const float* kn; const float* vn; const int* pages  ; int n;
    __device__ __forceinline__ size_t roff(int key) const { return (((size_t)pages[key >> 7] * PAGE_SIZE + (key & 127)) * N_KV + n) * 128; }
    __device__ __forceinline__ T ldk(int key, int col) const { const float* p = key < PAST_LEN ? ck + roff(key) : kn + (size_t)min(key - PAST_LEN, DEC_SEQ - 1) * 256; return *reinterpret_cast<const f32x8*>(p + col); }
    __device__ __forceinline__ T ldv(int key, int col) const { const float* p = key < PAST_LEN ? cv + roff(key) : vn + (size_t)min(key - PAST_LEN, DEC_SEQ - 1) * 256; return *reinterpret_cast<const f32x8*>(p + col); }
};

template <class KV>
__device__ __forceinline__ void attn_unit(const KV kv, const bf16_t* __restrict__ Aq, const float* __restrict__ qnw, const u64* __restrict__ mask, bf16_t* __restrict__ Odsa, int tok0, int nq_valid, int hd0, int NT, char* lds) {
    int tid_l = threadIdx.x; asm volatile("" : "+v"(tid_l));
    const int tid = tid_l, wid = tid >> 6, lane = tid & 63, r32 = lane & 31, hi = lane >> 5;
    char* V_lds = lds; char* K_lds = lds + 2 * SHM_V;
    float* wsx = (float*)(lds + 2 * SHM_V + 2 * SHM_K) + wid * 64; float* li_l = wsx; float* al_l = wsx + 32;
    float m_reg = -1e30f, l_reg = 0; f32x16 o[4] = {}; bf16x8 qr[8];
    const int mytok = tok0 + 8 * wid + (r32 >> 2);
    { const bf16_t* Qw = Aq + (size_t)mytok * 1024 + (hd0 + (r32 & 3)) * 128 + hi * 8;
#pragma unroll
      for (int d0 = 0; d0 < 8; ++d0) qr[d0] = *reinterpret_cast<const bf16x8*>(Qw + d0 * 16);
      float ssq = 0.f;
#pragma unroll
      for (int d0 = 0; d0 < 8; ++d0) { const u32x4 w = *reinterpret_cast<const u32x4*>(&qr[d0]);
#pragma unroll
          for (int j = 0; j < 4; ++j) { const float lo = __uint_as_float(w[j] << 16), hh = __uint_as_float(w[j] & 0xffff0000u); ssq += lo * lo + hh * hh; } }
      ssq += __shfl_xor(ssq, 32);
      const float rn = rsqrtf(ssq * (1.0f / 128.0f) + NORM_EPS);
#pragma unroll
      for (int d0 = 0; d0 < 8; ++d0) { const u32x4 w = *reinterpret_cast<const u32x4*>(&qr[d0]); const float4 g0 = *(const float4*)(qnw + d0 * 16 + hi * 8), g1 = *(const float4*)(qnw + d0 * 16 + hi * 8 + 4);
          u32x4 o; o[0] = cvtpk(__uint_as_float(w[0] << 16) * rn * g0.x, __uint_as_float(w[0] & 0xffff0000u) * rn * g0.y); o[1] = cvtpk(__uint_as_float(w[1] << 16) * rn * g0.z, __uint_as_float(w[1] & 0xffff0000u) * rn * g0.w);
          o[2] = cvtpk(__uint_as_float(w[2] << 16) * rn * g1.x, __uint_as_float(w[2] & 0xffff0000u) * rn * g1.y); o[3] = cvtpk(__uint_as_float(w[3] << 16) * rn * g1.z, __uint_as_float(w[3] & 0xffff0000u) * rn * g1.w);
          qr[d0] = *reinterpret_cast<const bf16x8*>(&o); } }
    const u64* mrow = mask + (size_t)mytok * MASK_WORDS;
    const int sr = tid >> 4, sc = (tid & 15) * 8, vst0 = v_st(sr, sc), vst1 = v_st(32 + sr, sc);
    const int vbase = (int)(uintptr_t)(PG8_LAS char*)V_lds + v_rd_base(lane);
    typename KV::T vs0, vs1, ks0, ks1;
#define ATT_SLOAD(k0) do { vs0 = kv.ldv((k0) + sr, sc); vs1 = kv.ldv((k0) + 32 + sr, sc); ks0 = kv.ldk((k0) + sr, sc); ks1 = kv.ldk((k0) + 32 + sr, sc); } while (0)
#define ATT_SWRITE(b) do { *(bf16x8*)(V_lds + (b) * SHM_V + vst0) = tobf(vs0); *(bf16x8*)(V_lds + (b) * SHM_V + vst1) = tobf(vs1); const int kc = sc * 2; \
    *(bf16x8*)(K_lds + (b) * SHM_K + ATT_KSWZ(sr, kc)) = tobf(ks0); *(bf16x8*)(K_lds + (b) * SHM_K + ATT_KSWZ(32 + sr, kc)) = tobf(ks1); } while (0)
    __syncthreads();
    ATT_SLOAD(0); ATT_SWRITE(0); __syncthreads();
    for (int j = 0; j < NT; ++j) {
        const int b = j & 1;
        const u64 mk = mrow[j];
        if (j + 1 < NT) ATT_SLOAD((j + 1) * 64);
        f32x16 p0, p1; float mn, alpha; bf16x8 pa0, pa1, pa2, pa3;
        ATT_SBAR(); qkt(p0, p1, K_lds + b * SHM_K, qr, r32, hi); apply_mask(p0, p1, mk, hi);
        partialSM(p0, p1, m_reg, mn, alpha);
        if (__any(alpha < 1.f)) { if (hi == 0) al_l[r32] = alpha; asm volatile("s_waitcnt lgkmcnt(0)" ::: "memory");
#pragma unroll
            for (int d = 0; d < 4; ++d)
#pragma unroll
                for (int r = 0; r < 16; ++r) o[d][r] *= al_l[crow(r, hi)]; }
        finishSM(p0, p1, alpha, l_reg, pa0, pa1, pa2, pa3); ATT_SBAR();
        pv_d0(o, vbase + b * SHM_V, pa0, pa1, pa2, pa3);
        if (j + 1 < NT) ATT_SWRITE(b ^ 1);
        __syncthreads();
    }
    if (hi == 0) li_l[r32] = l_reg; asm volatile("s_waitcnt lgkmcnt(0)" ::: "memory");
#pragma unroll
    for (int r = 0; r < 16; ++r) { const int orow = crow(r, hi); const float rli = __builtin_amdgcn_rcpf(li_l[orow]);
        const int q = 8 * wid + (orow >> 2);
        if (q < nq_valid) { bf16_t* Ow = Odsa + (size_t)(tok0 + q) * 1024 + (hd0 + (orow & 3)) * 128 + r32;
#pragma unroll
            for (int d0 = 0; d0 < 4; ++d0) Ow[d0 * 32] = f2bf(o[d0][r] * rli); } }
#undef ATT_SLOAD
#undef ATT_SWRITE
}
}
namespace idx {
using bf16x8 = __attribute__((ext_vector_type(8))) short;
using f32x16 = __attribute__((ext_vector_type(16))) float;
using f32x8  = __attribute__((ext_vector_type(8))) float;
constexpr int NTILE = 65;
constexpr int WAVE_LDS = NTILE * 64 * 4;
__device__ __forceinline__ unsigned ord_of(float f) { const unsigned u = __float_as_uint(f); return (u & 0x80000000u) ? ~u : (u | 0x80000000u); }
__device__ __forceinline__ int half_sum(int v) {
#pragma unroll
    for (int o = 16; o >= 1; o >>= 1) v += __shfl_xor(v, o);
    return v;
}
template <bool SAMPLE> struct KeySrc {
    const bf16_t* ikb; const float* ck; int pgv;
    struct Raw { f32x8 f[SAMPLE ? 4 : 1]; bf16x8 h[SAMPLE ? 1 : 4]; };
    __device__ __forceinline__ void load(int t, int c, int hi, Raw& R) const {
        if constexpr (!SAMPLE) { const bf16_t* p = ikb + (size_t)(32 * t + c) * 64 + hi * 8;
#pragma unroll
            for (int s = 0; s < 4; ++s) R.h[s] = *reinterpret_cast<const bf16x8*>(p + 16 * s); }
        else { const int tc = t < 64 ? t : 63; const int page = __builtin_amdgcn_readlane(pgv, tc >> 2);
            const float* p = ck + ((size_t)page * PAGE_SIZE + ((32 * tc) & 127) + c) * 64 + hi * 8;
            if (t >= 64) {
                const bf16_t* q = ikb + (size_t)(c < DEC_SEQ ? c : DEC_SEQ - 1) * 64 + hi * 8;
#pragma unroll
                for (int s = 0; s < 4; ++s) { const att::u32x4 w = *reinterpret_cast<const att::u32x4*>(q + 16 * s);
#pragma unroll
                    for (int e = 0; e < 4; ++e) { R.f[s][2 * e] = __uint_as_float(w[e] << 16); R.f[s][2 * e + 1] = __uint_as_float(w[e] & 0xffff0000u); } } }
            else {
#pragma unroll
                for (int s = 0; s < 4; ++s) R.f[s] = *reinterpret_cast<const f32x8*>(p + 16 * s); } }
    }
    __device__ __forceinline__ void cvt(const Raw& R, bf16x8 (&B)[4]) const {
#pragma unroll
        for (int s = 0; s < 4; ++s) { if constexpr (SAMPLE) B[s] = att::tobf(R.f[s]); else B[s] = R.h[s]; }
    }
};
template <int A_> __device__ __forceinline__ float head_sum(const f32x16& acc, const float (&w)[8]) {
    float s = 0.f;
#pragma unroll
    for (int h = 0; h < 8; ++h) s = fmaf(w[h], fmaxf(acc[8 * A_ + h], 0.f), s);
    return s;
}
template <bool SAMPLE, int A_>
__device__ __forceinline__ void pass(const KeySrc<SAMPLE>& ks, const bf16x8 (&A)[4], const float* Iw, int tokbase, int pos0, int nvalid, int ntiles, unsigned* strip, unsigned* mask32, int lane) {
    const int c = lane & 31, hi = lane >> 5, myq = 2 * hi + A_, mypos = pos0 + myq; const bool qvalid = myq < nvalid;
    float w[8];
    { const float* wp = Iw + (size_t)(tokbase + (qvalid ? myq : nvalid - 1)) * 8;
#pragma unroll
      for (int h = 0; h < 8; ++h) w[h] = wp[h]; }
    typename KeySrc<SAMPLE>::Raw R0, R1; bf16x8 B[4];
    ks.load(0, c, hi, R0); if (1 < ntiles) ks.load(1, c, hi, R1);
#define IDX_TILE(t_, R_) do { ks.cvt(R_, B); if ((t_) + 2 < ntiles) ks.load((t_) + 2, c, hi, R_); f32x16 acc = {}; \
        _Pragma("unroll") for (int s_ = 0; s_ < 4; ++s_) acc = __builtin_amdgcn_mfma_f32_32x32x16_bf16(A[s_], B[s_], acc, 0, 0, 0); \
        const float sc_ = head_sum<A_>(acc, w); strip[(t_) * 64 + lane] = (32 * (t_) + c <= mypos) ? ord_of(sc_) : 0u; } while (0)
    for (int t = 0; t < ntiles; t += 2) { IDX_TILE(t, R0); if (t + 1 < ntiles) IDX_TILE(t + 1, R1); }
#undef IDX_TILE
    unsigned x[NTILE];
#pragma unroll
    for (int t = 0; t < NTILE; ++t) x[t] = (t < ntiles) ? strip[t * 64 + lane] : 0u;
    unsigned tau = 0u; int r_ties = 0;
    if (__any(mypos + 1 > TOPK)) {
        for (int bit = 31; bit >= 0; --bit) { const unsigned cand = tau | (1u << bit); int cnt = 0;
#pragma unroll
            for (int t = 0; t < NTILE; ++t) cnt += (x[t] >= cand) ? 1 : 0;
            cnt = half_sum(cnt);
            if (cnt >= TOPK) tau = cand; }
        int cg = 0;
#pragma unroll
        for (int t = 0; t < NTILE; ++t) cg += (x[t] > tau) ? 1 : 0;
        cg = half_sum(cg);
        r_ties = TOPK - cg;
    }
    if (mypos + 1 <= TOPK) { tau = 0u; r_ties = 0; }
    int eq_before = 0; unsigned* mrow = mask32 + (size_t)(tokbase + myq) * (2 * MASK_WORDS);
#pragma unroll
    for (int t = 0; t < NTILE; ++t) {
        const bool eq = x[t] == tau, gt = x[t] > tau;
        const u64 eqm = __ballot(eq); const unsigned my_eqm = hi ? (unsigned)(eqm >> 32) : (unsigned)eqm;
        const int rank = eq_before + __popc(my_eqm & ((1u << c) - 1u));
        const bool sel = gt || (eq && rank < r_ties);
        eq_before += __popc(my_eqm);
        const u64 sm = __ballot(sel); const unsigned my_sm = hi ? (unsigned)(sm >> 32) : (unsigned)sm;
        if (c == 0 && qvalid) mrow[t] = my_sm;
    }
    if (c < 2 * MASK_WORDS - NTILE && qvalid) mrow[NTILE + c] = 0u;
}
template <bool SAMPLE>
__device__ __forceinline__ void wave_task(const KeySrc<SAMPLE>& ks, const bf16_t* Iq, const float* Iw, int tokbase, int pos0, int nvalid, unsigned* strip, unsigned* mask32, int lane) {
    const int c = lane & 31, hi = lane >> 5;
    const int aq_ = 2 * ((c >> 2) & 1) + (c >> 4), ah = 4 * ((c >> 3) & 1) + (c & 3);
    bf16x8 A[4];
    { const bf16_t* ap = Iq + (size_t)(tokbase + (aq_ < nvalid ? aq_ : nvalid - 1)) * 512 + ah * 64 + hi * 8;
#pragma unroll
      for (int s = 0; s < 4; ++s) A[s] = *reinterpret_cast<const bf16x8*>(ap + 16 * s); }
    const int pmax = pos0 + nvalid - 1; int ntiles = (pmax + 32) >> 5; if (ntiles > NTILE) ntiles = NTILE;
    pass<SAMPLE, 0>(ks, A, Iw, tokbase, pos0, nvalid, ntiles, strip, mask32, lane);
    pass<SAMPLE, 1>(ks, A, Iw, tokbase, pos0, nvalid, ntiles, strip, mask32, lane);
}
}
struct MegaArgs {
    PrepArgs prep;
    const float *cache_k, *cache_v, *cache_kidx, *state_ret; const int* page_table;
    const float *qnw, *knw, *ikw, *ikb;
    bf16_t *Rq, *Rk, *Rv, *G, *Aq, *Kb, *Vb, *Iq, *Ikb, *Gates, *OG, *An, *Odsa, *Mg, *A2, *Hid;
    float *Iw, *ssret, *rstd2, *Z, *M1, *M2, *H2, *Zf, *out;
    u64* mask; unsigned* bar;
};

namespace ret {
using bf16x8 = __attribute__((ext_vector_type(8))) short;
using s16x4  = __attribute__((ext_vector_type(4))) short;
using f32x4  = __attribute__((ext_vector_type(4))) float;
using u32x4  = __attribute__((ext_vector_type(4))) unsigned;
using u32x2  = __attribute__((ext_vector_type(2))) unsigned;
constexpr int QS = 528, VS = 144, PS = 80;
constexpr int OFF_Q = 0, OFF_K = OFF_Q + 32 * QS, OFF_V = OFF_K + 32 * QS, OFF_P = OFF_V + 32 * VS, OFF_ST = OFF_P + 32 * PS, OFF_SS = OFF_ST + 64 * QS, LDS_BYTES = OFF_SS + 32 * 4 * 4;
__device__ __forceinline__ s16x4 trr(int addr) { s16x4 r; asm volatile("ds_read_b64_tr_b16 %0, %1" : "=&v"(r) : "v"(addr) : "memory"); return r; }
__device__ __forceinline__ bf16x8 cat(s16x4 l, s16x4 h) { return (bf16x8){l[0], l[1], l[2], l[3], h[0], h[1], h[2], h[3]}; }
__device__ __forceinline__ u32x4 scale8(u32x4 v, float f) {
    u32x4 o;
#pragma unroll
    for (int i = 0; i < 4; ++i) o[i] = att::cvtpk(__uint_as_float(v[i] << 16) * f, __uint_as_float(v[i] & 0xffff0000u) * f);
    return o;
}
__device__ __forceinline__ void unit(const MegaArgs& a, int unit8, char* lds) {
    int tid_l = threadIdx.x; asm volatile("" : "+v"(tid_l));
    const int tid = tid_l, w = __builtin_amdgcn_readfirstlane(tid >> 6), lane = tid & 63, g = lane >> 4, c15 = lane & 15, q4 = c15 >> 2, p4 = c15 & 3;
    const int bh = unit8 >> 3, sl = unit8 & 7, b = bh >> 2, h = bh & 3;
    const int ldsb = (int)(uintptr_t)(PG8_LAS char*)lds;
    const float lg2 = log2f(1.0f - exp2f(-5.0f - (float)h));
    const int st_tok = tid >> 4, st_seg = tid & 15;
    const float fq = exp2f(lg2 * (float)(st_tok + 1)), fk = exp2f(-lg2 * (float)(st_tok + 1));
    f32x4 S[2][4];
#pragma unroll
    for (int i = 0; i < 2; ++i)
#pragma unroll
        for (int u = 0; u < 4; ++u) S[i][u] = (f32x4){0.f, 0.f, 0.f, 0.f};
    u32x4 rq0, rq1, rk0, rk1; u32x2 rv;
#define RET_LOAD(tok0_, len_) do { const bool ok_ = st_tok < (len_); const size_t r_ = (size_t)((tok0_) + (ok_ ? st_tok : 0)); \
        const u32x4* qp_ = (const u32x4*)(a.Rq + r_ * 1024 + h * 256 + st_seg * 16); const u32x4* kp_ = (const u32x4*)(a.Rk + r_ * 1024 + h * 256 + st_seg * 16); \
        rq0 = qp_[0]; rq1 = qp_[1]; rk0 = kp_[0]; rk1 = kp_[1]; rv = *(const u32x2*)(a.Rv + r_ * 2048 + h * 512 + sl * 64 + st_seg * 4); \
        if (!ok_) { rq0 = rq1 = rk0 = rk1 = (u32x4){0u, 0u, 0u, 0u}; rv = (u32x2){0u, 0u}; } } while (0)
    const int row0 = b * LP;
    RET_LOAD(row0, 16);
    __syncthreads();
    for (int c = 0; c < 65; ++c) {
        const int len = c == 0 ? 16 : 32, tok0 = c == 0 ? row0 : row0 + 16 + 32 * (c - 1);
        *(u32x4*)(lds + OFF_Q + st_tok * QS + st_seg * 32) = scale8(rq0, fq); *(u32x4*)(lds + OFF_Q + st_tok * QS + st_seg * 32 + 16) = scale8(rq1, fq);
        *(u32x4*)(lds + OFF_K + st_tok * QS + st_seg * 32) = scale8(rk0, fk); *(u32x4*)(lds + OFF_K + st_tok * QS + st_seg * 32 + 16) = scale8(rk1, fk);
        *(u32x2*)(lds + OFF_V + st_tok * VS + st_seg * 8) = rv;
#pragma unroll
        for (int i = 0; i < 2; ++i)
#pragma unroll
            for (int u = 0; u < 4; ++u) { u32x2 pk; pk.x = att::cvtpk(S[i][u][0], S[i][u][1]); pk.y = att::cvtpk(S[i][u][2], S[i][u][3]);
                *(u32x2*)(lds + OFF_ST + (16 * u + c15) * QS + (32 * w + 16 * i + 4 * g) * 2) = pk; }
        __syncthreads();
        if (c + 1 < 65) RET_LOAD(row0 + 16 + 32 * c, 32);
        if (w < 3) { const int jt = w >> 1, it = (w + 1) >> 1; f32x4 pacc = {0.f, 0.f, 0.f, 0.f};
#pragma unroll
            for (int s = 0; s < 8; ++s) { const bf16x8 A = *(const bf16x8*)(lds + OFF_K + (16 * jt + c15) * QS + (32 * s + 8 * g) * 2), B = *(const bf16x8*)(lds + OFF_Q + (16 * it + c15) * QS + (32 * s + 8 * g) * 2);
                pacc = __builtin_amdgcn_mfma_f32_16x16x32_bf16(A, B, pacc, 0, 0, 0); }
            const int ig = 16 * it + c15, jg0 = 16 * jt + 4 * g; float pv[4];
#pragma unroll
            for (int r = 0; r < 4; ++r) pv[r] = (jg0 + r <= ig) ? pacc[r] : 0.f;
            u32x2 pk; pk.x = att::cvtpk(pv[0], pv[1]); pk.y = att::cvtpk(pv[2], pv[3]);
            *(u32x2*)(lds + OFF_P + ig * PS + jg0 * 2) = pk; }
        else if (w == 3) { if (lane < 32) *(u32x4*)(lds + OFF_P + (lane >> 1) * PS + 32 + 16 * (lane & 1)) = (u32x4){0u, 0u, 0u, 0u}; }
        { s16x4 vl[4], vh[4], kl[2], kh[2];
#pragma unroll
          for (int u = 0; u < 4; ++u) { const int ad = ldsb + OFF_V + (8 * g + q4) * VS + (16 * u + 4 * p4) * 2; vl[u] = trr(ad); vh[u] = trr(ad + 4 * VS); }
#pragma unroll
          for (int i = 0; i < 2; ++i) { const int ad = ldsb + OFF_K + (8 * g + q4) * QS + (32 * w + 16 * i + 4 * p4) * 2; kl[i] = trr(ad); kh[i] = trr(ad + 4 * QS); }
          asm volatile("s_waitcnt lgkmcnt(0)" ::: "memory"); __builtin_amdgcn_sched_barrier(0);
          const float gl = exp2f(lg2 * (float)len);
#pragma unroll
          for (int i = 0; i < 2; ++i)
#pragma unroll
              for (int u = 0; u < 4; ++u) { S[i][u] = __builtin_amdgcn_mfma_f32_16x16x32_bf16(cat(kl[i], kh[i]), cat(vl[u], vh[u]), S[i][u], 0, 0, 0); S[i][u] *= gl; } }
        __syncthreads();
        { const int dt = w & 3, it = w >> 2; f32x4 o = {0.f, 0.f, 0.f, 0.f};
          { const int ad = ldsb + OFF_V + (8 * g + q4) * VS + (16 * dt + 4 * p4) * 2; const s16x4 lo = trr(ad), hi = trr(ad + 4 * VS);
            const bf16x8 Bp = *(const bf16x8*)(lds + OFF_P + (16 * it + c15) * PS + (8 * g) * 2);
            asm volatile("s_waitcnt lgkmcnt(0)" ::: "memory"); __builtin_amdgcn_sched_barrier(0);
            o = __builtin_amdgcn_mfma_f32_16x16x32_bf16(cat(lo, hi), Bp, o, 0, 0, 0); }
#pragma unroll
          for (int s = 0; s < 8; ++s) { const bf16x8 A = *(const bf16x8*)(lds + OFF_ST + (16 * dt + c15) * QS + (32 * s + 8 * g) * 2), B = *(const bf16x8*)(lds + OFF_Q + (16 * it + c15) * QS + (32 * s + 8 * g) * 2);
              o = __builtin_amdgcn_mfma_f32_16x16x32_bf16(A, B, o, 0, 0, 0); }
          const int i = 16 * it + c15; float ss = o[0] * o[0] + o[1] * o[1] + o[2] * o[2] + o[3] * o[3];
          ss += __shfl_xor(ss, 16); ss += __shfl_xor(ss, 32);
          if (g == 0) ((float*)(lds + OFF_SS))[i * 4 + dt] = ss;
          if (i < len) { const size_t ci = (size_t)(tok0 + i) * 2048 + h * 512 + sl * 64 + 16 * dt + 4 * g; const u32x2 gg = *(const u32x2*)(a.G + ci);
              u32x2 pk; pk.x = att::cvtpk(o[0] * __uint_as_float(gg.x << 16), o[1] * __uint_as_float(gg.x & 0xffff0000u)); pk.y = att::cvtpk(o[2] * __uint_as_float(gg.y << 16), o[3] * __uint_as_float(gg.y & 0xffff0000u));
              *(u32x2*)(a.OG + ci) = pk; } }
        __syncthreads();
        if (tid < len) { const float* sp = (const float*)(lds + OFF_SS) + tid * 4; a.ssret[(size_t)(tok0 + tid) * 32 + h * 8 + sl] = (sp[0] + sp[1]) + (sp[2] + sp[3]); }
    }
    float* so = a.out + (size_t)O_R_P + ((size_t)b * H_RET + h) * (DK_RET * DV_RET) + sl * 64;
#pragma unroll
    for (int i = 0; i < 2; ++i)
#pragma unroll
        for (int u = 0; u < 4; ++u)
#pragma unroll
            for (int r = 0; r < 4; ++r) so[(size_t)(32 * w + 16 * i + 4 * g + r) * DV_RET + 16 * u + c15] = S[i][u][r];
    __syncthreads();
#undef RET_LOAD
}
}
namespace epi {
using f32x4 = pg8::f32x4; using u32x4 = pg8::u32x4; typedef unsigned u32x2 __attribute__((ext_vector_type(2)));
__device__ __forceinline__ unsigned pk(float lo, float hi) { return pg8::cvt_pk_bf16(lo, hi); }
__device__ __forceinline__ u32x4 pack8(const f32x4& a, const f32x4& b) { u32x4 w; w.x = pk(a[0], a[1]); w.y = pk(a[2], a[3]); w.z = pk(b[0], b[1]); w.w = pk(b[2], b[3]); return w; }
__device__ __forceinline__ float bflo(unsigned w) { return __uint_as_float(w << 16); }
__device__ __forceinline__ float bfhi(unsigned w) { return __uint_as_float(w & 0xffff0000u); }
__device__ __forceinline__ f32x4 silu4(f32x4 x) { f32x4 o;
#pragma unroll
    for (int j = 0; j < 4; ++j) o[j] = x[j] * __builtin_amdgcn_rcpf(1.0f + __expf(-x[j])); return o; }
__device__ __forceinline__ f32x4 sigm4(f32x4 x) { f32x4 o;
#pragma unroll
    for (int j = 0; j < 4; ++j) o[j] = __builtin_amdgcn_rcpf(1.0f + __expf(-x[j])); return o; }

struct Epi1 {
    static constexpr bool PERM = true, AFTER_DRAIN = false;
    const float* rstd0; const float2* rope; const float *ikw, *ikb;
    bf16_t *Rq, *Rk, *Rv, *G, *Aq, *Vb, *Iq, *Ikb, *Gates; float* Iw; float* out; int gz0;
    template <int TY> __device__ __forceinline__ void run(const f32x4 (&acc)[2][2][4][2], int pm, int wr, int wc, int fr, int fq, bf16_t* dbase, int ld, float* fbase, float* fbase_s, float post, int isv) const {
        const int cl = wc * 32 + 8 * fq;
        float rsv[8];
#pragma unroll
        for (int i = 0; i < 8; ++i) { const int row = pm * 256 + (i >> 2) * 128 + wr * 64 + (i & 3) * 16 + fr; rsv[i] = rstd0[row < T_ALL ? row : T_ALL - 1]; }
#pragma unroll
        for (int ai = 0; ai < 2; ++ai)
#pragma unroll
            for (int m = 0; m < 4; ++m) {
                const int row = pm * 256 + ai * 128 + wr * 64 + m * 16 + fr; const bool ok = row < T_ALL; const int rowc = ok ? row : T_ALL - 1;
                const float rs = rsv[ai * 4 + m];
                f32x4 v[2][2];
#pragma unroll
                for (int bj = 0; bj < 2; ++bj)
#pragma unroll
                    for (int n = 0; n < 2; ++n) v[bj][n] = acc[ai][bj][m][n] * rs;
                if constexpr (TY == 0) {
                    bf16_t* dst = dbase + (size_t)rowc * 1024 + cl;
                    const float4* rp = (const float4*)(rope + (size_t)row_pos(rowc) * 128 + cl);
                    f32x4 o1[2], o2[2];
#pragma unroll
                    for (int n = 0; n < 2; ++n) { const float4 cs0 = rp[2 * n], cs1 = rp[2 * n + 1]; const float c[4] = {cs0.x, cs0.z, cs1.x, cs1.z}, s[4] = {cs0.y, cs0.w, cs1.y, cs1.w};
#pragma unroll
                        for (int j = 0; j < 4; ++j) { o1[n][j] = (v[0][n][j] * c[j] - v[1][n][j] * s[j]) * post; o2[n][j] = (v[0][n][j] * s[j] + v[1][n][j] * c[j]) * post; } }
                    if (ok) { *(u32x4*)dst = pack8(o1[0], o1[1]); *(u32x4*)(dst + 128) = pack8(o2[0], o2[1]); }
                } else if constexpr (TY == 1 || TY == 2 || TY == 3) {
                    bf16_t* dst = dbase + (size_t)rowc * ld + cl;
                    if constexpr (TY == 2) { v[0][0] = silu4(v[0][0]); v[0][1] = silu4(v[0][1]); v[1][0] = silu4(v[1][0]); v[1][1] = silu4(v[1][1]); }
                    if constexpr (TY == 3) { v[0][0] = sigm4(v[0][0]); v[0][1] = sigm4(v[0][1]); v[1][0] = sigm4(v[1][0]); v[1][1] = sigm4(v[1][1]); }
                    if (ok) { *(u32x4*)dst = pack8(v[0][0], v[0][1]); *(u32x4*)(dst + 128) = pack8(v[1][0], v[1][1]); }
                } else if constexpr (TY == 4) {
                    float* dst = (rowc < T_PROMPT ? fbase + (size_t)rowc * 256 : fbase_s + (size_t)(rowc - T_PROMPT) * 256) + cl;
                    if (ok) { *(f32x4*)dst = v[0][0]; *(f32x4*)(dst + 4) = v[0][1]; *(f32x4*)(dst + 128) = v[1][0]; *(f32x4*)(dst + 132) = v[1][1];
                        if (isv) { bf16_t* vb = Vb + (size_t)rowc * 256 + cl; *(u32x4*)vb = pack8(v[0][0], v[0][1]); *(u32x4*)(vb + 128) = pack8(v[1][0], v[1][1]); } }
                } else {
                    if (wc == 0) {
                        float s = 0.f;
#pragma unroll
                        for (int bj = 0; bj < 2; ++bj)
#pragma unroll
                            for (int n = 0; n < 2; ++n) s += (v[bj][n][0] + v[bj][n][1]) + (v[bj][n][2] + v[bj][n][3]);
                        s += __shfl_xor(s, 16); s += __shfl_xor(s, 32);
                        const float mu = s * (1.0f / 64.0f); float q = 0.f;
#pragma unroll
                        for (int bj = 0; bj < 2; ++bj)
#pragma unroll
                            for (int n = 0; n < 2; ++n) { const f32x4 d = v[bj][n] - mu; q += (d[0] * d[0] + d[1] * d[1]) + (d[2] * d[2] + d[3] * d[3]); }
                        q += __shfl_xor(q, 16); q += __shfl_xor(q, 32);
                        const float rn = rsqrtf(q * (1.0f / 64.0f) + NORM_EPS);
                        float* ko = out + (rowc < T_PROMPT ? (size_t)O_KI_P + (size_t)rowc * 64 : (size_t)O_KI_S + (size_t)(rowc - T_PROMPT) * 64);
#pragma unroll
                        for (int bj = 0; bj < 2; ++bj) { const int e0 = 32 * bj + 8 * fq; f32x4 y[2];
#pragma unroll
                            for (int n = 0; n < 2; ++n) { const f32x4 wv = *(const f32x4*)(ikw + e0 + 4 * n), bv = *(const f32x4*)(ikb + e0 + 4 * n); y[n] = (v[bj][n] - mu) * rn * wv + bv; }
                            if (ok) { *(f32x4*)(ko + e0) = y[0]; *(f32x4*)(ko + e0 + 4) = y[1]; *(u32x4*)(Ikb + (size_t)rowc * 64 + e0) = pack8(y[0], y[1]); } }
                    } else if (wc == 1 && fq == 0) {
                        if (ok) { *(f32x4*)(Iw + (size_t)rowc * 8) = v[0][0] * IDX_SCALE; *(f32x4*)(Iw + (size_t)rowc * 8 + 4) = v[0][1] * IDX_SCALE; }
                    }
                }
            }
    }
    __device__ __forceinline__ void operator()(const f32x4 (&acc)[2][2][4][2], const pg8::Unit& u, int wr, int wc, int fr, int fq) const {
        const int pn = u.pn + gz0, pm = u.pm;
        if (pn < 4)        run<0>(acc, pm, wr, wc, fr, fq, Rq + pn * 256, 1024, nullptr, nullptr, 1.0f, 0);
        else if (pn < 8)   run<0>(acc, pm, wr, wc, fr, fq, Rk + (pn - 4) * 256, 1024, nullptr, nullptr, 0.0625f, 0);
        else if (pn < 16)  run<1>(acc, pm, wr, wc, fr, fq, Rv + (pn - 8) * 256, 2048, nullptr, nullptr, 1.0f, 0);
        else if (pn < 24)  run<2>(acc, pm, wr, wc, fr, fq, G + (pn - 16) * 256, 2048, nullptr, nullptr, 1.0f, 0);
        else if (pn < 28)  run<1>(acc, pm, wr, wc, fr, fq, Aq + (pn - 24) * 256, 1024, nullptr, nullptr, 1.0f, 0);
        else if (pn == 28) run<4>(acc, pm, wr, wc, fr, fq, nullptr, 0, out + O_K_P, out + O_K_S, 1.0f, 0);
        else if (pn == 29) run<4>(acc, pm, wr, wc, fr, fq, nullptr, 0, out + O_V_P, out + O_V_S, 1.0f, 1);
        else if (pn < 32)  run<1>(acc, pm, wr, wc, fr, fq, Iq + (pn - 30) * 256, 512, nullptr, nullptr, 1.0f, 0);
        else if (pn == 32) run<5>(acc, pm, wr, wc, fr, fq, nullptr, 0, nullptr, nullptr, 1.0f, 0);
        else               run<3>(acc, pm, wr, wc, fr, fq, Gates + (pn - 33 + gz0) * 256, 2048, nullptr, nullptr, 1.0f, 0);
    }
};
struct EpiRet {
    static constexpr bool PERM = false, AFTER_DRAIN = false;
    float* M1;
    __device__ __forceinline__ void operator()(const f32x4 (&acc)[2][2][4][2], const pg8::Unit& u, int wr, int wc, int fr, int fq) const {
#pragma unroll
        for (int ai = 0; ai < 2; ++ai)
#pragma unroll
            for (int m = 0; m < 4; ++m) { const int row = u.pm * 256 + ai * 128 + wr * 64 + m * 16 + fr;
#pragma unroll
                for (int bj = 0; bj < 2; ++bj)
#pragma unroll
                    for (int n = 0; n < 2; ++n) *(f32x4*)(M1 + (size_t)row * 1024 + u.pn * 256 + bj * 128 + wc * 32 + 16 * n + 4 * fq) = acc[ai][bj][m][n]; }
    }
};
struct EpiDsa {
    static constexpr bool PERM = false, AFTER_DRAIN = false;
    const bf16_t* Gates; const float* M1; bf16_t* Mg;
    __device__ __forceinline__ void operator()(const f32x4 (&acc)[2][2][4][2], const pg8::Unit& u, int wr, int wc, int fr, int fq) const {
#pragma unroll
        for (int ai = 0; ai < 2; ++ai)
#pragma unroll
            for (int mp = 0; mp < 2; ++mp) {
                u32x2 gr[2][2][2], gd[2][2][2]; f32x4 mv[2][2][2];
#pragma unroll
                for (int mm = 0; mm < 2; ++mm) { const int row = u.pm * 256 + ai * 128 + wr * 64 + (2 * mp + mm) * 16 + fr;
#pragma unroll
                    for (int bj = 0; bj < 2; ++bj)
#pragma unroll
                        for (int n = 0; n < 2; ++n) { const int col = u.pn * 256 + bj * 128 + wc * 32 + 16 * n + 4 * fq;
                            gr[mm][bj][n] = *(const u32x2*)(Gates + (size_t)row * 2048 + col); gd[mm][bj][n] = *(const u32x2*)(Gates + (size_t)row * 2048 + 1024 + col); mv[mm][bj][n] = *(const f32x4*)(M1 + (size_t)row * 1024 + col); } }
#pragma unroll
                for (int mm = 0; mm < 2; ++mm) { const int m = 2 * mp + mm, row = u.pm * 256 + ai * 128 + wr * 64 + m * 16 + fr;
#pragma unroll
                    for (int bj = 0; bj < 2; ++bj)
#pragma unroll
                        for (int n = 0; n < 2; ++n) { const int col = u.pn * 256 + bj * 128 + wc * 32 + 16 * n + 4 * fq;
                            const f32x4 g1 = {bflo(gr[mm][bj][n].x), bfhi(gr[mm][bj][n].x), bflo(gr[mm][bj][n].y), bfhi(gr[mm][bj][n].y)}, g2 = {bflo(gd[mm][bj][n].x), bfhi(gd[mm][bj][n].x), bflo(gd[mm][bj][n].y), bfhi(gd[mm][bj][n].y)};
                            const f32x4 r = mv[mm][bj][n] * g1 + acc[ai][bj][m][n] * g2;
                            u32x2 w; w.x = pk(r[0], r[1]); w.y = pk(r[2], r[3]); *(u32x2*)(Mg + (size_t)row * 1024 + col) = w; } } }
    }
};
struct EpiOut {
    static constexpr bool PERM = false, AFTER_DRAIN = false;
    const float *xp, *xs, *meta; float* H2; bf16_t* A2; float* ss2;
    __device__ __forceinline__ void operator()(const f32x4 (&acc)[2][2][4][2], const pg8::Unit& u, int wr, int wc, int fr, int fq) const {
#pragma unroll
        for (int ai = 0; ai < 2; ++ai) {
            f32x4 hv[4][2][2];
#pragma unroll
            for (int m = 0; m < 4; ++m) { const int row = u.pm * 256 + ai * 128 + wr * 64 + m * 16 + fr; const float* h = h_row_ptr(row < T_ALL ? row : 0, xp, xs, meta);
#pragma unroll
                for (int bj = 0; bj < 2; ++bj)
#pragma unroll
                    for (int n = 0; n < 2; ++n) hv[m][bj][n] = *(const f32x4*)(h + u.pn * 256 + bj * 128 + wc * 32 + 16 * n + 4 * fq); }
#pragma unroll
            for (int m = 0; m < 4; ++m) { const int row = u.pm * 256 + ai * 128 + wr * 64 + m * 16 + fr; const bool ok = row < T_ALL; float ss = 0.f;
#pragma unroll
                for (int bj = 0; bj < 2; ++bj)
#pragma unroll
                    for (int n = 0; n < 2; ++n) { const int col = u.pn * 256 + bj * 128 + wc * 32 + 16 * n + 4 * fq; f32x4 r = acc[ai][bj][m][n]; if (ok) r += hv[m][bj][n];
                        *(f32x4*)(H2 + (size_t)row * 1024 + col) = r; u32x2 w; w.x = pk(r[0], r[1]); w.y = pk(r[2], r[3]); *(u32x2*)(A2 + (size_t)row * 1024 + col) = w;
                        ss += (r[0] * r[0] + r[1] * r[1]) + (r[2] * r[2] + r[3] * r[3]); }
                ss += __shfl_xor(ss, 16); ss += __shfl_xor(ss, 32);
                if (fq == 0) atomicAdd(ss2 + row, ss); } }
    }
};
struct EpiFfi {
    static constexpr bool PERM = true, AFTER_DRAIN = false;
    const float* ss2; bf16_t* Hid;
    __device__ __forceinline__ void operator()(const f32x4 (&acc)[2][2][4][2], const pg8::Unit& u, int wr, int wc, int fr, int fq) const {
        float sv[8];
#pragma unroll
        for (int i = 0; i < 8; ++i) sv[i] = ss2[u.pm * 256 + (i >> 2) * 128 + wr * 64 + (i & 3) * 16 + fr];
#pragma unroll
        for (int ai = 0; ai < 2; ++ai)
#pragma unroll
            for (int m = 0; m < 4; ++m) { const int row = u.pm * 256 + ai * 128 + wr * 64 + m * 16 + fr;
                const float rs = rsqrtf(sv[ai * 4 + m] * (1.0f / 1024.0f) + NORM_EPS);
                f32x4 hv[2];
#pragma unroll
                for (int n = 0; n < 2; ++n) hv[n] = silu4(acc[ai][0][m][n] * rs) * (acc[ai][1][m][n] * rs);
                *(u32x4*)(Hid + (size_t)row * D_FF + u.pn * 128 + wc * 32 + 8 * fq) = pack8(hv[0], hv[1]); }
    }
};
struct EpiFfo {
    static constexpr bool PERM = false, AFTER_DRAIN = false;
    const float* H2; float* out;
    __device__ __forceinline__ void operator()(const f32x4 (&acc)[2][2][4][2], const pg8::Unit& u, int wr, int wc, int fr, int fq) const {
#pragma unroll
        for (int ai = 0; ai < 2; ++ai) {
            f32x4 hv[4][2][2];
#pragma unroll
            for (int m = 0; m < 4; ++m) { const int row = u.pm * 256 + ai * 128 + wr * 64 + m * 16 + fr;
#pragma unroll
                for (int bj = 0; bj < 2; ++bj)
#pragma unroll
                    for (int n = 0; n < 2; ++n) hv[m][bj][n] = *(const f32x4*)(H2 + (size_t)row * 1024 + u.pn * 256 + bj * 128 + wc * 32 + 16 * n + 4 * fq); }
#pragma unroll
            for (int m = 0; m < 4; ++m) { const int row = u.pm * 256 + ai * 128 + wr * 64 + m * 16 + fr; float* dst = nullptr;
                if (row < T_PROMPT) { const int b = row / LP, l = row % LP; if (l >= N_META) dst = out + O_Y_P + ((size_t)b * SEQ + (l - N_META)) * 1024; }
                else if (row < T_ALL) dst = out + O_Y_S + (size_t)(row - T_PROMPT) * 1024;
                if (dst) {
#pragma unroll
                    for (int bj = 0; bj < 2; ++bj)
#pragma unroll
                        for (int n = 0; n < 2; ++n) *(f32x4*)(dst + u.pn * 256 + bj * 128 + wc * 32 + 16 * n + 4 * fq) = hv[m][bj][n] + acc[ai][bj][m][n]; } } }
    }
};
}
__device__ __forceinline__ void ret_sample_unit(const MegaArgs& a, int unit, float* lds) {
    float* qk = lds;
    int t_l = threadIdx.x; asm volatile("" : "+v"(t_l));
    const int t = t_l, w = t >> 6, db = unit >> 2, h = unit & 3, r0 = T_PROMPT + db * DEC_SEQ;
    __syncthreads();
    for (int e = t; e < 4096; e += 512) { const int which = e >> 11, i = (e >> 8) & 7, dk = e & 255;
        qk[dk * 16 + which * 8 + i] = bf2f((which ? a.Rk : a.Rq)[(size_t)(r0 + i) * 1024 + h * 256 + dk]); }
    float v[8], o[8];
#pragma unroll
    for (int i = 0; i < 8; ++i) { v[i] = bf2f(a.Rv[(size_t)(r0 + i) * 2048 + h * 512 + t]); o[i] = 0.f; }
    const float gamma = 1.0f - exp2f(-5.0f - (float)h);
    const size_t sb = ((size_t)db * H_RET + h) * (DK_RET * DV_RET) + t;
    const float* sin_ = a.state_ret + sb; float* sout = a.out + (size_t)O_R_S + sb;
    __syncthreads();
    for (int dk0 = 0; dk0 < 256; dk0 += 16) {
        float s[16];
#pragma unroll
        for (int j = 0; j < 16; ++j) s[j] = __builtin_nontemporal_load(sin_ + (size_t)(dk0 + j) * DV_RET);
#pragma unroll
        for (int j = 0; j < 16; ++j) { const float4* c = (const float4*)(qk + (dk0 + j) * 16); const float4 q0 = c[0], q1 = c[1], k0 = c[2], k1 = c[3];
            const float qq[8] = {q0.x, q0.y, q0.z, q0.w, q1.x, q1.y, q1.z, q1.w}, kk[8] = {k0.x, k0.y, k0.z, k0.w, k1.x, k1.y, k1.z, k1.w};
#pragma unroll
            for (int i = 0; i < 8; ++i) { s[j] = fmaf(s[j], gamma, kk[i] * v[i]); o[i] = fmaf(qq[i], s[j], o[i]); }
            __builtin_nontemporal_store(s[j], sout + (size_t)(dk0 + j) * DV_RET); }
    }
#pragma unroll
    for (int i = 0; i < 8; ++i) { float ss = o[i] * o[i];
#pragma unroll
        for (int of = 32; of >= 1; of >>= 1) ss += __shfl_xor(ss, of);
        const size_t ci = (size_t)(r0 + i) * 2048 + h * 512 + t;
        a.OG[ci] = f2bf(o[i] * bf2f(a.G[ci]));
        if ((t & 63) == 0) a.ssret[(size_t)(r0 + i) * 32 + h * 8 + w] = ss; }
}

__device__ __forceinline__ void make_an_row(const MegaArgs& a, int r, int lane) {
    for (int c = lane; c < 2048; c += 64) { const int h = c >> 9; float ss = 0.f;
#pragma unroll
        for (int s = 0; s < 8; ++s) ss += a.ssret[(size_t)r * 32 + h * 8 + s];
        a.An[(size_t)r * 2048 + c] = f2bf(bf2f(a.OG[(size_t)r * 2048 + c]) * rsqrtf(ss * (1.0f / 512.0f) + NORM_EPS)); }
}
__device__ __forceinline__ void knorm_row(const MegaArgs& a, int r, int lane) {
    float* kp = a.out + (r < T_PROMPT ? (size_t)O_K_P + (size_t)r * 256 : (size_t)O_K_S + (size_t)(r - T_PROMPT) * 256) + lane * 4;
    const float4 x = *(const float4*)kp; float ss = x.x * x.x + x.y * x.y + x.z * x.z + x.w * x.w;
#pragma unroll
    for (int o = 16; o >= 1; o >>= 1) ss += __shfl_xor(ss, o);
    const float rn = rsqrtf(ss * (1.0f / 128.0f) + NORM_EPS); const float4 w = *(const float4*)(a.knw + (lane & 31) * 4);
    const float4 y = make_float4(x.x * rn * w.x, x.y * rn * w.y, x.z * rn * w.z, x.w * rn * w.w);
    *(float4*)kp = y;
    uint2 o; o.x = (unsigned)f2bf(y.x) | ((unsigned)f2bf(y.y) << 16); o.y = (unsigned)f2bf(y.z) | ((unsigned)f2bf(y.w) << 16);
    *(uint2*)(a.Kb + (size_t)r * 256 + lane * 4) = o;
}
#define IDX_N_SAMPLE_TASKS (DEC_BATCH * 2)
#define IDX_N_PROMPT_TASKS (BATCH * (LP / 4))
#define IDX_N_TASKS (IDX_N_SAMPLE_TASKS + IDX_N_PROMPT_TASKS)
__device__ __forceinline__ void idx_task(const MegaArgs& a, int k, unsigned char* shm, int wave, int lane) {
    unsigned* strip = (unsigned*)(shm + (size_t)wave * idx::WAVE_LDS); unsigned* mask32 = (unsigned*)a.mask;
    if (k < IDX_N_SAMPLE_TASKS) {
        const int db = k >> 1, q0 = 4 * (k & 1);
        const int pgv = a.page_table[db * N_PAGES + (lane & 15)];
        idx::KeySrc<true> ks{a.Ikb + (size_t)(T_PROMPT + db * DEC_SEQ) * 64, a.cache_kidx, pgv};
        idx::wave_task<true>(ks, a.Iq, a.Iw, T_PROMPT + db * DEC_SEQ + q0, PAST_LEN + q0, 4, strip, mask32, lane);
    } else {
        const int pk = k - IDX_N_SAMPLE_TASKS, b = pk & 7, l0 = 4 * (LP / 4 - 1 - (pk >> 3));
        idx::KeySrc<false> ks{a.Ikb + (size_t)b * LP * 64, nullptr, 0};
        idx::wave_task<false>(ks, a.Iq, a.Iw, b * LP + l0, l0, 4, strip, mask32, lane);
    }
}
#define ATT_N_PROMPT_UNITS (BATCH * N_KV * 33)
__device__ __forceinline__ void attn_prompt_unit(const MegaArgs& a, int idx, char* lds) {
    const int qb = 32 - idx / 16, bn = idx % 16, b = bn >> 1, n = bn & 1;
    const int tok0 = b * LP + 64 * qb, nq = (LP - 64 * qb) < 64 ? (LP - 64 * qb) : 64;
    const int NT = qb + 1;
    att::KvPrompt kv{a.Kb + (size_t)b * LP * 256 + n * 128, a.Vb + (size_t)b * LP * 256 + n * 128};
    att::attn_unit<att::KvPrompt>(kv, a.Aq, a.qnw, a.mask, a.Odsa, tok0, nq, 4 * n, NT, lds);
}
__device__ __forceinline__ void attn_sample_unit(const MegaArgs& a, int u, char* lds) {
    const int db = u >> 1, n = u & 1;
    int* pages = (int*)(lds + 2 * att::SHM_V + 2 * att::SHM_K + 2048);
    __syncthreads();
    if (threadIdx.x < N_PAGES) pages[threadIdx.x] = a.page_table[db * N_PAGES + threadIdx.x];
    __syncthreads();
    att::KvSample kv{a.cache_k, a.cache_v, a.out + O_K_S + (size_t)db * DEC_SEQ * 256 + n * 128, a.out + O_V_S + (size_t)db * DEC_SEQ * 256 + n * 128, pages, n};
    att::attn_unit<att::KvSample>(kv, a.Aq, a.qnw, a.mask, a.Odsa, T_PROMPT + db * DEC_SEQ, DEC_SEQ, 4 * n, 33, lds);
}

#define LDS_TOTAL (8 * idx::WAVE_LDS + 2048)
__global__ void __launch_bounds__(512, 2) mega(MegaArgs a) {
    extern __shared__ __attribute__((aligned(16))) unsigned char shm[];
    float* lds = (float*)shm;
    volatile LAS unsigned* xbw = (volatile LAS unsigned*)(PG8_LAS unsigned char*)(shm + LDS_TOTAL - 16);
    const int tid = threadIdx.x, wave = tid >> 6, lane = tid & 63, half = tid >> 8, G = gridDim.x, bid = blockIdx.x;
    if (tid == 0) { xbw[0] = 0u; xbw[1] = 0u; xbw[2] = 0u; xbw[3] = 0u; }
    __syncthreads();
    XcdBarrier bar = xcd_barrier_post(a.bar, xbw);
    for (int jp = bid; jp < PREP_J_ROWS / 2; jp += G) prep_job(a.prep, 2 * jp + half, lds + half * (32 * 65));
    for (int j = PREP_J_ROWS + bid * 2 + half; j < PREP_N_JOBS; j += 2 * G) prep_job(a.prep, j, lds);
    for (int i = bid * 512 + tid; i < T_PAD; i += G * 512) a.rstd2[i] = 0.f;
    xcd_barrier(bar);
    { pg8::StaticOrder S; S.init(T_PAD, N1, G, bid);
      epi::Epi1 E{a.prep.rstd0, a.prep.rope, a.ikw, a.ikb, a.Rq, a.Rk, a.Rv, a.G, a.Aq, a.Vb, a.Iq, a.Ikb, a.Gates, a.Iw, a.out, 0};
      pg8::gemm_phase<epi::Epi1, pg8::StaticOrder, false>((PG8_LAS unsigned char*)shm, pg8::Gemm{a.prep.A0, a.prep.W1t, T_PAD, N1, 1024}, S, E, nullptr); }
    xcd_barrier(bar);
    for (int u = bid; u < BATCH * H_RET * 8; u += G) ret::unit(a, u, (char*)shm);
    for (int u = bid; u < DEC_BATCH * H_RET; u += G) ret_sample_unit(a, u, lds);
    { int tl = threadIdx.x; asm volatile("" : "+v"(tl)); const int wv = __builtin_amdgcn_readfirstlane(tl >> 6), ln = tl & 63, NW = 8 * G, g = wv * G + bid;
      for (int i = 0; i * NW < IDX_N_TASKS; ++i) { const int p = i * NW + ((i & 1) ? (NW - 1 - g) : g); if (p < IDX_N_TASKS) idx_task(a, p, shm, wv, ln); } }
    for (int r = bid * 8 + wave; r < T_ALL; r += 8 * G) knorm_row(a, r, lane);
    xcd_barrier(bar);
    for (int i = 0; ; ++i) { const long p = (long)i * G + ((i & 1) ? (G - 1 - bid) : bid); if (p >= ATT_N_PROMPT_UNITS) { if ((long)i * G >= ATT_N_PROMPT_UNITS) break; else continue; } attn_prompt_unit(a, (int)p, (char*)shm); }
    for (int u = bid; u < DEC_BATCH * N_KV; u += G) attn_sample_unit(a, u, (char*)shm);
    for (int r = bid * 8 + wave; r < T_ALL; r += 8 * G) make_an_row(a, r, lane);
    xcd_barrier(bar);
    { pg8::StaticOrder S; S.init(T_PAD, 1024, G, bid); pg8::gemm_phase<epi::EpiRet, pg8::StaticOrder, false>((PG8_LAS unsigned char*)shm, pg8::Gemm{a.An, a.prep.Wret, T_PAD, 1024, 2048}, S, epi::EpiRet{a.M1}, nullptr); }
    { pg8::StaticOrder S; S.init(T_PAD, 1024, G, bid); pg8::gemm_phase<epi::EpiDsa, pg8::StaticOrder, false>((PG8_LAS unsigned char*)shm, pg8::Gemm{a.Odsa, a.prep.Wdsa, T_PAD, 1024, 1024}, S, epi::EpiDsa{a.Gates, a.M1, a.Mg}, nullptr); }
    xcd_barrier(bar);
    { pg8::StaticOrder S; S.init(T_PAD, 1024, G, bid); pg8::gemm_phase<epi::EpiOut, pg8::StaticOrder, false>((PG8_LAS unsigned char*)shm, pg8::Gemm{a.Mg, a.prep.Wout, T_PAD, 1024, 1024}, S, epi::EpiOut{a.prep.x_prompt, a.prep.x_sample, a.prep.meta, a.H2, a.A2, a.rstd2}, nullptr); }
    xcd_barrier(bar);
    { pg8::StaticOrder S; S.init(T_PAD, NFF2, G, bid); pg8::gemm_phase<epi::EpiFfi, pg8::StaticOrder, false>((PG8_LAS unsigned char*)shm, pg8::Gemm{a.A2, a.prep.Wffi, T_PAD, NFF2, 1024}, S, epi::EpiFfi{a.rstd2, a.Hid}, nullptr); }
    xcd_barrier(bar);
    { pg8::StaticOrder S; S.init(T_PAD, 1024, G, bid); pg8::gemm_phase<epi::EpiFfo, pg8::StaticOrder, false>((PG8_LAS unsigned char*)shm, pg8::Gemm{a.Hid, a.prep.Wffo, T_PAD, 1024, 2816}, S, epi::EpiFfo{a.H2, a.out}, nullptr); }
}
extern "C" void kernel_launch(void* const* d_in, const int* in_sizes, int n_in, void* d_out, int out_size, void* d_ws, size_t ws_size, hipStream_t stream) {
    static int grid = 0;
    if (grid == 0) {
        if (n_in != 20 || out_size != OUT_TOTAL || ws_size < WS_END_B1 || ws_size < WS_END_B2) { fprintf(stderr, "kernel_launch: unexpected shapes (n_in %d out %d ws %zu need %llu)\n", n_in, out_size, ws_size, (unsigned long long)WS_END_B1); grid = -1; return; }
        int dev = 0, cus = 0, per_cu = 0;
        if (hipGetDevice(&dev) != hipSuccess || hipDeviceGetAttribute(&cus, hipDeviceAttributeMultiprocessorCount, dev) != hipSuccess) { grid = -1; return; }
        if (hipFuncSetAttribute((const void*)mega, hipFuncAttributeMaxDynamicSharedMemorySize, LDS_TOTAL) != hipSuccess) { fprintf(stderr, "kernel_launch: hipFuncSetAttribute failed\n"); grid = -1; return; }
        if (hipOccupancyMaxActiveBlocksPerMultiprocessor(&per_cu, (const void*)mega, 512, LDS_TOTAL) != hipSuccess || per_cu < 1) { fprintf(stderr, "kernel_launch: occupancy query says %d blocks per CU\n", per_cu); grid = -1; return; }
        grid = cus;
    }
    if (grid < 0) return;
    char* ws = (char*)d_ws;
    MegaArgs a{};
    a.prep.x_prompt = (const float*)d_in[0]; a.prep.x_sample = (const float*)d_in[1]; a.prep.meta = (const float*)d_in[7]; a.prep.norm_mix_w = (const float*)d_in[8]; a.prep.w_in = (const float*)d_in[9];
    a.prep.w_ret = (const float*)d_in[10]; a.prep.w_dsa = (const float*)d_in[15]; a.prep.w_out = (const float*)d_in[16]; a.prep.norm_ffn_w = (const float*)d_in[17]; a.prep.w_ffi = (const float*)d_in[18]; a.prep.w_ffo = (const float*)d_in[19];
    a.prep.W1t = (bf16_t*)(ws + WS_W1T); a.prep.Wret = (bf16_t*)(ws + WS_WRET); a.prep.Wdsa = (bf16_t*)(ws + WS_WDSA); a.prep.Wout = (bf16_t*)(ws + WS_WOUT); a.prep.Wffi = (bf16_t*)(ws + WS_WFFI); a.prep.Wffo = (bf16_t*)(ws + WS_WFFO);
    a.prep.A0 = (bf16_t*)(ws + WS_A0); a.prep.rstd0 = (float*)(ws + WS_RSTD0); a.prep.rope = (float2*)(ws + WS_ROPE);
    a.cache_k = (const float*)d_in[2]; a.cache_v = (const float*)d_in[3]; a.cache_kidx = (const float*)d_in[4]; a.state_ret = (const float*)d_in[5]; a.page_table = (const int*)d_in[6];
    a.qnw = (const float*)d_in[11]; a.knw = (const float*)d_in[12]; a.ikw = (const float*)d_in[13]; a.ikb = (const float*)d_in[14];
    a.Rq = (bf16_t*)(ws + WS_RQ); a.Rk = (bf16_t*)(ws + WS_RK); a.Rv = (bf16_t*)(ws + WS_RV); a.G = (bf16_t*)(ws + WS_G); a.Aq = (bf16_t*)(ws + WS_AQ); a.Kb = (bf16_t*)(ws + WS_KB); a.Vb = (bf16_t*)(ws + WS_VB);
    a.Iq = (bf16_t*)(ws + WS_IQ); a.Ikb = (bf16_t*)(ws + WS_IKB); a.Gates = (bf16_t*)(ws + WS_GATES); a.OG = (bf16_t*)(ws + WS_OG); a.An = (bf16_t*)(ws + WS_AN); a.Odsa = (bf16_t*)(ws + WS_ODSA); a.Mg = (bf16_t*)(ws + WS_MG);
    a.A2 = (bf16_t*)(ws + WS_A2); a.Hid = (bf16_t*)(ws + WS_HID);
    a.Iw = (float*)(ws + WS_IW); a.ssret = (float*)(ws + WS_SSRET); a.rstd2 = (float*)(ws + WS_RSTD2); a.Z = (float*)(ws + WS_Z); a.M1 = (float*)(ws + WS_M1); a.M2 = (float*)(ws + WS_M2); a.H2 = (float*)(ws + WS_H2); a.Zf = (float*)(ws + WS_ZF);
    a.out = (float*)d_out; a.mask = (u64*)(ws + WS_MASK); a.bar = (unsigned*)(ws + WS_CTL);
    if (hipMemsetAsync(ws + WS_CTL, 0, 65536, stream) != hipSuccess) return;
    hipLaunchKernelGGL(mega, dim3(grid), dim3(512), LDS_TOTAL, stream, a);
}
```

```cpp
#include <hip/hip_runtime.h>
#include <stdint.h>
#include <stdio.h>

#define D_MODEL 1024
#define BATCH 8
#define SEQ 2048
#define N_META 16
#define LP (N_META + SEQ)
#define DEC_BATCH 128
#define DEC_SEQ 8
#define PAST_LEN 2048
#define PAGE_SIZE 128
#define N_PAGES 16
#define H_RET 4
#define DK_RET 256
#define DV_RET 512
#define N_HEADS 8
#define N_KV 2
#define D_HEAD 128
#define N_IDXH 8
#define D_IDX 64
#define TOPK 256
#define D_FF 2816
#define IN_COLS 10312
#define NORM_EPS 1e-6f
#define IDX_SCALE 0.04419417382415922f
#define T_PROMPT (BATCH * LP)
#define T_SAMPLE (DEC_BATCH * DEC_SEQ)
#define T_ALL (T_PROMPT + T_SAMPLE)
#define T_PAD 17664
#define N1 10496
#define NFF2 5632
#define MASK_WORDS 34
#define SAMPLE_L (PAST_LEN + DEC_SEQ)

#define O_Y_P   0
#define O_Y_S   16777216
#define O_K_P   17825792
#define O_V_P   22052864
#define O_KI_P  26279936
#define O_R_P   27336704
#define O_K_S   31531008
#define O_V_S   31793152
#define O_KI_S  32055296
#define O_R_S   32120832
#define OUT_TOTAL 99229696

typedef unsigned short bf16_t;
typedef unsigned long long u64;

__device__ __forceinline__ bf16_t f2bf(float f) { unsigned u = __float_as_uint(f); u += 0x7FFFu + ((u >> 16) & 1u); return (bf16_t)(u >> 16); }
__device__ __forceinline__ float bf2f(bf16_t b) { return __uint_as_float(((unsigned)b) << 16); }
__device__ __forceinline__ float silu_f(float x) { return x / (1.0f + __expf(-x)); }
__device__ __forceinline__ float sigmoid_f(float x) { return 1.0f / (1.0f + __expf(-x)); }

__device__ __forceinline__ int row_pos(int r) { return r < T_PROMPT ? (r % LP) : (PAST_LEN + ((r - T_PROMPT) & (DEC_SEQ - 1))); }

#define WS_CTL      0ull
#define WS_W1T      (WS_CTL + 65536ull)
#define WS_WRET     (WS_W1T + (u64)N1 * 1024 * 2)
#define WS_WDSA     (WS_WRET + 1024ull * 2048 * 2)
#define WS_WOUT     (WS_WDSA + 1024ull * 1024 * 2)
#define WS_WFFI     (WS_WOUT + 1024ull * 1024 * 2)
#define WS_WFFO     (WS_WFFI + (u64)NFF2 * 1024 * 2)
#define WS_ROPE     (WS_WFFO + 1024ull * 2816 * 2)
#define WS_RSTD0    (WS_ROPE + (u64)LP * 128 * 8)
#define WS_A0       (WS_RSTD0 + (u64)T_PAD * 4)
#define WS_RQ       (WS_A0 + (u64)T_PAD * 1024 * 2)
#define WS_RK       (WS_RQ + (u64)T_PAD * 1024 * 2)
#define WS_RV       (WS_RK + (u64)T_PAD * 1024 * 2)
#define WS_G        (WS_RV + (u64)T_PAD * 2048 * 2)
#define WS_AQ       (WS_G + (u64)T_PAD * 2048 * 2)
#define WS_KB       (WS_AQ + (u64)T_PAD * 1024 * 2)
#define WS_VB       (WS_KB + (u64)T_PAD * 256 * 2)
#define WS_IQ       (WS_VB + (u64)T_PAD * 256 * 2)
#define WS_IKB      (WS_IQ + (u64)T_PAD * 512 * 2)
#define WS_IW       (WS_IKB + (u64)T_PAD * 64 * 2)
#define WS_GATES    (WS_IW + (u64)T_PAD * 8 * 4)
#define WS_MASK     (WS_GATES + (u64)T_PAD * 2048 * 2)
#define WS_SSRET    (WS_MASK + (u64)T_PAD * MASK_WORDS * 8)
#define WS_RSTD2    (WS_SSRET + (u64)T_PAD * 32 * 4)
#define WS_REGION_B (((WS_RSTD2 + (u64)T_PAD * 16 * 4) + 4095ull) & ~4095ull)
#define WS_Z        WS_REGION_B
#define WS_H2       WS_REGION_B
#define WS_A2       (WS_H2 + (u64)T_PAD * 1024 * 4)
#define WS_HID      (WS_A2 + (u64)T_PAD * 1024 * 2)
#define WS_MG       (WS_HID + (u64)T_PAD * 2816 * 2)
#define WS_OG       (WS_MG + (u64)T_PAD * 1024 * 2)
#define WS_AN       (WS_OG + (u64)T_PAD * 2048 * 2)
#define WS_ODSA     (WS_AN + (u64)T_PAD * 2048 * 2)
#define WS_M1       (WS_ODSA + (u64)T_PAD * 1024 * 2)
#define WS_M2       (WS_M1 + (u64)T_PAD * 1024 * 4)
#define WS_ZF       WS_OG
#define WS_END_B1   (WS_Z + (u64)T_PAD * N1 * 4)
#define WS_END_B2   (WS_ZF + (u64)T_PAD * NFF2 * 4)
namespace pg8 {
#define PG8_LAS __attribute__((address_space(3)))
typedef unsigned short bf16_t;
typedef short bf16x8 __attribute__((ext_vector_type(8)));
typedef float f32x4 __attribute__((ext_vector_type(4)));
typedef unsigned u32x4 __attribute__((ext_vector_type(4)));
constexpr int BM = 256, BK = 64, HALF = 128, HTB = HALF * BK * 2  , STAGE_BYTES = 8 * HTB, NXCD = 8, WGM = 8;

__host__ __device__ __forceinline__ int lds_byte(int r, int c) { const int st = (r >> 4) * 2 + (c >> 5), rr = r & 15, cc = c & 31, ob = rr * 64 + cc * 2; return st * 1024 + (ob ^ (((ob >> 9) & 1) << 5)); }
__host__ __device__ __forceinline__ void stage_rc(int b, int& R, int& C) { const int st = b / 1024, sb = b % 1024, swz = sb ^ (((sb >> 9) & 1) << 5); R = (st >> 1) * 16 + swz / 64; C = (st & 1) * 32 + (swz % 64) / 2; }
__host__ __device__ __forceinline__ int perm32(int rho) { const int n = rho >> 4, i = rho & 15; return 8 * (i >> 2) + 4 * n + (i & 3); }

struct Unit { int pm, pn; };
struct Gemm { const bf16_t* A; const bf16_t* Bt; int M, N, K; };

struct StaticOrder {
    int nM, nN, nwg, G, c;
    __host__ __device__ void init(int M, int N, int G_, int c_) { nM = M / BM; nN = N / BM; nwg = nM * nN; G = G_; c = c_; }
    __host__ __device__ bool next(int i, Unit& u) const {
        const long L = (long)i * G + c; if (L >= nwg) return false;
        int wgid = (int)L; { const int q = nwg / NXCD, r = nwg % NXCD, xcd = wgid % NXCD, off = wgid / NXCD; wgid = (xcd < r ? xcd * (q + 1) : r * (q + 1) + (xcd - r) * q) + off; }
        const int nig = WGM * nN, gid = wgid / nig, fm = gid * WGM, gsz = (nM - fm) < WGM ? (nM - fm) : WGM;
        u.pm = fm + ((wgid % nig) % gsz); u.pn = (wgid % nig) / gsz; return true;
    }
    __device__ __forceinline__ void a_ready(const Unit&) const {}
    __device__ __forceinline__ void done(const Unit&) const {}
};
struct CountedOrder : StaticOrder {
    const unsigned* ready; unsigned need; unsigned* tmo;
    __device__ __forceinline__ void a_ready(const Unit& u) const {
        if (threadIdx.x < 64) {
            const unsigned long long t0 = __builtin_amdgcn_s_memrealtime(); unsigned polls = 0;
            while ((unsigned)__builtin_amdgcn_readfirstlane(__hip_atomic_load(ready + 64 * u.pm, __ATOMIC_RELAXED, __HIP_MEMORY_SCOPE_AGENT)) < need) {
                if ((++polls & 255u) == 0u && __builtin_amdgcn_readfirstlane(__hip_atomic_load(tmo, __ATOMIC_RELAXED, __HIP_MEMORY_SCOPE_AGENT)) != 0u) break;
                if (__builtin_amdgcn_s_memrealtime() - t0 > 2000000ull) {
                    if (threadIdx.x == 0) { unsigned expect = 0u; __hip_atomic_compare_exchange_strong(tmo + 1, &expect, 0x600u | (unsigned)(u.pm & 0xff), __ATOMIC_RELAXED, __ATOMIC_RELAXED, __HIP_MEMORY_SCOPE_AGENT); __hip_atomic_store(tmo, 1u, __ATOMIC_RELAXED, __HIP_MEMORY_SCOPE_AGENT); }
                    break; }
                __builtin_amdgcn_s_sleep(2); }
            __builtin_amdgcn_fence(__ATOMIC_ACQUIRE, "agent");
            asm volatile("s_waitcnt vmcnt(0)" ::: "memory");
        }
#if !defined(BROKEN_HOOK_NO_BARRIER)
        asm volatile("" ::: "memory"); __builtin_amdgcn_s_barrier(); asm volatile("" ::: "memory");
#endif
    }
};

typedef float f32x2c __attribute__((ext_vector_type(2))); typedef __bf16 bf16x2c __attribute__((ext_vector_type(2)));
__device__ __forceinline__ unsigned cvt_pk_bf16(float lo, float hi) { const f32x2c v = {lo, hi}; return __builtin_bit_cast(unsigned, __builtin_convertvector(v, bf16x2c)); }
typedef float f32x2 __attribute__((ext_vector_type(2)));
__device__ __forceinline__ f32x2 gelu_pk(f32x2 v) {
    const f32x2 av = __builtin_elementwise_abs(v), d = av * 0.2316418882f + 1.0f;
    f32x2 t; t.x = __builtin_amdgcn_rcpf(d.x); t.y = __builtin_amdgcn_rcpf(d.y);
    f32x2 q = t * 0.5307027145f + (-0.7265760135f); q = q * t + 0.7107068705f; q = q * t + (-0.142248368f); q = q * t + 0.127414796f; q = q * t;
    const f32x2 s = (v * v) * (-0.72134752044f);
    f32x2 e; e.x = __builtin_amdgcn_exp2f(s.x); e.y = __builtin_amdgcn_exp2f(s.y);
    const f32x2 m = v * (q * e), r = v - m;
    f32x2 o; o.x = v.x < 0.f ? m.x : r.x; o.y = v.y < 0.f ? m.y : r.y; return o;
}

struct EpiF32 {
    static constexpr bool PERM = false, AFTER_DRAIN = false;
    float* C; int ldc; const float* bias;
    __device__ __forceinline__ void operator()(const f32x4 (&acc)[2][2][4][2], const Unit& u, int wr, int wc, int fr, int fq) const {
        const int row0 = u.pm * BM + wr * 64 + fr, col0 = u.pn * BM + wc * 32 + 4 * fq;
        f32x4 bv[2][2];
#pragma unroll
        for (int bj = 0; bj < 2; ++bj)
#pragma unroll
            for (int n = 0; n < 2; ++n) bv[bj][n] = bias ? *(const f32x4*)(bias + col0 + bj * HALF + n * 16) : (f32x4){0.f, 0.f, 0.f, 0.f};
#pragma unroll
        for (int ai = 0; ai < 2; ++ai)
#pragma unroll
            for (int m = 0; m < 4; ++m) { float* rowp = C + (size_t)(row0 + ai * HALF + m * 16) * ldc + col0;
#pragma unroll
                for (int bj = 0; bj < 2; ++bj)
#pragma unroll
                    for (int n = 0; n < 2; ++n) *(f32x4*)(rowp + bj * HALF + n * 16) = acc[ai][bj][m][n] + bv[bj][n]; }
    }
};
template <int ACT  > struct EpiBf16 {
    static constexpr bool PERM = true, AFTER_DRAIN = false;
    bf16_t* O; int ldc; const float* bias; int split_cols; size_t split_stride;
    __device__ __forceinline__ void operator()(const f32x4 (&acc)[2][2][4][2], const Unit& u, int wr, int wc, int fr, int fq) const {
        const int row0 = u.pm * BM + wr * 64 + fr; int colt = u.pn * BM; bf16_t* base = O;
        if (split_cols) { const int t = colt / split_cols; base += (size_t)t * split_stride; colt -= t * split_cols; }
        const int col0 = colt + wc * 32 + 8 * fq, bcol0 = u.pn * BM + wc * 32 + 8 * fq;
        f32x4 bv[2][2];
#pragma unroll
        for (int bj = 0; bj < 2; ++bj)
#pragma unroll
            for (int n = 0; n < 2; ++n) bv[bj][n] = bias ? *(const f32x4*)(bias + bcol0 + bj * HALF + 4 * n) : (f32x4){0.f, 0.f, 0.f, 0.f};
#pragma unroll
        for (int ai = 0; ai < 2; ++ai)
#pragma unroll
            for (int m = 0; m < 4; ++m) { bf16_t* rowp = base + (size_t)(row0 + ai * HALF + m * 16) * ldc + col0;
#pragma unroll
                for (int bj = 0; bj < 2; ++bj) { f32x4 v0 = acc[ai][bj][m][0] + bv[bj][0], v1 = acc[ai][bj][m][1] + bv[bj][1];
                    if (ACT == 1) { f32x2 a = gelu_pk((f32x2){v0[0], v0[1]}), b = gelu_pk((f32x2){v0[2], v0[3]}), c = gelu_pk((f32x2){v1[0], v1[1]}), d = gelu_pk((f32x2){v1[2], v1[3]});
                        v0 = (f32x4){a.x, a.y, b.x, b.y}; v1 = (f32x4){c.x, c.y, d.x, d.y}; }
                    if (ACT == 2) {
#pragma unroll
                        for (int j = 0; j < 4; ++j) { v0[j] = 0.5f * v0[j] * (1.0f + erff(v0[j] * 0.70710678f)); v1[j] = 0.5f * v1[j] * (1.0f + erff(v1[j] * 0.70710678f)); } }
                    u32x4 w; w.x = cvt_pk_bf16(v0[0], v0[1]); w.y = cvt_pk_bf16(v0[2], v0[3]); w.z = cvt_pk_bf16(v1[0], v1[1]); w.w = cvt_pk_bf16(v1[2], v1[3]);
                    *(u32x4*)(rowp + bj * HALF) = w; } }
    }
};
template <class Epi, class Sched, bool STAMP = false>
__device__ __forceinline__ void gemm_phase(PG8_LAS unsigned char* lds, const Gemm g, const Sched& S, const Epi& E, unsigned long long* stamps) {
    int tid_l = threadIdx.x; asm volatile("" : "+v"(tid_l));
    const int tid = tid_l, wid = __builtin_amdgcn_readfirstlane(tid >> 6), lane = tid & 63, wr = wid >> 2, wc = wid & 3, fr = lane & 15, fq = lane >> 4;
    const int K = g.K, nt = K / BK;
    int ts_lo = 0, ts_hi = 0, nts = 0; const unsigned long long rt_entry = STAMP ? (unsigned long long)wall_clock64() : 0ull;
#define PG8_STAMP() do { if (STAMP && wid == 0 && nts < 64) { const unsigned long long _c = (unsigned long long)clock64(); \
        ts_lo = (lane == nts) ? (int)(unsigned)_c : ts_lo; ts_hi = (lane == nts) ? (int)(unsigned)(_c >> 32) : ts_hi; ++nts; } } while (0)
    PG8_STAMP();
    unsigned voffA[2], voffB[2];
#pragma unroll
    for (int i = 0; i < 2; ++i) { int R, C; stage_rc(tid * 16 + i * 8192, R, C); const int Rb = Epi::PERM ? ((R & ~31) + perm32(R & 31)) : R;
        voffA[i] = (unsigned)(R * K + C) * 2u; voffB[i] = (unsigned)(Rb * K + C) * 2u; }
    const size_t kstep = (size_t)(BK * 2);
    const size_t hstep = (size_t)HALF * K * 2;
    const size_t tstep = 2 * hstep;
    const unsigned ldsw = (unsigned)wid * 1024u;
    const int aoff = lds_byte(wr * 64 + fr, fq * 8), boff = lds_byte(wc * 32 + fr, fq * 8);
#define PG8_SA(b, h) (((b) * 2 + (h)) * HTB)
#define PG8_SB(b, h) ((4 + (b) * 2 + (h)) * HTB)
#define PG8_STAGE(bufoff, gbase, voff) do { _Pragma("unroll") for (int _i = 0; _i < 2; ++_i) \
        __builtin_amdgcn_global_load_lds((const unsigned*)((const char*)(gbase) + (voff)[_i]), (PG8_LAS unsigned*)(lds + (bufoff) + ldsw + _i * 8192), 16, 0, 0); } while (0)
#define PG8_LDA(dst, b, h) do { _Pragma("unroll") for (int m = 0; m < 4; ++m) _Pragma("unroll") for (int k = 0; k < 2; ++k) dst[m][k] = *(const PG8_LAS bf16x8*)(lds + PG8_SA(b, h) + aoff + m * 2048 + k * 1024); } while (0)
#define PG8_LDB(dst, b, h) do { _Pragma("unroll") for (int n = 0; n < 2; ++n) _Pragma("unroll") for (int k = 0; k < 2; ++k) dst[n][k] = *(const PG8_LAS bf16x8*)(lds + PG8_SB(b, h) + boff + n * 2048 + k * 1024); } while (0)
#define PG8_MMA(ai, bj, At, Bt) do { __builtin_amdgcn_s_setprio(1); _Pragma("unroll") for (int m = 0; m < 4; ++m) _Pragma("unroll") for (int n = 0; n < 2; ++n) _Pragma("unroll") for (int k = 0; k < 2; ++k) \
        acc[ai][bj][m][n] = __builtin_amdgcn_mfma_f32_16x16x32_bf16(Bt[n][k], At[m][k], acc[ai][bj][m][n], 0, 0, 0); __builtin_amdgcn_s_setprio(0); } while (0)
#define PG8_WAIT_V(n) asm volatile("s_waitcnt vmcnt(" #n ")" ::: "memory")
#define PG8_WAIT_L(n) asm volatile("s_waitcnt lgkmcnt(" #n ")" ::: "memory")
#define PG8_BAR __builtin_amdgcn_s_barrier()
#define PG8_SCHED __builtin_amdgcn_sched_barrier(0)
    Unit cur, nxt; int ui = 0;
    if (!S.next(0, cur)) return;
    f32x4 acc[2][2][4][2];
#pragma unroll
    for (int a = 0; a < 2; ++a)
#pragma unroll
        for (int b = 0; b < 2; ++b)
#pragma unroll
            for (int m = 0; m < 4; ++m)
#pragma unroll
                for (int n = 0; n < 2; ++n) acc[a][b][m][n] = (f32x4){0.f, 0.f, 0.f, 0.f};
    bf16x8 At[4][2], B0[2][2], B1[2][2];
    const char* cA = (const char*)g.A + (size_t)cur.pm * tstep; const char* cB = (const char*)g.Bt + (size_t)cur.pn * tstep;
    S.a_ready(cur);
    PG8_STAGE(PG8_SB(0, 0), cB, voffB); PG8_STAGE(PG8_SA(0, 0), cA, voffA); PG8_STAGE(PG8_SB(0, 1), cB + hstep, voffB); PG8_STAGE(PG8_SA(0, 1), cA + hstep, voffA);
    if (wr == 1) PG8_BAR;
    PG8_WAIT_V(4); PG8_BAR;
    PG8_STAGE(PG8_SB(1, 0), cB + kstep, voffB); PG8_STAGE(PG8_SA(1, 0), cA + kstep, voffA); PG8_STAGE(PG8_SB(1, 1), cB + hstep + kstep, voffB);
    PG8_WAIT_V(6); PG8_BAR;
    PG8_STAMP();
    for (;;) {
        const bool has_next = S.next(ui + 1, nxt);
        const char* nA = has_next ? (const char*)g.A + (size_t)nxt.pm * tstep : cA; const char* nB = has_next ? (const char*)g.Bt + (size_t)nxt.pn * tstep : cB;
        for (int t = 0; t < nt; t += 2) {
            const bool last = (t == nt - 2);
            const char* a1 = cA + (size_t)(t + 1) * kstep;
            const char* a2 = last ? nA : cA + (size_t)(t + 2) * kstep; const char* b2 = last ? nB : cB + (size_t)(t + 2) * kstep;
            const char* a3 = a2 + kstep; const char* b3 = b2 + kstep;
            if (last && has_next) S.a_ready(nxt);
            PG8_LDB(B0, 0, 0); PG8_SCHED; PG8_LDA(At, 0, 0); PG8_STAGE(PG8_SA(1, 1), a1 + hstep, voffA);
            PG8_WAIT_L(8); PG8_BAR; PG8_WAIT_L(0); PG8_MMA(0, 0, At, B0); PG8_BAR; PG8_SCHED;
            PG8_LDB(B1, 0, 1); PG8_STAGE(PG8_SB(0, 0), b2, voffB);
            PG8_BAR; PG8_WAIT_L(0); PG8_MMA(0, 1, At, B1); PG8_BAR;
            PG8_LDA(At, 0, 1); PG8_STAGE(PG8_SA(0, 0), a2, voffA);
            PG8_BAR; PG8_WAIT_L(0); PG8_MMA(1, 0, At, B0); PG8_BAR; PG8_SCHED;
            PG8_STAGE(PG8_SB(0, 1), b2 + hstep, voffB);
            PG8_WAIT_V(6); PG8_BAR; PG8_MMA(1, 1, At, B1); PG8_BAR;
            PG8_LDB(B0, 1, 0); PG8_SCHED; PG8_LDA(At, 1, 0); PG8_STAGE(PG8_SA(0, 1), a2 + hstep, voffA);
            PG8_WAIT_L(8); PG8_BAR; PG8_WAIT_L(0); PG8_MMA(0, 0, At, B0); PG8_BAR; PG8_SCHED;
            PG8_LDB(B1, 1, 1); PG8_STAGE(PG8_SB(1, 0), b3, voffB);
            PG8_BAR; PG8_WAIT_L(0); PG8_MMA(0, 1, At, B1); PG8_BAR;
            PG8_LDA(At, 1, 1); PG8_STAGE(PG8_SA(1, 0), a3, voffA);
            PG8_BAR; PG8_WAIT_L(0); PG8_MMA(1, 0, At, B0); PG8_BAR; PG8_SCHED;
            PG8_STAGE(PG8_SB(1, 1), b3 + hstep, voffB);
            PG8_WAIT_V(6); PG8_BAR; PG8_MMA(1, 1, At, B1); PG8_BAR;
        }
        PG8_STAMP();
        if constexpr (!Epi::AFTER_DRAIN) { E(acc, cur, wr, wc, fr, fq); S.done(cur); }
        PG8_STAMP();
        if (!has_next) break;
#pragma unroll
        for (int a = 0; a < 2; ++a)
#pragma unroll
            for (int b = 0; b < 2; ++b)
#pragma unroll
                for (int m = 0; m < 4; ++m)
#pragma unroll
                    for (int n = 0; n < 2; ++n) acc[a][b][m][n] = (f32x4){0.f, 0.f, 0.f, 0.f};
        cur = nxt; cA = nA; cB = nB; ++ui;
    }
    PG8_WAIT_V(0);
    if (wr == 0) PG8_BAR;
    PG8_BAR;
    if constexpr (Epi::AFTER_DRAIN) { E.fused(acc, cur, wr, wc, fr, fq, lds, wid, lane); S.done(cur); }
    PG8_STAMP();
    if (STAMP && wid == 0) { stamps[lane] = lane < nts ? (((unsigned long long)(unsigned)ts_hi << 32) | (unsigned)ts_lo) : 0ull;
        if (lane == 62) stamps[62] = rt_entry; if (lane == 63) stamps[63] = (unsigned long long)wall_clock64(); }
#undef PG8_STAMP
#undef PG8_SA
#undef PG8_SB
#undef PG8_STAGE
#undef PG8_LDA
#undef PG8_LDB
#undef PG8_MMA
#undef PG8_WAIT_V
#undef PG8_WAIT_L
#undef PG8_BAR
#undef PG8_SCHED
}
}
#define XB_TMO      128
#define XB_XCNT(j)  (256  + 64 * (j))
#define XB_XSUB(j)  (1280 + 64 * (j))
#define XB_XGEN(j)  (2304 + 64 * (j))
#define XB_TOP      3328
#define XB_TOPGEN   3392
#define XCD_BAR_WORDS 3456
#define XB_SPIN_CAP (1u << 18)
#define LAS __attribute__((address_space(3)))

__device__ __forceinline__ unsigned xb_ld(unsigned* p)              { return __hip_atomic_load(p, __ATOMIC_RELAXED, __HIP_MEMORY_SCOPE_AGENT); }
__device__ __forceinline__ unsigned xb_add(unsigned* p, unsigned v) { return __hip_atomic_fetch_add(p, v, __ATOMIC_RELAXED, __HIP_MEMORY_SCOPE_AGENT); }
__device__ __forceinline__ unsigned xb_xcc_id() { return (unsigned)__builtin_amdgcn_s_getreg((3 << 11) | 20) & 0xFu; }
#define XB_SPIN(cond, bar) do { unsigned _sp = 0; while (cond) { __builtin_amdgcn_s_sleep(1); \
    if ((++_sp & 255u) == 0u) { if (xb_ld(&(bar)[XB_TMO])) break; if (_sp > XB_SPIN_CAP) { atomicAdd(&(bar)[XB_TMO], 1u); break; } } } } while (0)

struct XcdBarrier {
    unsigned* bar; unsigned x;
    volatile LAS unsigned* st;
};

__device__ __forceinline__ XcdBarrier xcd_barrier_post(unsigned* bar, volatile LAS unsigned* st) {
    XcdBarrier b; b.bar = bar; b.x = xb_xcc_id(); b.st = st;
    if (threadIdx.x == 0) (void)xb_add(&bar[XB_XCNT(b.x)], 1u);
    return b;
}
__device__ __forceinline__ void xcd_barrier_complete(unsigned* bar, unsigned x, unsigned& nloc, unsigned& nx) {
    const unsigned G = gridDim.x * gridDim.y * gridDim.z;
    unsigned sum, cnt, mine, sp = 0u;
    for (;;) {
        sum = 0u; cnt = 0u; mine = 0u;
#pragma unroll
        for (unsigned j = 0; j < 16; ++j) { const unsigned c = xb_ld(&bar[XB_XCNT(j)]); sum += c; cnt += (c > 0u) ? 1u : 0u; mine = (j == x) ? c : mine; }
        if (sum == G) break;
        __builtin_amdgcn_s_sleep(1);
        if ((++sp & 255u) == 0u) { if (xb_ld(&bar[XB_TMO])) break; if (sp > XB_SPIN_CAP) { atomicAdd(&bar[XB_TMO], 1u); break; } }
    }
    nloc = mine > 0u ? mine : 1u; nx = cnt > 0u ? cnt : 1u;
}

__device__ __forceinline__ void xcd_barrier(const XcdBarrier& b) {
    asm volatile("s_waitcnt vmcnt(0)" ::: "memory");
    __syncthreads();
    if (threadIdx.x == 0) {
        unsigned* bar = b.bar;
        __builtin_amdgcn_s_waitcnt(0);
        unsigned nloc = b.st[0], nx = b.st[1];
        if (nloc == 0u) { xcd_barrier_complete(bar, b.x, nloc, nx); b.st[0] = nloc; b.st[1] = nx; }
        const unsigned old = xb_add(&bar[XB_XSUB(b.x)], 1u);
        const unsigned gen = old / nloc;
        if (old + 1u == (gen + 1u) * nloc) {
            __builtin_amdgcn_fence(__ATOMIC_RELEASE, "agent");
            asm volatile("s_waitcnt vmcnt(0)" ::: "memory");
            const unsigned og = xb_add(&bar[XB_TOP], 1u);
            const unsigned tg = og / nx;
            if (og + 1u == (tg + 1u) * nx) xb_add(&bar[XB_TOPGEN], 1u);
            else XB_SPIN(xb_ld(&bar[XB_TOPGEN]) == tg, bar);
            __builtin_amdgcn_fence(__ATOMIC_ACQUIRE, "agent");
            xb_add(&bar[XB_XGEN(b.x)], 1u);
            asm volatile("s_waitcnt vmcnt(0)" ::: "memory");
        } else {
            XB_SPIN(xb_ld(&bar[XB_XGEN(b.x)]) == gen, bar);
            __builtin_amdgcn_fence(__ATOMIC_ACQUIRE, "agent");
            asm volatile("s_waitcnt vmcnt(0)" ::: "memory");
        }
    }
    __syncthreads();
}
__host__ __device__ __forceinline__ int ikiw_src(int c) {
    if (c < 32) return 8192 + c;
    if (c < 40) return 8256 + (c - 32);
    if (c >= 128 && c < 160) return 8192 + 32 + (c - 128);
    return -1;
}
__host__ __device__ __forceinline__ int ik_tilecol(int e) { return e < 32 ? e : 128 + (e - 32); }
__device__ __forceinline__ int src_col(int mode, int n) {
    if (mode == 0) return n;
    if (mode == 1) { if (n < 8192) return n; if (n < 8448) return ikiw_src(n - 8192); return 8264 + (n - 8448); }
    const int pn = n >> 8, c = n & 255; return c < 128 ? pn * 128 + c : D_FF + pn * 128 + (c - 128);
}
__device__ __forceinline__ void prep_weight_tile(const float* __restrict__ w, int ldw, const float* __restrict__ scale, bf16_t* __restrict__ Wt, int K, int mode, int tile, float* lds  ) {
    const int ktiles = K / 32, nt = tile / ktiles, kt = tile % ktiles, tid = threadIdx.x & 255;
    const int n0 = nt * 64, k0 = kt * 32;
    {   const int nn = tid & 63, kk0 = tid >> 6; const int sc = src_col(mode, n0 + nn);
#pragma unroll
        for (int i = 0; i < 8; ++i) { const int kk = kk0 + i * 4; float v = 0.f; if (sc >= 0) { v = w[(size_t)(k0 + kk) * ldw + sc]; if (scale) v *= scale[k0 + kk]; } lds[kk * 65 + nn] = v; } }
    __syncthreads();
    {   const int kk = tid & 31, nn0 = tid >> 5;
#pragma unroll
        for (int i = 0; i < 8; ++i) { const int nn = nn0 + i * 8; Wt[(size_t)(n0 + nn) * K + k0 + kk] = f2bf(lds[kk * 65 + nn]); } }
    __syncthreads();
}
__device__ __forceinline__ const float* h_row_ptr(int r, const float* xp, const float* xs, const float* meta) {
    if (r < T_PROMPT) { const int b = r / LP, l = r % LP; return l < N_META ? meta + (size_t)l * D_MODEL : xp + ((size_t)b * SEQ + (l - N_META)) * D_MODEL; }
    return xs + (size_t)(r - T_PROMPT) * D_MODEL;
}
__device__ __forceinline__ void prep_row(int r, const float* xp, const float* xs, const float* meta, bf16_t* A0, float* rstd0, int lane) {
    if (r >= T_ALL) { for (int i = lane; i < D_MODEL / 2; i += 64) ((unsigned*)(A0 + (size_t)r * D_MODEL))[i] = 0u; if (lane == 0) rstd0[r] = 0.f; return; }
    const float4* src = (const float4*)h_row_ptr(r, xp, xs, meta); float ss = 0.f;
#pragma unroll
    for (int i = 0; i < 4; ++i) { const float4 v = src[lane + i * 64]; ss += v.x * v.x + v.y * v.y + v.z * v.z + v.w * v.w;
        uint2 o; o.x = (unsigned)f2bf(v.x) | ((unsigned)f2bf(v.y) << 16); o.y = (unsigned)f2bf(v.z) | ((unsigned)f2bf(v.w) << 16);
        ((uint2*)(A0 + (size_t)r * D_MODEL))[lane + i * 64] = o; }
#pragma unroll
    for (int o = 32; o >= 1; o >>= 1) ss += __shfl_xor(ss, o);
    if (lane == 0) rstd0[r] = rsqrtf(ss * (1.0f / D_MODEL) + NORM_EPS);
}
__device__ __forceinline__ void rope_entry(int idx, float2* tab) {
    const int pos = idx >> 7, i = idx & 127;
    const float inv = exp2f(-(float)i * (13.287712379549449f / 128.0f));
    const float angf = (float)pos * inv; const double a = (double)angf;
    const double kq = rint(a * 0.63661977236758134308);
    double r = fma(-kq, 1.57079632679489655800e+00, a); r = fma(-kq, 6.12323399573676603587e-17, r);
    const double r2 = r * r;
    const double sp = r * (1.0 + r2 * (-1.0 / 6 + r2 * (1.0 / 120 + r2 * (-1.0 / 5040 + r2 * (1.0 / 362880 + r2 * (-1.0 / 39916800 + r2 * (1.0 / 6227020800.0)))))));
    const double cp = 1.0 + r2 * (-0.5 + r2 * (1.0 / 24 + r2 * (-1.0 / 720 + r2 * (1.0 / 40320 + r2 * (-1.0 / 3628800 + r2 * (1.0 / 479001600 + r2 * (-1.0 / 87178291200.0)))))));
    const int q = ((int)kq) & 3;
    const double sv = (q == 0) ? sp : (q == 1) ? cp : (q == 2) ? -sp : -cp;
    const double cv = (q == 0) ? cp : (q == 1) ? -sp : (q == 2) ? -cp : sp;
    tab[idx] = make_float2((float)cv, (float)sv);
}

struct PrepArgs {
    const float *x_prompt, *x_sample, *meta, *norm_mix_w, *w_in, *w_ret, *w_dsa, *w_out, *norm_ffn_w, *w_ffi, *w_ffo;
    bf16_t *W1t, *Wret, *Wdsa, *Wout, *Wffi, *Wffo, *A0; float* rstd0; float2* rope;
};
#define PREP_J_W1   0
#define PREP_N_W1   ((N1 / 64) * (1024 / 32))
#define PREP_J_WRET (PREP_J_W1 + PREP_N_W1)
#define PREP_N_WRET ((1024 / 64) * (2048 / 32))
#define PREP_J_WDSA (PREP_J_WRET + PREP_N_WRET)
#define PREP_N_WDSA ((1024 / 64) * (1024 / 32))
#define PREP_J_WOUT (PREP_J_WDSA + PREP_N_WDSA)
#define PREP_N_WOUT ((1024 / 64) * (1024 / 32))
#define PREP_J_WFFI (PREP_J_WOUT + PREP_N_WOUT)
#define PREP_N_WFFI ((NFF2 / 64) * (1024 / 32))
#define PREP_J_WFFO (PREP_J_WFFI + PREP_N_WFFI)
#define PREP_N_WFFO ((1024 / 64) * (2816 / 32))
#define PREP_J_ROWS (PREP_J_WFFO + PREP_N_WFFO)
#define PREP_N_ROWS (T_PAD / 4)
#define PREP_J_ROPE (PREP_J_ROWS + PREP_N_ROWS)
#define PREP_N_ROPE ((LP * 128) / 256)
#define PREP_N_JOBS (PREP_J_ROPE + PREP_N_ROPE)
__device__ __forceinline__ void prep_job(const PrepArgs& a, int job, float* lds) {
    if (job < PREP_J_WRET)      prep_weight_tile(a.w_in, IN_COLS, a.norm_mix_w, a.W1t, 1024, 1, job - PREP_J_W1, lds);
    else if (job < PREP_J_WDSA) prep_weight_tile(a.w_ret, 1024, nullptr, a.Wret, 2048, 0, job - PREP_J_WRET, lds);
    else if (job < PREP_J_WOUT) prep_weight_tile(a.w_dsa, 1024, nullptr, a.Wdsa, 1024, 0, job - PREP_J_WDSA, lds);
    else if (job < PREP_J_WFFI) prep_weight_tile(a.w_out, 1024, nullptr, a.Wout, 1024, 0, job - PREP_J_WOUT, lds);
    else if (job < PREP_J_WFFO) prep_weight_tile(a.w_ffi, 2 * D_FF, a.norm_ffn_w, a.Wffi, 1024, 2, job - PREP_J_WFFI, lds);
    else if (job < PREP_J_ROWS) prep_weight_tile(a.w_ffo, 1024, nullptr, a.Wffo, 2816, 0, job - PREP_J_WFFO, lds);
    else if (job < PREP_J_ROPE) prep_row((job - PREP_J_ROWS) * 4 + ((threadIdx.x & 255) >> 6), a.x_prompt, a.x_sample, a.meta, a.A0, a.rstd0, threadIdx.x & 63);
    else rope_entry((job - PREP_J_ROPE) * 256 + (threadIdx.x & 255), a.rope);
}
namespace att {
using bf16x8 = __attribute__((ext_vector_type(8))) short;
using s16x4  = __attribute__((ext_vector_type(4))) short;
using f32x16 = __attribute__((ext_vector_type(16))) float;
using f32x8  = __attribute__((ext_vector_type(8))) float;
using u32x4  = __attribute__((ext_vector_type(4))) unsigned;
constexpr float SCALE = 0.088388347648318440f;
constexpr float THR = 8.f;
constexpr float NEG = -3.0e38f;
constexpr int SHM_V = 64 * 128 * 2, SHM_K = 64 * 128 * 2;
#define ATT_KSWZ(row, colB) ((row) * 256 + ((colB) ^ (((row) & 7) << 4)))
#define ATT_SBAR() __builtin_amdgcn_sched_barrier(0)
__device__ __forceinline__ int crow(int r, int hi) { return (r & 3) + 8 * (r >> 2) + 4 * hi; }
__device__ __forceinline__ unsigned cvtpk(float lo, float hi) { return pg8::cvt_pk_bf16(lo, hi); }
__device__ __forceinline__ bf16x8 tobf(f32x8 x) { u32x4 w = {cvtpk(x[0], x[1]), cvtpk(x[2], x[3]), cvtpk(x[4], x[5]), cvtpk(x[6], x[7])}; return *reinterpret_cast<bf16x8*>(&w); }
__device__ __forceinline__ bf16x8 tobf(bf16x8 x) { return x; }

__device__ __forceinline__ void apply_mask(f32x16& p0, f32x16& p1, u64 mk, int hi) {
    const unsigned lo = (unsigned)mk >> (4 * hi), hw = (unsigned)(mk >> 32) >> (4 * hi);
#pragma unroll
    for (int r = 0; r < 16; ++r) { const unsigned bit = 1u << ((r & 3) + 8 * (r >> 2)); p0[r] = (lo & bit) ? p0[r] : NEG; p1[r] = (hw & bit) ? p1[r] : NEG; }
}
__device__ __forceinline__ void partialSM(f32x16& p0, f32x16& p1, float& m_reg, float& mn, float& alpha) {
    constexpr float C = SCALE * 1.4426950408889634f;
    float pmax = p0[0];
#pragma unroll
    for (int r = 1; r < 16; ++r) pmax = fmaxf(pmax, p0[r]);
#pragma unroll
    for (int r = 0; r < 16; ++r) pmax = fmaxf(pmax, p1[r]);
    { auto rr = __builtin_amdgcn_permlane32_swap(__float_as_uint(pmax), __float_as_uint(pmax), false, false);
      pmax = fmaxf(__uint_as_float(rr[0]), __uint_as_float(rr[1])); }
    if (__builtin_expect(__all(pmax - m_reg <= THR / SCALE), 1)) { mn = m_reg; alpha = 1.f; }
    else { mn = fmaxf(m_reg, pmax); alpha = __builtin_amdgcn_exp2f((m_reg - mn) * C); m_reg = mn; }
    const float mnC = -mn * C;
#pragma unroll
    for (int r = 0; r < 16; ++r) p0[r] = fmaf(p0[r], C, mnC);
#pragma unroll
    for (int r = 0; r < 16; ++r) p1[r] = fmaf(p1[r], C, mnC);
#pragma unroll
    for (int r = 0; r < 16; ++r) p0[r] = __builtin_amdgcn_exp2f(p0[r]);
}
__device__ __forceinline__ void finishSM(f32x16& p0, f32x16& p1, float alpha, float& l_reg, bf16x8& pa0, bf16x8& pa1, bf16x8& pa2, bf16x8& pa3) {
#pragma unroll
    for (int r = 0; r < 16; ++r) p1[r] = __builtin_amdgcn_exp2f(p1[r]);
    float ps = 0;
#pragma unroll
    for (int r = 0; r < 16; ++r) ps += p0[r];
#pragma unroll
    for (int r = 0; r < 16; ++r) ps += p1[r];
    { auto rr = __builtin_amdgcn_permlane32_swap(__float_as_uint(ps), __float_as_uint(ps), false, false);
      ps = __uint_as_float(rr[0]) + __uint_as_float(rr[1]); }
    l_reg = l_reg * alpha + ps;
#define ATT_PK4(P, BASE, OUT) do { unsigned a0 = cvtpk(P[BASE + 0], P[BASE + 1]), a1 = cvtpk(P[BASE + 2], P[BASE + 3]);   \
    unsigned b0 = cvtpk(P[BASE + 4], P[BASE + 5]), b1 = cvtpk(P[BASE + 6], P[BASE + 7]);                              \
    auto r0 = __builtin_amdgcn_permlane32_swap(a0, b0, false, false); auto r1 = __builtin_amdgcn_permlane32_swap(a1, b1, false, false); \
    u32x4 w = {r0[0], r1[0], r0[1], r1[1]}; OUT = *reinterpret_cast<bf16x8*>(&w); } while (0)
    ATT_PK4(p0, 0, pa0); ATT_PK4(p0, 8, pa1); ATT_PK4(p1, 0, pa2); ATT_PK4(p1, 8, pa3);
#undef ATT_PK4
}
__device__ __forceinline__ void qkt(f32x16& p0, f32x16& p1, const char* Ks, const bf16x8* qr, int r32, int hi) {
    p0 = f32x16{}; p1 = f32x16{};
#pragma unroll
    for (int d0 = 0; d0 < 8; ++d0) { const int cb = (d0 * 16 + hi * 8) * 2;
        const bf16x8 b0 = *reinterpret_cast<const bf16x8*>(Ks + ATT_KSWZ(r32, cb));
        const bf16x8 b1 = *reinterpret_cast<const bf16x8*>(Ks + ATT_KSWZ(32 + r32, cb));
        p0 = __builtin_amdgcn_mfma_f32_32x32x16_bf16(b0, qr[d0], p0, 0, 0, 0);
        p1 = __builtin_amdgcn_mfma_f32_32x32x16_bf16(b1, qr[d0], p1, 0, 0, 0); }
}
__device__ __forceinline__ int v_st(int k, int c) { const int kk = (k & ~0xC) | ((k & 4) << 1) | ((k & 8) >> 1); return ((kk >> 3) * 4 + (c >> 5)) * 512 + ((kk & 7) * 32 + (c & 31)) * 2; }
__device__ __forceinline__ int v_rd_base(int lane) { return ((lane & 3) << 3) | (((lane >> 2) & 3) << 6) | (((lane >> 4) & 1) << 5) | (((lane >> 5) & 1) << 8); }
constexpr int v_rd_off(int d0, int ks, int half) { return d0 * 512 + ks * 4096 + half * 2048; }
template <int OFF> __device__ __forceinline__ s16x4 tr_read(int vb) { s16x4 r; asm volatile("ds_read_b64_tr_b16 %0, %1 offset:%2" : "=&v"(r) : "v"(vb), "i"(OFF) : "memory"); return r; }
template <int D0> __device__ __forceinline__ void pv_one(f32x16& od, int vb, bf16x8 pa0, bf16x8 pa1, bf16x8 pa2, bf16x8 pa3) {
    const s16x4 l0 = tr_read<v_rd_off(D0, 0, 0)>(vb), h0 = tr_read<v_rd_off(D0, 0, 1)>(vb), l1 = tr_read<v_rd_off(D0, 1, 0)>(vb), h1 = tr_read<v_rd_off(D0, 1, 1)>(vb);
    const s16x4 l2 = tr_read<v_rd_off(D0, 2, 0)>(vb), h2 = tr_read<v_rd_off(D0, 2, 1)>(vb), l3 = tr_read<v_rd_off(D0, 3, 0)>(vb), h3 = tr_read<v_rd_off(D0, 3, 1)>(vb);
    asm volatile("s_waitcnt lgkmcnt(0)" ::: "memory"); ATT_SBAR();
#define ATT_PK(L, H) (bf16x8){L[0], L[1], L[2], L[3], H[0], H[1], H[2], H[3]}
    od = __builtin_amdgcn_mfma_f32_32x32x16_bf16(pa0, ATT_PK(l0, h0), od, 0, 0, 0);
    od = __builtin_amdgcn_mfma_f32_32x32x16_bf16(pa1, ATT_PK(l1, h1), od, 0, 0, 0);
    od = __builtin_amdgcn_mfma_f32_32x32x16_bf16(pa2, ATT_PK(l2, h2), od, 0, 0, 0);
    od = __builtin_amdgcn_mfma_f32_32x32x16_bf16(pa3, ATT_PK(l3, h3), od, 0, 0, 0);
#undef ATT_PK
}
__device__ __forceinline__ void pv_d0(f32x16* o, int vb, bf16x8 pa0, bf16x8 pa1, bf16x8 pa2, bf16x8 pa3) {
    pv_one<0>(o[0], vb, pa0, pa1, pa2, pa3); pv_one<1>(o[1], vb, pa0, pa1, pa2, pa3); pv_one<2>(o[2], vb, pa0, pa1, pa2, pa3); pv_one<3>(o[3], vb, pa0, pa1, pa2, pa3);
}

struct KvPrompt {
    using T = bf16x8; const bf16_t* K; const bf16_t* V;
    __device__ __forceinline__ T ldk(int key, int col) const { return *reinterpret_cast<const bf16x8*>(K + (size_t)key * 256 + col); }
    __device__ __forceinline__ T ldv(int key, int col) const { return *reinterpret_cast<const bf16x8*>(V + (size_t)key * 256 + col); }
};
struct KvSample {
    using T = f32x8; const float* ck; const float* cv; const float* kn; const float* vn; const int* pages  ; int n;
    __device__ __forceinline__ size_t roff(int key) const { return (((size_t)pages[key >> 7] * PAGE_SIZE + (key & 127)) * N_KV + n) * 128; }
    __device__ __forceinline__ T ldk(int key, int col) const { const float* p = key < PAST_LEN ? ck + roff(key) : kn + (size_t)min(key - PAST_LEN, DEC_SEQ - 1) * 256; return *reinterpret_cast<const f32x8*>(p + col); }
    __device__ __forceinline__ T ldv(int key, int col) const { const float* p = key < PAST_LEN ? cv + roff(key) : vn + (size_t)min(key - PAST_LEN, DEC_SEQ - 1) * 256; return *reinterpret_cast<const f32x8*>(p + col); }
};

template <class KV>
__device__ __forceinline__ void attn_unit(const KV kv, const bf16_t* __restrict__ Aq, const float* __restrict__ qnw, const u64* __restrict__ mask, bf16_t* __restrict__ Odsa, int tok0, int nq_valid, int hd0, int NT, char* lds) {
    int tid_l = threadIdx.x; asm volatile("" : "+v"(tid_l));
    const int tid = tid_l, wid = tid >> 6, lane = tid & 63, r32 = lane & 31, hi = lane >> 5;
    char* V_lds = lds; char* K_lds = lds + 2 * SHM_V;
    float* wsx = (float*)(lds + 2 * SHM_V + 2 * SHM_K) + wid * 64; float* li_l = wsx; float* al_l = wsx + 32;
    float m_reg = -1e30f, l_reg = 0; f32x16 o[4] = {}; bf16x8 qr[8];
    const int mytok = tok0 + 8 * wid + (r32 >> 2);
    { const bf16_t* Qw = Aq + (size_t)mytok * 1024 + (hd0 + (r32 & 3)) * 128 + hi * 8;
#pragma unroll
      for (int d0 = 0; d0 < 8; ++d0) qr[d0] = *reinterpret_cast<const bf16x8*>(Qw + d0 * 16);
      float ssq = 0.f;
#pragma unroll
      for (int d0 = 0; d0 < 8; ++d0) { const u32x4 w = *reinterpret_cast<const u32x4*>(&qr[d0]);
#pragma unroll
          for (int j = 0; j < 4; ++j) { const float lo = __uint_as_float(w[j] << 16), hh = __uint_as_float(w[j] & 0xffff0000u); ssq += lo * lo + hh * hh; } }
      ssq += __shfl_xor(ssq, 32);
      const float rn = rsqrtf(ssq * (1.0f / 128.0f) + NORM_EPS);
#pragma unroll
      for (int d0 = 0; d0 < 8; ++d0) { const u32x4 w = *reinterpret_cast<const u32x4*>(&qr[d0]); const float4 g0 = *(const float4*)(qnw + d0 * 16 + hi * 8), g1 = *(const float4*)(qnw + d0 * 16 + hi * 8 + 4);
          u32x4 o; o[0] = cvtpk(__uint_as_float(w[0] << 16) * rn * g0.x, __uint_as_float(w[0] & 0xffff0000u) * rn * g0.y); o[1] = cvtpk(__uint_as_float(w[1] << 16) * rn * g0.z, __uint_as_float(w[1] & 0xffff0000u) * rn * g0.w);
          o[2] = cvtpk(__uint_as_float(w[2] << 16) * rn * g1.x, __uint_as_float(w[2] & 0xffff0000u) * rn * g1.y); o[3] = cvtpk(__uint_as_float(w[3] << 16) * rn * g1.z, __uint_as_float(w[3] & 0xffff0000u) * rn * g1.w);
          qr[d0] = *reinterpret_cast<const bf16x8*>(&o); } }
    const u64* mrow = mask + (size_t)mytok * MASK_WORDS;
    const int sr = tid >> 4, sc = (tid & 15) * 8, vst0 = v_st(sr, sc), vst1 = v_st(32 + sr, sc);
    const int vbase = (int)(uintptr_t)(PG8_LAS char*)V_lds + v_rd_base(lane);
    typename KV::T vs0, vs1, ks0, ks1;
#define ATT_SLOAD(k0) do { vs0 = kv.ldv((k0) + sr, sc); vs1 = kv.ldv((k0) + 32 + sr, sc); ks0 = kv.ldk((k0) + sr, sc); ks1 = kv.ldk((k0) + 32 + sr, sc); } while (0)
#define ATT_SWRITE(b) do { *(bf16x8*)(V_lds + (b) * SHM_V + vst0) = tobf(vs0); *(bf16x8*)(V_lds + (b) * SHM_V + vst1) = tobf(vs1); const int kc = sc * 2; \
    *(bf16x8*)(K_lds + (b) * SHM_K + ATT_KSWZ(sr, kc)) = tobf(ks0); *(bf16x8*)(K_lds + (b) * SHM_K + ATT_KSWZ(32 + sr, kc)) = tobf(ks1); } while (0)
    __syncthreads();
    ATT_SLOAD(0); ATT_SWRITE(0); __syncthreads();
    for (int j = 0; j < NT; ++j) {
        const int b = j & 1;
        const u64 mk = mrow[j];
        if (j + 1 < NT) ATT_SLOAD((j + 1) * 64);
        f32x16 p0, p1; float mn, alpha; bf16x8 pa0, pa1, pa2, pa3;
        ATT_SBAR(); qkt(p0, p1, K_lds + b * SHM_K, qr, r32, hi); apply_mask(p0, p1, mk, hi);
        partialSM(p0, p1, m_reg, mn, alpha);
        if (__any(alpha < 1.f)) { if (hi == 0) al_l[r32] = alpha; asm volatile("s_waitcnt lgkmcnt(0)" ::: "memory");
#pragma unroll
            for (int d = 0; d < 4; ++d)
#pragma unroll
                for (int r = 0; r < 16; ++r) o[d][r] *= al_l[crow(r, hi)]; }
        finishSM(p0, p1, alpha, l_reg, pa0, pa1, pa2, pa3); ATT_SBAR();
        pv_d0(o, vbase + b * SHM_V, pa0, pa1, pa2, pa3);
        if (j + 1 < NT) ATT_SWRITE(b ^ 1);
        __syncthreads();
    }
    if (hi == 0) li_l[r32] = l_reg; asm volatile("s_waitcnt lgkmcnt(0)" ::: "memory");
#pragma unroll
    for (int r = 0; r < 16; ++r) { const int orow = crow(r, hi); const float rli = __builtin_amdgcn_rcpf(li_l[orow]);
        const int q = 8 * wid + (orow >> 2);
        if (q < nq_valid) { bf16_t* Ow = Odsa + (size_t)(tok0 + q) * 1024 + (hd0 + (orow & 3)) * 128 + r32;
#pragma unroll
            for (int d0 = 0; d0 < 4; ++d0) Ow[d0 * 32] = f2bf(o[d0][r] * rli); } }
#undef ATT_SLOAD
#undef ATT_SWRITE
}
}
namespace idx {
using bf16x8 = __attribute__((ext_vector_type(8))) short;
using f32x16 = __attribute__((ext_vector_type(16))) float;
using f32x8  = __attribute__((ext_vector_type(8))) float;
constexpr int NTILE = 65;
constexpr int WAVE_LDS = NTILE * 64 * 4;
__device__ __forceinline__ unsigned ord_of(float f) { const unsigned u = __float_as_uint(f); return (u & 0x80000000u) ? ~u : (u | 0x80000000u); }
__device__ __forceinline__ int half_sum(int v) {
#pragma unroll
    for (int o = 16; o >= 1; o >>= 1) v += __shfl_xor(v, o);
    return v;
}
template <bool SAMPLE> struct KeySrc {
    const bf16_t* ikb; const float* ck; int pgv;
    struct Raw { f32x8 f[SAMPLE ? 4 : 1]; bf16x8 h[SAMPLE ? 1 : 4]; };
    __device__ __forceinline__ void load(int t, int c, int hi, Raw& R) const {
        if constexpr (!SAMPLE) { const bf16_t* p = ikb + (size_t)(32 * t + c) * 64 + hi * 8;
#pragma unroll
            for (int s = 0; s < 4; ++s) R.h[s] = *reinterpret_cast<const bf16x8*>(p + 16 * s); }
        else { const int tc = t < 64 ? t : 63; const int page = __builtin_amdgcn_readlane(pgv, tc >> 2);
            const float* p = ck + ((size_t)page * PAGE_SIZE + ((32 * tc) & 127) + c) * 64 + hi * 8;
            if (t >= 64) {
                const bf16_t* q = ikb + (size_t)(c < DEC_SEQ ? c : DEC_SEQ - 1) * 64 + hi * 8;
#pragma unroll
                for (int s = 0; s < 4; ++s) { const att::u32x4 w = *reinterpret_cast<const att::u32x4*>(q + 16 * s);
#pragma unroll
                    for (int e = 0; e < 4; ++e) { R.f[s][2 * e] = __uint_as_float(w[e] << 16); R.f[s][2 * e + 1] = __uint_as_float(w[e] & 0xffff0000u); } } }
            else {
#pragma unroll
                for (int s = 0; s < 4; ++s) R.f[s] = *reinterpret_cast<const f32x8*>(p + 16 * s); } }
    }
    __device__ __forceinline__ void cvt(const Raw& R, bf16x8 (&B)[4]) const {
#pragma unroll
        for (int s = 0; s < 4; ++s) { if constexpr (SAMPLE) B[s] = att::tobf(R.f[s]); else B[s] = R.h[s]; }
    }
};
template <int A_> __device__ __forceinline__ float head_sum(const f32x16& acc, const float (&w)[8]) {
    float s = 0.f;
#pragma unroll
    for (int h = 0; h < 8; ++h) s = fmaf(w[h], fmaxf(acc[8 * A_ + h], 0.f), s);
    return s;
}
template <bool SAMPLE, int A_>
__device__ __forceinline__ void pass(const KeySrc<SAMPLE>& ks, const bf16x8 (&A)[4], const float* Iw, int tokbase, int pos0, int nvalid, int ntiles, unsigned* strip, unsigned* mask32, int lane) {
    const int c = lane & 31, hi = lane >> 5, myq = 2 * hi + A_, mypos = pos0 + myq; const bool qvalid = myq < nvalid;
    float w[8];
    { const float* wp = Iw + (size_t)(tokbase + (qvalid ? myq : nvalid - 1)) * 8;
#pragma unroll
      for (int h = 0; h < 8; ++h) w[h] = wp[h]; }
    typename KeySrc<SAMPLE>::Raw R0, R1; bf16x8 B[4];
    ks.load(0, c, hi, R0); if (1 < ntiles) ks.load(1, c, hi, R1);
#define IDX_TILE(t_, R_) do { ks.cvt(R_, B); if ((t_) + 2 < ntiles) ks.load((t_) + 2, c, hi, R_); f32x16 acc = {}; \
        _Pragma("unroll") for (int s_ = 0; s_ < 4; ++s_) acc = __builtin_amdgcn_mfma_f32_32x32x16_bf16(A[s_], B[s_], acc, 0, 0, 0); \
        const float sc_ = head_sum<A_>(acc, w); strip[(t_) * 64 + lane] = (32 * (t_) + c <= mypos) ? ord_of(sc_) : 0u; } while (0)
    for (int t = 0; t < ntiles; t += 2) { IDX_TILE(t, R0); if (t + 1 < ntiles) IDX_TILE(t + 1, R1); }
#undef IDX_TILE
    unsigned x[NTILE];
#pragma unroll
    for (int t = 0; t < NTILE; ++t) x[t] = (t < ntiles) ? strip[t * 64 + lane] : 0u;
    unsigned tau = 0u; int r_ties = 0;
    if (__any(mypos + 1 > TOPK)) {
        for (int bit = 31; bit >= 0; --bit) { const unsigned cand = tau | (1u << bit); int cnt = 0;
#pragma unroll
            for (int t = 0; t < NTILE; ++t) cnt += (x[t] >= cand) ? 1 : 0;
            cnt = half_sum(cnt);
            if (cnt >= TOPK) tau = cand; }
        int cg = 0;
#pragma unroll
        for (int t = 0; t < NTILE; ++t) cg += (x[t] > tau) ? 1 : 0;
        cg = half_sum(cg);
        r_ties = TOPK - cg;
    }
    if (mypos + 1 <= TOPK) { tau = 0u; r_ties = 0; }
    int eq_before = 0; unsigned* mrow = mask32 + (size_t)(tokbase + myq) * (2 * MASK_WORDS);
#pragma unroll
    for (int t = 0; t < NTILE; ++t) {
        const bool eq = x[t] == tau, gt = x[t] > tau;
        const u64 eqm = __ballot(eq); const unsigned my_eqm = hi ? (unsigned)(eqm >> 32) : (unsigned)eqm;
        const int rank = eq_before + __popc(my_eqm & ((1u << c) - 1u));
        const bool sel = gt || (eq && rank < r_ties);
        eq_before += __popc(my_eqm);
        const u64 sm = __ballot(sel); const unsigned my_sm = hi ? (unsigned)(sm >> 32) : (unsigned)sm;
        if (c == 0 && qvalid) mrow[t] = my_sm;
    }
    if (c < 2 * MASK_WORDS - NTILE && qvalid) mrow[NTILE + c] = 0u;
}
template <bool SAMPLE>
__device__ __forceinline__ void wave_task(const KeySrc<SAMPLE>& ks, const bf16_t* Iq, const float* Iw, int tokbase, int pos0, int nvalid, unsigned* strip, unsigned* mask32, int lane) {
    const int c = lane & 31, hi = lane >> 5;
    const int aq_ = 2 * ((c >> 2) & 1) + (c >> 4), ah = 4 * ((c >> 3) & 1) + (c & 3);
    bf16x8 A[4];
    { const bf16_t* ap = Iq + (size_t)(tokbase + (aq_ < nvalid ? aq_ : nvalid - 1)) * 512 + ah * 64 + hi * 8;
#pragma unroll
      for (int s = 0; s < 4; ++s) A[s] = *reinterpret_cast<const bf16x8*>(ap + 16 * s); }
    const int pmax = pos0 + nvalid - 1; int ntiles = (pmax + 32) >> 5; if (ntiles > NTILE) ntiles = NTILE;
    pass<SAMPLE, 0>(ks, A, Iw, tokbase, pos0, nvalid, ntiles, strip, mask32, lane);
    pass<SAMPLE, 1>(ks, A, Iw, tokbase, pos0, nvalid, ntiles, strip, mask32, lane);
}
}
struct MegaArgs {
    PrepArgs prep;
    const float *cache_k, *cache_v, *cache_kidx, *state_ret; const int* page_table;
    const float *qnw, *knw, *ikw, *ikb;
    bf16_t *Rq, *Rk, *Rv, *G, *Aq, *Kb, *Vb, *Iq, *Ikb, *Gates, *OG, *An, *Odsa, *Mg, *A2, *Hid;
    float *Iw, *ssret, *rstd2, *Z, *M1, *M2, *H2, *Zf, *out;
    u64* mask; unsigned* bar;
};

namespace ret {
using bf16x8 = __attribute__((ext_vector_type(8))) short;
using s16x4  = __attribute__((ext_vector_type(4))) short;
using f32x4  = __attribute__((ext_vector_type(4))) float;
using u32x4  = __attribute__((ext_vector_type(4))) unsigned;
using u32x2  = __attribute__((ext_vector_type(2))) unsigned;
constexpr int QS = 528, VS = 144, PS = 80;
constexpr int OFF_Q = 0, OFF_K = OFF_Q + 32 * QS, OFF_V = OFF_K + 32 * QS, OFF_P = OFF_V + 32 * VS, OFF_ST = OFF_P + 32 * PS, OFF_SS = OFF_ST + 64 * QS, LDS_BYTES = OFF_SS + 32 * 4 * 4;
__device__ __forceinline__ s16x4 trr(int addr) { s16x4 r; asm volatile("ds_read_b64_tr_b16 %0, %1" : "=&v"(r) : "v"(addr) : "memory"); return r; }
__device__ __forceinline__ bf16x8 cat(s16x4 l, s16x4 h) { return (bf16x8){l[0], l[1], l[2], l[3], h[0], h[1], h[2], h[3]}; }
__device__ __forceinline__ u32x4 scale8(u32x4 v, float f) {
    u32x4 o;
#pragma unroll
    for (int i = 0; i < 4; ++i) o[i] = att::cvtpk(__uint_as_float(v[i] << 16) * f, __uint_as_float(v[i] & 0xffff0000u) * f);
    return o;
}
__device__ __forceinline__ void unit(const MegaArgs& a, int unit8, char* lds) {
    int tid_l = threadIdx.x; asm volatile("" : "+v"(tid_l));
    const int tid = tid_l, w = __builtin_amdgcn_readfirstlane(tid >> 6), lane = tid & 63, g = lane >> 4, c15 = lane & 15, q4 = c15 >> 2, p4 = c15 & 3;
    const int bh = unit8 >> 3, sl = unit8 & 7, b = bh >> 2, h = bh & 3;
    const int ldsb = (int)(uintptr_t)(PG8_LAS char*)lds;
    const float lg2 = log2f(1.0f - exp2f(-5.0f - (float)h));
    const int st_tok = tid >> 4, st_seg = tid & 15;
    const float fq = exp2f(lg2 * (float)(st_tok + 1)), fk = exp2f(-lg2 * (float)(st_tok + 1));
    f32x4 S[2][4];
#pragma unroll
    for (int i = 0; i < 2; ++i)
#pragma unroll
        for (int u = 0; u < 4; ++u) S[i][u] = (f32x4){0.f, 0.f, 0.f, 0.f};
    u32x4 rq0, rq1, rk0, rk1; u32x2 rv;
#define RET_LOAD(tok0_, len_) do { const bool ok_ = st_tok < (len_); const size_t r_ = (size_t)((tok0_) + (ok_ ? st_tok : 0)); \
        const u32x4* qp_ = (const u32x4*)(a.Rq + r_ * 1024 + h * 256 + st_seg * 16); const u32x4* kp_ = (const u32x4*)(a.Rk + r_ * 1024 + h * 256 + st_seg * 16); \
        rq0 = qp_[0]; rq1 = qp_[1]; rk0 = kp_[0]; rk1 = kp_[1]; rv = *(const u32x2*)(a.Rv + r_ * 2048 + h * 512 + sl * 64 + st_seg * 4); \
        if (!ok_) { rq0 = rq1 = rk0 = rk1 = (u32x4){0u, 0u, 0u, 0u}; rv = (u32x2){0u, 0u}; } } while (0)
    const int row0 = b * LP;
    RET_LOAD(row0, 16);
    __syncthreads();
    for (int c = 0; c < 65; ++c) {
        const int len = c == 0 ? 16 : 32, tok0 = c == 0 ? row0 : row0 + 16 + 32 * (c - 1);
        *(u32x4*)(lds + OFF_Q + st_tok * QS + st_seg * 32) = scale8(rq0, fq); *(u32x4*)(lds + OFF_Q + st_tok * QS + st_seg * 32 + 16) = scale8(rq1, fq);
        *(u32x4*)(lds + OFF_K + st_tok * QS + st_seg * 32) = scale8(rk0, fk); *(u32x4*)(lds + OFF_K + st_tok * QS + st_seg * 32 + 16) = scale8(rk1, fk);
        *(u32x2*)(lds + OFF_V + st_tok * VS + st_seg * 8) = rv;
#pragma unroll
        for (int i = 0; i < 2; ++i)
#pragma unroll
            for (int u = 0; u < 4; ++u) { u32x2 pk; pk.x = att::cvtpk(S[i][u][0], S[i][u][1]); pk.y = att::cvtpk(S[i][u][2], S[i][u][3]);
                *(u32x2*)(lds + OFF_ST + (16 * u + c15) * QS + (32 * w + 16 * i + 4 * g) * 2) = pk; }
        __syncthreads();
        if (c + 1 < 65) RET_LOAD(row0 + 16 + 32 * c, 32);
        if (w < 3) { const int jt = w >> 1, it = (w + 1) >> 1; f32x4 pacc = {0.f, 0.f, 0.f, 0.f};
#pragma unroll
            for (int s = 0; s < 8; ++s) { const bf16x8 A = *(const bf16x8*)(lds + OFF_K + (16 * jt + c15) * QS + (32 * s + 8 * g) * 2), B = *(const bf16x8*)(lds + OFF_Q + (16 * it + c15) * QS + (32 * s + 8 * g) * 2);
                pacc = __builtin_amdgcn_mfma_f32_16x16x32_bf16(A, B, pacc, 0, 0, 0); }
            const int ig = 16 * it + c15, jg0 = 16 * jt + 4 * g; float pv[4];
#pragma unroll
            for (int r = 0; r < 4; ++r) pv[r] = (jg0 + r <= ig) ? pacc[r] : 0.f;
            u32x2 pk; pk.x = att::cvtpk(pv[0], pv[1]); pk.y = att::cvtpk(pv[2], pv[3]);
            *(u32x2*)(lds + OFF_P + ig * PS + jg0 * 2) = pk; }
        else if (w == 3) { if (lane < 32) *(u32x4*)(lds + OFF_P + (lane >> 1) * PS + 32 + 16 * (lane & 1)) = (u32x4){0u, 0u, 0u, 0u}; }
        { s16x4 vl[4], vh[4], kl[2], kh[2];
#pragma unroll
          for (int u = 0; u < 4; ++u) { const int ad = ldsb + OFF_V + (8 * g + q4) * VS + (16 * u + 4 * p4) * 2; vl[u] = trr(ad); vh[u] = trr(ad + 4 * VS); }
#pragma unroll
          for (int i = 0; i < 2; ++i) { const int ad = ldsb + OFF_K + (8 * g + q4) * QS + (32 * w + 16 * i + 4 * p4) * 2; kl[i] = trr(ad); kh[i] = trr(ad + 4 * QS); }
          asm volatile("s_waitcnt lgkmcnt(0)" ::: "memory"); __builtin_amdgcn_sched_barrier(0);
          const float gl = exp2f(lg2 * (float)len);
#pragma unroll
          for (int i = 0; i < 2; ++i)
#pragma unroll
              for (int u = 0; u < 4; ++u) { S[i][u] = __builtin_amdgcn_mfma_f32_16x16x32_bf16(cat(kl[i], kh[i]), cat(vl[u], vh[u]), S[i][u], 0, 0, 0); S[i][u] *= gl; } }
        __syncthreads();
        { const int dt = w & 3, it = w >> 2; f32x4 o = {0.f, 0.f, 0.f, 0.f};
          { const int ad = ldsb + OFF_V + (8 * g + q4) * VS + (16 * dt + 4 * p4) * 2; const s16x4 lo = trr(ad), hi = trr(ad + 4 * VS);
            const bf16x8 Bp = *(const bf16x8*)(lds + OFF_P + (16 * it + c15) * PS + (8 * g) * 2);
            asm volatile("s_waitcnt lgkmcnt(0)" ::: "memory"); __builtin_amdgcn_sched_barrier(0);
            o = __builtin_amdgcn_mfma_f32_16x16x32_bf16(cat(lo, hi), Bp, o, 0, 0, 0); }
#pragma unroll
          for (int s = 0; s < 8; ++s) { const bf16x8 A = *(const bf16x8*)(lds + OFF_ST + (16 * dt + c15) * QS + (32 * s + 8 * g) * 2), B = *(const bf16x8*)(lds + OFF_Q + (16 * it + c15) * QS + (32 * s + 8 * g) * 2);
              o = __builtin_amdgcn_mfma_f32_16x16x32_bf16(A, B, o, 0, 0, 0); }
          const int i = 16 * it + c15; float ss = o[0] * o[0] + o[1] * o[1] + o[2] * o[2] + o[3] * o[3];
          ss += __shfl_xor(ss, 16); ss += __shfl_xor(ss, 32);
          if (g == 0) ((float*)(lds + OFF_SS))[i * 4 + dt] = ss;
          if (i < len) { const size_t ci = (size_t)(tok0 + i) * 2048 + h * 512 + sl * 64 + 16 * dt + 4 * g; const u32x2 gg = *(const u32x2*)(a.G + ci);
              u32x2 pk; pk.x = att::cvtpk(o[0] * __uint_as_float(gg.x << 16), o[1] * __uint_as_float(gg.x & 0xffff0000u)); pk.y = att::cvtpk(o[2] * __uint_as_float(gg.y << 16), o[3] * __uint_as_float(gg.y & 0xffff0000u));
              *(u32x2*)(a.OG + ci) = pk; } }
        __syncthreads();
        if (tid < len) { const float* sp = (const float*)(lds + OFF_SS) + tid * 4; a.ssret[(size_t)(tok0 + tid) * 32 + h * 8 + sl] = (sp[0] + sp[1]) + (sp[2] + sp[3]); }
    }
    float* so = a.out + (size_t)O_R_P + ((size_t)b * H_RET + h) * (DK_RET * DV_RET) + sl * 64;
#pragma unroll
    for (int i = 0; i < 2; ++i)
#pragma unroll
        for (int u = 0; u < 4; ++u)
#pragma unroll
            for (int r = 0; r < 4; ++r) so[(size_t)(32 * w + 16 * i + 4 * g + r) * DV_RET + 16 * u + c15] = S[i][u][r];
    __syncthreads();
#undef RET_LOAD
}
}
namespace epi {
using f32x4 = pg8::f32x4; using u32x4 = pg8::u32x4; typedef unsigned u32x2 __attribute__((ext_vector_type(2)));
__device__ __forceinline__ unsigned pk(float lo, float hi) { return pg8::cvt_pk_bf16(lo, hi); }
__device__ __forceinline__ u32x4 pack8(const f32x4& a, const f32x4& b) { u32x4 w; w.x = pk(a[0], a[1]); w.y = pk(a[2], a[3]); w.z = pk(b[0], b[1]); w.w = pk(b[2], b[3]); return w; }
__device__ __forceinline__ float bflo(unsigned w) { return __uint_as_float(w << 16); }
__device__ __forceinline__ float bfhi(unsigned w) { return __uint_as_float(w & 0xffff0000u); }
__device__ __forceinline__ f32x4 silu4(f32x4 x) { f32x4 o;
#pragma unroll
    for (int j = 0; j < 4; ++j) o[j] = x[j] * __builtin_amdgcn_rcpf(1.0f + __expf(-x[j])); return o; }
__device__ __forceinline__ f32x4 sigm4(f32x4 x) { f32x4 o;
#pragma unroll
    for (int j = 0; j < 4; ++j) o[j] = __builtin_amdgcn_rcpf(1.0f + __expf(-x[j])); return o; }

struct Epi1 {
    static constexpr bool PERM = true, AFTER_DRAIN = false;
    const float* rstd0; const float2* rope; const float *ikw, *ikb;
    bf16_t *Rq, *Rk, *Rv, *G, *Aq, *Vb, *Iq, *Ikb, *Gates; float* Iw; float* out; int gz0;
    template <int TY> __device__ __forceinline__ void run(const f32x4 (&acc)[2][2][4][2], int pm, int wr, int wc, int fr, int fq, bf16_t* dbase, int ld, float* fbase, float* fbase_s, float post, int isv) const {
        const int cl = wc * 32 + 8 * fq;
        float rsv[8];
#pragma unroll
        for (int i = 0; i < 8; ++i) { const int row = pm * 256 + (i >> 2) * 128 + wr * 64 + (i & 3) * 16 + fr; rsv[i] = rstd0[row < T_ALL ? row : T_ALL - 1]; }
#pragma unroll
        for (int ai = 0; ai < 2; ++ai)
#pragma unroll
            for (int m = 0; m < 4; ++m) {
                const int row = pm * 256 + ai * 128 + wr * 64 + m * 16 + fr; const bool ok = row < T_ALL; const int rowc = ok ? row : T_ALL - 1;
                const float rs = rsv[ai * 4 + m];
                f32x4 v[2][2];
#pragma unroll
                for (int bj = 0; bj < 2; ++bj)
#pragma unroll
                    for (int n = 0; n < 2; ++n) v[bj][n] = acc[ai][bj][m][n] * rs;
                if constexpr (TY == 0) {
                    bf16_t* dst = dbase + (size_t)rowc * 1024 + cl;
                    const float4* rp = (const float4*)(rope + (size_t)row_pos(rowc) * 128 + cl);
                    f32x4 o1[2], o2[2];
#pragma unroll
                    for (int n = 0; n < 2; ++n) { const float4 cs0 = rp[2 * n], cs1 = rp[2 * n + 1]; const float c[4] = {cs0.x, cs0.z, cs1.x, cs1.z}, s[4] = {cs0.y, cs0.w, cs1.y, cs1.w};
#pragma unroll
                        for (int j = 0; j < 4; ++j) { o1[n][j] = (v[0][n][j] * c[j] - v[1][n][j] * s[j]) * post; o2[n][j] = (v[0][n][j] * s[j] + v[1][n][j] * c[j]) * post; } }
                    if (ok) { *(u32x4*)dst = pack8(o1[0], o1[1]); *(u32x4*)(dst + 128) = pack8(o2[0], o2[1]); }
                } else if constexpr (TY == 1 || TY == 2 || TY == 3) {
                    bf16_t* dst = dbase + (size_t)rowc * ld + cl;
                    if constexpr (TY == 2) { v[0][0] = silu4(v[0][0]); v[0][1] = silu4(v[0][1]); v[1][0] = silu4(v[1][0]); v[1][1] = silu4(v[1][1]); }
                    if constexpr (TY == 3) { v[0][0] = sigm4(v[0][0]); v[0][1] = sigm4(v[0][1]); v[1][0] = sigm4(v[1][0]); v[1][1] = sigm4(v[1][1]); }
                    if (ok) { *(u32x4*)dst = pack8(v[0][0], v[0][1]); *(u32x4*)(dst + 128) = pack8(v[1][0], v[1][1]); }
                } else if constexpr (TY == 4) {
                    float* dst = (rowc < T_PROMPT ? fbase + (size_t)rowc * 256 : fbase_s + (size_t)(rowc - T_PROMPT) * 256) + cl;
                    if (ok) { *(f32x4*)dst = v[0][0]; *(f32x4*)(dst + 4) = v[0][1]; *(f32x4*)(dst + 128) = v[1][0]; *(f32x4*)(dst + 132) = v[1][1];
                        if (isv) { bf16_t* vb = Vb + (size_t)rowc * 256 + cl; *(u32x4*)vb = pack8(v[0][0], v[0][1]); *(u32x4*)(vb + 128) = pack8(v[1][0], v[1][1]); } }
                } else {
                    if (wc == 0) {
                        float s = 0.f;
#pragma unroll
                        for (int bj = 0; bj < 2; ++bj)
#pragma unroll
                            for (int n = 0; n < 2; ++n) s += (v[bj][n][0] + v[bj][n][1]) + (v[bj][n][2] + v[bj][n][3]);
                        s += __shfl_xor(s, 16); s += __shfl_xor(s, 32);
                        const float mu = s * (1.0f / 64.0f); float q = 0.f;
#pragma unroll
                        for (int bj = 0; bj < 2; ++bj)
#pragma unroll
                            for (int n = 0; n < 2; ++n) { const f32x4 d = v[bj][n] - mu; q += (d[0] * d[0] + d[1] * d[1]) + (d[2] * d[2] + d[3] * d[3]); }
                        q += __shfl_xor(q, 16); q += __shfl_xor(q, 32);
                        const float rn = rsqrtf(q * (1.0f / 64.0f) + NORM_EPS);
                        float* ko = out + (rowc < T_PROMPT ? (size_t)O_KI_P + (size_t)rowc * 64 : (size_t)O_KI_S + (size_t)(rowc - T_PROMPT) * 64);
#pragma unroll
                        for (int bj = 0; bj < 2; ++bj) { const int e0 = 32 * bj + 8 * fq; f32x4 y[2];
#pragma unroll
                            for (int n = 0; n < 2; ++n) { const f32x4 wv = *(const f32x4*)(ikw + e0 + 4 * n), bv = *(const f32x4*)(ikb + e0 + 4 * n); y[n] = (v[bj][n] - mu) * rn * wv + bv; }
                            if (ok) { *(f32x4*)(ko + e0) = y[0]; *(f32x4*)(ko + e0 + 4) = y[1]; *(u32x4*)(Ikb + (size_t)rowc * 64 + e0) = pack8(y[0], y[1]); } }
                    } else if (wc == 1 && fq == 0) {
                        if (ok) { *(f32x4*)(Iw + (size_t)rowc * 8) = v[0][0] * IDX_SCALE; *(f32x4*)(Iw + (size_t)rowc * 8 + 4) = v[0][1] * IDX_SCALE; }
                    }
                }
            }
    }
    __device__ __forceinline__ void operator()(const f32x4 (&acc)[2][2][4][2], const pg8::Unit& u, int wr, int wc, int fr_in, int fq_in) const {
        int fr = fr_in, fq = fq_in; asm volatile("" : "+v"(fr), "+v"(fq));
        const int pn = u.pn + gz0, pm = u.pm;
        if (pn < 4)        run<0>(acc, pm, wr, wc, fr, fq, Rq + pn * 256, 1024, nullptr, nullptr, 1.0f, 0);
        else if (pn < 8)   run<0>(acc, pm, wr, wc, fr, fq, Rk + (pn - 4) * 256, 1024, nullptr, nullptr, 0.0625f, 0);
        else if (pn < 16)  run<1>(acc, pm, wr, wc, fr, fq, Rv + (pn - 8) * 256, 2048, nullptr, nullptr, 1.0f, 0);
        else if (pn < 24)  run<2>(acc, pm, wr, wc, fr, fq, G + (pn - 16) * 256, 2048, nullptr, nullptr, 1.0f, 0);
        else if (pn < 28)  run<1>(acc, pm, wr, wc, fr, fq, Aq + (pn - 24) * 256, 1024, nullptr, nullptr, 1.0f, 0);
        else if (pn == 28) run<4>(acc, pm, wr, wc, fr, fq, nullptr, 0, out + O_K_P, out + O_K_S, 1.0f, 0);
        else if (pn == 29) run<4>(acc, pm, wr, wc, fr, fq, nullptr, 0, out + O_V_P, out + O_V_S, 1.0f, 1);
        else if (pn < 32)  run<1>(acc, pm, wr, wc, fr, fq, Iq + (pn - 30) * 256, 512, nullptr, nullptr, 1.0f, 0);
        else if (pn == 32) run<5>(acc, pm, wr, wc, fr, fq, nullptr, 0, nullptr, nullptr, 1.0f, 0);
        else               run<3>(acc, pm, wr, wc, fr, fq, Gates + (pn - 33 + gz0) * 256, 2048, nullptr, nullptr, 1.0f, 0);
    }
};
struct EpiRet {
    static constexpr bool PERM = false, AFTER_DRAIN = false;
    float* M1;
    __device__ __forceinline__ void operator()(const f32x4 (&acc)[2][2][4][2], const pg8::Unit& u, int wr, int wc, int fr_in, int fq_in) const {
        int fr = fr_in, fq = fq_in; asm volatile("" : "+v"(fr), "+v"(fq));
#pragma unroll
        for (int ai = 0; ai < 2; ++ai)
#pragma unroll
            for (int m = 0; m < 4; ++m) { const int row = u.pm * 256 + ai * 128 + wr * 64 + m * 16 + fr;
#pragma unroll
                for (int bj = 0; bj < 2; ++bj)
#pragma unroll
                    for (int n = 0; n < 2; ++n) *(f32x4*)(M1 + (size_t)row * 1024 + u.pn * 256 + bj * 128 + wc * 32 + 16 * n + 4 * fq) = acc[ai][bj][m][n]; }
    }
};
struct EpiDsa {
    static constexpr bool PERM = false, AFTER_DRAIN = false;
    const bf16_t* Gates; const float* M1; bf16_t* Mg;
    __device__ __forceinline__ void operator()(const f32x4 (&acc)[2][2][4][2], const pg8::Unit& u, int wr, int wc, int fr_in, int fq_in) const {
        int fr = fr_in, fq = fq_in; asm volatile("" : "+v"(fr), "+v"(fq));
#pragma unroll
        for (int ai = 0; ai < 2; ++ai)
#pragma unroll
            for (int mp = 0; mp < 2; ++mp) {
                u32x2 gr[2][2][2], gd[2][2][2]; f32x4 mv[2][2][2];
#pragma unroll
                for (int mm = 0; mm < 2; ++mm) { const int row = u.pm * 256 + ai * 128 + wr * 64 + (2 * mp + mm) * 16 + fr;
#pragma unroll
                    for (int bj = 0; bj < 2; ++bj)
#pragma unroll
                        for (int n = 0; n < 2; ++n) { const int col = u.pn * 256 + bj * 128 + wc * 32 + 16 * n + 4 * fq;
                            gr[mm][bj][n] = *(const u32x2*)(Gates + (size_t)row * 2048 + col); gd[mm][bj][n] = *(const u32x2*)(Gates + (size_t)row * 2048 + 1024 + col); mv[mm][bj][n] = *(const f32x4*)(M1 + (size_t)row * 1024 + col); } }
#pragma unroll
                for (int mm = 0; mm < 2; ++mm) { const int m = 2 * mp + mm, row = u.pm * 256 + ai * 128 + wr * 64 + m * 16 + fr;
#pragma unroll
                    for (int bj = 0; bj < 2; ++bj)
#pragma unroll
                        for (int n = 0; n < 2; ++n) { const int col = u.pn * 256 + bj * 128 + wc * 32 + 16 * n + 4 * fq;
                            const f32x4 g1 = {bflo(gr[mm][bj][n].x), bfhi(gr[mm][bj][n].x), bflo(gr[mm][bj][n].y), bfhi(gr[mm][bj][n].y)}, g2 = {bflo(gd[mm][bj][n].x), bfhi(gd[mm][bj][n].x), bflo(gd[mm][bj][n].y), bfhi(gd[mm][bj][n].y)};
                            const f32x4 r = mv[mm][bj][n] * g1 + acc[ai][bj][m][n] * g2;
                            u32x2 w; w.x = pk(r[0], r[1]); w.y = pk(r[2], r[3]); *(u32x2*)(Mg + (size_t)row * 1024 + col) = w; } } }
    }
};
struct EpiOut {
    static constexpr bool PERM = false, AFTER_DRAIN = false;
    const float *xp, *xs, *meta; float* H2; bf16_t* A2; float* ss2;
    __device__ __forceinline__ void operator()(const f32x4 (&acc)[2][2][4][2], const pg8::Unit& u, int wr, int wc, int fr_in, int fq_in) const {
        int fr = fr_in, fq = fq_in; asm volatile("" : "+v"(fr), "+v"(fq));
#pragma unroll
        for (int ai = 0; ai < 2; ++ai) {
            f32x4 hv[4][2][2];
#pragma unroll
            for (int m = 0; m < 4; ++m) { const int row = u.pm * 256 + ai * 128 + wr * 64 + m * 16 + fr; const float* h = h_row_ptr(row < T_ALL ? row : 0, xp, xs, meta);
#pragma unroll
                for (int bj = 0; bj < 2; ++bj)
#pragma unroll
                    for (int n = 0; n < 2; ++n) hv[m][bj][n] = *(const f32x4*)(h + u.pn * 256 + bj * 128 + wc * 32 + 16 * n + 4 * fq); }
#pragma unroll
            for (int m = 0; m < 4; ++m) { const int row = u.pm * 256 + ai * 128 + wr * 64 + m * 16 + fr; const bool ok = row < T_ALL; float ss = 0.f;
#pragma unroll
                for (int bj = 0; bj < 2; ++bj)
#pragma unroll
                    for (int n = 0; n < 2; ++n) { const int col = u.pn * 256 + bj * 128 + wc * 32 + 16 * n + 4 * fq; f32x4 r = acc[ai][bj][m][n]; if (ok) r += hv[m][bj][n];
                        *(f32x4*)(H2 + (size_t)row * 1024 + col) = r; u32x2 w; w.x = pk(r[0], r[1]); w.y = pk(r[2], r[3]); *(u32x2*)(A2 + (size_t)row * 1024 + col) = w;
                        ss += (r[0] * r[0] + r[1] * r[1]) + (r[2] * r[2] + r[3] * r[3]); }
                ss += __shfl_xor(ss, 16); ss += __shfl_xor(ss, 32);
                if (fq == 0) atomicAdd(ss2 + row, ss); } }
    }
};
struct EpiFfi {
    static constexpr bool PERM = true, AFTER_DRAIN = false;
    const float* ss2; bf16_t* Hid;
    __device__ __forceinline__ void operator()(const f32x4 (&acc)[2][2][4][2], const pg8::Unit& u, int wr, int wc, int fr_in, int fq_in) const {
        int fr = fr_in, fq = fq_in; asm volatile("" : "+v"(fr), "+v"(fq));
        float sv[8];
#pragma unroll
        for (int i = 0; i < 8; ++i) sv[i] = ss2[u.pm * 256 + (i >> 2) * 128 + wr * 64 + (i & 3) * 16 + fr];
#pragma unroll
        for (int ai = 0; ai < 2; ++ai)
#pragma unroll
            for (int m = 0; m < 4; ++m) { const int row = u.pm * 256 + ai * 128 + wr * 64 + m * 16 + fr;
                const float rs = rsqrtf(sv[ai * 4 + m] * (1.0f / 1024.0f) + NORM_EPS);
                f32x4 hv[2];
#pragma unroll
                for (int n = 0; n < 2; ++n) hv[n] = silu4(acc[ai][0][m][n] * rs) * (acc[ai][1][m][n] * rs);
                *(u32x4*)(Hid + (size_t)row * D_FF + u.pn * 128 + wc * 32 + 8 * fq) = pack8(hv[0], hv[1]); }
    }
};
struct EpiFfo {
    static constexpr bool PERM = false, AFTER_DRAIN = false;
    const float* H2; float* out;
    __device__ __forceinline__ void operator()(const f32x4 (&acc)[2][2][4][2], const pg8::Unit& u, int wr, int wc, int fr_in, int fq_in) const {
        int fr = fr_in, fq = fq_in; asm volatile("" : "+v"(fr), "+v"(fq));
#pragma unroll
        for (int ai = 0; ai < 2; ++ai) {
            f32x4 hv[4][2][2];
#pragma unroll
            for (int m = 0; m < 4; ++m) { const int row = u.pm * 256 + ai * 128 + wr * 64 + m * 16 + fr;
#pragma unroll
                for (int bj = 0; bj < 2; ++bj)
#pragma unroll
                    for (int n = 0; n < 2; ++n) hv[m][bj][n] = *(const f32x4*)(H2 + (size_t)row * 1024 + u.pn * 256 + bj * 128 + wc * 32 + 16 * n + 4 * fq); }
#pragma unroll
            for (int m = 0; m < 4; ++m) { const int row = u.pm * 256 + ai * 128 + wr * 64 + m * 16 + fr; float* dst = nullptr;
                if (row < T_PROMPT) { const int b = row / LP, l = row % LP; if (l >= N_META) dst = out + O_Y_P + ((size_t)b * SEQ + (l - N_META)) * 1024; }
                else if (row < T_ALL) dst = out + O_Y_S + (size_t)(row - T_PROMPT) * 1024;
                if (dst) {
#pragma unroll
                    for (int bj = 0; bj < 2; ++bj)
#pragma unroll
                        for (int n = 0; n < 2; ++n) *(f32x4*)(dst + u.pn * 256 + bj * 128 + wc * 32 + 16 * n + 4 * fq) = hv[m][bj][n] + acc[ai][bj][m][n]; } } }
    }
};
}
#define RETS_N_TASKS (DEC_BATCH * H_RET * 8)
__device__ __forceinline__ void ret_sample_task(const MegaArgs& a, int task, float* qk  , int lane) {
    const int sl = task & 7, h = (task >> 3) & 3, db = task >> 5, r0 = T_PROMPT + db * DEC_SEQ;
    { const int which = lane >> 5, ch = lane & 31; const bf16_t* src = (which ? a.Rk : a.Rq) + (size_t)r0 * 1024 + h * 256 + ch * 8;
#pragma unroll
      for (int i = 0; i < 8; ++i) { const uint4 v = *(const uint4*)(src + (size_t)i * 1024); const unsigned wv[4] = {v.x, v.y, v.z, v.w};
#pragma unroll
          for (int e = 0; e < 4; ++e) { qk[(ch * 8 + 2 * e) * 16 + which * 8 + i] = __uint_as_float(wv[e] << 16); qk[(ch * 8 + 2 * e + 1) * 16 + which * 8 + i] = __uint_as_float(wv[e] & 0xffff0000u); } } }
    float v[8], o[8]; const int dv = sl * 64 + lane;
#pragma unroll
    for (int i = 0; i < 8; ++i) { v[i] = bf2f(a.Rv[(size_t)(r0 + i) * 2048 + h * 512 + dv]); o[i] = 0.f; }
    const float gamma = 1.0f - exp2f(-5.0f - (float)h);
    const size_t sb = ((size_t)db * H_RET + h) * (DK_RET * DV_RET) + dv;
    const float* sin_ = a.state_ret + sb; float* sout = a.out + (size_t)O_R_S + sb;
    for (int dk0 = 0; dk0 < 256; dk0 += 32) {
        float s[32];
#pragma unroll
        for (int j = 0; j < 32; ++j) s[j] = __builtin_nontemporal_load(sin_ + (size_t)(dk0 + j) * DV_RET);
#pragma unroll
        for (int j = 0; j < 32; ++j) { const float4* c = (const float4*)(qk + (dk0 + j) * 16); const float4 q0 = c[0], q1 = c[1], k0 = c[2], k1 = c[3];
            const float qq[8] = {q0.x, q0.y, q0.z, q0.w, q1.x, q1.y, q1.z, q1.w}, kk[8] = {k0.x, k0.y, k0.z, k0.w, k1.x, k1.y, k1.z, k1.w};
#pragma unroll
            for (int i = 0; i < 8; ++i) { s[j] = fmaf(s[j], gamma, kk[i] * v[i]); o[i] = fmaf(qq[i], s[j], o[i]); }
            __builtin_nontemporal_store(s[j], sout + (size_t)(dk0 + j) * DV_RET); }
    }
#pragma unroll
    for (int i = 0; i < 8; ++i) { float ss = o[i] * o[i];
#pragma unroll
        for (int of = 32; of >= 1; of >>= 1) ss += __shfl_xor(ss, of);
        const size_t ci = (size_t)(r0 + i) * 2048 + h * 512 + dv;
        a.OG[ci] = f2bf(o[i] * bf2f(a.G[ci]));
        if (lane == 0) a.ssret[(size_t)(r0 + i) * 32 + h * 8 + sl] = ss; }
}

__device__ __forceinline__ void make_an_row(const MegaArgs& a, int r, int lane) {
    const float4* sp = (const float4*)(a.ssret + (size_t)r * 32);
    float rn[4];
#pragma unroll
    for (int h = 0; h < 4; ++h) { const float4 s0 = sp[2 * h], s1 = sp[2 * h + 1]; rn[h] = rsqrtf(((s0.x + s0.y) + (s0.z + s0.w) + (s1.x + s1.y) + (s1.z + s1.w)) * (1.0f / 512.0f) + NORM_EPS); }
#pragma unroll
    for (int h = 0; h < 4; ++h) { const uint4 v = ((const uint4*)(a.OG + (size_t)r * 2048))[h * 64 + lane]; const float f = rn[h]; uint4 o;
        o.x = pg8::cvt_pk_bf16(__uint_as_float(v.x << 16) * f, __uint_as_float(v.x & 0xffff0000u) * f); o.y = pg8::cvt_pk_bf16(__uint_as_float(v.y << 16) * f, __uint_as_float(v.y & 0xffff0000u) * f);
        o.z = pg8::cvt_pk_bf16(__uint_as_float(v.z << 16) * f, __uint_as_float(v.z & 0xffff0000u) * f); o.w = pg8::cvt_pk_bf16(__uint_as_float(v.w << 16) * f, __uint_as_float(v.w & 0xffff0000u) * f);
        ((uint4*)(a.An + (size_t)r * 2048))[h * 64 + lane] = o; }
}
__device__ __forceinline__ void knorm_row(const MegaArgs& a, int r, int lane) {
    float* kp = a.out + (r < T_PROMPT ? (size_t)O_K_P + (size_t)r * 256 : (size_t)O_K_S + (size_t)(r - T_PROMPT) * 256) + lane * 4;
    const float4 x = *(const float4*)kp; float ss = x.x * x.x + x.y * x.y + x.z * x.z + x.w * x.w;
#pragma unroll
    for (int o = 16; o >= 1; o >>= 1) ss += __shfl_xor(ss, o);
    const float rn = rsqrtf(ss * (1.0f / 128.0f) + NORM_EPS); const float4 w = *(const float4*)(a.knw + (lane & 31) * 4);
    const float4 y = make_float4(x.x * rn * w.x, x.y * rn * w.y, x.z * rn * w.z, x.w * rn * w.w);
    *(float4*)kp = y;
    uint2 o; o.x = (unsigned)f2bf(y.x) | ((unsigned)f2bf(y.y) << 16); o.y = (unsigned)f2bf(y.z) | ((unsigned)f2bf(y.w) << 16);
    *(uint2*)(a.Kb + (size_t)r * 256 + lane * 4) = o;
}
#define IDX_N_SAMPLE_TASKS (DEC_BATCH * 2)
#define IDX_N_PROMPT_TASKS (BATCH * (LP / 4))
#define IDX_N_TASKS (IDX_N_SAMPLE_TASKS + IDX_N_PROMPT_TASKS)
__device__ __forceinline__ void idx_task(const MegaArgs& a, int k, unsigned char* shm, int wave, int lane) {
    unsigned* strip = (unsigned*)(shm + (size_t)wave * idx::WAVE_LDS); unsigned* mask32 = (unsigned*)a.mask;
    if (k < IDX_N_SAMPLE_TASKS) {
        const int db = k >> 1, q0 = 4 * (k & 1);
        const int pgv = a.page_table[db * N_PAGES + (lane & 15)];
        idx::KeySrc<true> ks{a.Ikb + (size_t)(T_PROMPT + db * DEC_SEQ) * 64, a.cache_kidx, pgv};
        idx::wave_task<true>(ks, a.Iq, a.Iw, T_PROMPT + db * DEC_SEQ + q0, PAST_LEN + q0, 4, strip, mask32, lane);
    } else {
        const int pk = k - IDX_N_SAMPLE_TASKS, b = pk & 7, l0 = 4 * (LP / 4 - 1 - (pk >> 3));
        idx::KeySrc<false> ks{a.Ikb + (size_t)b * LP * 64, nullptr, 0};
        idx::wave_task<false>(ks, a.Iq, a.Iw, b * LP + l0, l0, 4, strip, mask32, lane);
    }
}
#define ATT_N_PROMPT_UNITS (BATCH * N_KV * 33)
__device__ __forceinline__ void attn_prompt_unit(const MegaArgs& a, int idx, char* lds) {
    const int qb = 32 - idx / 16, bn = idx % 16, b = bn >> 1, n = bn & 1;
    const int tok0 = b * LP + 64 * qb, nq = (LP - 64 * qb) < 64 ? (LP - 64 * qb) : 64;
    const int NT = qb + 1;
    att::KvPrompt kv{a.Kb + (size_t)b * LP * 256 + n * 128, a.Vb + (size_t)b * LP * 256 + n * 128};
    att::attn_unit<att::KvPrompt>(kv, a.Aq, a.qnw, a.mask, a.Odsa, tok0, nq, 4 * n, NT, lds);
}
__device__ __forceinline__ void attn_sample_unit(const MegaArgs& a, int u, char* lds) {
    const int db = u >> 1, n = u & 1;
    int* pages = (int*)(lds + 2 * att::SHM_V + 2 * att::SHM_K + 2048);
    __syncthreads();
    if (threadIdx.x < N_PAGES) pages[threadIdx.x] = a.page_table[db * N_PAGES + threadIdx.x];
    __syncthreads();
    att::KvSample kv{a.cache_k, a.cache_v, a.out + O_K_S + (size_t)db * DEC_SEQ * 256 + n * 128, a.out + O_V_S + (size_t)db * DEC_SEQ * 256 + n * 128, pages, n};
    att::attn_unit<att::KvSample>(kv, a.Aq, a.qnw, a.mask, a.Odsa, T_PROMPT + db * DEC_SEQ, DEC_SEQ, 4 * n, 33, lds);
}

#define LDS_TOTAL (8 * idx::WAVE_LDS + 2048)
__global__ void __launch_bounds__(512, 2) mega(MegaArgs a) {
    extern __shared__ __attribute__((aligned(16))) unsigned char shm[];
    float* lds = (float*)shm;
    volatile LAS unsigned* xbw = (volatile LAS unsigned*)(PG8_LAS unsigned char*)(shm + LDS_TOTAL - 16);
    const int tid = threadIdx.x, wave = tid >> 6, lane = tid & 63, half = tid >> 8, G = gridDim.x, bid = blockIdx.x;
    if (tid == 0) { xbw[0] = 0u; xbw[1] = 0u; xbw[2] = 0u; xbw[3] = 0u; }
    __syncthreads();
    XcdBarrier bar = xcd_barrier_post(a.bar, xbw);
    for (int jp = bid; jp < PREP_J_ROWS / 2; jp += G) prep_job(a.prep, 2 * jp + half, lds + half * (32 * 65));
    for (int j = PREP_J_ROWS + bid * 2 + half; j < PREP_N_JOBS; j += 2 * G) prep_job(a.prep, j, lds);
    for (int i = bid * 512 + tid; i < T_PAD; i += G * 512) a.rstd2[i] = 0.f;
    xcd_barrier(bar);
    { pg8::StaticOrder S; S.init(T_PAD, N1, G, bid);
      epi::Epi1 E{a.prep.rstd0, a.prep.rope, a.ikw, a.ikb, a.Rq, a.Rk, a.Rv, a.G, a.Aq, a.Vb, a.Iq, a.Ikb, a.Gates, a.Iw, a.out, 0};
      pg8::gemm_phase<epi::Epi1, pg8::StaticOrder, false>((PG8_LAS unsigned char*)shm, pg8::Gemm{a.prep.A0, a.prep.W1t, T_PAD, N1, 1024}, S, E, nullptr); }
    xcd_barrier(bar);
    for (int u = bid; u < BATCH * H_RET * 8; u += G) ret::unit(a, u, (char*)shm);
    { int tl = threadIdx.x; asm volatile("" : "+v"(tl)); const int wv = __builtin_amdgcn_readfirstlane(tl >> 6), NW = 8 * G, g = wv * G + bid;
      float* strip = (float*)(shm + (size_t)wv * idx::WAVE_LDS);
      for (int step = 0; step < 6; ++step) { const int i = step >> 1;
          int ln_o = tl & 63; asm volatile("" : "+v"(ln_o)); const int ln = ln_o;
          if ((step + wv) & 1) { const int pi = i * NW + ((i & 1) ? (NW - 1 - g) : g); if (pi < IDX_N_TASKS) idx_task(a, pi, shm, wv, ln); }
          else                 { const int pr = i * NW + g; if (pr < RETS_N_TASKS) ret_sample_task(a, pr, strip, ln); } } }
    for (int r = bid * 8 + wave; r < T_ALL; r += 8 * G) knorm_row(a, r, lane);
    xcd_barrier(bar);
    for (int i = 0; ; ++i) { const long p = (long)i * G + ((i & 1) ? (G - 1 - bid) : bid); if (p >= ATT_N_PROMPT_UNITS) { if ((long)i * G >= ATT_N_PROMPT_UNITS) break; else continue; } attn_prompt_unit(a, (int)p, (char*)shm); }
    for (int u = bid; u < DEC_BATCH * N_KV; u += G) attn_sample_unit(a, u, (char*)shm);
    for (int r = bid * 8 + wave; r < T_ALL; r += 8 * G) make_an_row(a, r, lane);
    xcd_barrier(bar);
    { pg8::StaticOrder S; S.init(T_PAD, 1024, G, bid); pg8::gemm_phase<epi::EpiRet, pg8::StaticOrder, false>((PG8_LAS unsigned char*)shm, pg8::Gemm{a.An, a.prep.Wret, T_PAD, 1024, 2048}, S, epi::EpiRet{a.M1}, nullptr); }
    { pg8::StaticOrder S; S.init(T_PAD, 1024, G, bid); pg8::gemm_phase<epi::EpiDsa, pg8::StaticOrder, false>((PG8_LAS unsigned char*)shm, pg8::Gemm{a.Odsa, a.prep.Wdsa, T_PAD, 1024, 1024}, S, epi::EpiDsa{a.Gates, a.M1, a.Mg}, nullptr); }
    xcd_barrier(bar);
    { pg8::StaticOrder S; S.init(T_PAD, 1024, G, bid); pg8::gemm_phase<epi::EpiOut, pg8::StaticOrder, false>((PG8_LAS unsigned char*)shm, pg8::Gemm{a.Mg, a.prep.Wout, T_PAD, 1024, 1024}, S, epi::EpiOut{a.prep.x_prompt, a.prep.x_sample, a.prep.meta, a.H2, a.A2, a.rstd2}, nullptr); }
    xcd_barrier(bar);
    { pg8::StaticOrder S; S.init(T_PAD, NFF2, G, bid); pg8::gemm_phase<epi::EpiFfi, pg8::StaticOrder, false>((PG8_LAS unsigned char*)shm, pg8::Gemm{a.A2, a.prep.Wffi, T_PAD, NFF2, 1024}, S, epi::EpiFfi{a.rstd2, a.Hid}, nullptr); }
    xcd_barrier(bar);
    { pg8::StaticOrder S; S.init(T_PAD, 1024, G, bid); pg8::gemm_phase<epi::EpiFfo, pg8::StaticOrder, false>((PG8_LAS unsigned char*)shm, pg8::Gemm{a.Hid, a.prep.Wffo, T_PAD, 1024, 2816}, S, epi::EpiFfo{a.H2, a.out}, nullptr); }
}
extern "C" void kernel_launch(void* const* d_in, const int* in_sizes, int n_in, void* d_out, int out_size, void* d_ws, size_t ws_size, hipStream_t stream) {
    static int grid = 0;
    if (grid == 0) {
        if (n_in != 20 || out_size != OUT_TOTAL || ws_size < WS_END_B1 || ws_size < WS_END_B2) { fprintf(stderr, "kernel_launch: unexpected shapes (n_in %d out %d ws %zu need %llu)\n", n_in, out_size, ws_size, (unsigned long long)WS_END_B1); grid = -1; return; }
        int dev = 0, cus = 0, per_cu = 0;
        if (hipGetDevice(&dev) != hipSuccess || hipDeviceGetAttribute(&cus, hipDeviceAttributeMultiprocessorCount, dev) != hipSuccess) { grid = -1; return; }
        if (hipFuncSetAttribute((const void*)mega, hipFuncAttributeMaxDynamicSharedMemorySize, LDS_TOTAL) != hipSuccess) { fprintf(stderr, "kernel_launch: hipFuncSetAttribute failed\n"); grid = -1; return; }
        if (hipOccupancyMaxActiveBlocksPerMultiprocessor(&per_cu, (const void*)mega, 512, LDS_TOTAL) != hipSuccess || per_cu < 1) { fprintf(stderr, "kernel_launch: occupancy query says %d blocks per CU\n", per_cu); grid = -1; return; }
        grid = cus;
    }
    if (grid < 0) return;
    char* ws = (char*)d_ws;
    MegaArgs a{};
    a.prep.x_prompt = (const float*)d_in[0]; a.prep.x_sample = (const float*)d_in[1]; a.prep.meta = (const float*)d_in[7]; a.prep.norm_mix_w = (const float*)d_in[8]; a.prep.w_in = (const float*)d_in[9];
    a.prep.w_ret = (const float*)d_in[10]; a.prep.w_dsa = (const float*)d_in[15]; a.prep.w_out = (const float*)d_in[16]; a.prep.norm_ffn_w = (const float*)d_in[17]; a.prep.w_ffi = (const float*)d_in[18]; a.prep.w_ffo = (const float*)d_in[19];
    a.prep.W1t = (bf16_t*)(ws + WS_W1T); a.prep.Wret = (bf16_t*)(ws + WS_WRET); a.prep.Wdsa = (bf16_t*)(ws + WS_WDSA); a.prep.Wout = (bf16_t*)(ws + WS_WOUT); a.prep.Wffi = (bf16_t*)(ws + WS_WFFI); a.prep.Wffo = (bf16_t*)(ws + WS_WFFO);
    a.prep.A0 = (bf16_t*)(ws + WS_A0); a.prep.rstd0 = (float*)(ws + WS_RSTD0); a.prep.rope = (float2*)(ws + WS_ROPE);
    a.cache_k = (const float*)d_in[2]; a.cache_v = (const float*)d_in[3]; a.cache_kidx = (const float*)d_in[4]; a.state_ret = (const float*)d_in[5]; a.page_table = (const int*)d_in[6];
    a.qnw = (const float*)d_in[11]; a.knw = (const float*)d_in[12]; a.ikw = (const float*)d_in[13]; a.ikb = (const float*)d_in[14];
    a.Rq = (bf16_t*)(ws + WS_RQ); a.Rk = (bf16_t*)(ws + WS_RK); a.Rv = (bf16_t*)(ws + WS_RV); a.G = (bf16_t*)(ws + WS_G); a.Aq = (bf16_t*)(ws + WS_AQ); a.Kb = (bf16_t*)(ws + WS_KB); a.Vb = (bf16_t*)(ws + WS_VB);
    a.Iq = (bf16_t*)(ws + WS_IQ); a.Ikb = (bf16_t*)(ws + WS_IKB); a.Gates = (bf16_t*)(ws + WS_GATES); a.OG = (bf16_t*)(ws + WS_OG); a.An = (bf16_t*)(ws + WS_AN); a.Odsa = (bf16_t*)(ws + WS_ODSA); a.Mg = (bf16_t*)(ws + WS_MG);
    a.A2 = (bf16_t*)(ws + WS_A2); a.Hid = (bf16_t*)(ws + WS_HID);
    a.Iw = (float*)(ws + WS_IW); a.ssret = (float*)(ws + WS_SSRET); a.rstd2 = (float*)(ws + WS_RSTD2); a.Z = (float*)(ws + WS_Z); a.M1 = (float*)(ws + WS_M1); a.M2 = (float*)(ws + WS_M2); a.H2 = (float*)(ws + WS_H2); a.Zf = (float*)(ws + WS_ZF);
    a.out = (float*)d_out; a.mask = (u64*)(ws + WS_MASK); a.bar = (unsigned*)(ws + WS_CTL);
    if (hipMemsetAsync(ws + WS_CTL, 0, 65536, stream) != hipSuccess) return;
    hipLaunchKernelGGL(mega, dim3(grid), dim3(512), LDS_TOTAL, stream, a);
}
```

```cpp
#include <hip/hip_runtime.h>
#include <stdint.h>
#include <stdio.h>

#define D_MODEL 1024
#define BATCH 8
#define SEQ 2048
#define N_META 16
#define LP (N_META + SEQ)
#define DEC_BATCH 128
#define DEC_SEQ 8
#define PAST_LEN 2048
#define PAGE_SIZE 128
#define N_PAGES 16
#define H_RET 4
#define DK_RET 256
#define DV_RET 512
#define N_HEADS 8
#define N_KV 2
#define D_HEAD 128
#define N_IDXH 8
#define D_IDX 64
#define TOPK 256
#define D_FF 2816
#define IN_COLS 10312
#define NORM_EPS 1e-6f
#define IDX_SCALE 0.04419417382415922f
#define T_PROMPT (BATCH * LP)
#define T_SAMPLE (DEC_BATCH * DEC_SEQ)
#define T_ALL (T_PROMPT + T_SAMPLE)
#define T_PAD 17664
#define N1 10496
#define NFF2 5632
#define MASK_WORDS 34
#define SAMPLE_L (PAST_LEN + DEC_SEQ)

#define O_Y_P   0
#define O_Y_S   16777216
#define O_K_P   17825792
#define O_V_P   22052864
#define O_KI_P  26279936
#define O_R_P   27336704
#define O_K_S   31531008
#define O_V_S   31793152
#define O_KI_S  32055296
#define O_R_S   32120832
#define OUT_TOTAL 99229696

typedef unsigned short bf16_t;
typedef unsigned long long u64;

__device__ __forceinline__ bf16_t f2bf(float f) { unsigned u = __float_as_uint(f); u += 0x7FFFu + ((u >> 16) & 1u); return (bf16_t)(u >> 16); }
__device__ __forceinline__ float bf2f(bf16_t b) { return __uint_as_float(((unsigned)b) << 16); }
__device__ __forceinline__ float silu_f(float x) { return x / (1.0f + __expf(-x)); }
__device__ __forceinline__ float sigmoid_f(float x) { return 1.0f / (1.0f + __expf(-x)); }

__device__ __forceinline__ int row_pos(int r) { return r < T_PROMPT ? (r % LP) : (PAST_LEN + ((r - T_PROMPT) & (DEC_SEQ - 1))); }

#define WS_CTL      0ull
#define WS_W1T      (WS_CTL + 65536ull)
#define WS_WRET     (WS_W1T + (u64)N1 * 1024 * 2)
#define WS_WDSA     (WS_WRET + 1024ull * 2048 * 2)
#define WS_WOUT     (WS_WDSA + 1024ull * 1024 * 2)
#define WS_WFFI     (WS_WOUT + 1024ull * 1024 * 2)
#define WS_WFFO     (WS_WFFI + (u64)NFF2 * 1024 * 2)
#define WS_ROPE     (WS_WFFO + 1024ull * 2816 * 2)
#define WS_RSTD0    (WS_ROPE + (u64)LP * 128 * 8)
#define WS_A0       (WS_RSTD0 + (u64)T_PAD * 4)
#define WS_RQ       (WS_A0 + (u64)T_PAD * 1024 * 2)
#define WS_RK       (WS_RQ + (u64)T_PAD * 1024 * 2)
#define WS_RV       (WS_RK + (u64)T_PAD * 1024 * 2)
#define WS_G        (WS_RV + (u64)T_PAD * 2048 * 2)
#define WS_AQ       (WS_G + (u64)T_PAD * 2048 * 2)
#define WS_KB       (WS_AQ + (u64)T_PAD * 1024 * 2)
#define WS_VB       (WS_KB + (u64)T_PAD * 256 * 2)
#define WS_IQ       (WS_VB + (u64)T_PAD * 256 * 2)
#define WS_IKB      (WS_IQ + (u64)T_PAD * 512 * 2)
#define WS_IW       (WS_IKB + (u64)T_PAD * 64 * 2)
#define WS_GATES    (WS_IW + (u64)T_PAD * 8 * 4)
#define WS_MASK     (WS_GATES + (u64)T_PAD * 2048 * 2)
#define WS_SSRET    (WS_MASK + (u64)T_PAD * MASK_WORDS * 8)
#define WS_RSTD2    (WS_SSRET + (u64)T_PAD * 32 * 4)
#define WS_REGION_B (((WS_RSTD2 + (u64)T_PAD * 16 * 4) + 4095ull) & ~4095ull)
#define WS_Z        WS_REGION_B
#define WS_H2       WS_REGION_B
#define WS_A2       (WS_H2 + (u64)T_PAD * 1024 * 4)
#define WS_HID      (WS_A2 + (u64)T_PAD * 1024 * 2)
#define WS_MG       (WS_HID + (u64)T_PAD * 2816 * 2)
#define WS_OG       (WS_MG + (u64)T_PAD * 1024 * 2)
#define WS_AN       (WS_OG + (u64)T_PAD * 2048 * 2)
#define WS_ODSA     (WS_AN + (u64)T_PAD * 2048 * 2)
#define WS_M1       (WS_ODSA + (u64)T_PAD * 1024 * 2)
#define WS_M2       (WS_M1 + (u64)T_PAD * 1024 * 4)
#define WS_ZF       WS_OG
#define WS_END_B1   (WS_Z + (u64)T_PAD * N1 * 4)
#define WS_END_B2   (WS_ZF + (u64)T_PAD * NFF2 * 4)
namespace pg8 {
#define PG8_LAS __attribute__((address_space(3)))
typedef unsigned short bf16_t;
typedef short bf16x8 __attribute__((ext_vector_type(8)));
typedef float f32x4 __attribute__((ext_vector_type(4)));
typedef unsigned u32x4 __attribute__((ext_vector_type(4)));
constexpr int BM = 256, BK = 64, HALF = 128, HTB = HALF * BK * 2  , STAGE_BYTES = 8 * HTB, NXCD = 8, WGM = 8;

__host__ __device__ __forceinline__ int lds_byte(int r, int c) { const int st = (r >> 4) * 2 + (c >> 5), rr = r & 15, cc = c & 31, ob = rr * 64 + cc * 2; return st * 1024 + (ob ^ (((ob >> 9) & 1) << 5)); }
__host__ __device__ __forceinline__ void stage_rc(int b, int& R, int& C) { const int st = b / 1024, sb = b % 1024, swz = sb ^ (((sb >> 9) & 1) << 5); R = (st >> 1) * 16 + swz / 64; C = (st & 1) * 32 + (swz % 64) / 2; }
__host__ __device__ __forceinline__ int perm32(int rho) { const int n = rho >> 4, i = rho & 15; return 8 * (i >> 2) + 4 * n + (i & 3); }

struct Unit { int pm, pn; };
struct Gemm { const bf16_t* A; const bf16_t* Bt; int M, N, K; };

struct StaticOrder {
    int nM, nN, nwg, G, c;
    __host__ __device__ void init(int M, int N, int G_, int c_) { nM = M / BM; nN = N / BM; nwg = nM * nN; G = G_; c = c_; }
    __host__ __device__ bool next(int i, Unit& u) const {
        const long L = (long)i * G + c; if (L >= nwg) return false;
        int wgid = (int)L; { const int q = nwg / NXCD, r = nwg % NXCD, xcd = wgid % NXCD, off = wgid / NXCD; wgid = (xcd < r ? xcd * (q + 1) : r * (q + 1) + (xcd - r) * q) + off; }
        const int nig = WGM * nN, gid = wgid / nig, fm = gid * WGM, gsz = (nM - fm) < WGM ? (nM - fm) : WGM;
        u.pm = fm + ((wgid % nig) % gsz); u.pn = (wgid % nig) / gsz; return true;
    }
    __device__ __forceinline__ void a_ready(const Unit&) const {}
    __device__ __forceinline__ void done(const Unit&) const {}
};
struct CountedOrder : StaticOrder {
    const unsigned* ready; unsigned need; unsigned* tmo;
    __device__ __forceinline__ void a_ready(const Unit& u) const {
        if (threadIdx.x < 64) {
            const unsigned long long t0 = __builtin_amdgcn_s_memrealtime(); unsigned polls = 0;
            while ((unsigned)__builtin_amdgcn_readfirstlane(__hip_atomic_load(ready + 64 * u.pm, __ATOMIC_RELAXED, __HIP_MEMORY_SCOPE_AGENT)) < need) {
                if ((++polls & 255u) == 0u && __builtin_amdgcn_readfirstlane(__hip_atomic_load(tmo, __ATOMIC_RELAXED, __HIP_MEMORY_SCOPE_AGENT)) != 0u) break;
                if (__builtin_amdgcn_s_memrealtime() - t0 > 2000000ull) {
                    if (threadIdx.x == 0) { unsigned expect = 0u; __hip_atomic_compare_exchange_strong(tmo + 1, &expect, 0x600u | (unsigned)(u.pm & 0xff), __ATOMIC_RELAXED, __ATOMIC_RELAXED, __HIP_MEMORY_SCOPE_AGENT); __hip_atomic_store(tmo, 1u, __ATOMIC_RELAXED, __HIP_MEMORY_SCOPE_AGENT); }
                    break; }
                __builtin_amdgcn_s_sleep(2); }
            __builtin_amdgcn_fence(__ATOMIC_ACQUIRE, "agent");
            asm volatile("s_waitcnt vmcnt(0)" ::: "memory");
        }
#if !defined(BROKEN_HOOK_NO_BARRIER)
        asm volatile("" ::: "memory"); __builtin_amdgcn_s_barrier(); asm volatile("" ::: "memory");
#endif
    }
};

typedef float f32x2c __attribute__((ext_vector_type(2))); typedef __bf16 bf16x2c __attribute__((ext_vector_type(2)));
__device__ __forceinline__ unsigned cvt_pk_bf16(float lo, float hi) { const f32x2c v = {lo, hi}; return __builtin_bit_cast(unsigned, __builtin_convertvector(v, bf16x2c)); }
typedef float f32x2 __attribute__((ext_vector_type(2)));
__device__ __forceinline__ f32x2 gelu_pk(f32x2 v) {
    const f32x2 av = __builtin_elementwise_abs(v), d = av * 0.2316418882f + 1.0f;
    f32x2 t; t.x = __builtin_amdgcn_rcpf(d.x); t.y = __builtin_amdgcn_rcpf(d.y);
    f32x2 q = t * 0.5307027145f + (-0.7265760135f); q = q * t + 0.7107068705f; q = q * t + (-0.142248368f); q = q * t + 0.127414796f; q = q * t;
    const f32x2 s = (v * v) * (-0.72134752044f);
    f32x2 e; e.x = __builtin_amdgcn_exp2f(s.x); e.y = __builtin_amdgcn_exp2f(s.y);
    const f32x2 m = v * (q * e), r = v - m;
    f32x2 o; o.x = v.x < 0.f ? m.x : r.x; o.y = v.y < 0.f ? m.y : r.y; return o;
}

struct EpiF32 {
    static constexpr bool PERM = false, AFTER_DRAIN = false;
    float* C; int ldc; const float* bias;
    __device__ __forceinline__ void operator()(const f32x4 (&acc)[2][2][4][2], const Unit& u, int wr, int wc, int fr, int fq) const {
        const int row0 = u.pm * BM + wr * 64 + fr, col0 = u.pn * BM + wc * 32 + 4 * fq;
        f32x4 bv[2][2];
#pragma unroll
        for (int bj = 0; bj < 2; ++bj)
#pragma unroll
            for (int n = 0; n < 2; ++n) bv[bj][n] = bias ? *(const f32x4*)(bias + col0 + bj * HALF + n * 16) : (f32x4){0.f, 0.f, 0.f, 0.f};
#pragma unroll
        for (int ai = 0; ai < 2; ++ai)
#pragma unroll
            for (int m = 0; m < 4; ++m) { float* rowp = C + (size_t)(row0 + ai * HALF + m * 16) * ldc + col0;
#pragma unroll
                for (int bj = 0; bj < 2; ++bj)
#pragma unroll
                    for (int n = 0; n < 2; ++n) *(f32x4*)(rowp + bj * HALF + n * 16) = acc[ai][bj][m][n] + bv[bj][n]; }
    }
};
template <int ACT  > struct EpiBf16 {
    static constexpr bool PERM = true, AFTER_DRAIN = false;
    bf16_t* O; int ldc; const float* bias; int split_cols; size_t split_stride;
    __device__ __forceinline__ void operator()(const f32x4 (&acc)[2][2][4][2], const Unit& u, int wr, int wc, int fr, int fq) const {
        const int row0 = u.pm * BM + wr * 64 + fr; int colt = u.pn * BM; bf16_t* base = O;
        if (split_cols) { const int t = colt / split_cols; base += (size_t)t * split_stride; colt -= t * split_cols; }
        const int col0 = colt + wc * 32 + 8 * fq, bcol0 = u.pn * BM + wc * 32 + 8 * fq;
        f32x4 bv[2][2];
#pragma unroll
        for (int bj = 0; bj < 2; ++bj)
#pragma unroll
            for (int n = 0; n < 2; ++n) bv[bj][n] = bias ? *(const f32x4*)(bias + bcol0 + bj * HALF + 4 * n) : (f32x4){0.f, 0.f, 0.f, 0.f};
#pragma unroll
        for (int ai = 0; ai < 2; ++ai)
#pragma unroll
            for (int m = 0; m < 4; ++m) { bf16_t* rowp = base + (size_t)(row0 + ai * HALF + m * 16) * ldc + col0;
#pragma unroll
                for (int bj = 0; bj < 2; ++bj) { f32x4 v0 = acc[ai][bj][m][0] + bv[bj][0], v1 = acc[ai][bj][m][1] + bv[bj][1];
                    if (ACT == 1) { f32x2 a = gelu_pk((f32x2){v0[0], v0[1]}), b = gelu_pk((f32x2){v0[2], v0[3]}), c = gelu_pk((f32x2){v1[0], v1[1]}), d = gelu_pk((f32x2){v1[2], v1[3]});
                        v0 = (f32x4){a.x, a.y, b.x, b.y}; v1 = (f32x4){c.x, c.y, d.x, d.y}; }
                    if (ACT == 2) {
#pragma unroll
                        for (int j = 0; j < 4; ++j) { v0[j] = 0.5f * v0[j] * (1.0f + erff(v0[j] * 0.70710678f)); v1[j] = 0.5f * v1[j] * (1.0f + erff(v1[j] * 0.70710678f)); } }
                    u32x4 w; w.x = cvt_pk_bf16(v0[0], v0[1]); w.y = cvt_pk_bf16(v0[2], v0[3]); w.z = cvt_pk_bf16(v1[0], v1[1]); w.w = cvt_pk_bf16(v1[2], v1[3]);
                    *(u32x4*)(rowp + bj * HALF) = w; } }
    }
};
template <class Epi, class Sched, bool STAMP = false>
__device__ __forceinline__ void gemm_phase(PG8_LAS unsigned char* lds, const Gemm g, const Sched& S, const Epi& E, unsigned long long* stamps) {
    int tid_l = threadIdx.x; asm volatile("" : "+v"(tid_l));
    const int tid = tid_l, wid = __builtin_amdgcn_readfirstlane(tid >> 6), lane = tid & 63, wr = wid >> 2, wc = wid & 3, fr = lane & 15, fq = lane >> 4;
    const int K = g.K, nt = K / BK;
    int ts_lo = 0, ts_hi = 0, nts = 0; const unsigned long long rt_entry = STAMP ? (unsigned long long)wall_clock64() : 0ull;
#define PG8_STAMP() do { if (STAMP && wid == 0 && nts < 64) { const unsigned long long _c = (unsigned long long)clock64(); \
        ts_lo = (lane == nts) ? (int)(unsigned)_c : ts_lo; ts_hi = (lane == nts) ? (int)(unsigned)(_c >> 32) : ts_hi; ++nts; } } while (0)
    PG8_STAMP();
    unsigned voffA[2], voffB[2];
#pragma unroll
    for (int i = 0; i < 2; ++i) { int R, C; stage_rc(tid * 16 + i * 8192, R, C); const int Rb = Epi::PERM ? ((R & ~31) + perm32(R & 31)) : R;
        voffA[i] = (unsigned)(R * K + C) * 2u; voffB[i] = (unsigned)(Rb * K + C) * 2u; }
    const size_t kstep = (size_t)(BK * 2);
    const size_t hstep = (size_t)HALF * K * 2;
    const size_t tstep = 2 * hstep;
    const unsigned ldsw = (unsigned)wid * 1024u;
    const int aoff = lds_byte(wr * 64 + fr, fq * 8), boff = lds_byte(wc * 32 + fr, fq * 8);
#define PG8_SA(b, h) (((b) * 2 + (h)) * HTB)
#define PG8_SB(b, h) ((4 + (b) * 2 + (h)) * HTB)
#define PG8_STAGE(bufoff, gbase, voff) do { _Pragma("unroll") for (int _i = 0; _i < 2; ++_i) \
        __builtin_amdgcn_global_load_lds((const unsigned*)((const char*)(gbase) + (voff)[_i]), (PG8_LAS unsigned*)(lds + (bufoff) + ldsw + _i * 8192), 16, 0, 0); } while (0)
#define PG8_LDA(dst, b, h) do { _Pragma("unroll") for (int m = 0; m < 4; ++m) _Pragma("unroll") for (int k = 0; k < 2; ++k) dst[m][k] = *(const PG8_LAS bf16x8*)(lds + PG8_SA(b, h) + aoff + m * 2048 + k * 1024); } while (0)
#define PG8_LDB(dst, b, h) do { _Pragma("unroll") for (int n = 0; n < 2; ++n) _Pragma("unroll") for (int k = 0; k < 2; ++k) dst[n][k] = *(const PG8_LAS bf16x8*)(lds + PG8_SB(b, h) + boff + n * 2048 + k * 1024); } while (0)
#define PG8_MMA(ai, bj, At, Bt) do { __builtin_amdgcn_s_setprio(1); _Pragma("unroll") for (int m = 0; m < 4; ++m) _Pragma("unroll") for (int n = 0; n < 2; ++n) _Pragma("unroll") for (int k = 0; k < 2; ++k) \
        acc[ai][bj][m][n] = __builtin_amdgcn_mfma_f32_16x16x32_bf16(Bt[n][k], At[m][k], acc[ai][bj][m][n], 0, 0, 0); __builtin_amdgcn_s_setprio(0); } while (0)
#define PG8_WAIT_V(n) asm volatile("s_waitcnt vmcnt(" #n ")" ::: "memory")
#define PG8_WAIT_L(n) asm volatile("s_waitcnt lgkmcnt(" #n ")" ::: "memory")
#define PG8_BAR __builtin_amdgcn_s_barrier()
#define PG8_SCHED __builtin_amdgcn_sched_barrier(0)
    Unit cur, nxt; int ui = 0;
    if (!S.next(0, cur)) return;
    f32x4 acc[2][2][4][2];
#pragma unroll
    for (int a = 0; a < 2; ++a)
#pragma unroll
        for (int b = 0; b < 2; ++b)
#pragma unroll
            for (int m = 0; m < 4; ++m)
#pragma unroll
                for (int n = 0; n < 2; ++n) acc[a][b][m][n] = (f32x4){0.f, 0.f, 0.f, 0.f};
    bf16x8 At[4][2], B0[2][2], B1[2][2];
    const char* cA = (const char*)g.A + (size_t)cur.pm * tstep; const char* cB = (const char*)g.Bt + (size_t)cur.pn * tstep;
    S.a_ready(cur);
    PG8_STAGE(PG8_SB(0, 0), cB, voffB); PG8_STAGE(PG8_SA(0, 0), cA, voffA); PG8_STAGE(PG8_SB(0, 1), cB + hstep, voffB); PG8_STAGE(PG8_SA(0, 1), cA + hstep, voffA);
    if (wr == 1) PG8_BAR;
    PG8_WAIT_V(4); PG8_BAR;
    PG8_STAGE(PG8_SB(1, 0), cB + kstep, voffB); PG8_STAGE(PG8_SA(1, 0), cA + kstep, voffA); PG8_STAGE(PG8_SB(1, 1), cB + hstep + kstep, voffB);
    PG8_WAIT_V(6); PG8_BAR;
    PG8_STAMP();
    for (;;) {
        const bool has_next = S.next(ui + 1, nxt);
        const char* nA = has_next ? (const char*)g.A + (size_t)nxt.pm * tstep : cA; const char* nB = has_next ? (const char*)g.Bt + (size_t)nxt.pn * tstep : cB;
        for (int t = 0; t < nt; t += 2) {
            const bool last = (t == nt - 2);
            const char* a1 = cA + (size_t)(t + 1) * kstep;
            const char* a2 = last ? nA : cA + (size_t)(t + 2) * kstep; const char* b2 = last ? nB : cB + (size_t)(t + 2) * kstep;
            const char* a3 = a2 + kstep; const char* b3 = b2 + kstep;
            if (last && has_next) S.a_ready(nxt);
            PG8_LDB(B0, 0, 0); PG8_SCHED; PG8_LDA(At, 0, 0); PG8_STAGE(PG8_SA(1, 1), a1 + hstep, voffA);
            PG8_WAIT_L(8); PG8_BAR; PG8_WAIT_L(0); PG8_MMA(0, 0, At, B0); PG8_BAR; PG8_SCHED;
            PG8_LDB(B1, 0, 1); PG8_STAGE(PG8_SB(0, 0), b2, voffB);
            PG8_BAR; PG8_WAIT_L(0); PG8_MMA(0, 1, At, B1); PG8_BAR;
            PG8_LDA(At, 0, 1); PG8_STAGE(PG8_SA(0, 0), a2, voffA);
            PG8_BAR; PG8_WAIT_L(0); PG8_MMA(1, 0, At, B0); PG8_BAR; PG8_SCHED;
            PG8_STAGE(PG8_SB(0, 1), b2 + hstep, voffB);
            PG8_WAIT_V(6); PG8_BAR; PG8_MMA(1, 1, At, B1); PG8_BAR;
            PG8_LDB(B0, 1, 0); PG8_SCHED; PG8_LDA(At, 1, 0); PG8_STAGE(PG8_SA(0, 1), a2 + hstep, voffA);
            PG8_WAIT_L(8); PG8_BAR; PG8_WAIT_L(0); PG8_MMA(0, 0, At, B0); PG8_BAR; PG8_SCHED;
            PG8_LDB(B1, 1, 1); PG8_STAGE(PG8_SB(1, 0), b3, voffB);
            PG8_BAR; PG8_WAIT_L(0); PG8_MMA(0, 1, At, B1); PG8_BAR;
            PG8_LDA(At, 1, 1); PG8_STAGE(PG8_SA(1, 0), a3, voffA);
            PG8_BAR; PG8_WAIT_L(0); PG8_MMA(1, 0, At, B0); PG8_BAR; PG8_SCHED;
            PG8_STAGE(PG8_SB(1, 1), b3 + hstep, voffB);
            PG8_WAIT_V(6); PG8_BAR; PG8_MMA(1, 1, At, B1); PG8_BAR;
        }
        PG8_STAMP();
        if constexpr (!Epi::AFTER_DRAIN) { E(acc, cur, wr, wc, fr, fq); S.done(cur); }
        PG8_STAMP();
        if (!has_next) break;
#pragma unroll
        for (int a = 0; a < 2; ++a)
#pragma unroll
            for (int b = 0; b < 2; ++b)
#pragma unroll
                for (int m = 0; m < 4; ++m)
#pragma unroll
                    for (int n = 0; n < 2; ++n) acc[a][b][m][n] = (f32x4){0.f, 0.f, 0.f, 0.f};
        cur = nxt; cA = nA; cB = nB; ++ui;
    }
    PG8_WAIT_V(0);
    if (wr == 0) PG8_BAR;
    PG8_BAR;
    if constexpr (Epi::AFTER_DRAIN) { E.fused(acc, cur, wr, wc, fr, fq, lds, wid, lane); S.done(cur); }
    PG8_STAMP();
    if (STAMP && wid == 0) { stamps[lane] = lane < nts ? (((unsigned long long)(unsigned)ts_hi << 32) | (unsigned)ts_lo) : 0ull;
        if (lane == 62) stamps[62] = rt_entry; if (lane == 63) stamps[63] = (unsigned long long)wall_clock64(); }
#undef PG8_STAMP
#undef PG8_SA
#undef PG8_SB
#undef PG8_STAGE
#undef PG8_LDA
#undef PG8_LDB
#undef PG8_MMA
#undef PG8_WAIT_V
#undef PG8_WAIT_L
#undef PG8_BAR
#undef PG8_SCHED
}
}
#define XB_TMO      128
#define XB_XCNT(j)  (256  + 64 * (j))
#define XB_XSUB(j)  (1280 + 64 * (j))
#define XB_XGEN(j)  (2304 + 64 * (j))
#define XB_TOP      3328
#define XB_TOPGEN   3392
#define XCD_BAR_WORDS 3456
#define XB_SPIN_CAP (1u << 18)
#define LAS __attribute__((address_space(3)))

__device__ __forceinline__ unsigned xb_ld(unsigned* p)              { return __hip_atomic_load(p, __ATOMIC_RELAXED, __HIP_MEMORY_SCOPE_AGENT); }
__device__ __forceinline__ unsigned xb_add(unsigned* p, unsigned v) { return __hip_atomic_fetch_add(p, v, __ATOMIC_RELAXED, __HIP_MEMORY_SCOPE_AGENT); }
__device__ __forceinline__ unsigned xb_xcc_id() { return (unsigned)__builtin_amdgcn_s_getreg((3 << 11) | 20) & 0xFu; }
#define XB_SPIN(cond, bar) do { unsigned _sp = 0; while (cond) { __builtin_amdgcn_s_sleep(1); \
    if ((++_sp & 255u) == 0u) { if (xb_ld(&(bar)[XB_TMO])) break; if (_sp > XB_SPIN_CAP) { atomicAdd(&(bar)[XB_TMO], 1u); break; } } } } while (0)

struct XcdBarrier {
    unsigned* bar; unsigned x;
    volatile LAS unsigned* st;
};

__device__ __forceinline__ XcdBarrier xcd_barrier_post(unsigned* bar, volatile LAS unsigned* st) {
    XcdBarrier b; b.bar = bar; b.x = xb_xcc_id(); b.st = st;
    if (threadIdx.x == 0) (void)xb_add(&bar[XB_XCNT(b.x)], 1u);
    return b;
}
__device__ __forceinline__ void xcd_barrier_complete(unsigned* bar, unsigned x, unsigned& nloc, unsigned& nx) {
    const unsigned G = gridDim.x * gridDim.y * gridDim.z;
    unsigned sum, cnt, mine, sp = 0u;
    for (;;) {
        sum = 0u; cnt = 0u; mine = 0u;
#pragma unroll
        for (unsigned j = 0; j < 16; ++j) { const unsigned c = xb_ld(&bar[XB_XCNT(j)]); sum += c; cnt += (c > 0u) ? 1u : 0u; mine = (j == x) ? c : mine; }
        if (sum == G) break;
        __builtin_amdgcn_s_sleep(1);
        if ((++sp & 255u) == 0u) { if (xb_ld(&bar[XB_TMO])) break; if (sp > XB_SPIN_CAP) { atomicAdd(&bar[XB_TMO], 1u); break; } }
    }
    nloc = mine > 0u ? mine : 1u; nx = cnt > 0u ? cnt : 1u;
}

__device__ __forceinline__ void xcd_barrier(const XcdBarrier& b) {
    asm volatile("s_waitcnt vmcnt(0)" ::: "memory");
    __syncthreads();
    if (threadIdx.x == 0) {
        unsigned* bar = b.bar;
        __builtin_amdgcn_s_waitcnt(0);
        unsigned nloc = b.st[0], nx = b.st[1];
        if (nloc == 0u) { xcd_barrier_complete(bar, b.x, nloc, nx); b.st[0] = nloc; b.st[1] = nx; }
        const unsigned old = xb_add(&bar[XB_XSUB(b.x)], 1u);
        const unsigned gen = old / nloc;
        if (old + 1u == (gen + 1u) * nloc) {
            __builtin_amdgcn_fence(__ATOMIC_RELEASE, "agent");
            asm volatile("s_waitcnt vmcnt(0)" ::: "memory");
            const unsigned og = xb_add(&bar[XB_TOP], 1u);
            const unsigned tg = og / nx;
            if (og + 1u == (tg + 1u) * nx) xb_add(&bar[XB_TOPGEN], 1u);
            else XB_SPIN(xb_ld(&bar[XB_TOPGEN]) == tg, bar);
            __builtin_amdgcn_fence(__ATOMIC_ACQUIRE, "agent");
            xb_add(&bar[XB_XGEN(b.x)], 1u);
            asm volatile("s_waitcnt vmcnt(0)" ::: "memory");
        } else {
            XB_SPIN(xb_ld(&bar[XB_XGEN(b.x)]) == gen, bar);
            __builtin_amdgcn_fence(__ATOMIC_ACQUIRE, "agent");
            asm volatile("s_waitcnt vmcnt(0)" ::: "memory");
        }
    }
    __syncthreads();
}
__host__ __device__ __forceinline__ int ikiw_src(int c) {
    if (c < 32) return 8192 + c;
    if (c < 40) return 8256 + (c - 32);
    if (c >= 128 && c < 160) return 8192 + 32 + (c - 128);
    return -1;
}
__host__ __device__ __forceinline__ int ik_tilecol(int e) { return e < 32 ? e : 128 + (e - 32); }
__device__ __forceinline__ int src_col(int mode, int n) {
    if (mode == 0) return n;
    if (mode == 1) { if (n < 8192) return n; if (n < 8448) return ikiw_src(n - 8192); return 8264 + (n - 8448); }
    const int pn = n >> 8, c = n & 255; return c < 128 ? pn * 128 + c : D_FF + pn * 128 + (c - 128);
}
__device__ __forceinline__ void prep_weight_tile(const float* __restrict__ w, int ldw, const float* __restrict__ scale, bf16_t* __restrict__ Wt, int K, int mode, int tile, float* lds  ) {
    const int ktiles = K / 64, nt = tile / ktiles, kt = tile % ktiles, tid = threadIdx.x & 255;
    const int n0 = nt * 64, k0 = kt * 64;
    {   const int nn = tid & 63, kk0 = tid >> 6; const int sc = src_col(mode, n0 + nn); float v[16];
#pragma unroll
        for (int i = 0; i < 16; ++i) { const int kk = kk0 + i * 4; v[i] = sc >= 0 ? w[(size_t)(k0 + kk) * ldw + sc] : 0.f; }
        if (scale) {
#pragma unroll
            for (int i = 0; i < 16; ++i) v[i] *= scale[k0 + kk0 + i * 4]; }
#pragma unroll
        for (int i = 0; i < 16; ++i) lds[(kk0 + i * 4) * 65 + nn] = v[i]; }
    __syncthreads();
    {   const int kp = tid & 31, nn0 = tid >> 5;
#pragma unroll
        for (int i = 0; i < 8; ++i) { const int nn = nn0 + i * 8; ((unsigned*)(Wt + (size_t)(n0 + nn) * K + k0))[kp] = (unsigned)f2bf(lds[(2 * kp) * 65 + nn]) | ((unsigned)f2bf(lds[(2 * kp + 1) * 65 + nn]) << 16); } }
    __syncthreads();
}
__device__ __forceinline__ const float* h_row_ptr(int r, const float* xp, const float* xs, const float* meta) {
    if (r < T_PROMPT) { const int b = r / LP, l = r % LP; return l < N_META ? meta + (size_t)l * D_MODEL : xp + ((size_t)b * SEQ + (l - N_META)) * D_MODEL; }
    return xs + (size_t)(r - T_PROMPT) * D_MODEL;
}
__device__ __forceinline__ void prep_row(int r, const float* xp, const float* xs, const float* meta, bf16_t* A0, float* rstd0, int lane) {
    if (r >= T_ALL) { for (int i = lane; i < D_MODEL / 2; i += 64) ((unsigned*)(A0 + (size_t)r * D_MODEL))[i] = 0u; if (lane == 0) rstd0[r] = 0.f; return; }
    const float4* src = (const float4*)h_row_ptr(r, xp, xs, meta); float ss = 0.f;
#pragma unroll
    for (int i = 0; i < 4; ++i) { const float4 v = src[lane + i * 64]; ss += v.x * v.x + v.y * v.y + v.z * v.z + v.w * v.w;
        uint2 o; o.x = (unsigned)f2bf(v.x) | ((unsigned)f2bf(v.y) << 16); o.y = (unsigned)f2bf(v.z) | ((unsigned)f2bf(v.w) << 16);
        ((uint2*)(A0 + (size_t)r * D_MODEL))[lane + i * 64] = o; }
#pragma unroll
    for (int o = 32; o >= 1; o >>= 1) ss += __shfl_xor(ss, o);
    if (lane == 0) rstd0[r] = rsqrtf(ss * (1.0f / D_MODEL) + NORM_EPS);
}
__device__ __forceinline__ void rope_entry(int idx, float2* tab) {
    const int pos = idx >> 7, i = idx & 127;
    const float inv = exp2f(-(float)i * (13.287712379549449f / 128.0f));
    const float angf = (float)pos * inv; const double a = (double)angf;
    const double kq = rint(a * 0.63661977236758134308);
    double r = fma(-kq, 1.57079632679489655800e+00, a); r = fma(-kq, 6.12323399573676603587e-17, r);
    const double r2 = r * r;
    const double sp = r * (1.0 + r2 * (-1.0 / 6 + r2 * (1.0 / 120 + r2 * (-1.0 / 5040 + r2 * (1.0 / 362880 + r2 * (-1.0 / 39916800 + r2 * (1.0 / 6227020800.0)))))));
    const double cp = 1.0 + r2 * (-0.5 + r2 * (1.0 / 24 + r2 * (-1.0 / 720 + r2 * (1.0 / 40320 + r2 * (-1.0 / 3628800 + r2 * (1.0 / 479001600 + r2 * (-1.0 / 87178291200.0)))))));
    const int q = ((int)kq) & 3;
    const double sv = (q == 0) ? sp : (q == 1) ? cp : (q == 2) ? -sp : -cp;
    const double cv = (q == 0) ? cp : (q == 1) ? -sp : (q == 2) ? -cp : sp;
    tab[idx] = make_float2((float)cv, (float)sv);
}

struct PrepArgs {
    const float *x_prompt, *x_sample, *meta, *norm_mix_w, *w_in, *w_ret, *w_dsa, *w_out, *norm_ffn_w, *w_ffi, *w_ffo;
    bf16_t *W1t, *Wret, *Wdsa, *Wout, *Wffi, *Wffo, *A0; float* rstd0; float2* rope;
};
#define PREP_J_W1   0
#define PREP_N_W1   ((N1 / 64) * (1024 / 64))
#define PREP_J_WRET (PREP_J_W1 + PREP_N_W1)
#define PREP_N_WRET ((1024 / 64) * (2048 / 64))
#define PREP_J_WDSA (PREP_J_WRET + PREP_N_WRET)
#define PREP_N_WDSA ((1024 / 64) * (1024 / 64))
#define PREP_J_WOUT (PREP_J_WDSA + PREP_N_WDSA)
#define PREP_N_WOUT ((1024 / 64) * (1024 / 64))
#define PREP_J_WFFI (PREP_J_WOUT + PREP_N_WOUT)
#define PREP_N_WFFI ((NFF2 / 64) * (1024 / 64))
#define PREP_J_WFFO (PREP_J_WFFI + PREP_N_WFFI)
#define PREP_N_WFFO ((1024 / 64) * (2816 / 64))
#define PREP_J_ROWS (PREP_J_WFFO + PREP_N_WFFO)
#define PREP_N_ROWS (T_PAD / 4)
#define PREP_J_ROPE (PREP_J_ROWS + PREP_N_ROWS)
#define PREP_N_ROPE ((LP * 128) / 256)
#define PREP_N_JOBS (PREP_J_ROPE + PREP_N_ROPE)
__device__ __forceinline__ void prep_job(const PrepArgs& a, int job, float* lds) {
    if (job < PREP_J_WRET)      prep_weight_tile(a.w_in, IN_COLS, a.norm_mix_w, a.W1t, 1024, 1, job - PREP_J_W1, lds);
    else if (job < PREP_J_WDSA) prep_weight_tile(a.w_ret, 1024, nullptr, a.Wret, 2048, 0, job - PREP_J_WRET, lds);
    else if (job < PREP_J_WOUT) prep_weight_tile(a.w_dsa, 1024, nullptr, a.Wdsa, 1024, 0, job - PREP_J_WDSA, lds);
    else if (job < PREP_J_WFFI) prep_weight_tile(a.w_out, 1024, nullptr, a.Wout, 1024, 0, job - PREP_J_WOUT, lds);
    else if (job < PREP_J_WFFO) prep_weight_tile(a.w_ffi, 2 * D_FF, a.norm_ffn_w, a.Wffi, 1024, 2, job - PREP_J_WFFI, lds);
    else if (job < PREP_J_ROWS) prep_weight_tile(a.w_ffo, 1024, nullptr, a.Wffo, 2816, 0, job - PREP_J_WFFO, lds);
    else if (job < PREP_J_ROPE) prep_row((job - PREP_J_ROWS) * 4 + ((threadIdx.x & 255) >> 6), a.x_prompt, a.x_sample, a.meta, a.A0, a.rstd0, threadIdx.x & 63);
    else rope_entry((job - PREP_J_ROPE) * 256 + (threadIdx.x & 255), a.rope);
}
namespace att {
using bf16x8 = __attribute__((ext_vector_type(8))) short;
using s16x4  = __attribute__((ext_vector_type(4))) short;
using f32x16 = __attribute__((ext_vector_type(16))) float;
using f32x8  = __attribute__((ext_vector_type(8))) float;
using u32x4  = __attribute__((ext_vector_type(4))) unsigned;
constexpr float SCALE = 0.088388347648318440f;
constexpr float THR = 8.f;
constexpr float NEG = -3.0e38f;
constexpr int SHM_V = 64 * 128 * 2, SHM_K = 64 * 128 * 2;
#define ATT_KSWZ(row, colB) ((row) * 256 + ((colB) ^ (((row) & 7) << 4)))
#define ATT_SBAR() __builtin_amdgcn_sched_barrier(0)
__device__ __forceinline__ int crow(int r, int hi) { return (r & 3) + 8 * (r >> 2) + 4 * hi; }
__device__ __forceinline__ unsigned cvtpk(float lo, float hi) { return pg8::cvt_pk_bf16(lo, hi); }
__device__ __forceinline__ bf16x8 tobf(f32x8 x) { u32x4 w = {cvtpk(x[0], x[1]), cvtpk(x[2], x[3]), cvtpk(x[4], x[5]), cvtpk(x[6], x[7])}; return *reinterpret_cast<bf16x8*>(&w); }
__device__ __forceinline__ bf16x8 tobf(bf16x8 x) { return x; }

__device__ __forceinline__ void apply_mask(f32x16& p0, f32x16& p1, u64 mk, int hi) {
    const unsigned lo = (unsigned)mk >> (4 * hi), hw = (unsigned)(mk >> 32) >> (4 * hi);
#pragma unroll
    for (int r = 0; r < 16; ++r) { const unsigned bit = 1u << ((r & 3) + 8 * (r >> 2)); p0[r] = (lo & bit) ? p0[r] : NEG; p1[r] = (hw & bit) ? p1[r] : NEG; }
}
__device__ __forceinline__ void partialSM(f32x16& p0, f32x16& p1, float& m_reg, float& mn, float& alpha) {
    constexpr float C = SCALE * 1.4426950408889634f;
    float pmax = p0[0];
#pragma unroll
    for (int r = 1; r < 16; ++r) pmax = fmaxf(pmax, p0[r]);
#pragma unroll
    for (int r = 0; r < 16; ++r) pmax = fmaxf(pmax, p1[r]);
    { auto rr = __builtin_amdgcn_permlane32_swap(__float_as_uint(pmax), __float_as_uint(pmax), false, false);
      pmax = fmaxf(__uint_as_float(rr[0]), __uint_as_float(rr[1])); }
    if (__builtin_expect(__all(pmax - m_reg <= THR / SCALE), 1)) { mn = m_reg; alpha = 1.f; }
    else { mn = fmaxf(m_reg, pmax); alpha = __builtin_amdgcn_exp2f((m_reg - mn) * C); m_reg = mn; }
    const float mnC = -mn * C;
#pragma unroll
    for (int r = 0; r < 16; ++r) p0[r] = fmaf(p0[r], C, mnC);
#pragma unroll
    for (int r = 0; r < 16; ++r) p1[r] = fmaf(p1[r], C, mnC);
#pragma unroll
    for (int r = 0; r < 16; ++r) p0[r] = __builtin_amdgcn_exp2f(p0[r]);
}
__device__ __forceinline__ void finishSM(f32x16& p0, f32x16& p1, float alpha, float& l_reg, bf16x8& pa0, bf16x8& pa1, bf16x8& pa2, bf16x8& pa3) {
#pragma unroll
    for (int r = 0; r < 16; ++r) p1[r] = __builtin_amdgcn_exp2f(p1[r]);
    float ps = 0;
#pragma unroll
    for (int r = 0; r < 16; ++r) ps += p0[r];
#pragma unroll
    for (int r = 0; r < 16; ++r) ps += p1[r];
    { auto rr = __builtin_amdgcn_permlane32_swap(__float_as_uint(ps), __float_as_uint(ps), false, false);
      ps = __uint_as_float(rr[0]) + __uint_as_float(rr[1]); }
    l_reg = l_reg * alpha + ps;
#define ATT_PK4(P, BASE, OUT) do { unsigned a0 = cvtpk(P[BASE + 0], P[BASE + 1]), a1 = cvtpk(P[BASE + 2], P[BASE + 3]);   \
    unsigned b0 = cvtpk(P[BASE + 4], P[BASE + 5]), b1 = cvtpk(P[BASE + 6], P[BASE + 7]);                              \
    auto r0 = __builtin_amdgcn_permlane32_swap(a0, b0, false, false); auto r1 = __builtin_amdgcn_permlane32_swap(a1, b1, false, false); \
    u32x4 w = {r0[0], r1[0], r0[1], r1[1]}; OUT = *reinterpret_cast<bf16x8*>(&w); } while (0)
    ATT_PK4(p0, 0, pa0); ATT_PK4(p0, 8, pa1); ATT_PK4(p1, 0, pa2); ATT_PK4(p1, 8, pa3);
#undef ATT_PK4
}
__device__ __forceinline__ void qkt(f32x16& p0, f32x16& p1, const char* Ks, const bf16x8* qr, int r32, int hi) {
    p0 = f32x16{}; p1 = f32x16{};
#pragma unroll
    for (int d0 = 0; d0 < 8; ++d0) { const int cb = (d0 * 16 + hi * 8) * 2;
        const bf16x8 b0 = *reinterpret_cast<const bf16x8*>(Ks + ATT_KSWZ(r32, cb));
        const bf16x8 b1 = *reinterpret_cast<const bf16x8*>(Ks + ATT_KSWZ(32 + r32, cb));
        p0 = __builtin_amdgcn_mfma_f32_32x32x16_bf16(b0, qr[d0], p0, 0, 0, 0);
        p1 = __builtin_amdgcn_mfma_f32_32x32x16_bf16(b1, qr[d0], p1, 0, 0, 0); }
}
__device__ __forceinline__ int v_st(int k, int c) { const int kk = (k & ~0xC) | ((k & 4) << 1) | ((k & 8) >> 1); return ((kk >> 3) * 4 + (c >> 5)) * 512 + ((kk & 7) * 32 + (c & 31)) * 2; }
__device__ __forceinline__ int v_rd_base(int lane) { return ((lane & 3) << 3) | (((lane >> 2) & 3) << 6) | (((lane >> 4) & 1) << 5) | (((lane >> 5) & 1) << 8); }
constexpr int v_rd_off(int d0, int ks, int half) { return d0 * 512 + ks * 4096 + half * 2048; }
template <int OFF> __device__ __forceinline__ s16x4 tr_read(int vb) { s16x4 r; asm volatile("ds_read_b64_tr_b16 %0, %1 offset:%2" : "=&v"(r) : "v"(vb), "i"(OFF) : "memory"); return r; }
template <int D0> __device__ __forceinline__ void pv_one(f32x16& od, int vb, bf16x8 pa0, bf16x8 pa1, bf16x8 pa2, bf16x8 pa3) {
    const s16x4 l0 = tr_read<v_rd_off(D0, 0, 0)>(vb), h0 = tr_read<v_rd_off(D0, 0, 1)>(vb), l1 = tr_read<v_rd_off(D0, 1, 0)>(vb), h1 = tr_read<v_rd_off(D0, 1, 1)>(vb);
    const s16x4 l2 = tr_read<v_rd_off(D0, 2, 0)>(vb), h2 = tr_read<v_rd_off(D0, 2, 1)>(vb), l3 = tr_read<v_rd_off(D0, 3, 0)>(vb), h3 = tr_read<v_rd_off(D0, 3, 1)>(vb);
    asm volatile("s_waitcnt lgkmcnt(0)" ::: "memory"); ATT_SBAR();
#define ATT_PK(L, H) (bf16x8){L[0], L[1], L[2], L[3], H[0], H[1], H[2], H[3]}
    od = __builtin_amdgcn_mfma_f32_32x32x16_bf16(pa0, ATT_PK(l0, h0), od, 0, 0, 0);
    od = __builtin_amdgcn_mfma_f32_32x32x16_bf16(pa1, ATT_PK(l1, h1), od, 0, 0, 0);
    od = __builtin_amdgcn_mfma_f32_32x32x16_bf16(pa2, ATT_PK(l2, h2), od, 0, 0, 0);
    od = __builtin_amdgcn_mfma_f32_32x32x16_bf16(pa3, ATT_PK(l3, h3), od, 0, 0, 0);
#undef ATT_PK
}
__device__ __forceinline__ void pv_d0(f32x16* o, int vb, bf16x8 pa0, bf16x8 pa1, bf16x8 pa2, bf16x8 pa3) {
    pv_one<0>(o[0], vb, pa0, pa1, pa2, pa3); pv_one<1>(o[1], vb, pa0, pa1, pa2, pa3); pv_one<2>(o[2], vb, pa0, pa1, pa2, pa3); pv_one<3>(o[3], vb, pa0, pa1, pa2, pa3);
}

struct KvPrompt {
    using T = bf16x8; const bf16_t* K; const bf16_t* V;
    __device__ __forceinline__ T ldk(int key, int col) const { return *reinterpret_cast<const bf16x8*>(K + (size_t)key * 256 + col); }
    __device__ __forceinline__ T ldv(int key, int col) const { return *reinterpret_cast<const bf16x8*>(V + (size_t)key * 256 + col); }
};
struct KvSample {
    using T = f32x8; const float* ck; const float* cv; const float* kn; const float* vn; const int* pages  ; int n;
    __device__ __forceinline__ size_t roff(int key) const { return (((size_t)pages[key >> 7] * PAGE_SIZE + (key & 127)) * N_KV + n) * 128; }
    __device__ __forceinline__ T ldk(int key, int col) const { const float* p = key < PAST_LEN ? ck + roff(key) : kn + (size_t)min(key - PAST_LEN, DEC_SEQ - 1) * 256; return *reinterpret_cast<const f32x8*>(p + col); }
    __device__ __forceinline__ T ldv(int key, int col) const { const float* p = key < PAST_LEN ? cv + roff(key) : vn + (size_t)min(key - PAST_LEN, DEC_SEQ - 1) * 256; return *reinterpret_cast<const f32x8*>(p + col); }
};

template <class KV>
__device__ __forceinline__ void attn_unit(const KV kv, const bf16_t* __restrict__ Aq, const float* __restrict__ qnw, const u64* __restrict__ mask, bf16_t* __restrict__ Odsa, int tok0, int nq_valid, int hd0, int NT, char* lds) {
    int tid_l = threadIdx.x; asm volatile("" : "+v"(tid_l));
    const int tid = tid_l, wid = tid >> 6, lane = tid & 63, r32 = lane & 31, hi = lane >> 5;
    char* V_lds = lds; char* K_lds = lds + 2 * SHM_V;
    float* wsx = (float*)(lds + 2 * SHM_V + 2 * SHM_K) + wid * 64; float* li_l = wsx; float* al_l = wsx + 32;
    float m_reg = -1e30f, l_reg = 0; f32x16 o[4] = {}; bf16x8 qr[8];
    const int mytok = tok0 + 8 * wid + (r32 >> 2);
    { const bf16_t* Qw = Aq + (size_t)mytok * 1024 + (hd0 + (r32 & 3)) * 128 + hi * 8;
#pragma unroll
      for (int d0 = 0; d0 < 8; ++d0) qr[d0] = *reinterpret_cast<const bf16x8*>(Qw + d0 * 16);
      float ssq = 0.f;
#pragma unroll
      for (int d0 = 0; d0 < 8; ++d0) { const u32x4 w = *reinterpret_cast<const u32x4*>(&qr[d0]);
#pragma unroll
          for (int j = 0; j < 4; ++j) { const float lo = __uint_as_float(w[j] << 16), hh = __uint_as_float(w[j] & 0xffff0000u); ssq += lo * lo + hh * hh; } }
      ssq += __shfl_xor(ssq, 32);
      const float rn = rsqrtf(ssq * (1.0f / 128.0f) + NORM_EPS);
#pragma unroll
      for (int d0 = 0; d0 < 8; ++d0) { const u32x4 w = *reinterpret_cast<const u32x4*>(&qr[d0]); const float4 g0 = *(const float4*)(qnw + d0 * 16 + hi * 8), g1 = *(const float4*)(qnw + d0 * 16 + hi * 8 + 4);
          u32x4 o; o[0] = cvtpk(__uint_as_float(w[0] << 16) * rn * g0.x, __uint_as_float(w[0] & 0xffff0000u) * rn * g0.y); o[1] = cvtpk(__uint_as_float(w[1] << 16) * rn * g0.z, __uint_as_float(w[1] & 0xffff0000u) * rn * g0.w);
          o[2] = cvtpk(__uint_as_float(w[2] << 16) * rn * g1.x, __uint_as_float(w[2] & 0xffff0000u) * rn * g1.y); o[3] = cvtpk(__uint_as_float(w[3] << 16) * rn * g1.z, __uint_as_float(w[3] & 0xffff0000u) * rn * g1.w);
          qr[d0] = *reinterpret_cast<const bf16x8*>(&o); } }
    const u64* mrow = mask + (size_t)mytok * MASK_WORDS;
    const int sr = tid >> 4, sc = (tid & 15) * 8, vst0 = v_st(sr, sc), vst1 = v_st(32 + sr, sc);
    const int vbase = (int)(uintptr_t)(PG8_LAS char*)V_lds + v_rd_base(lane);
    typename KV::T vs0, vs1, ks0, ks1;
#define ATT_SLOAD(k0) do { vs0 = kv.ldv((k0) + sr, sc); vs1 = kv.ldv((k0) + 32 + sr, sc); ks0 = kv.ldk((k0) + sr, sc); ks1 = kv.ldk((k0) + 32 + sr, sc); } while (0)
#define ATT_SWRITE(b) do { *(bf16x8*)(V_lds + (b) * SHM_V + vst0) = tobf(vs0); *(bf16x8*)(V_lds + (b) * SHM_V + vst1) = tobf(vs1); const int kc = sc * 2; \
    *(bf16x8*)(K_lds + (b) * SHM_K + ATT_KSWZ(sr, kc)) = tobf(ks0); *(bf16x8*)(K_lds + (b) * SHM_K + ATT_KSWZ(32 + sr, kc)) = tobf(ks1); } while (0)
    __syncthreads();
    ATT_SLOAD(0); ATT_SWRITE(0); __syncthreads();
    for (int j = 0; j < NT; ++j) {
        const int b = j & 1;
        const u64 mk = mrow[j];
        if (j + 1 < NT) ATT_SLOAD((j + 1) * 64);
        f32x16 p0, p1; float mn, alpha; bf16x8 pa0, pa1, pa2, pa3;
        ATT_SBAR(); qkt(p0, p1, K_lds + b * SHM_K, qr, r32, hi); apply_mask(p0, p1, mk, hi);
        partialSM(p0, p1, m_reg, mn, alpha);
        if (__any(alpha < 1.f)) { if (hi == 0) al_l[r32] = alpha; asm volatile("s_waitcnt lgkmcnt(0)" ::: "memory");
#pragma unroll
            for (int d = 0; d < 4; ++d)
#pragma unroll
                for (int r = 0; r < 16; ++r) o[d][r] *= al_l[crow(r, hi)]; }
        finishSM(p0, p1, alpha, l_reg, pa0, pa1, pa2, pa3); ATT_SBAR();
        pv_d0(o, vbase + b * SHM_V, pa0, pa1, pa2, pa3);
        if (j + 1 < NT) ATT_SWRITE(b ^ 1);
        __syncthreads();
    }
    if (hi == 0) li_l[r32] = l_reg; asm volatile("s_waitcnt lgkmcnt(0)" ::: "memory");
#pragma unroll
    for (int r = 0; r < 16; ++r) { const int orow = crow(r, hi); const float rli = __builtin_amdgcn_rcpf(li_l[orow]);
        const int q = 8 * wid + (orow >> 2);
        if (q < nq_valid) { bf16_t* Ow = Odsa + (size_t)(tok0 + q) * 1024 + (hd0 + (orow & 3)) * 128 + r32;
#pragma unroll
            for (int d0 = 0; d0 < 4; ++d0) Ow[d0 * 32] = f2bf(o[d0][r] * rli); } }
#undef ATT_SLOAD
#undef ATT_SWRITE
}
}
namespace idx {
using bf16x8 = __attribute__((ext_vector_type(8))) short;
using f32x16 = __attribute__((ext_vector_type(16))) float;
using f32x8  = __attribute__((ext_vector_type(8))) float;
constexpr int NTILE = 65;
constexpr int WAVE_LDS = NTILE * 64 * 4;
__device__ __forceinline__ unsigned ord_of(float f) { const unsigned u = __float_as_uint(f); return (u & 0x80000000u) ? ~u : (u | 0x80000000u); }
__device__ __forceinline__ int half_sum(int v) {
    v += __builtin_amdgcn_mov_dpp(v, 0xB1, 0xF, 0xF, true);
    v += __builtin_amdgcn_mov_dpp(v, 0x4E, 0xF, 0xF, true);
    v += __builtin_amdgcn_mov_dpp(v, 0x141, 0xF, 0xF, true);
    v += __builtin_amdgcn_mov_dpp(v, 0x140, 0xF, 0xF, true);
    v += __shfl_xor(v, 16);
    return v;
}
template <bool SAMPLE> struct KeySrc {
    const bf16_t* ikb; const float* ck; int pgv;
    struct Raw { f32x8 f[SAMPLE ? 4 : 1]; bf16x8 h[SAMPLE ? 1 : 4]; };
    __device__ __forceinline__ void load(int t, int c, int hi, Raw& R) const {
        if constexpr (!SAMPLE) { const bf16_t* p = ikb + (size_t)(32 * t + c) * 64 + hi * 8;
#pragma unroll
            for (int s = 0; s < 4; ++s) R.h[s] = *reinterpret_cast<const bf16x8*>(p + 16 * s); }
        else { const int tc = t < 64 ? t : 63; const int page = __builtin_amdgcn_readlane(pgv, tc >> 2);
            const float* p = ck + ((size_t)page * PAGE_SIZE + ((32 * tc) & 127) + c) * 64 + hi * 8;
            if (t >= 64) {
                const bf16_t* q = ikb + (size_t)(c < DEC_SEQ ? c : DEC_SEQ - 1) * 64 + hi * 8;
#pragma unroll
                for (int s = 0; s < 4; ++s) { const att::u32x4 w = *reinterpret_cast<const att::u32x4*>(q + 16 * s);
#pragma unroll
                    for (int e = 0; e < 4; ++e) { R.f[s][2 * e] = __uint_as_float(w[e] << 16); R.f[s][2 * e + 1] = __uint_as_float(w[e] & 0xffff0000u); } } }
            else {
#pragma unroll
                for (int s = 0; s < 4; ++s) R.f[s] = *reinterpret_cast<const f32x8*>(p + 16 * s); } }
    }
    __device__ __forceinline__ void cvt(const Raw& R, bf16x8 (&B)[4]) const {
#pragma unroll
        for (int s = 0; s < 4; ++s) { if constexpr (SAMPLE) B[s] = att::tobf(R.f[s]); else B[s] = R.h[s]; }
    }
};
template <int A_> __device__ __forceinline__ float head_sum(const f32x16& acc, const float (&w)[8]) {
    float s = 0.f;
#pragma unroll
    for (int h = 0; h < 8; ++h) s = fmaf(w[h], fmaxf(acc[8 * A_ + h], 0.f), s);
    return s;
}
template <bool SAMPLE, int A_>
__device__ __forceinline__ void pass(const KeySrc<SAMPLE>& ks, const bf16x8 (&A)[4], const float* Iw, int tokbase, int pos0, int nvalid, int ntiles, unsigned* strip, unsigned* mask32, int lane) {
    const int c = lane & 31, hi = lane >> 5, myq = 2 * hi + A_, mypos = pos0 + myq; const bool qvalid = myq < nvalid;
    float w[8];
    { const float* wp = Iw + (size_t)(tokbase + (qvalid ? myq : nvalid - 1)) * 8;
#pragma unroll
      for (int h = 0; h < 8; ++h) w[h] = wp[h]; }
    typename KeySrc<SAMPLE>::Raw R0, R1; bf16x8 B[4];
    ks.load(0, c, hi, R0); if (1 < ntiles) ks.load(1, c, hi, R1);
#define IDX_TILE(t_, R_) do { ks.cvt(R_, B); if ((t_) + 2 < ntiles) ks.load((t_) + 2, c, hi, R_); f32x16 acc = {}; \
        _Pragma("unroll") for (int s_ = 0; s_ < 4; ++s_) acc = __builtin_amdgcn_mfma_f32_32x32x16_bf16(A[s_], B[s_], acc, 0, 0, 0); \
        const float sc_ = head_sum<A_>(acc, w); strip[(t_) * 64 + lane] = (32 * (t_) + c <= mypos) ? ord_of(sc_) : 0u; } while (0)
    for (int t = 0; t < ntiles; t += 2) { IDX_TILE(t, R0); if (t + 1 < ntiles) IDX_TILE(t + 1, R1); }
#undef IDX_TILE
    unsigned x[NTILE];
#pragma unroll
    for (int t = 0; t < NTILE; ++t) x[t] = (t < ntiles) ? strip[t * 64 + lane] : 0u;
    unsigned tau = 0u; int r_ties = 0;
    if (__any(mypos + 1 > TOPK)) {
        for (int bit = 31; bit >= 0; --bit) { const unsigned cand = tau | (1u << bit); int cnt = 0;
#pragma unroll
            for (int t = 0; t < NTILE; ++t) cnt += (x[t] >= cand) ? 1 : 0;
            cnt = half_sum(cnt);
            if (cnt >= TOPK) tau = cand; }
        int cg = 0;
#pragma unroll
        for (int t = 0; t < NTILE; ++t) cg += (x[t] > tau) ? 1 : 0;
        cg = half_sum(cg);
        r_ties = TOPK - cg;
    }
    if (mypos + 1 <= TOPK) { tau = 0u; r_ties = 0; }
    int eq_before = 0; unsigned* mrow = mask32 + (size_t)(tokbase + myq) * (2 * MASK_WORDS);
#pragma unroll
    for (int t = 0; t < NTILE; ++t) {
        const bool eq = x[t] == tau, gt = x[t] > tau;
        const u64 eqm = __ballot(eq); const unsigned my_eqm = hi ? (unsigned)(eqm >> 32) : (unsigned)eqm;
        const int rank = eq_before + __popc(my_eqm & ((1u << c) - 1u));
        const bool sel = gt || (eq && rank < r_ties);
        eq_before += __popc(my_eqm);
        const u64 sm = __ballot(sel); const unsigned my_sm = hi ? (unsigned)(sm >> 32) : (unsigned)sm;
        if (c == 0 && qvalid) mrow[t] = my_sm;
    }
    if (c < 2 * MASK_WORDS - NTILE && qvalid) mrow[NTILE + c] = 0u;
}
template <bool SAMPLE>
__device__ __forceinline__ void wave_task(const KeySrc<SAMPLE>& ks, const bf16_t* Iq, const float* Iw, int tokbase, int pos0, int nvalid, unsigned* strip, unsigned* mask32, int lane) {
    const int c = lane & 31, hi = lane >> 5;
    const int aq_ = 2 * ((c >> 2) & 1) + (c >> 4), ah = 4 * ((c >> 3) & 1) + (c & 3);
    bf16x8 A[4];
    { const bf16_t* ap = Iq + (size_t)(tokbase + (aq_ < nvalid ? aq_ : nvalid - 1)) * 512 + ah * 64 + hi * 8;
#pragma unroll
      for (int s = 0; s < 4; ++s) A[s] = *reinterpret_cast<const bf16x8*>(ap + 16 * s); }
    const int pmax = pos0 + nvalid - 1; int ntiles = (pmax + 32) >> 5; if (ntiles > NTILE) ntiles = NTILE;
    pass<SAMPLE, 0>(ks, A, Iw, tokbase, pos0, nvalid, ntiles, strip, mask32, lane);
    pass<SAMPLE, 1>(ks, A, Iw, tokbase, pos0, nvalid, ntiles, strip, mask32, lane);
}
}
struct MegaArgs {
    PrepArgs prep;
    const float *cache_k, *cache_v, *cache_kidx, *state_ret; const int* page_table;
    const float *qnw, *knw, *ikw, *ikb;
    bf16_t *Rq, *Rk, *Rv, *G, *Aq, *Kb, *Vb, *Iq, *Ikb, *Gates, *OG, *An, *Odsa, *Mg, *A2, *Hid;
    float *Iw, *ssret, *rstd2, *Z, *M1, *M2, *H2, *Zf, *out;
    u64* mask; unsigned* bar;
};

namespace ret {
using bf16x8 = __attribute__((ext_vector_type(8))) short;
using s16x4  = __attribute__((ext_vector_type(4))) short;
using f32x4  = __attribute__((ext_vector_type(4))) float;
using u32x4  = __attribute__((ext_vector_type(4))) unsigned;
using u32x2  = __attribute__((ext_vector_type(2))) unsigned;
constexpr int QS = 528, VS = 144, PS = 80;
constexpr int OFF_Q = 0, OFF_K = OFF_Q + 32 * QS, OFF_V = OFF_K + 32 * QS, OFF_P = OFF_V + 32 * VS, OFF_ST = OFF_P + 32 * PS, OFF_SS = OFF_ST + 64 * QS, LDS_BYTES = OFF_SS + 32 * 4 * 4;
__device__ __forceinline__ s16x4 trr(int addr) { s16x4 r; asm volatile("ds_read_b64_tr_b16 %0, %1" : "=&v"(r) : "v"(addr) : "memory"); return r; }
__device__ __forceinline__ bf16x8 cat(s16x4 l, s16x4 h) { return (bf16x8){l[0], l[1], l[2], l[3], h[0], h[1], h[2], h[3]}; }
__device__ __forceinline__ u32x4 scale8(u32x4 v, float f) {
    u32x4 o;
#pragma unroll
    for (int i = 0; i < 4; ++i) o[i] = att::cvtpk(__uint_as_float(v[i] << 16) * f, __uint_as_float(v[i] & 0xffff0000u) * f);
    return o;
}
__device__ __forceinline__ void unit(const MegaArgs& a, int unit8, char* lds) {
    int tid_l = threadIdx.x; asm volatile("" : "+v"(tid_l));
    const int tid = tid_l, w = __builtin_amdgcn_readfirstlane(tid >> 6), lane = tid & 63, g = lane >> 4, c15 = lane & 15, q4 = c15 >> 2, p4 = c15 & 3;
    const int bh = unit8 >> 3, sl = unit8 & 7, b = bh >> 2, h = bh & 3;
    const int ldsb = (int)(uintptr_t)(PG8_LAS char*)lds;
    const float lg2 = log2f(1.0f - exp2f(-5.0f - (float)h));
    const int st_tok = tid >> 4, st_seg = tid & 15;
    const float fq = exp2f(lg2 * (float)(st_tok + 1)), fk = exp2f(-lg2 * (float)(st_tok + 1));
    f32x4 S[2][4];
#pragma unroll
    for (int i = 0; i < 2; ++i)
#pragma unroll
        for (int u = 0; u < 4; ++u) S[i][u] = (f32x4){0.f, 0.f, 0.f, 0.f};
    u32x4 rq0, rq1, rk0, rk1; u32x2 rv;
#define RET_LOAD(tok0_, len_) do { const bool ok_ = st_tok < (len_); const size_t r_ = (size_t)((tok0_) + (ok_ ? st_tok : 0)); \
        const u32x4* qp_ = (const u32x4*)(a.Rq + r_ * 1024 + h * 256 + st_seg * 16); const u32x4* kp_ = (const u32x4*)(a.Rk + r_ * 1024 + h * 256 + st_seg * 16); \
        rq0 = qp_[0]; rq1 = qp_[1]; rk0 = kp_[0]; rk1 = kp_[1]; rv = *(const u32x2*)(a.Rv + r_ * 2048 + h * 512 + sl * 64 + st_seg * 4); \
        if (!ok_) { rq0 = rq1 = rk0 = rk1 = (u32x4){0u, 0u, 0u, 0u}; rv = (u32x2){0u, 0u}; } } while (0)
    const int row0 = b * LP;
    RET_LOAD(row0, 16);
    __syncthreads();
    for (int c = 0; c < 65; ++c) {
        const int len = c == 0 ? 16 : 32, tok0 = c == 0 ? row0 : row0 + 16 + 32 * (c - 1);
        *(u32x4*)(lds + OFF_Q + st_tok * QS + st_seg * 32) = scale8(rq0, fq); *(u32x4*)(lds + OFF_Q + st_tok * QS + st_seg * 32 + 16) = scale8(rq1, fq);
        *(u32x4*)(lds + OFF_K + st_tok * QS + st_seg * 32) = scale8(rk0, fk); *(u32x4*)(lds + OFF_K + st_tok * QS + st_seg * 32 + 16) = scale8(rk1, fk);
        *(u32x2*)(lds + OFF_V + st_tok * VS + st_seg * 8) = rv;
#pragma unroll
        for (int i = 0; i < 2; ++i)
#pragma unroll
            for (int u = 0; u < 4; ++u) { u32x2 pk; pk.x = att::cvtpk(S[i][u][0], S[i][u][1]); pk.y = att::cvtpk(S[i][u][2], S[i][u][3]);
                *(u32x2*)(lds + OFF_ST + (16 * u + c15) * QS + (32 * w + 16 * i + 4 * g) * 2) = pk; }
        __syncthreads();
        if (c + 1 < 65) RET_LOAD(row0 + 16 + 32 * c, 32);
        if (w < 3) { const int jt = w >> 1, it = (w + 1) >> 1; f32x4 pacc = {0.f, 0.f, 0.f, 0.f};
#pragma unroll
            for (int s = 0; s < 8; ++s) { const bf16x8 A = *(const bf16x8*)(lds + OFF_K + (16 * jt + c15) * QS + (32 * s + 8 * g) * 2), B = *(const bf16x8*)(lds + OFF_Q + (16 * it + c15) * QS + (32 * s + 8 * g) * 2);
                pacc = __builtin_amdgcn_mfma_f32_16x16x32_bf16(A, B, pacc, 0, 0, 0); }
            const int ig = 16 * it + c15, jg0 = 16 * jt + 4 * g; float pv[4];
#pragma unroll
            for (int r = 0; r < 4; ++r) pv[r] = (jg0 + r <= ig) ? pacc[r] : 0.f;
            u32x2 pk; pk.x = att::cvtpk(pv[0], pv[1]); pk.y = att::cvtpk(pv[2], pv[3]);
            *(u32x2*)(lds + OFF_P + ig * PS + jg0 * 2) = pk; }
        else if (w == 3) { if (lane < 32) *(u32x4*)(lds + OFF_P + (lane >> 1) * PS + 32 + 16 * (lane & 1)) = (u32x4){0u, 0u, 0u, 0u}; }
        { s16x4 vl[4], vh[4], kl[2], kh[2];
#pragma unroll
          for (int u = 0; u < 4; ++u) { const int ad = ldsb + OFF_V + (8 * g + q4) * VS + (16 * u + 4 * p4) * 2; vl[u] = trr(ad); vh[u] = trr(ad + 4 * VS); }
#pragma unroll
          for (int i = 0; i < 2; ++i) { const int ad = ldsb + OFF_K + (8 * g + q4) * QS + (32 * w + 16 * i + 4 * p4) * 2; kl[i] = trr(ad); kh[i] = trr(ad + 4 * QS); }
          asm volatile("s_waitcnt lgkmcnt(0)" ::: "memory"); __builtin_amdgcn_sched_barrier(0);
          const float gl = exp2f(lg2 * (float)len);
#pragma unroll
          for (int i = 0; i < 2; ++i)
#pragma unroll
              for (int u = 0; u < 4; ++u) { S[i][u] = __builtin_amdgcn_mfma_f32_16x16x32_bf16(cat(kl[i], kh[i]), cat(vl[u], vh[u]), S[i][u], 0, 0, 0); S[i][u] *= gl; } }
        __syncthreads();
        { const int dt = w & 3, it = w >> 2; f32x4 o = {0.f, 0.f, 0.f, 0.f};
          { const int ad = ldsb + OFF_V + (8 * g + q4) * VS + (16 * dt + 4 * p4) * 2; const s16x4 lo = trr(ad), hi = trr(ad + 4 * VS);
            const bf16x8 Bp = *(const bf16x8*)(lds + OFF_P + (16 * it + c15) * PS + (8 * g) * 2);
            asm volatile("s_waitcnt lgkmcnt(0)" ::: "memory"); __builtin_amdgcn_sched_barrier(0);
            o = __builtin_amdgcn_mfma_f32_16x16x32_bf16(cat(lo, hi), Bp, o, 0, 0, 0); }
#pragma unroll
          for (int s = 0; s < 8; ++s) { const bf16x8 A = *(const bf16x8*)(lds + OFF_ST + (16 * dt + c15) * QS + (32 * s + 8 * g) * 2), B = *(const bf16x8*)(lds + OFF_Q + (16 * it + c15) * QS + (32 * s + 8 * g) * 2);
              o = __builtin_amdgcn_mfma_f32_16x16x32_bf16(A, B, o, 0, 0, 0); }
          const int i = 16 * it + c15; float ss = o[0] * o[0] + o[1] * o[1] + o[2] * o[2] + o[3] * o[3];
          ss += __shfl_xor(ss, 16); ss += __shfl_xor(ss, 32);
          if (g == 0) ((float*)(lds + OFF_SS))[i * 4 + dt] = ss;
          if (i < len) { const size_t ci = (size_t)(tok0 + i) * 2048 + h * 512 + sl * 64 + 16 * dt + 4 * g; const u32x2 gg = *(const u32x2*)(a.G + ci);
              u32x2 pk; pk.x = att::cvtpk(o[0] * __uint_as_float(gg.x << 16), o[1] * __uint_as_float(gg.x & 0xffff0000u)); pk.y = att::cvtpk(o[2] * __uint_as_float(gg.y << 16), o[3] * __uint_as_float(gg.y & 0xffff0000u));
              *(u32x2*)(a.OG + ci) = pk; } }
        __syncthreads();
        if (tid < len) { const float* sp = (const float*)(lds + OFF_SS) + tid * 4; a.ssret[(size_t)(tok0 + tid) * 32 + h * 8 + sl] = (sp[0] + sp[1]) + (sp[2] + sp[3]); }
    }
    float* so = a.out + (size_t)O_R_P + ((size_t)b * H_RET + h) * (DK_RET * DV_RET) + sl * 64;
#pragma unroll
    for (int i = 0; i < 2; ++i)
#pragma unroll
        for (int u = 0; u < 4; ++u)
#pragma unroll
            for (int r = 0; r < 4; ++r) so[(size_t)(32 * w + 16 * i + 4 * g + r) * DV_RET + 16 * u + c15] = S[i][u][r];
    __syncthreads();
#undef RET_LOAD
}
}
namespace epi {
using f32x4 = pg8::f32x4; using u32x4 = pg8::u32x4; typedef unsigned u32x2 __attribute__((ext_vector_type(2)));
__device__ __forceinline__ unsigned pk(float lo, float hi) { return pg8::cvt_pk_bf16(lo, hi); }
__device__ __forceinline__ u32x4 pack8(const f32x4& a, const f32x4& b) { u32x4 w; w.x = pk(a[0], a[1]); w.y = pk(a[2], a[3]); w.z = pk(b[0], b[1]); w.w = pk(b[2], b[3]); return w; }
__device__ __forceinline__ float bflo(unsigned w) { return __uint_as_float(w << 16); }
__device__ __forceinline__ float bfhi(unsigned w) { return __uint_as_float(w & 0xffff0000u); }
__device__ __forceinline__ f32x4 silu4(f32x4 x) { f32x4 o;
#pragma unroll
    for (int j = 0; j < 4; ++j) o[j] = x[j] * __builtin_amdgcn_rcpf(1.0f + __expf(-x[j])); return o; }
__device__ __forceinline__ f32x4 sigm4(f32x4 x) { f32x4 o;
#pragma unroll
    for (int j = 0; j < 4; ++j) o[j] = __builtin_amdgcn_rcpf(1.0f + __expf(-x[j])); return o; }

struct Epi1 {
    static constexpr bool PERM = true, AFTER_DRAIN = false;
    const float* rstd0; const float2* rope; const float *ikw, *ikb;
    bf16_t *Rq, *Rk, *Rv, *G, *Aq, *Vb, *Iq, *Ikb, *Gates; float* Iw; float* out; int gz0;
    template <int TY> __device__ __forceinline__ void run(const f32x4 (&acc)[2][2][4][2], int pm, int wr, int wc, int fr, int fq, bf16_t* dbase, int ld, float* fbase, float* fbase_s, float post, int isv) const {
        const int cl = wc * 32 + 8 * fq;
        float rsv[8];
#pragma unroll
        for (int i = 0; i < 8; ++i) { const int row = pm * 256 + (i >> 2) * 128 + wr * 64 + (i & 3) * 16 + fr; rsv[i] = rstd0[row < T_ALL ? row : T_ALL - 1]; }
#pragma unroll
        for (int ai = 0; ai < 2; ++ai)
#pragma unroll
            for (int m = 0; m < 4; ++m) {
                const int row = pm * 256 + ai * 128 + wr * 64 + m * 16 + fr; const bool ok = row < T_ALL; const int rowc = ok ? row : T_ALL - 1;
                const float rs = rsv[ai * 4 + m];
                f32x4 v[2][2];
#pragma unroll
                for (int bj = 0; bj < 2; ++bj)
#pragma unroll
                    for (int n = 0; n < 2; ++n) v[bj][n] = acc[ai][bj][m][n] * rs;
                if constexpr (TY == 0) {
                    bf16_t* dst = dbase + (size_t)rowc * 1024 + cl;
                    const float4* rp = (const float4*)(rope + (size_t)row_pos(rowc) * 128 + cl);
                    f32x4 o1[2], o2[2];
#pragma unroll
                    for (int n = 0; n < 2; ++n) { const float4 cs0 = rp[2 * n], cs1 = rp[2 * n + 1]; const float c[4] = {cs0.x, cs0.z, cs1.x, cs1.z}, s[4] = {cs0.y, cs0.w, cs1.y, cs1.w};
#pragma unroll
                        for (int j = 0; j < 4; ++j) { o1[n][j] = (v[0][n][j] * c[j] - v[1][n][j] * s[j]) * post; o2[n][j] = (v[0][n][j] * s[j] + v[1][n][j] * c[j]) * post; } }
                    if (ok) { *(u32x4*)dst = pack8(o1[0], o1[1]); *(u32x4*)(dst + 128) = pack8(o2[0], o2[1]); }
                } else if constexpr (TY == 1 || TY == 2 || TY == 3) {
                    bf16_t* dst = dbase + (size_t)rowc * ld + cl;
                    if constexpr (TY == 2) { v[0][0] = silu4(v[0][0]); v[0][1] = silu4(v[0][1]); v[1][0] = silu4(v[1][0]); v[1][1] = silu4(v[1][1]); }
                    if constexpr (TY == 3) { v[0][0] = sigm4(v[0][0]); v[0][1] = sigm4(v[0][1]); v[1][0] = sigm4(v[1][0]); v[1][1] = sigm4(v[1][1]); }
                    if (ok) { *(u32x4*)dst = pack8(v[0][0], v[0][1]); *(u32x4*)(dst + 128) = pack8(v[1][0], v[1][1]); }
                } else if constexpr (TY == 4) {
                    float* dst = (rowc < T_PROMPT ? fbase + (size_t)rowc * 256 : fbase_s + (size_t)(rowc - T_PROMPT) * 256) + cl;
                    if (ok) { *(f32x4*)dst = v[0][0]; *(f32x4*)(dst + 4) = v[0][1]; *(f32x4*)(dst + 128) = v[1][0]; *(f32x4*)(dst + 132) = v[1][1];
                        if (isv) { bf16_t* vb = Vb + (size_t)rowc * 256 + cl; *(u32x4*)vb = pack8(v[0][0], v[0][1]); *(u32x4*)(vb + 128) = pack8(v[1][0], v[1][1]); } }
                } else {
                    if (wc == 0) {
                        float s = 0.f;
#pragma unroll
                        for (int bj = 0; bj < 2; ++bj)
#pragma unroll
                            for (int n = 0; n < 2; ++n) s += (v[bj][n][0] + v[bj][n][1]) + (v[bj][n][2] + v[bj][n][3]);
                        s += __shfl_xor(s, 16); s += __shfl_xor(s, 32);
                        const float mu = s * (1.0f / 64.0f); float q = 0.f;
#pragma unroll
                        for (int bj = 0; bj < 2; ++bj)
#pragma unroll
                            for (int n = 0; n < 2; ++n) { const f32x4 d = v[bj][n] - mu; q += (d[0] * d[0] + d[1] * d[1]) + (d[2] * d[2] + d[3] * d[3]); }
                        q += __shfl_xor(q, 16); q += __shfl_xor(q, 32);
                        const float rn = rsqrtf(q * (1.0f / 64.0f) + NORM_EPS);
                        float* ko = out + (rowc < T_PROMPT ? (size_t)O_KI_P + (size_t)rowc * 64 : (size_t)O_KI_S + (size_t)(rowc - T_PROMPT) * 64);
#pragma unroll
                        for (int bj = 0; bj < 2; ++bj) { const int e0 = 32 * bj + 8 * fq; f32x4 y[2];
#pragma unroll
                            for (int n = 0; n < 2; ++n) { const f32x4 wv = *(const f32x4*)(ikw + e0 + 4 * n), bv = *(const f32x4*)(ikb + e0 + 4 * n); y[n] = (v[bj][n] - mu) * rn * wv + bv; }
                            if (ok) { *(f32x4*)(ko + e0) = y[0]; *(f32x4*)(ko + e0 + 4) = y[1]; *(u32x4*)(Ikb + (size_t)rowc * 64 + e0) = pack8(y[0], y[1]); } }
                    } else if (wc == 1 && fq == 0) {
                        if (ok) { *(f32x4*)(Iw + (size_t)rowc * 8) = v[0][0] * IDX_SCALE; *(f32x4*)(Iw + (size_t)rowc * 8 + 4) = v[0][1] * IDX_SCALE; }
                    }
                }
            }
    }
    __device__ __forceinline__ void operator()(const f32x4 (&acc)[2][2][4][2], const pg8::Unit& u, int wr, int wc, int fr_in, int fq_in) const {
        int fr = fr_in, fq = fq_in; asm volatile("" : "+v"(fr), "+v"(fq));
        const int pn = u.pn + gz0, pm = u.pm;
        if (pn < 4)        run<0>(acc, pm, wr, wc, fr, fq, Rq + pn * 256, 1024, nullptr, nullptr, 1.0f, 0);
        else if (pn < 8)   run<0>(acc, pm, wr, wc, fr, fq, Rk + (pn - 4) * 256, 1024, nullptr, nullptr, 0.0625f, 0);
        else if (pn < 16)  run<1>(acc, pm, wr, wc, fr, fq, Rv + (pn - 8) * 256, 2048, nullptr, nullptr, 1.0f, 0);
        else if (pn < 24)  run<2>(acc, pm, wr, wc, fr, fq, G + (pn - 16) * 256, 2048, nullptr, nullptr, 1.0f, 0);
        else if (pn < 28)  run<1>(acc, pm, wr, wc, fr, fq, Aq + (pn - 24) * 256, 1024, nullptr, nullptr, 1.0f, 0);
        else if (pn == 28) run<4>(acc, pm, wr, wc, fr, fq, nullptr, 0, out + O_K_P, out + O_K_S, 1.0f, 0);
        else if (pn == 29) run<4>(acc, pm, wr, wc, fr, fq, nullptr, 0, out + O_V_P, out + O_V_S, 1.0f, 1);
        else if (pn < 32)  run<1>(acc, pm, wr, wc, fr, fq, Iq + (pn - 30) * 256, 512, nullptr, nullptr, 1.0f, 0);
        else if (pn == 32) run<5>(acc, pm, wr, wc, fr, fq, nullptr, 0, nullptr, nullptr, 1.0f, 0);
        else               run<3>(acc, pm, wr, wc, fr, fq, Gates + (pn - 33 + gz0) * 256, 2048, nullptr, nullptr, 1.0f, 0);
    }
};
struct EpiRet {
    static constexpr bool PERM = false, AFTER_DRAIN = false;
    float* M1;
    __device__ __forceinline__ void operator()(const f32x4 (&acc)[2][2][4][2], const pg8::Unit& u, int wr, int wc, int fr_in, int fq_in) const {
        int fr = fr_in, fq = fq_in; asm volatile("" : "+v"(fr), "+v"(fq));
#pragma unroll
        for (int ai = 0; ai < 2; ++ai)
#pragma unroll
            for (int m = 0; m < 4; ++m) { const int row = u.pm * 256 + ai * 128 + wr * 64 + m * 16 + fr;
#pragma unroll
                for (int bj = 0; bj < 2; ++bj)
#pragma unroll
                    for (int n = 0; n < 2; ++n) *(f32x4*)(M1 + (size_t)row * 1024 + u.pn * 256 + bj * 128 + wc * 32 + 16 * n + 4 * fq) = acc[ai][bj][m][n]; }
    }
};
struct EpiDsa {
    static constexpr bool PERM = false, AFTER_DRAIN = false;
    const bf16_t* Gates; const float* M1; bf16_t* Mg;
    __device__ __forceinline__ void operator()(const f32x4 (&acc)[2][2][4][2], const pg8::Unit& u, int wr, int wc, int fr_in, int fq_in) const {
        int fr = fr_in, fq = fq_in; asm volatile("" : "+v"(fr), "+v"(fq));
#pragma unroll
        for (int ai = 0; ai < 2; ++ai)
#pragma unroll
            for (int mp = 0; mp < 2; ++mp) {
                u32x2 gr[2][2][2], gd[2][2][2]; f32x4 mv[2][2][2];
#pragma unroll
                for (int mm = 0; mm < 2; ++mm) { const int row = u.pm * 256 + ai * 128 + wr * 64 + (2 * mp + mm) * 16 + fr;
#pragma unroll
                    for (int bj = 0; bj < 2; ++bj)
#pragma unroll
                        for (int n = 0; n < 2; ++n) { const int col = u.pn * 256 + bj * 128 + wc * 32 + 16 * n + 4 * fq;
                            gr[mm][bj][n] = *(const u32x2*)(Gates + (size_t)row * 2048 + col); gd[mm][bj][n] = *(const u32x2*)(Gates + (size_t)row * 2048 + 1024 + col); mv[mm][bj][n] = *(const f32x4*)(M1 + (size_t)row * 1024 + col); } }
#pragma unroll
                for (int mm = 0; mm < 2; ++mm) { const int m = 2 * mp + mm, row = u.pm * 256 + ai * 128 + wr * 64 + m * 16 + fr;
#pragma unroll
                    for (int bj = 0; bj < 2; ++bj)
#pragma unroll
                        for (int n = 0; n < 2; ++n) { const int col = u.pn * 256 + bj * 128 + wc * 32 + 16 * n + 4 * fq;
                            const f32x4 g1 = {bflo(gr[mm][bj][n].x), bfhi(gr[mm][bj][n].x), bflo(gr[mm][bj][n].y), bfhi(gr[mm][bj][n].y)}, g2 = {bflo(gd[mm][bj][n].x), bfhi(gd[mm][bj][n].x), bflo(gd[mm][bj][n].y), bfhi(gd[mm][bj][n].y)};
                            const f32x4 r = mv[mm][bj][n] * g1 + acc[ai][bj][m][n] * g2;
                            u32x2 w; w.x = pk(r[0], r[1]); w.y = pk(r[2], r[3]); *(u32x2*)(Mg + (size_t)row * 1024 + col) = w; } } }
    }
};
struct EpiOut {
    static constexpr bool PERM = false, AFTER_DRAIN = false;
    const float *xp, *xs, *meta; float* H2; bf16_t* A2; float* ss2;
    __device__ __forceinline__ void operator()(const f32x4 (&acc)[2][2][4][2], const pg8::Unit& u, int wr, int wc, int fr_in, int fq_in) const {
        int fr = fr_in, fq = fq_in; asm volatile("" : "+v"(fr), "+v"(fq));
#pragma unroll
        for (int ai = 0; ai < 2; ++ai) {
            f32x4 hv[4][2][2];
#pragma unroll
            for (int m = 0; m < 4; ++m) { const int row = u.pm * 256 + ai * 128 + wr * 64 + m * 16 + fr; const float* h = h_row_ptr(row < T_ALL ? row : 0, xp, xs, meta);
#pragma unroll
                for (int bj = 0; bj < 2; ++bj)
#pragma unroll
                    for (int n = 0; n < 2; ++n) hv[m][bj][n] = *(const f32x4*)(h + u.pn * 256 + bj * 128 + wc * 32 + 16 * n + 4 * fq); }
#pragma unroll
            for (int m = 0; m < 4; ++m) { const int row = u.pm * 256 + ai * 128 + wr * 64 + m * 16 + fr; const bool ok = row < T_ALL; float ss = 0.f;
#pragma unroll
                for (int bj = 0; bj < 2; ++bj)
#pragma unroll
                    for (int n = 0; n < 2; ++n) { const int col = u.pn * 256 + bj * 128 + wc * 32 + 16 * n + 4 * fq; f32x4 r = acc[ai][bj][m][n]; if (ok) r += hv[m][bj][n];
                        *(f32x4*)(H2 + (size_t)row * 1024 + col) = r; u32x2 w; w.x = pk(r[0], r[1]); w.y = pk(r[2], r[3]); *(u32x2*)(A2 + (size_t)row * 1024 + col) = w;
                        ss += (r[0] * r[0] + r[1] * r[1]) + (r[2] * r[2] + r[3] * r[3]); }
                ss += __shfl_xor(ss, 16); ss += __shfl_xor(ss, 32);
                if (fq == 0) atomicAdd(ss2 + row, ss); } }
    }
};
struct EpiFfi {
    static constexpr bool PERM = true, AFTER_DRAIN = false;
    const float* ss2; bf16_t* Hid;
    __device__ __forceinline__ void operator()(const f32x4 (&acc)[2][2][4][2], const pg8::Unit& u, int wr, int wc, int fr_in, int fq_in) const {
        int fr = fr_in, fq = fq_in; asm volatile("" : "+v"(fr), "+v"(fq));
        float sv[8];
#pragma unroll
        for (int i = 0; i < 8; ++i) sv[i] = ss2[u.pm * 256 + (i >> 2) * 128 + wr * 64 + (i & 3) * 16 + fr];
#pragma unroll
        for (int ai = 0; ai < 2; ++ai)
#pragma unroll
            for (int m = 0; m < 4; ++m) { const int row = u.pm * 256 + ai * 128 + wr * 64 + m * 16 + fr;
                const float rs = rsqrtf(sv[ai * 4 + m] * (1.0f / 1024.0f) + NORM_EPS);
                f32x4 hv[2];
#pragma unroll
                for (int n = 0; n < 2; ++n) hv[n] = silu4(acc[ai][0][m][n] * rs) * (acc[ai][1][m][n] * rs);
                *(u32x4*)(Hid + (size_t)row * D_FF + u.pn * 128 + wc * 32 + 8 * fq) = pack8(hv[0], hv[1]); }
    }
};
struct EpiFfo {
    static constexpr bool PERM = false, AFTER_DRAIN = false;
    const float* H2; float* out;
    __device__ __forceinline__ void operator()(const f32x4 (&acc)[2][2][4][2], const pg8::Unit& u, int wr, int wc, int fr_in, int fq_in) const {
        int fr = fr_in, fq = fq_in; asm volatile("" : "+v"(fr), "+v"(fq));
#pragma unroll
        for (int ai = 0; ai < 2; ++ai) {
            f32x4 hv[4][2][2];
#pragma unroll
            for (int m = 0; m < 4; ++m) { const int row = u.pm * 256 + ai * 128 + wr * 64 + m * 16 + fr;
#pragma unroll
                for (int bj = 0; bj < 2; ++bj)
#pragma unroll
                    for (int n = 0; n < 2; ++n) hv[m][bj][n] = *(const f32x4*)(H2 + (size_t)row * 1024 + u.pn * 256 + bj * 128 + wc * 32 + 16 * n + 4 * fq); }
#pragma unroll
            for (int m = 0; m < 4; ++m) { const int row = u.pm * 256 + ai * 128 + wr * 64 + m * 16 + fr; float* dst = nullptr;
                if (row < T_PROMPT) { const int b = row / LP, l = row % LP; if (l >= N_META) dst = out + O_Y_P + ((size_t)b * SEQ + (l - N_META)) * 1024; }
                else if (row < T_ALL) dst = out + O_Y_S + (size_t)(row - T_PROMPT) * 1024;
                if (dst) {
#pragma unroll
                    for (int bj = 0; bj < 2; ++bj)
#pragma unroll
                        for (int n = 0; n < 2; ++n) *(f32x4*)(dst + u.pn * 256 + bj * 128 + wc * 32 + 16 * n + 4 * fq) = hv[m][bj][n] + acc[ai][bj][m][n]; } } }
    }
};
}
#define RETS_N_TASKS (DEC_BATCH * H_RET * 8)
__device__ __forceinline__ void ret_sample_task(const MegaArgs& a, int task, float* qk  , int lane) {
    const int sl = task & 7, h = (task >> 3) & 3, db = task >> 5, r0 = T_PROMPT + db * DEC_SEQ;
    { const int which = lane >> 5, ch = lane & 31; const bf16_t* src = (which ? a.Rk : a.Rq) + (size_t)r0 * 1024 + h * 256 + ch * 8;
#pragma unroll
      for (int i = 0; i < 8; ++i) { const uint4 v = *(const uint4*)(src + (size_t)i * 1024); const unsigned wv[4] = {v.x, v.y, v.z, v.w};
#pragma unroll
          for (int e = 0; e < 4; ++e) { qk[(ch * 8 + 2 * e) * 16 + which * 8 + i] = __uint_as_float(wv[e] << 16); qk[(ch * 8 + 2 * e + 1) * 16 + which * 8 + i] = __uint_as_float(wv[e] & 0xffff0000u); } } }
    float v[8], o[8]; const int dv = sl * 64 + lane;
#pragma unroll
    for (int i = 0; i < 8; ++i) { v[i] = bf2f(a.Rv[(size_t)(r0 + i) * 2048 + h * 512 + dv]); o[i] = 0.f; }
    const float gamma = 1.0f - exp2f(-5.0f - (float)h);
    const size_t sb = ((size_t)db * H_RET + h) * (DK_RET * DV_RET) + dv;
    const float* sin_ = a.state_ret + sb; float* sout = a.out + (size_t)O_R_S + sb;
    for (int dk0 = 0; dk0 < 256; dk0 += 32) {
        float s[32];
#pragma unroll
        for (int j = 0; j < 32; ++j) s[j] = __builtin_nontemporal_load(sin_ + (size_t)(dk0 + j) * DV_RET);
#pragma unroll
        for (int j = 0; j < 32; ++j) { const float4* c = (const float4*)(qk + (dk0 + j) * 16); const float4 q0 = c[0], q1 = c[1], k0 = c[2], k1 = c[3];
            const float qq[8] = {q0.x, q0.y, q0.z, q0.w, q1.x, q1.y, q1.z, q1.w}, kk[8] = {k0.x, k0.y, k0.z, k0.w, k1.x, k1.y, k1.z, k1.w};
#pragma unroll
            for (int i = 0; i < 8; ++i) { s[j] = fmaf(s[j], gamma, kk[i] * v[i]); o[i] = fmaf(qq[i], s[j], o[i]); }
            __builtin_nontemporal_store(s[j], sout + (size_t)(dk0 + j) * DV_RET); }
    }
#pragma unroll
    for (int i = 0; i < 8; ++i) { float ss = o[i] * o[i];
#pragma unroll
        for (int of = 32; of >= 1; of >>= 1) ss += __shfl_xor(ss, of);
        const size_t ci = (size_t)(r0 + i) * 2048 + h * 512 + dv;
        a.OG[ci] = f2bf(o[i] * bf2f(a.G[ci]));
        if (lane == 0) a.ssret[(size_t)(r0 + i) * 32 + h * 8 + sl] = ss; }
}

__device__ __forceinline__ void make_an_row(const MegaArgs& a, int r, int lane) {
    const float4* sp = (const float4*)(a.ssret + (size_t)r * 32);
    float rn[4];
#pragma unroll
    for (int h = 0; h < 4; ++h) { const float4 s0 = sp[2 * h], s1 = sp[2 * h + 1]; rn[h] = rsqrtf(((s0.x + s0.y) + (s0.z + s0.w) + (s1.x + s1.y) + (s1.z + s1.w)) * (1.0f / 512.0f) + NORM_EPS); }
#pragma unroll
    for (int h = 0; h < 4; ++h) { const uint4 v = ((const uint4*)(a.OG + (size_t)r * 2048))[h * 64 + lane]; const float f = rn[h]; uint4 o;
        o.x = pg8::cvt_pk_bf16(__uint_as_float(v.x << 16) * f, __uint_as_float(v.x & 0xffff0000u) * f); o.y = pg8::cvt_pk_bf16(__uint_as_float(v.y << 16) * f, __uint_as_float(v.y & 0xffff0000u) * f);
        o.z = pg8::cvt_pk_bf16(__uint_as_float(v.z << 16) * f, __uint_as_float(v.z & 0xffff0000u) * f); o.w = pg8::cvt_pk_bf16(__uint_as_float(v.w << 16) * f, __uint_as_float(v.w & 0xffff0000u) * f);
        ((uint4*)(a.An + (size_t)r * 2048))[h * 64 + lane] = o; }
}
__device__ __forceinline__ void knorm_row(const MegaArgs& a, int r, int lane) {
    float* kp = a.out + (r < T_PROMPT ? (size_t)O_K_P + (size_t)r * 256 : (size_t)O_K_S + (size_t)(r - T_PROMPT) * 256) + lane * 4;
    const float4 x = *(const float4*)kp; float ss = x.x * x.x + x.y * x.y + x.z * x.z + x.w * x.w;
#pragma unroll
    for (int o = 16; o >= 1; o >>= 1) ss += __shfl_xor(ss, o);
    const float rn = rsqrtf(ss * (1.0f / 128.0f) + NORM_EPS); const float4 w = *(const float4*)(a.knw + (lane & 31) * 4);
    const float4 y = make_float4(x.x * rn * w.x, x.y * rn * w.y, x.z * rn * w.z, x.w * rn * w.w);
    *(float4*)kp = y;
    uint2 o; o.x = (unsigned)f2bf(y.x) | ((unsigned)f2bf(y.y) << 16); o.y = (unsigned)f2bf(y.z) | ((unsigned)f2bf(y.w) << 16);
    *(uint2*)(a.Kb + (size_t)r * 256 + lane * 4) = o;
}
#define IDX_N_SAMPLE_TASKS (DEC_BATCH * 2)
#define IDX_N_PROMPT_TASKS (BATCH * (LP / 4))
#define IDX_N_TASKS (IDX_N_SAMPLE_TASKS + IDX_N_PROMPT_TASKS)
__device__ __forceinline__ void idx_task(const MegaArgs& a, int k, unsigned char* shm, int wave, int lane) {
    unsigned* strip = (unsigned*)(shm + (size_t)wave * idx::WAVE_LDS); unsigned* mask32 = (unsigned*)a.mask;
    if (k < IDX_N_SAMPLE_TASKS) {
        const int db = k >> 1, q0 = 4 * (k & 1);
        const int pgv = a.page_table[db * N_PAGES + (lane & 15)];
        idx::KeySrc<true> ks{a.Ikb + (size_t)(T_PROMPT + db * DEC_SEQ) * 64, a.cache_kidx, pgv};
        idx::wave_task<true>(ks, a.Iq, a.Iw, T_PROMPT + db * DEC_SEQ + q0, PAST_LEN + q0, 4, strip, mask32, lane);
    } else {
        const int pk = k - IDX_N_SAMPLE_TASKS, b = pk & 7, l0 = 4 * (LP / 4 - 1 - (pk >> 3));
        idx::KeySrc<false> ks{a.Ikb + (size_t)b * LP * 64, nullptr, 0};
        idx::wave_task<false>(ks, a.Iq, a.Iw, b * LP + l0, l0, 4, strip, mask32, lane);
    }
}
#define ATT_N_PROMPT_UNITS (BATCH * N_KV * 33)
__device__ __forceinline__ void attn_prompt_unit(const MegaArgs& a, int idx, char* lds) {
    const int qb = 32 - idx / 16, bn = idx % 16, b = bn >> 1, n = bn & 1;
    const int tok0 = b * LP + 64 * qb, nq = (LP - 64 * qb) < 64 ? (LP - 64 * qb) : 64;
    const int NT = qb + 1;
    att::KvPrompt kv{a.Kb + (size_t)b * LP * 256 + n * 128, a.Vb + (size_t)b * LP * 256 + n * 128};
    att::attn_unit<att::KvPrompt>(kv, a.Aq, a.qnw, a.mask, a.Odsa, tok0, nq, 4 * n, NT, lds);
}
__device__ __forceinline__ void attn_sample_unit(const MegaArgs& a, int u, char* lds) {
    const int db = u >> 1, n = u & 1;
    int* pages = (int*)(lds + 2 * att::SHM_V + 2 * att::SHM_K + 2048);
    __syncthreads();
    if (threadIdx.x < N_PAGES) pages[threadIdx.x] = a.page_table[db * N_PAGES + threadIdx.x];
    __syncthreads();
    att::KvSample kv{a.cache_k, a.cache_v, a.out + O_K_S + (size_t)db * DEC_SEQ * 256 + n * 128, a.out + O_V_S + (size_t)db * DEC_SEQ * 256 + n * 128, pages, n};
    att::attn_unit<att::KvSample>(kv, a.Aq, a.qnw, a.mask, a.Odsa, T_PROMPT + db * DEC_SEQ, DEC_SEQ, 4 * n, 33, lds);
}

#define LDS_TOTAL (8 * idx::WAVE_LDS + 2048)
__global__ void __launch_bounds__(512, 2) mega(MegaArgs a) {
    extern __shared__ __attribute__((aligned(16))) unsigned char shm[];
    float* lds = (float*)shm;
    volatile LAS unsigned* xbw = (volatile LAS unsigned*)(PG8_LAS unsigned char*)(shm + LDS_TOTAL - 16);
    const int tid = threadIdx.x, wave = tid >> 6, lane = tid & 63, half = tid >> 8, G = gridDim.x, bid = blockIdx.x;
    if (tid == 0) { xbw[0] = 0u; xbw[1] = 0u; xbw[2] = 0u; xbw[3] = 0u; }
    __syncthreads();
    XcdBarrier bar = xcd_barrier_post(a.bar, xbw);
    for (int jp = bid; jp < PREP_J_ROWS / 2; jp += G) prep_job(a.prep, 2 * jp + half, lds + half * (64 * 65));
    for (int j = PREP_J_ROWS + bid * 2 + half; j < PREP_N_JOBS; j += 2 * G) prep_job(a.prep, j, lds);
    for (int i = bid * 512 + tid; i < T_PAD; i += G * 512) a.rstd2[i] = 0.f;
    xcd_barrier(bar);
    { pg8::StaticOrder S; S.init(T_PAD, N1, G, bid);
      epi::Epi1 E{a.prep.rstd0, a.prep.rope, a.ikw, a.ikb, a.Rq, a.Rk, a.Rv, a.G, a.Aq, a.Vb, a.Iq, a.Ikb, a.Gates, a.Iw, a.out, 0};
      pg8::gemm_phase<epi::Epi1, pg8::StaticOrder, false>((PG8_LAS unsigned char*)shm, pg8::Gemm{a.prep.A0, a.prep.W1t, T_PAD, N1, 1024}, S, E, nullptr); }
    xcd_barrier(bar);
    for (int ord = 0; ord < 2; ++ord) {
      if ((ord ^ (bid & 1)) == 0) {
        for (int u = bid; u < BATCH * H_RET * 8; u += G) ret::unit(a, u, (char*)shm);
      } else {
      { int tl = threadIdx.x; asm volatile("" : "+v"(tl)); const int wv = __builtin_amdgcn_readfirstlane(tl >> 6), NW = 8 * G, g = wv * G + bid;
        float* strip = (float*)(shm + (size_t)wv * idx::WAVE_LDS);
        for (int step = 0; step < 6; ++step) { const int i = step >> 1;
            int ln_o = tl & 63; asm volatile("" : "+v"(ln_o)); const int ln = ln_o;
            if ((step + wv) & 1) { const int pi = i * NW + ((i & 1) ? (NW - 1 - g) : g); if (pi < IDX_N_TASKS) idx_task(a, pi, shm, wv, ln); }
            else                 { const int pr = i * NW + g; if (pr < RETS_N_TASKS) ret_sample_task(a, pr, strip, ln); } } }
        __syncthreads();
      }
    }
    { int t2 = threadIdx.x; asm volatile("" : "+v"(t2)); for (int r = bid * 8 + (t2 >> 6); r < T_ALL; r += 8 * G) knorm_row(a, r, t2 & 63); }
    xcd_barrier(bar);
    for (int ord = 0; ord < 2; ++ord) {
      if ((ord ^ (bid & 1)) == 0) {
        for (int i = 0; ; ++i) { const long p = (long)i * G + ((i & 1) ? (G - 1 - bid) : bid); if (p >= ATT_N_PROMPT_UNITS) { if ((long)i * G >= ATT_N_PROMPT_UNITS) break; else continue; } attn_prompt_unit(a, (int)p, (char*)shm); }
      } else {
        for (int u = bid; u < DEC_BATCH * N_KV; u += G) attn_sample_unit(a, u, (char*)shm);
      }
    }
    { int t2 = threadIdx.x; asm volatile("" : "+v"(t2)); for (int r = bid * 8 + (t2 >> 6); r < T_ALL; r += 8 * G) make_an_row(a, r, t2 & 63); }
    xcd_barrier(bar);
    { pg8::StaticOrder S; S.init(T_PAD, 1024, G, bid); pg8::gemm_phase<epi::EpiRet, pg8::StaticOrder, false>((PG8_LAS unsigned char*)shm, pg8::Gemm{a.An, a.prep.Wret, T_PAD, 1024, 2048}, S, epi::EpiRet{a.M1}, nullptr); }
    { pg8::StaticOrder S; S.init(T_PAD, 1024, G, bid); pg8::gemm_phase<epi::EpiDsa, pg8::StaticOrder, false>((PG8_LAS unsigned char*)shm, pg8::Gemm{a.Odsa, a.prep.Wdsa, T_PAD, 1024, 1024}, S, epi::EpiDsa{a.Gates, a.M1, a.Mg}, nullptr); }
    xcd_barrier(bar);
    { pg8::StaticOrder S; S.init(T_PAD, 1024, G, bid); pg8::gemm_phase<epi::EpiOut, pg8::StaticOrder, false>((PG8_LAS unsigned char*)shm, pg8::Gemm{a.Mg, a.prep.Wout, T_PAD, 1024, 1024}, S, epi::EpiOut{a.prep.x_prompt, a.prep.x_sample, a.prep.meta, a.H2, a.A2, a.rstd2}, nullptr); }
    xcd_barrier(bar);
    { pg8::StaticOrder S; S.init(T_PAD, NFF2, G, bid); pg8::gemm_phase<epi::EpiFfi, pg8::StaticOrder, false>((PG8_LAS unsigned char*)shm, pg8::Gemm{a.A2, a.prep.Wffi, T_PAD, NFF2, 1024}, S, epi::EpiFfi{a.rstd2, a.Hid}, nullptr); }
    xcd_barrier(bar);
    { pg8::StaticOrder S; S.init(T_PAD, 1024, G, bid); pg8::gemm_phase<epi::EpiFfo, pg8::StaticOrder, false>((PG8_LAS unsigned char*)shm, pg8::Gemm{a.Hid, a.prep.Wffo, T_PAD, 1024, 2816}, S, epi::EpiFfo{a.H2, a.out}, nullptr); }
}
extern "C" void kernel_launch(void* const* d_in, const int* in_sizes, int n_in, void* d_out, int out_size, void* d_ws, size_t ws_size, hipStream_t stream) {
    static int grid = 0;
    if (grid == 0) {
        if (n_in != 20 || out_size != OUT_TOTAL || ws_size < WS_END_B1 || ws_size < WS_END_B2) { fprintf(stderr, "kernel_launch: unexpected shapes (n_in %d out %d ws %zu need %llu)\n", n_in, out_size, ws_size, (unsigned long long)WS_END_B1); grid = -1; return; }
        int dev = 0, cus = 0, per_cu = 0;
        if (hipGetDevice(&dev) != hipSuccess || hipDeviceGetAttribute(&cus, hipDeviceAttributeMultiprocessorCount, dev) != hipSuccess) { grid = -1; return; }
        if (hipFuncSetAttribute((const void*)mega, hipFuncAttributeMaxDynamicSharedMemorySize, LDS_TOTAL) != hipSuccess) { fprintf(stderr, "kernel_launch: hipFuncSetAttribute failed\n"); grid = -1; return; }
        if (hipOccupancyMaxActiveBlocksPerMultiprocessor(&per_cu, (const void*)mega, 512, LDS_TOTAL) != hipSuccess || per_cu < 1) { fprintf(stderr, "kernel_launch: occupancy query says %d blocks per CU\n", per_cu); grid = -1; return; }
        grid = cus;
    }
    if (grid < 0) return;
    char* ws = (char*)d_ws;
    MegaArgs a{};
    a.prep.x_prompt = (const float*)d_in[0]; a.prep.x_sample = (const float*)d_in[1]; a.prep.meta = (const float*)d_in[7]; a.prep.norm_mix_w = (const float*)d_in[8]; a.prep.w_in = (const float*)d_in[9];
    a.prep.w_ret = (const float*)d_in[10]; a.prep.w_dsa = (const float*)d_in[15]; a.prep.w_out = (const float*)d_in[16]; a.prep.norm_ffn_w = (const float*)d_in[17]; a.prep.w_ffi = (const float*)d_in[18]; a.prep.w_ffo = (const float*)d_in[19];
    a.prep.W1t = (bf16_t*)(ws + WS_W1T); a.prep.Wret = (bf16_t*)(ws + WS_WRET); a.prep.Wdsa = (bf16_t*)(ws + WS_WDSA); a.prep.Wout = (bf16_t*)(ws + WS_WOUT); a.prep.Wffi = (bf16_t*)(ws + WS_WFFI); a.prep.Wffo = (bf16_t*)(ws + WS_WFFO);
    a.prep.A0 = (bf16_t*)(ws + WS_A0); a.prep.rstd0 = (float*)(ws + WS_RSTD0); a.prep.rope = (float2*)(ws + WS_ROPE);
    a.cache_k = (const float*)d_in[2]; a.cache_v = (const float*)d_in[3]; a.cache_kidx = (const float*)d_in[4]; a.state_ret = (const float*)d_in[5]; a.page_table = (const int*)d_in[6];
    a.qnw = (const float*)d_in[11]; a.knw = (const float*)d_in[12]; a.ikw = (const float*)d_in[13]; a.ikb = (const float*)d_in[14];
    a.Rq = (bf16_t*)(ws + WS_RQ); a.Rk = (bf16_t*)(ws + WS_RK); a.Rv = (bf16_t*)(ws + WS_RV); a.G = (bf16_t*)(ws + WS_G); a.Aq = (bf16_t*)(ws + WS_AQ); a.Kb = (bf16_t*)(ws + WS_KB); a.Vb = (bf16_t*)(ws + WS_VB);
    a.Iq = (bf16_t*)(ws + WS_IQ); a.Ikb = (bf16_t*)(ws + WS_IKB); a.Gates = (bf16_t*)(ws + WS_GATES); a.OG = (bf16_t*)(ws + WS_OG); a.An = (bf16_t*)(ws + WS_AN); a.Odsa = (bf16_t*)(ws + WS_ODSA); a.Mg = (bf16_t*)(ws + WS_MG);
    a.A2 = (bf16_t*)(ws + WS_A2); a.Hid = (bf16_t*)(ws + WS_HID);
    a.Iw = (float*)(ws + WS_IW); a.ssret = (float*)(ws + WS_SSRET); a.rstd2 = (float*)(ws + WS_RSTD2); a.Z = (float*)(ws + WS_Z); a.M1 = (float*)(ws + WS_M1); a.M2 = (float*)(ws + WS_M2); a.H2 = (float*)(ws + WS_H2); a.Zf = (float*)(ws + WS_ZF);
    a.out = (float*)d_out; a.mask = (u64*)(ws + WS_MASK); a.bar = (unsigned*)(ws + WS_CTL);
    if (hipMemsetAsync(ws + WS_CTL, 0, 65536, stream) != hipSuccess) return;
    hipLaunchKernelGGL(mega, dim3(grid), dim3(512), LDS_TOTAL, stream, a);
}
```

```cpp
#include <hip/hip_runtime.h>
#include <stdint.h>
#include <stdio.h>

#define D_MODEL 1024
#define BATCH 8
#define SEQ 2048
#define N_META 16
#define LP (N_META + SEQ)
#define DEC_BATCH 128
#define DEC_SEQ 8
#define PAST_LEN 2048
#define PAGE_SIZE 128
#define N_PAGES 16
#define H_RET 4
#define DK_RET 256
#define DV_RET 512
#define N_HEADS 8
#define N_KV 2
#define D_HEAD 128
#define N_IDXH 8
#define D_IDX 64
#define TOPK 256
#define D_FF 2816
#define IN_COLS 10312
#define NORM_EPS 1e-6f
#define IDX_SCALE 0.04419417382415922f
#define T_PROMPT (BATCH * LP)
#define T_SAMPLE (DEC_BATCH * DEC_SEQ)
#define T_ALL (T_PROMPT + T_SAMPLE)
#define T_PAD 17664
#define N1 10496
#define NFF2 5632
#define MASK_WORDS 34
#define SAMPLE_L (PAST_LEN + DEC_SEQ)

#define O_Y_P   0
#define O_Y_S   16777216
#define O_K_P   17825792
#define O_V_P   22052864
#define O_KI_P  26279936
#define O_R_P   27336704
#define O_K_S   31531008
#define O_V_S   31793152
#define O_KI_S  32055296
#define O_R_S   32120832
#define OUT_TOTAL 99229696

typedef unsigned short bf16_t;
typedef unsigned long long u64;

__device__ __forceinline__ bf16_t f2bf(float f) { unsigned u = __float_as_uint(f); u += 0x7FFFu + ((u >> 16) & 1u); return (bf16_t)(u >> 16); }
__device__ __forceinline__ float bf2f(bf16_t b) { return __uint_as_float(((unsigned)b) << 16); }
__device__ __forceinline__ float silu_f(float x) { return x / (1.0f + __expf(-x)); }
__device__ __forceinline__ float sigmoid_f(float x) { return 1.0f / (1.0f + __expf(-x)); }

__device__ __forceinline__ int row_pos(int r) { return r < T_PROMPT ? (r % LP) : (PAST_LEN + ((r - T_PROMPT) & (DEC_SEQ - 1))); }

#define WS_CTL      0ull
#define WS_W1T      (WS_CTL + 65536ull)
#define WS_WRET     (WS_W1T + (u64)N1 * 1024 * 2)
#define WS_WDSA     (WS_WRET + 1024ull * 2048 * 2)
#define WS_WOUT     (WS_WDSA + 1024ull * 1024 * 2)
#define WS_WFFI     (WS_WOUT + 1024ull * 1024 * 2)
#define WS_WFFO     (WS_WFFI + (u64)NFF2 * 1024 * 2)
#define WS_ROPE     (WS_WFFO + 1024ull * 2816 * 2)
#define WS_RSTD0    (WS_ROPE + (u64)LP * 128 * 8)
#define WS_A0       (WS_RSTD0 + (u64)T_PAD * 4)
#define WS_RQ       (WS_A0 + (u64)T_PAD * 1024 * 2)
#define WS_RK       (WS_RQ + (u64)T_PAD * 1024 * 2)
#define WS_RV       (WS_RK + (u64)T_PAD * 1024 * 2)
#define WS_G        (WS_RV + (u64)T_PAD * 2048 * 2)
#define WS_AQ       (WS_G + (u64)T_PAD * 2048 * 2)
#define WS_KB       (WS_AQ + (u64)T_PAD * 1024 * 2)
#define WS_VB       (WS_KB + (u64)T_PAD * 256 * 2)
#define WS_IQ       (WS_VB + (u64)T_PAD * 256 * 2)
#define WS_IKB      (WS_IQ + (u64)T_PAD * 512 * 2)
#define WS_IW       (WS_IKB + (u64)T_PAD * 64 * 2)
#define WS_GATES    (WS_IW + (u64)T_PAD * 8 * 4)
#define WS_MASK     (WS_GATES + (u64)T_PAD * 2048 * 2)
#define WS_SSRET    (WS_MASK + (u64)T_PAD * MASK_WORDS * 8)
#define WS_RSTD2    (WS_SSRET + (u64)T_PAD * 32 * 4)
#define WS_REGION_B (((WS_RSTD2 + (u64)T_PAD * 16 * 4) + 4095ull) & ~4095ull)
#define WS_Z        WS_REGION_B
#define WS_H2       WS_REGION_B
#define WS_A2       (WS_H2 + (u64)T_PAD * 1024 * 4)
#define WS_HID      (WS_A2 + (u64)T_PAD * 1024 * 2)
#define WS_MG       (WS_HID + (u64)T_PAD * 2816 * 2)
#define WS_OG       (WS_MG + (u64)T_PAD * 1024 * 2)
#define WS_AN       (WS_OG + (u64)T_PAD * 2048 * 2)
#define WS_ODSA     (WS_AN + (u64)T_PAD * 2048 * 2)
#define WS_M1       (WS_ODSA + (u64)T_PAD * 1024 * 2)
#define WS_M2       (WS_M1 + (u64)T_PAD * 1024 * 4)
#define WS_ZF       WS_OG
#define WS_END_B1   (WS_Z + (u64)T_PAD * N1 * 4)
#define WS_END_B2   (WS_ZF + (u64)T_PAD * NFF2 * 4)
namespace pg8 {
#define PG8_LAS __attribute__((address_space(3)))
typedef unsigned short bf16_t;
typedef short bf16x8 __attribute__((ext_vector_type(8)));
typedef float f32x4 __attribute__((ext_vector_type(4)));
typedef unsigned u32x4 __attribute__((ext_vector_type(4)));
constexpr int BM = 256, BK = 64, HALF = 128, HTB = HALF * BK * 2  , STAGE_BYTES = 8 * HTB, NXCD = 8, WGM = 8;

__host__ __device__ __forceinline__ int lds_byte(int r, int c) { const int st = (r >> 4) * 2 + (c >> 5), rr = r & 15, cc = c & 31, ob = rr * 64 + cc * 2; return st * 1024 + (ob ^ (((ob >> 9) & 1) << 5)); }
__host__ __device__ __forceinline__ void stage_rc(int b, int& R, int& C) { const int st = b / 1024, sb = b % 1024, swz = sb ^ (((sb >> 9) & 1) << 5); R = (st >> 1) * 16 + swz / 64; C = (st & 1) * 32 + (swz % 64) / 2; }
__host__ __device__ __forceinline__ int perm32(int rho) { const int n = rho >> 4, i = rho & 15; return 8 * (i >> 2) + 4 * n + (i & 3); }

struct Unit { int pm, pn; };
struct Gemm { const bf16_t* A; const bf16_t* Bt; int M, N, K; };

struct StaticOrder {
    int nM, nN, nwg, G, c;
    __host__ __device__ void init(int M, int N, int G_, int c_) { nM = M / BM; nN = N / BM; nwg = nM * nN; G = G_; c = c_; }
    __host__ __device__ bool next(int i, Unit& u) const {
        const long L = (long)i * G + c; if (L >= nwg) return false;
        int wgid = (int)L; { const int q = nwg / NXCD, r = nwg % NXCD, xcd = wgid % NXCD, off = wgid / NXCD; wgid = (xcd < r ? xcd * (q + 1) : r * (q + 1) + (xcd - r) * q) + off; }
        const int nig = WGM * nN, gid = wgid / nig, fm = gid * WGM, gsz = (nM - fm) < WGM ? (nM - fm) : WGM;
        u.pm = fm + ((wgid % nig) % gsz); u.pn = (wgid % nig) / gsz; return true;
    }
    __device__ __forceinline__ void a_ready(const Unit&) const {}
    __device__ __forceinline__ void done(const Unit&) const {}
};
struct CountedOrder : StaticOrder {
    const unsigned* ready; unsigned need; unsigned* tmo;
    __device__ __forceinline__ void a_ready(const Unit& u) const {
        if (threadIdx.x < 64) {
            const unsigned long long t0 = __builtin_amdgcn_s_memrealtime(); unsigned polls = 0;
            while ((unsigned)__builtin_amdgcn_readfirstlane(__hip_atomic_load(ready + 64 * u.pm, __ATOMIC_RELAXED, __HIP_MEMORY_SCOPE_AGENT)) < need) {
                if ((++polls & 255u) == 0u && __builtin_amdgcn_readfirstlane(__hip_atomic_load(tmo, __ATOMIC_RELAXED, __HIP_MEMORY_SCOPE_AGENT)) != 0u) break;
                if (__builtin_amdgcn_s_memrealtime() - t0 > 2000000ull) {
                    if (threadIdx.x == 0) { unsigned expect = 0u; __hip_atomic_compare_exchange_strong(tmo + 1, &expect, 0x600u | (unsigned)(u.pm & 0xff), __ATOMIC_RELAXED, __ATOMIC_RELAXED, __HIP_MEMORY_SCOPE_AGENT); __hip_atomic_store(tmo, 1u, __ATOMIC_RELAXED, __HIP_MEMORY_SCOPE_AGENT); }
                    break; }
                __builtin_amdgcn_s_sleep(2); }
            __builtin_amdgcn_fence(__ATOMIC_ACQUIRE, "agent");
            asm volatile("s_waitcnt vmcnt(0)" ::: "memory");
        }
#if !defined(BROKEN_HOOK_NO_BARRIER)
        asm volatile("" ::: "memory"); __builtin_amdgcn_s_barrier(); asm volatile("" ::: "memory");
#endif
    }
};

typedef float f32x2c __attribute__((ext_vector_type(2))); typedef __bf16 bf16x2c __attribute__((ext_vector_type(2)));
__device__ __forceinline__ unsigned cvt_pk_bf16(float lo, float hi) { const f32x2c v = {lo, hi}; return __builtin_bit_cast(unsigned, __builtin_convertvector(v, bf16x2c)); }
typedef float f32x2 __attribute__((ext_vector_type(2)));
__device__ __forceinline__ f32x2 gelu_pk(f32x2 v) {
    const f32x2 av = __builtin_elementwise_abs(v), d = av * 0.2316418882f + 1.0f;
    f32x2 t; t.x = __builtin_amdgcn_rcpf(d.x); t.y = __builtin_amdgcn_rcpf(d.y);
    f32x2 q = t * 0.5307027145f + (-0.7265760135f); q = q * t + 0.7107068705f; q = q * t + (-0.142248368f); q = q * t + 0.127414796f; q = q * t;
    const f32x2 s = (v * v) * (-0.72134752044f);
    f32x2 e; e.x = __builtin_amdgcn_exp2f(s.x); e.y = __builtin_amdgcn_exp2f(s.y);
    const f32x2 m = v * (q * e), r = v - m;
    f32x2 o; o.x = v.x < 0.f ? m.x : r.x; o.y = v.y < 0.f ? m.y : r.y; return o;
}

struct EpiF32 {
    static constexpr bool PERM = false, AFTER_DRAIN = false;
    float* C; int ldc; const float* bias;
    __device__ __forceinline__ void operator()(const f32x4 (&acc)[2][2][4][2], const Unit& u, int wr, int wc, int fr, int fq) const {
        const int row0 = u.pm * BM + wr * 64 + fr, col0 = u.pn * BM + wc * 32 + 4 * fq;
        f32x4 bv[2][2];
#pragma unroll
        for (int bj = 0; bj < 2; ++bj)
#pragma unroll
            for (int n = 0; n < 2; ++n) bv[bj][n] = bias ? *(const f32x4*)(bias + col0 + bj * HALF + n * 16) : (f32x4){0.f, 0.f, 0.f, 0.f};
#pragma unroll
        for (int ai = 0; ai < 2; ++ai)
#pragma unroll
            for (int m = 0; m < 4; ++m) { float* rowp = C + (size_t)(row0 + ai * HALF + m * 16) * ldc + col0;
#pragma unroll
                for (int bj = 0; bj < 2; ++bj)
#pragma unroll
                    for (int n = 0; n < 2; ++n) *(f32x4*)(rowp + bj * HALF + n * 16) = acc[ai][bj][m][n] + bv[bj][n]; }
    }
};
template <int ACT  > struct EpiBf16 {
    static constexpr bool PERM = true, AFTER_DRAIN = false;
    bf16_t* O; int ldc; const float* bias; int split_cols; size_t split_stride;
    __device__ __forceinline__ void operator()(const f32x4 (&acc)[2][2][4][2], const Unit& u, int wr, int wc, int fr, int fq) const {
        const int row0 = u.pm * BM + wr * 64 + fr; int colt = u.pn * BM; bf16_t* base = O;
        if (split_cols) { const int t = colt / split_cols; base += (size_t)t * split_stride; colt -= t * split_cols; }
        const int col0 = colt + wc * 32 + 8 * fq, bcol0 = u.pn * BM + wc * 32 + 8 * fq;
        f32x4 bv[2][2];
#pragma unroll
        for (int bj = 0; bj < 2; ++bj)
#pragma unroll
            for (int n = 0; n < 2; ++n) bv[bj][n] = bias ? *(const f32x4*)(bias + bcol0 + bj * HALF + 4 * n) : (f32x4){0.f, 0.f, 0.f, 0.f};
#pragma unroll
        for (int ai = 0; ai < 2; ++ai)
#pragma unroll
            for (int m = 0; m < 4; ++m) { bf16_t* rowp = base + (size_t)(row0 + ai * HALF + m * 16) * ldc + col0;
#pragma unroll
                for (int bj = 0; bj < 2; ++bj) { f32x4 v0 = acc[ai][bj][m][0] + bv[bj][0], v1 = acc[ai][bj][m][1] + bv[bj][1];
                    if (ACT == 1) { f32x2 a = gelu_pk((f32x2){v0[0], v0[1]}), b = gelu_pk((f32x2){v0[2], v0[3]}), c = gelu_pk((f32x2){v1[0], v1[1]}), d = gelu_pk((f32x2){v1[2], v1[3]});
                        v0 = (f32x4){a.x, a.y, b.x, b.y}; v1 = (f32x4){c.x, c.y, d.x, d.y}; }
                    if (ACT == 2) {
#pragma unroll
                        for (int j = 0; j < 4; ++j) { v0[j] = 0.5f * v0[j] * (1.0f + erff(v0[j] * 0.70710678f)); v1[j] = 0.5f * v1[j] * (1.0f + erff(v1[j] * 0.70710678f)); } }
                    u32x4 w; w.x = cvt_pk_bf16(v0[0], v0[1]); w.y = cvt_pk_bf16(v0[2], v0[3]); w.z = cvt_pk_bf16(v1[0], v1[1]); w.w = cvt_pk_bf16(v1[2], v1[3]);
                    *(u32x4*)(rowp + bj * HALF) = w; } }
    }
};
template <class Epi, class Sched, bool STAMP = false>
__device__ __forceinline__ void gemm_phase(PG8_LAS unsigned char* lds, const Gemm g, const Sched& S, const Epi& E, unsigned long long* stamps) {
    int tid_l = threadIdx.x; asm volatile("" : "+v"(tid_l));
    const int tid = tid_l, wid = __builtin_amdgcn_readfirstlane(tid >> 6), lane = tid & 63, wr = wid >> 2, wc = wid & 3, fr = lane & 15, fq = lane >> 4;
    const int K = g.K, nt = K / BK;
    int ts_lo = 0, ts_hi = 0, nts = 0; const unsigned long long rt_entry = STAMP ? (unsigned long long)wall_clock64() : 0ull;
#define PG8_STAMP() do { if (STAMP && wid == 0 && nts < 64) { const unsigned long long _c = (unsigned long long)clock64(); \
        ts_lo = (lane == nts) ? (int)(unsigned)_c : ts_lo; ts_hi = (lane == nts) ? (int)(unsigned)(_c >> 32) : ts_hi; ++nts; } } while (0)
    PG8_STAMP();
    unsigned voffA[2], voffB[2];
#pragma unroll
    for (int i = 0; i < 2; ++i) { int R, C; stage_rc(tid * 16 + i * 8192, R, C); const int Rb = Epi::PERM ? ((R & ~31) + perm32(R & 31)) : R;
        voffA[i] = (unsigned)(R * K + C) * 2u; voffB[i] = (unsigned)(Rb * K + C) * 2u; }
    const size_t kstep = (size_t)(BK * 2);
    const size_t hstep = (size_t)HALF * K * 2;
    const size_t tstep = 2 * hstep;
    const unsigned ldsw = (unsigned)wid * 1024u;
    const int aoff = lds_byte(wr * 64 + fr, fq * 8), boff = lds_byte(wc * 32 + fr, fq * 8);
#define PG8_SA(b, h) (((b) * 2 + (h)) * HTB)
#define PG8_SB(b, h) ((4 + (b) * 2 + (h)) * HTB)
#define PG8_STAGE(bufoff, gbase, voff) do { _Pragma("unroll") for (int _i = 0; _i < 2; ++_i) \
        __builtin_amdgcn_global_load_lds((const unsigned*)((const char*)(gbase) + (voff)[_i]), (PG8_LAS unsigned*)(lds + (bufoff) + ldsw + _i * 8192), 16, 0, 0); } while (0)
#define PG8_LDA(dst, b, h) do { _Pragma("unroll") for (int m = 0; m < 4; ++m) _Pragma("unroll") for (int k = 0; k < 2; ++k) dst[m][k] = *(const PG8_LAS bf16x8*)(lds + PG8_SA(b, h) + aoff + m * 2048 + k * 1024); } while (0)
#define PG8_LDB(dst, b, h) do { _Pragma("unroll") for (int n = 0; n < 2; ++n) _Pragma("unroll") for (int k = 0; k < 2; ++k) dst[n][k] = *(const PG8_LAS bf16x8*)(lds + PG8_SB(b, h) + boff + n * 2048 + k * 1024); } while (0)
#define PG8_MMA(ai, bj, At, Bt) do { __builtin_amdgcn_s_setprio(1); _Pragma("unroll") for (int m = 0; m < 4; ++m) _Pragma("unroll") for (int n = 0; n < 2; ++n) _Pragma("unroll") for (int k = 0; k < 2; ++k) \
        acc[ai][bj][m][n] = __builtin_amdgcn_mfma_f32_16x16x32_bf16(Bt[n][k], At[m][k], acc[ai][bj][m][n], 0, 0, 0); __builtin_amdgcn_s_setprio(0); } while (0)
#define PG8_WAIT_V(n) asm volatile("s_waitcnt vmcnt(" #n ")" ::: "memory")
#define PG8_WAIT_L(n) asm volatile("s_waitcnt lgkmcnt(" #n ")" ::: "memory")
#define PG8_BAR __builtin_amdgcn_s_barrier()
#define PG8_SCHED __builtin_amdgcn_sched_barrier(0)
    Unit cur, nxt; int ui = 0;
    if (!S.next(0, cur)) return;
    f32x4 acc[2][2][4][2];
#pragma unroll
    for (int a = 0; a < 2; ++a)
#pragma unroll
        for (int b = 0; b < 2; ++b)
#pragma unroll
            for (int m = 0; m < 4; ++m)
#pragma unroll
                for (int n = 0; n < 2; ++n) acc[a][b][m][n] = (f32x4){0.f, 0.f, 0.f, 0.f};
    bf16x8 At[4][2], B0[2][2], B1[2][2];
    const char* cA = (const char*)g.A + (size_t)cur.pm * tstep; const char* cB = (const char*)g.Bt + (size_t)cur.pn * tstep;
    S.a_ready(cur);
    PG8_STAGE(PG8_SB(0, 0), cB, voffB); PG8_STAGE(PG8_SA(0, 0), cA, voffA); PG8_STAGE(PG8_SB(0, 1), cB + hstep, voffB); PG8_STAGE(PG8_SA(0, 1), cA + hstep, voffA);
    if (wr == 1) PG8_BAR;
    PG8_WAIT_V(4); PG8_BAR;
    PG8_STAGE(PG8_SB(1, 0), cB + kstep, voffB); PG8_STAGE(PG8_SA(1, 0), cA + kstep, voffA); PG8_STAGE(PG8_SB(1, 1), cB + hstep + kstep, voffB);
    PG8_WAIT_V(6); PG8_BAR;
    PG8_STAMP();
    for (;;) {
        const bool has_next = S.next(ui + 1, nxt);
        const char* nA = has_next ? (const char*)g.A + (size_t)nxt.pm * tstep : cA; const char* nB = has_next ? (const char*)g.Bt + (size_t)nxt.pn * tstep : cB;
        for (int t = 0; t < nt; t += 2) {
            const bool last = (t == nt - 2);
            const char* a1 = cA + (size_t)(t + 1) * kstep;
            const char* a2 = last ? nA : cA + (size_t)(t + 2) * kstep; const char* b2 = last ? nB : cB + (size_t)(t + 2) * kstep;
            const char* a3 = a2 + kstep; const char* b3 = b2 + kstep;
            if (last && has_next) S.a_ready(nxt);
            PG8_LDB(B0, 0, 0); PG8_SCHED; PG8_LDA(At, 0, 0); PG8_STAGE(PG8_SA(1, 1), a1 + hstep, voffA);
            PG8_WAIT_L(8); PG8_BAR; PG8_WAIT_L(0); PG8_MMA(0, 0, At, B0); PG8_BAR; PG8_SCHED;
            PG8_LDB(B1, 0, 1); PG8_STAGE(PG8_SB(0, 0), b2, voffB);
            PG8_BAR; PG8_WAIT_L(0); PG8_MMA(0, 1, At, B1); PG8_BAR;
            PG8_LDA(At, 0, 1); PG8_STAGE(PG8_SA(0, 0), a2, voffA);
            PG8_BAR; PG8_WAIT_L(0); PG8_MMA(1, 0, At, B0); PG8_BAR; PG8_SCHED;
            PG8_STAGE(PG8_SB(0, 1), b2 + hstep, voffB);
            PG8_WAIT_V(6); PG8_BAR; PG8_MMA(1, 1, At, B1); PG8_BAR;
            PG8_LDB(B0, 1, 0); PG8_SCHED; PG8_LDA(At, 1, 0); PG8_STAGE(PG8_SA(0, 1), a2 + hstep, voffA);
            PG8_WAIT_L(8); PG8_BAR; PG8_WAIT_L(0); PG8_MMA(0, 0, At, B0); PG8_BAR; PG8_SCHED;
            PG8_LDB(B1, 1, 1); PG8_STAGE(PG8_SB(1, 0), b3, voffB);
            PG8_BAR; PG8_WAIT_L(0); PG8_MMA(0, 1, At, B1); PG8_BAR;
            PG8_LDA(At, 1, 1); PG8_STAGE(PG8_SA(1, 0), a3, voffA);
            PG8_BAR; PG8_WAIT_L(0); PG8_MMA(1, 0, At, B0); PG8_BAR; PG8_SCHED;
            PG8_STAGE(PG8_SB(1, 1), b3 + hstep, voffB);
            PG8_WAIT_V(6); PG8_BAR; PG8_MMA(1, 1, At, B1); PG8_BAR;
        }
        PG8_STAMP();
        if constexpr (!Epi::AFTER_DRAIN) { E(acc, cur, wr, wc, fr, fq); S.done(cur); }
        PG8_STAMP();
        if (!has_next) break;
#pragma unroll
        for (int a = 0; a < 2; ++a)
#pragma unroll
            for (int b = 0; b < 2; ++b)
#pragma unroll
                for (int m = 0; m < 4; ++m)
#pragma unroll
                    for (int n = 0; n < 2; ++n) acc[a][b][m][n] = (f32x4){0.f, 0.f, 0.f, 0.f};
        cur = nxt; cA = nA; cB = nB; ++ui;
    }
    PG8_WAIT_V(0);
    if (wr == 0) PG8_BAR;
    PG8_BAR;
    if constexpr (Epi::AFTER_DRAIN) { E.fused(acc, cur, wr, wc, fr, fq, lds, wid, lane); S.done(cur); }
    PG8_STAMP();
    if (STAMP && wid == 0) { stamps[lane] = lane < nts ? (((unsigned long long)(unsigned)ts_hi << 32) | (unsigned)ts_lo) : 0ull;
        if (lane == 62) stamps[62] = rt_entry; if (lane == 63) stamps[63] = (unsigned long long)wall_clock64(); }
#undef PG8_STAMP
#undef PG8_SA
#undef PG8_SB
#undef PG8_STAGE
#undef PG8_LDA
#undef PG8_LDB
#undef PG8_MMA
#undef PG8_WAIT_V
#undef PG8_WAIT_L
#undef PG8_BAR
#undef PG8_SCHED
}
}
#define XB_TMO      128
#define XB_XCNT(j)  (256  + 64 * (j))
#define XB_XSUB(j)  (1280 + 64 * (j))
#define XB_XGEN(j)  (2304 + 64 * (j))
#define XB_TOP      3328
#define XB_TOPGEN   3392
#define XCD_BAR_WORDS 3456
#define XB_SPIN_CAP (1u << 18)
#define LAS __attribute__((address_space(3)))

__device__ __forceinline__ unsigned xb_ld(unsigned* p)              { return __hip_atomic_load(p, __ATOMIC_RELAXED, __HIP_MEMORY_SCOPE_AGENT); }
__device__ __forceinline__ unsigned xb_add(unsigned* p, unsigned v) { return __hip_atomic_fetch_add(p, v, __ATOMIC_RELAXED, __HIP_MEMORY_SCOPE_AGENT); }
__device__ __forceinline__ unsigned xb_xcc_id() { return (unsigned)__builtin_amdgcn_s_getreg((3 << 11) | 20) & 0xFu; }
#define XB_SPIN(cond, bar) do { unsigned _sp = 0; while (cond) { __builtin_amdgcn_s_sleep(1); \
    if ((++_sp & 255u) == 0u) { if (xb_ld(&(bar)[XB_TMO])) break; if (_sp > XB_SPIN_CAP) { atomicAdd(&(bar)[XB_TMO], 1u); break; } } } } while (0)

struct XcdBarrier {
    unsigned* bar; unsigned x;
    volatile LAS unsigned* st;
};

__device__ __forceinline__ XcdBarrier xcd_barrier_post(unsigned* bar, volatile LAS unsigned* st) {
    XcdBarrier b; b.bar = bar; b.x = xb_xcc_id(); b.st = st;
    if (threadIdx.x == 0) (void)xb_add(&bar[XB_XCNT(b.x)], 1u);
    return b;
}
__device__ __forceinline__ void xcd_barrier_complete(unsigned* bar, unsigned x, unsigned& nloc, unsigned& nx) {
    const unsigned G = gridDim.x * gridDim.y * gridDim.z;
    unsigned sum, cnt, mine, sp = 0u;
    for (;;) {
        sum = 0u; cnt = 0u; mine = 0u;
#pragma unroll
        for (unsigned j = 0; j < 16; ++j) { const unsigned c = xb_ld(&bar[XB_XCNT(j)]); sum += c; cnt += (c > 0u) ? 1u : 0u; mine = (j == x) ? c : mine; }
        if (sum == G) break;
        __builtin_amdgcn_s_sleep(1);
        if ((++sp & 255u) == 0u) { if (xb_ld(&bar[XB_TMO])) break; if (sp > XB_SPIN_CAP) { atomicAdd(&bar[XB_TMO], 1u); break; } }
    }
    nloc = mine > 0u ? mine : 1u; nx = cnt > 0u ? cnt : 1u;
}

__device__ __forceinline__ void xcd_barrier(const XcdBarrier& b) {
    asm volatile("s_waitcnt vmcnt(0)" ::: "memory");
    __syncthreads();
    if (threadIdx.x == 0) {
        unsigned* bar = b.bar;
        __builtin_amdgcn_s_waitcnt(0);
        unsigned nloc = b.st[0], nx = b.st[1];
        if (nloc == 0u) { xcd_barrier_complete(bar, b.x, nloc, nx); b.st[0] = nloc; b.st[1] = nx; }
        const unsigned old = xb_add(&bar[XB_XSUB(b.x)], 1u);
        const unsigned gen = old / nloc;
        if (old + 1u == (gen + 1u) * nloc) {
            __builtin_amdgcn_fence(__ATOMIC_RELEASE, "agent");
            asm volatile("s_waitcnt vmcnt(0)" ::: "memory");
            const unsigned og = xb_add(&bar[XB_TOP], 1u);
            const unsigned tg = og / nx;
            if (og + 1u == (tg + 1u) * nx) xb_add(&bar[XB_TOPGEN], 1u);
            else XB_SPIN(xb_ld(&bar[XB_TOPGEN]) == tg, bar);
            __builtin_amdgcn_fence(__ATOMIC_ACQUIRE, "agent");
            xb_add(&bar[XB_XGEN(b.x)], 1u);
            asm volatile("s_waitcnt vmcnt(0)" ::: "memory");
        } else {
            XB_SPIN(xb_ld(&bar[XB_XGEN(b.x)]) == gen, bar);
            __builtin_amdgcn_fence(__ATOMIC_ACQUIRE, "agent");
            asm volatile("s_waitcnt vmcnt(0)" ::: "memory");
        }
    }
    __syncthreads();
}
__host__ __device__ __forceinline__ int ikiw_src(int c) {
    if (c < 32) return 8192 + c;
    if (c < 40) return 8256 + (c - 32);
    if (c >= 128 && c < 160) return 8192 + 32 + (c - 128);
    return -1;
}
__host__ __device__ __forceinline__ int ik_tilecol(int e) { return e < 32 ? e : 128 + (e - 32); }
__device__ __forceinline__ int src_col(int mode, int n) {
    if (mode == 0) return n;
    if (mode == 1) { if (n < 8192) return n; if (n < 8448) return ikiw_src(n - 8192); return 8264 + (n - 8448); }
    const int pn = n >> 8, c = n & 255; return c < 128 ? pn * 128 + c : D_FF + pn * 128 + (c - 128);
}
__device__ __forceinline__ void prep_weight_tile(const float* __restrict__ w, int ldw, const float* __restrict__ scale, bf16_t* __restrict__ Wt, int K, int mode, int tile, float* lds  ) {
    const int ktiles = K / 64, nt = tile / ktiles, kt = tile % ktiles, tid = threadIdx.x & 255;
    const int n0 = nt * 64, k0 = kt * 64;
    {   const int nn = tid & 63, kk0 = tid >> 6; const int sc = src_col(mode, n0 + nn); float v[16];
#pragma unroll
        for (int i = 0; i < 16; ++i) { const int kk = kk0 + i * 4; v[i] = sc >= 0 ? w[(size_t)(k0 + kk) * ldw + sc] : 0.f; }
        if (scale) {
#pragma unroll
            for (int i = 0; i < 16; ++i) v[i] *= scale[k0 + kk0 + i * 4]; }
#pragma unroll
        for (int i = 0; i < 16; ++i) lds[(kk0 + i * 4) * 65 + nn] = v[i]; }
    __syncthreads();
    {   const int kp = tid & 31, nn0 = tid >> 5;
#pragma unroll
        for (int i = 0; i < 8; ++i) { const int nn = nn0 + i * 8; ((unsigned*)(Wt + (size_t)(n0 + nn) * K + k0))[kp] = (unsigned)f2bf(lds[(2 * kp) * 65 + nn]) | ((unsigned)f2bf(lds[(2 * kp + 1) * 65 + nn]) << 16); } }
    __syncthreads();
}
__device__ __forceinline__ const float* h_row_ptr(int r, const float* xp, const float* xs, const float* meta) {
    if (r < T_PROMPT) { const int b = r / LP, l = r % LP; return l < N_META ? meta + (size_t)l * D_MODEL : xp + ((size_t)b * SEQ + (l - N_META)) * D_MODEL; }
    return xs + (size_t)(r - T_PROMPT) * D_MODEL;
}
__device__ __forceinline__ void prep_row(int r, const float* xp, const float* xs, const float* meta, bf16_t* A0, float* rstd0, int lane) {
    if (r >= T_ALL) { for (int i = lane; i < D_MODEL / 2; i += 64) ((unsigned*)(A0 + (size_t)r * D_MODEL))[i] = 0u; if (lane == 0) rstd0[r] = 0.f; return; }
    const float4* src = (const float4*)h_row_ptr(r, xp, xs, meta); float ss = 0.f;
#pragma unroll
    for (int i = 0; i < 4; ++i) { const float4 v = src[lane + i * 64]; ss += v.x * v.x + v.y * v.y + v.z * v.z + v.w * v.w;
        uint2 o; o.x = (unsigned)f2bf(v.x) | ((unsigned)f2bf(v.y) << 16); o.y = (unsigned)f2bf(v.z) | ((unsigned)f2bf(v.w) << 16);
        ((uint2*)(A0 + (size_t)r * D_MODEL))[lane + i * 64] = o; }
#pragma unroll
    for (int o = 32; o >= 1; o >>= 1) ss += __shfl_xor(ss, o);
    if (lane == 0) rstd0[r] = rsqrtf(ss * (1.0f / D_MODEL) + NORM_EPS);
}
__device__ __forceinline__ void rope_entry(int idx, float2* tab) {
    const int pos = idx >> 7, i = idx & 127;
    const float inv = exp2f(-(float)i * (13.287712379549449f / 128.0f));
    const float angf = (float)pos * inv; const double a = (double)angf;
    const double kq = rint(a * 0.63661977236758134308);
    double r = fma(-kq, 1.57079632679489655800e+00, a); r = fma(-kq, 6.12323399573676603587e-17, r);
    const double r2 = r * r;
    const double sp = r * (1.0 + r2 * (-1.0 / 6 + r2 * (1.0 / 120 + r2 * (-1.0 / 5040 + r2 * (1.0 / 362880 + r2 * (-1.0 / 39916800 + r2 * (1.0 / 6227020800.0)))))));
    const double cp = 1.0 + r2 * (-0.5 + r2 * (1.0 / 24 + r2 * (-1.0 / 720 + r2 * (1.0 / 40320 + r2 * (-1.0 / 3628800 + r2 * (1.0 / 479001600 + r2 * (-1.0 / 87178291200.0)))))));
    const int q = ((int)kq) & 3;
    const double sv = (q == 0) ? sp : (q == 1) ? cp : (q == 2) ? -sp : -cp;
    const double cv = (q == 0) ? cp : (q == 1) ? -sp : (q == 2) ? -cp : sp;
    tab[idx] = make_float2((float)cv, (float)sv);
}

struct PrepArgs {
    const float *x_prompt, *x_sample, *meta, *norm_mix_w, *w_in, *w_ret, *w_dsa, *w_out, *norm_ffn_w, *w_ffi, *w_ffo;
    bf16_t *W1t, *Wret, *Wdsa, *Wout, *Wffi, *Wffo, *A0; float* rstd0; float2* rope;
};
#define PREP_J_W1   0
#define PREP_N_W1   ((N1 / 64) * (1024 / 64))
#define PREP_J_WRET (PREP_J_W1 + PREP_N_W1)
#define PREP_N_WRET ((1024 / 64) * (2048 / 64))
#define PREP_J_WDSA (PREP_J_WRET + PREP_N_WRET)
#define PREP_N_WDSA ((1024 / 64) * (1024 / 64))
#define PREP_J_WOUT (PREP_J_WDSA + PREP_N_WDSA)
#define PREP_N_WOUT ((1024 / 64) * (1024 / 64))
#define PREP_J_WFFI (PREP_J_WOUT + PREP_N_WOUT)
#define PREP_N_WFFI ((NFF2 / 64) * (1024 / 64))
#define PREP_J_WFFO (PREP_J_WFFI + PREP_N_WFFI)
#define PREP_N_WFFO ((1024 / 64) * (2816 / 64))
#define PREP_J_ROWS (PREP_J_WFFO + PREP_N_WFFO)
#define PREP_N_ROWS (T_PAD / 4)
#define PREP_J_ROPE (PREP_J_ROWS + PREP_N_ROWS)
#define PREP_N_ROPE ((LP * 128) / 256)
#define PREP_N_JOBS (PREP_J_ROPE + PREP_N_ROPE)
__device__ __forceinline__ void prep_job(const PrepArgs& a, int job, float* lds) {
    if (job < PREP_J_WRET)      prep_weight_tile(a.w_in, IN_COLS, a.norm_mix_w, a.W1t, 1024, 1, job - PREP_J_W1, lds);
    else if (job < PREP_J_WDSA) prep_weight_tile(a.w_ret, 1024, nullptr, a.Wret, 2048, 0, job - PREP_J_WRET, lds);
    else if (job < PREP_J_WOUT) prep_weight_tile(a.w_dsa, 1024, nullptr, a.Wdsa, 1024, 0, job - PREP_J_WDSA, lds);
    else if (job < PREP_J_WFFI) prep_weight_tile(a.w_out, 1024, nullptr, a.Wout, 1024, 0, job - PREP_J_WOUT, lds);
    else if (job < PREP_J_WFFO) prep_weight_tile(a.w_ffi, 2 * D_FF, a.norm_ffn_w, a.Wffi, 1024, 2, job - PREP_J_WFFI, lds);
    else if (job < PREP_J_ROWS) prep_weight_tile(a.w_ffo, 1024, nullptr, a.Wffo, 2816, 0, job - PREP_J_WFFO, lds);
    else if (job < PREP_J_ROPE) prep_row((job - PREP_J_ROWS) * 4 + ((threadIdx.x & 255) >> 6), a.x_prompt, a.x_sample, a.meta, a.A0, a.rstd0, threadIdx.x & 63);
    else rope_entry((job - PREP_J_ROPE) * 256 + (threadIdx.x & 255), a.rope);
}
namespace att {
using bf16x8 = __attribute__((ext_vector_type(8))) short;
using s16x4  = __attribute__((ext_vector_type(4))) short;
using f32x16 = __attribute__((ext_vector_type(16))) float;
using f32x8  = __attribute__((ext_vector_type(8))) float;
using u32x4  = __attribute__((ext_vector_type(4))) unsigned;
constexpr float SCALE = 0.088388347648318440f;
constexpr float THR = 8.f;
constexpr float NEG = -3.0e38f;
constexpr int SHM_V = 64 * 128 * 2, SHM_K = 64 * 128 * 2;
#define ATT_KSWZ(row, colB) ((row) * 256 + ((colB) ^ (((row) & 7) << 4)))
#define ATT_SBAR() __builtin_amdgcn_sched_barrier(0)
__device__ __forceinline__ int crow(int r, int hi) { return (r & 3) + 8 * (r >> 2) + 4 * hi; }
__device__ __forceinline__ unsigned cvtpk(float lo, float hi) { return pg8::cvt_pk_bf16(lo, hi); }
__device__ __forceinline__ bf16x8 tobf(f32x8 x) { u32x4 w = {cvtpk(x[0], x[1]), cvtpk(x[2], x[3]), cvtpk(x[4], x[5]), cvtpk(x[6], x[7])}; return *reinterpret_cast<bf16x8*>(&w); }
__device__ __forceinline__ bf16x8 tobf(bf16x8 x) { return x; }

__device__ __forceinline__ void apply_mask(f32x16& p0, f32x16& p1, u64 mk, int hi) {
    const unsigned lo = (unsigned)mk >> (4 * hi), hw = (unsigned)(mk >> 32) >> (4 * hi);
#pragma unroll
    for (int r = 0; r < 16; ++r) { const unsigned bit = 1u << ((r & 3) + 8 * (r >> 2)); p0[r] = (lo & bit) ? p0[r] : NEG; p1[r] = (hw & bit) ? p1[r] : NEG; }
}
__device__ __forceinline__ void partialSM(f32x16& p0, f32x16& p1, float& m_reg, float& mn, float& alpha) {
    constexpr float C = SCALE * 1.4426950408889634f;
    float pmax = p0[0];
#pragma unroll
    for (int r = 1; r < 16; ++r) pmax = fmaxf(pmax, p0[r]);
#pragma unroll
    for (int r = 0; r < 16; ++r) pmax = fmaxf(pmax, p1[r]);
    { auto rr = __builtin_amdgcn_permlane32_swap(__float_as_uint(pmax), __float_as_uint(pmax), false, false);
      pmax = fmaxf(__uint_as_float(rr[0]), __uint_as_float(rr[1])); }
    if (__builtin_expect(__all(pmax - m_reg <= THR / SCALE), 1)) { mn = m_reg; alpha = 1.f; }
    else { mn = fmaxf(m_reg, pmax); alpha = __builtin_amdgcn_exp2f((m_reg - mn) * C); m_reg = mn; }
    const float mnC = -mn * C;
#pragma unroll
    for (int r = 0; r < 16; ++r) p0[r] = fmaf(p0[r], C, mnC);
#pragma unroll
    for (int r = 0; r < 16; ++r) p1[r] = fmaf(p1[r], C, mnC);
#pragma unroll
    for (int r = 0; r < 16; ++r) p0[r] = __builtin_amdgcn_exp2f(p0[r]);
}
__device__ __forceinline__ void finishSM(f32x16& p0, f32x16& p1, float alpha, float& l_reg, bf16x8& pa0, bf16x8& pa1, bf16x8& pa2, bf16x8& pa3) {
#pragma unroll
    for (int r = 0; r < 16; ++r) p1[r] = __builtin_amdgcn_exp2f(p1[r]);
    float ps = 0;
#pragma unroll
    for (int r = 0; r < 16; ++r) ps += p0[r];
#pragma unroll
    for (int r = 0; r < 16; ++r) ps += p1[r];
    { auto rr = __builtin_amdgcn_permlane32_swap(__float_as_uint(ps), __float_as_uint(ps), false, false);
      ps = __uint_as_float(rr[0]) + __uint_as_float(rr[1]); }
    l_reg = l_reg * alpha + ps;
#define ATT_PK4(P, BASE, OUT) do { unsigned a0 = cvtpk(P[BASE + 0], P[BASE + 1]), a1 = cvtpk(P[BASE + 2], P[BASE + 3]);   \
    unsigned b0 = cvtpk(P[BASE + 4], P[BASE + 5]), b1 = cvtpk(P[BASE + 6], P[BASE + 7]);                              \
    auto r0 = __builtin_amdgcn_permlane32_swap(a0, b0, false, false); auto r1 = __builtin_amdgcn_permlane32_swap(a1, b1, false, false); \
    u32x4 w = {r0[0], r1[0], r0[1], r1[1]}; OUT = *reinterpret_cast<bf16x8*>(&w); } while (0)
    ATT_PK4(p0, 0, pa0); ATT_PK4(p0, 8, pa1); ATT_PK4(p1, 0, pa2); ATT_PK4(p1, 8, pa3);
#undef ATT_PK4
}
__device__ __forceinline__ void qkt(f32x16& p0, f32x16& p1, const char* Ks, const bf16x8* qr, int r32, int hi) {
    p0 = f32x16{}; p1 = f32x16{};
#pragma unroll
    for (int d0 = 0; d0 < 8; ++d0) { const int cb = (d0 * 16 + hi * 8) * 2;
        const bf16x8 b0 = *reinterpret_cast<const bf16x8*>(Ks + ATT_KSWZ(r32, cb));
        const bf16x8 b1 = *reinterpret_cast<const bf16x8*>(Ks + ATT_KSWZ(32 + r32, cb));
        p0 = __builtin_amdgcn_mfma_f32_32x32x16_bf16(b0, qr[d0], p0, 0, 0, 0);
        p1 = __builtin_amdgcn_mfma_f32_32x32x16_bf16(b1, qr[d0], p1, 0, 0, 0); }
}
__device__ __forceinline__ int v_st(int k, int c) { const int kk = (k & ~0xC) | ((k & 4) << 1) | ((k & 8) >> 1); return ((kk >> 3) * 4 + (c >> 5)) * 512 + ((kk & 7) * 32 + (c & 31)) * 2; }
__device__ __forceinline__ int v_rd_base(int lane) { return ((lane & 3) << 3) | (((lane >> 2) & 3) << 6) | (((lane >> 4) & 1) << 5) | (((lane >> 5) & 1) << 8); }
constexpr int v_rd_off(int d0, int ks, int half) { return d0 * 512 + ks * 4096 + half * 2048; }
template <int OFF> __device__ __forceinline__ s16x4 tr_read(int vb) { s16x4 r; asm volatile("ds_read_b64_tr_b16 %0, %1 offset:%2" : "=&v"(r) : "v"(vb), "i"(OFF) : "memory"); return r; }
template <int D0> __device__ __forceinline__ void pv_one(f32x16& od, int vb, bf16x8 pa0, bf16x8 pa1, bf16x8 pa2, bf16x8 pa3) {
    const s16x4 l0 = tr_read<v_rd_off(D0, 0, 0)>(vb), h0 = tr_read<v_rd_off(D0, 0, 1)>(vb), l1 = tr_read<v_rd_off(D0, 1, 0)>(vb), h1 = tr_read<v_rd_off(D0, 1, 1)>(vb);
    const s16x4 l2 = tr_read<v_rd_off(D0, 2, 0)>(vb), h2 = tr_read<v_rd_off(D0, 2, 1)>(vb), l3 = tr_read<v_rd_off(D0, 3, 0)>(vb), h3 = tr_read<v_rd_off(D0, 3, 1)>(vb);
    asm volatile("s_waitcnt lgkmcnt(0)" ::: "memory"); ATT_SBAR();
#define ATT_PK(L, H) (bf16x8){L[0], L[1], L[2], L[3], H[0], H[1], H[2], H[3]}
    od = __builtin_amdgcn_mfma_f32_32x32x16_bf16(pa0, ATT_PK(l0, h0), od, 0, 0, 0);
    od = __builtin_amdgcn_mfma_f32_32x32x16_bf16(pa1, ATT_PK(l1, h1), od, 0, 0, 0);
    od = __builtin_amdgcn_mfma_f32_32x32x16_bf16(pa2, ATT_PK(l2, h2), od, 0, 0, 0);
    od = __builtin_amdgcn_mfma_f32_32x32x16_bf16(pa3, ATT_PK(l3, h3), od, 0, 0, 0);
#undef ATT_PK
}
__device__ __forceinline__ void pv_d0(f32x16* o, int vb, bf16x8 pa0, bf16x8 pa1, bf16x8 pa2, bf16x8 pa3) {
    pv_one<0>(o[0], vb, pa0, pa1, pa2, pa3); pv_one<1>(o[1], vb, pa0, pa1, pa2, pa3); pv_one<2>(o[2], vb, pa0, pa1, pa2, pa3); pv_one<3>(o[3], vb, pa0, pa1, pa2, pa3);
}

struct KvPrompt {
    using T = bf16x8; const bf16_t* K; const bf16_t* V;
    __device__ __forceinline__ T ldk(int key, int col) const { return *reinterpret_cast<const bf16x8*>(K + (size_t)key * 256 + col); }
    __device__ __forceinline__ T ldv(int key, int col) const { return *reinterpret_cast<const bf16x8*>(V + (size_t)key * 256 + col); }
};
struct KvSample {
    using T = f32x8; const float* ck; const float* cv; const float* kn; const float* vn; const int* pages  ; int n;
    __device__ __forceinline__ size_t roff(int key) const { return (((size_t)pages[key >> 7] * PAGE_SIZE + (key & 127)) * N_KV + n) * 128; }
    __device__ __forceinline__ T ldk(int key, int col) const { const float* p = key < PAST_LEN ? ck + roff(key) : kn + (size_t)min(key - PAST_LEN, DEC_SEQ - 1) * 256; return *reinterpret_cast<const f32x8*>(p + col); }
    __device__ __forceinline__ T ldv(int key, int col) const { const float* p = key < PAST_LEN ? cv + roff(key) : vn + (size_t)min(key - PAST_LEN, DEC_SEQ - 1) * 256; return *reinterpret_cast<const f32x8*>(p + col); }
};

template <class KV>
__device__ __forceinline__ void attn_unit(const KV kv, const bf16_t* __restrict__ Aq, const float* __restrict__ qnw, const u64* __restrict__ mask, bf16_t* __restrict__ Odsa, int tok0, int nq_valid, int hd0, int NT, char* lds) {
    int tid_l = threadIdx.x; asm volatile("" : "+v"(tid_l));
    const int tid = tid_l, wid = tid >> 6, lane = tid & 63, r32 = lane & 31, hi = lane >> 5;
    char* V_lds = lds; char* K_lds = lds + 2 * SHM_V;
    float* wsx = (float*)(lds + 2 * SHM_V + 2 * SHM_K) + wid * 64; float* li_l = wsx; float* al_l = wsx + 32;
    float m_reg = -1e30f, l_reg = 0; f32x16 o[4] = {}; bf16x8 qr[8];
    const int mytok = tok0 + 8 * wid + (r32 >> 2);
    { const bf16_t* Qw = Aq + (size_t)mytok * 1024 + (hd0 + (r32 & 3)) * 128 + hi * 8;
#pragma unroll
      for (int d0 = 0; d0 < 8; ++d0) qr[d0] = *reinterpret_cast<const bf16x8*>(Qw + d0 * 16);
      float ssq = 0.f;
#pragma unroll
      for (int d0 = 0; d0 < 8; ++d0) { const u32x4 w = *reinterpret_cast<const u32x4*>(&qr[d0]);
#pragma unroll
          for (int j = 0; j < 4; ++j) { const float lo = __uint_as_float(w[j] << 16), hh = __uint_as_float(w[j] & 0xffff0000u); ssq += lo * lo + hh * hh; } }
      ssq += __shfl_xor(ssq, 32);
      const float rn = rsqrtf(ssq * (1.0f / 128.0f) + NORM_EPS);
#pragma unroll
      for (int d0 = 0; d0 < 8; ++d0) { const u32x4 w = *reinterpret_cast<const u32x4*>(&qr[d0]); const float4 g0 = *(const float4*)(qnw + d0 * 16 + hi * 8), g1 = *(const float4*)(qnw + d0 * 16 + hi * 8 + 4);
          u32x4 o; o[0] = cvtpk(__uint_as_float(w[0] << 16) * rn * g0.x, __uint_as_float(w[0] & 0xffff0000u) * rn * g0.y); o[1] = cvtpk(__uint_as_float(w[1] << 16) * rn * g0.z, __uint_as_float(w[1] & 0xffff0000u) * rn * g0.w);
          o[2] = cvtpk(__uint_as_float(w[2] << 16) * rn * g1.x, __uint_as_float(w[2] & 0xffff0000u) * rn * g1.y); o[3] = cvtpk(__uint_as_float(w[3] << 16) * rn * g1.z, __uint_as_float(w[3] & 0xffff0000u) * rn * g1.w);
          qr[d0] = *reinterpret_cast<const bf16x8*>(&o); } }
    const u64* mrow = mask + (size_t)mytok * MASK_WORDS;
    const int sr = tid >> 4, sc = (tid & 15) * 8, vst0 = v_st(sr, sc), vst1 = v_st(32 + sr, sc);
    const int vbase = (int)(uintptr_t)(PG8_LAS char*)V_lds + v_rd_base(lane);
    typename KV::T vs0, vs1, ks0, ks1;
#define ATT_SLOAD(k0) do { vs0 = kv.ldv((k0) + sr, sc); vs1 = kv.ldv((k0) + 32 + sr, sc); ks0 = kv.ldk((k0) + sr, sc); ks1 = kv.ldk((k0) + 32 + sr, sc); } while (0)
#define ATT_SWRITE(b) do { *(bf16x8*)(V_lds + (b) * SHM_V + vst0) = tobf(vs0); *(bf16x8*)(V_lds + (b) * SHM_V + vst1) = tobf(vs1); const int kc = sc * 2; \
    *(bf16x8*)(K_lds + (b) * SHM_K + ATT_KSWZ(sr, kc)) = tobf(ks0); *(bf16x8*)(K_lds + (b) * SHM_K + ATT_KSWZ(32 + sr, kc)) = tobf(ks1); } while (0)
    __syncthreads();
    ATT_SLOAD(0); ATT_SWRITE(0); __syncthreads();
    u64 mk_next = mrow[0];
    for (int j = 0; j < NT; ++j) {
        const int b = j & 1;
        const u64 mk = mk_next; mk_next = mrow[j + 1 < NT ? j + 1 : j];
        if (j + 1 < NT) ATT_SLOAD((j + 1) * 64);
        f32x16 p0, p1; float mn, alpha; bf16x8 pa0, pa1, pa2, pa3;
        ATT_SBAR(); qkt(p0, p1, K_lds + b * SHM_K, qr, r32, hi); apply_mask(p0, p1, mk, hi);
        partialSM(p0, p1, m_reg, mn, alpha);
        if (__any(alpha < 1.f)) { if (hi == 0) al_l[r32] = alpha; asm volatile("s_waitcnt lgkmcnt(0)" ::: "memory");
#pragma unroll
            for (int d = 0; d < 4; ++d)
#pragma unroll
                for (int r = 0; r < 16; ++r) o[d][r] *= al_l[crow(r, hi)]; }
        finishSM(p0, p1, alpha, l_reg, pa0, pa1, pa2, pa3); ATT_SBAR();
        pv_d0(o, vbase + b * SHM_V, pa0, pa1, pa2, pa3);
        if (j + 1 < NT) ATT_SWRITE(b ^ 1);
        __syncthreads();
    }
    if (hi == 0) li_l[r32] = l_reg; asm volatile("s_waitcnt lgkmcnt(0)" ::: "memory");
#pragma unroll
    for (int r = 0; r < 16; ++r) { const int orow = crow(r, hi); const float rli = __builtin_amdgcn_rcpf(li_l[orow]);
        const int q = 8 * wid + (orow >> 2);
        if (q < nq_valid) { bf16_t* Ow = Odsa + (size_t)(tok0 + q) * 1024 + (hd0 + (orow & 3)) * 128 + r32;
#pragma unroll
            for (int d0 = 0; d0 < 4; ++d0) Ow[d0 * 32] = f2bf(o[d0][r] * rli); } }
#undef ATT_SLOAD
#undef ATT_SWRITE
}
}
namespace idx {
using bf16x8 = __attribute__((ext_vector_type(8))) short;
using f32x16 = __attribute__((ext_vector_type(16))) float;
using f32x8  = __attribute__((ext_vector_type(8))) float;
constexpr int NTILE = 65;
constexpr int WAVE_LDS = NTILE * 64 * 4;
__device__ __forceinline__ unsigned ord_of(float f) { const unsigned u = __float_as_uint(f); return (u & 0x80000000u) ? ~u : (u | 0x80000000u); }
__device__ __forceinline__ int half_sum(int v) {
    v += __builtin_amdgcn_mov_dpp(v, 0xB1, 0xF, 0xF, true);
    v += __builtin_amdgcn_mov_dpp(v, 0x4E, 0xF, 0xF, true);
    v += __builtin_amdgcn_mov_dpp(v, 0x141, 0xF, 0xF, true);
    v += __builtin_amdgcn_mov_dpp(v, 0x140, 0xF, 0xF, true);
    v += __shfl_xor(v, 16);
    return v;
}
template <bool SAMPLE> struct KeySrc {
    const bf16_t* ikb; const float* ck; int pgv;
    struct Raw { f32x8 f[SAMPLE ? 4 : 1]; bf16x8 h[SAMPLE ? 1 : 4]; };
    __device__ __forceinline__ void load(int t, int c, int hi, Raw& R) const {
        if constexpr (!SAMPLE) { const bf16_t* p = ikb + (size_t)(32 * t + c) * 64 + hi * 8;
#pragma unroll
            for (int s = 0; s < 4; ++s) R.h[s] = *reinterpret_cast<const bf16x8*>(p + 16 * s); }
        else { const int tc = t < 64 ? t : 63; const int page = __builtin_amdgcn_readlane(pgv, tc >> 2);
            const float* p = ck + ((size_t)page * PAGE_SIZE + ((32 * tc) & 127) + c) * 64 + hi * 8;
            if (t >= 64) {
                const bf16_t* q = ikb + (size_t)(c < DEC_SEQ ? c : DEC_SEQ - 1) * 64 + hi * 8;
#pragma unroll
                for (int s = 0; s < 4; ++s) { const att::u32x4 w = *reinterpret_cast<const att::u32x4*>(q + 16 * s);
#pragma unroll
                    for (int e = 0; e < 4; ++e) { R.f[s][2 * e] = __uint_as_float(w[e] << 16); R.f[s][2 * e + 1] = __uint_as_float(w[e] & 0xffff0000u); } } }
            else {
#pragma unroll
                for (int s = 0; s < 4; ++s) R.f[s] = *reinterpret_cast<const f32x8*>(p + 16 * s); } }
    }
    __device__ __forceinline__ void cvt(const Raw& R, bf16x8 (&B)[4]) const {
#pragma unroll
        for (int s = 0; s < 4; ++s) { if constexpr (SAMPLE) B[s] = att::tobf(R.f[s]); else B[s] = R.h[s]; }
    }
};
template <int A_> __device__ __forceinline__ float head_sum(const f32x16& acc, const float (&w)[8]) {
    float s = 0.f;
#pragma unroll
    for (int h = 0; h < 8; ++h) s = fmaf(w[h], fmaxf(acc[8 * A_ + h], 0.f), s);
    return s;
}
template <bool SAMPLE, int A_>
__device__ __forceinline__ void pass(const KeySrc<SAMPLE>& ks, const bf16x8 (&A)[4], const float* Iw, int tokbase, int pos0, int nvalid, int ntiles, unsigned* strip, unsigned* mask32, int lane) {
    const int c = lane & 31, hi = lane >> 5, myq = 2 * hi + A_, mypos = pos0 + myq; const bool qvalid = myq < nvalid;
    float w[8];
    { const float* wp = Iw + (size_t)(tokbase + (qvalid ? myq : nvalid - 1)) * 8;
#pragma unroll
      for (int h = 0; h < 8; ++h) w[h] = wp[h]; }
    typename KeySrc<SAMPLE>::Raw R0, R1; bf16x8 B[4];
    ks.load(0, c, hi, R0); if (1 < ntiles) ks.load(1, c, hi, R1);
#define IDX_TILE(t_, R_) do { ks.cvt(R_, B); if ((t_) + 2 < ntiles) ks.load((t_) + 2, c, hi, R_); f32x16 acc = {}; \
        _Pragma("unroll") for (int s_ = 0; s_ < 4; ++s_) acc = __builtin_amdgcn_mfma_f32_32x32x16_bf16(A[s_], B[s_], acc, 0, 0, 0); \
        const float sc_ = head_sum<A_>(acc, w); strip[(t_) * 64 + lane] = (32 * (t_) + c <= mypos) ? ord_of(sc_) : 0u; } while (0)
    for (int t = 0; t < ntiles; t += 2) { IDX_TILE(t, R0); if (t + 1 < ntiles) IDX_TILE(t + 1, R1); }
#undef IDX_TILE
    unsigned x[NTILE];
#pragma unroll
    for (int t = 0; t < NTILE; ++t) x[t] = (t < ntiles) ? strip[t * 64 + lane] : 0u;
    unsigned tau = 0u; int r_ties = 0;
    if (__any(mypos + 1 > TOPK)) {
        for (int bit = 31; bit >= 0; --bit) { const unsigned cand = tau | (1u << bit); int cnt = 0;
#pragma unroll
            for (int t = 0; t < NTILE; ++t) cnt += (x[t] >= cand) ? 1 : 0;
            cnt = half_sum(cnt);
            if (cnt >= TOPK) tau = cand; }
        int cg = 0;
#pragma unroll
        for (int t = 0; t < NTILE; ++t) cg += (x[t] > tau) ? 1 : 0;
        cg = half_sum(cg);
        r_ties = TOPK - cg;
    }
    if (mypos + 1 <= TOPK) { tau = 0u; r_ties = 0; }
    int eq_before = 0; unsigned* mrow = mask32 + (size_t)(tokbase + myq) * (2 * MASK_WORDS);
#pragma unroll
    for (int t = 0; t < NTILE; ++t) {
        const bool eq = x[t] == tau, gt = x[t] > tau;
        const u64 eqm = __ballot(eq); const unsigned my_eqm = hi ? (unsigned)(eqm >> 32) : (unsigned)eqm;
        const int rank = eq_before + __popc(my_eqm & ((1u << c) - 1u));
        const bool sel = gt || (eq && rank < r_ties);
        eq_before += __popc(my_eqm);
        const u64 sm = __ballot(sel); const unsigned my_sm = hi ? (unsigned)(sm >> 32) : (unsigned)sm;
        if (c == 0 && qvalid) mrow[t] = my_sm;
    }
    if (c < 2 * MASK_WORDS - NTILE && qvalid) mrow[NTILE + c] = 0u;
}
template <bool SAMPLE>
__device__ __forceinline__ void wave_task(const KeySrc<SAMPLE>& ks, const bf16_t* Iq, const float* Iw, int tokbase, int pos0, int nvalid, unsigned* strip, unsigned* mask32, int lane) {
    const int c = lane & 31, hi = lane >> 5;
    const int aq_ = 2 * ((c >> 2) & 1) + (c >> 4), ah = 4 * ((c >> 3) & 1) + (c & 3);
    bf16x8 A[4];
    { const bf16_t* ap = Iq + (size_t)(tokbase + (aq_ < nvalid ? aq_ : nvalid - 1)) * 512 + ah * 64 + hi * 8;
#pragma unroll
      for (int s = 0; s < 4; ++s) A[s] = *reinterpret_cast<const bf16x8*>(ap + 16 * s); }
    const int pmax = pos0 + nvalid - 1; int ntiles = (pmax + 32) >> 5; if (ntiles > NTILE) ntiles = NTILE;
    pass<SAMPLE, 0>(ks, A, Iw, tokbase, pos0, nvalid, ntiles, strip, mask32, lane);
    pass<SAMPLE, 1>(ks, A, Iw, tokbase, pos0, nvalid, ntiles, strip, mask32, lane);
}
}
struct MegaArgs {
    PrepArgs prep;
    const float *cache_k, *cache_v, *cache_kidx, *state_ret; const int* page_table;
    const float *qnw, *knw, *ikw, *ikb;
    bf16_t *Rq, *Rk, *Rv, *G, *Aq, *Kb, *Vb, *Iq, *Ikb, *Gates, *OG, *An, *Odsa, *Mg, *A2, *Hid;
    float *Iw, *ssret, *rstd2, *Z, *M1, *M2, *H2, *Zf, *out;
    u64* mask; unsigned* bar;
};

namespace ret {
using bf16x8 = __attribute__((ext_vector_type(8))) short;
using s16x4  = __attribute__((ext_vector_type(4))) short;
using f32x4  = __attribute__((ext_vector_type(4))) float;
using u32x4  = __attribute__((ext_vector_type(4))) unsigned;
using u32x2  = __attribute__((ext_vector_type(2))) unsigned;
constexpr int QS = 528, VS = 144, PS = 80;
constexpr int OFF_Q = 0, OFF_K = OFF_Q + 32 * QS, OFF_V = OFF_K + 32 * QS, OFF_P = OFF_V + 32 * VS, OFF_ST = OFF_P + 32 * PS, OFF_SS = OFF_ST + 64 * QS, LDS_BYTES = OFF_SS + 32 * 4 * 4;
__device__ __forceinline__ s16x4 trr(int addr) { s16x4 r; asm volatile("ds_read_b64_tr_b16 %0, %1" : "=&v"(r) : "v"(addr) : "memory"); return r; }
__device__ __forceinline__ bf16x8 cat(s16x4 l, s16x4 h) { return (bf16x8){l[0], l[1], l[2], l[3], h[0], h[1], h[2], h[3]}; }
__device__ __forceinline__ u32x4 scale8(u32x4 v, float f) {
    u32x4 o;
#pragma unroll
    for (int i = 0; i < 4; ++i) o[i] = att::cvtpk(__uint_as_float(v[i] << 16) * f, __uint_as_float(v[i] & 0xffff0000u) * f);
    return o;
}
__device__ __forceinline__ void unit(const MegaArgs& a, int unit8, char* lds) {
    int tid_l = threadIdx.x; asm volatile("" : "+v"(tid_l));
    const int tid = tid_l, w = __builtin_amdgcn_readfirstlane(tid >> 6), lane = tid & 63, g = lane >> 4, c15 = lane & 15, q4 = c15 >> 2, p4 = c15 & 3;
    const int bh = unit8 >> 3, sl = unit8 & 7, b = bh >> 2, h = bh & 3;
    const int ldsb = (int)(uintptr_t)(PG8_LAS char*)lds;
    const float lg2 = log2f(1.0f - exp2f(-5.0f - (float)h));
    const int st_tok = tid >> 4, st_seg = tid & 15;
    const float fq = exp2f(lg2 * (float)(st_tok + 1)), fk = exp2f(-lg2 * (float)(st_tok + 1));
    f32x4 S[2][4];
#pragma unroll
    for (int i = 0; i < 2; ++i)
#pragma unroll
        for (int u = 0; u < 4; ++u) S[i][u] = (f32x4){0.f, 0.f, 0.f, 0.f};
    u32x4 rq0, rq1, rk0, rk1; u32x2 rv;
#define RET_LOAD(tok0_, len_) do { const bool ok_ = st_tok < (len_); const size_t r_ = (size_t)((tok0_) + (ok_ ? st_tok : 0)); \
        const u32x4* qp_ = (const u32x4*)(a.Rq + r_ * 1024 + h * 256 + st_seg * 16); const u32x4* kp_ = (const u32x4*)(a.Rk + r_ * 1024 + h * 256 + st_seg * 16); \
        rq0 = qp_[0]; rq1 = qp_[1]; rk0 = kp_[0]; rk1 = kp_[1]; rv = *(const u32x2*)(a.Rv + r_ * 2048 + h * 512 + sl * 64 + st_seg * 4); \
        if (!ok_) { rq0 = rq1 = rk0 = rk1 = (u32x4){0u, 0u, 0u, 0u}; rv = (u32x2){0u, 0u}; } } while (0)
    const int row0 = b * LP;
    RET_LOAD(row0, 16);
    __syncthreads();
    for (int c = 0; c < 65; ++c) {
        const int len = c == 0 ? 16 : 32, tok0 = c == 0 ? row0 : row0 + 16 + 32 * (c - 1);
        *(u32x4*)(lds + OFF_Q + st_tok * QS + st_seg * 32) = scale8(rq0, fq); *(u32x4*)(lds + OFF_Q + st_tok * QS + st_seg * 32 + 16) = scale8(rq1, fq);
        *(u32x4*)(lds + OFF_K + st_tok * QS + st_seg * 32) = scale8(rk0, fk); *(u32x4*)(lds + OFF_K + st_tok * QS + st_seg * 32 + 16) = scale8(rk1, fk);
        *(u32x2*)(lds + OFF_V + st_tok * VS + st_seg * 8) = rv;
#pragma unroll
        for (int i = 0; i < 2; ++i)
#pragma unroll
            for (int u = 0; u < 4; ++u) { u32x2 pk; pk.x = att::cvtpk(S[i][u][0], S[i][u][1]); pk.y = att::cvtpk(S[i][u][2], S[i][u][3]);
                *(u32x2*)(lds + OFF_ST + (16 * u + c15) * QS + (32 * w + 16 * i + 4 * g) * 2) = pk; }
        __syncthreads();
        if (c + 1 < 65) RET_LOAD(row0 + 16 + 32 * c, 32);
        u32x2 gg_pre;
        { const int dt_ = w & 3, it_ = w >> 2, i_ = 16 * it_ + c15; const size_t ci_ = (size_t)(tok0 + (i_ < len ? i_ : 0)) * 2048 + h * 512 + sl * 64 + 16 * dt_ + 4 * g; gg_pre = *(const u32x2*)(a.G + ci_); }
        if (w < 3) { const int jt = w >> 1, it = (w + 1) >> 1; f32x4 pacc = {0.f, 0.f, 0.f, 0.f};
#pragma unroll
            for (int s = 0; s < 8; ++s) { const bf16x8 A = *(const bf16x8*)(lds + OFF_K + (16 * jt + c15) * QS + (32 * s + 8 * g) * 2), B = *(const bf16x8*)(lds + OFF_Q + (16 * it + c15) * QS + (32 * s + 8 * g) * 2);
                pacc = __builtin_amdgcn_mfma_f32_16x16x32_bf16(A, B, pacc, 0, 0, 0); }
            const int ig = 16 * it + c15, jg0 = 16 * jt + 4 * g; float pv[4];
#pragma unroll
            for (int r = 0; r < 4; ++r) pv[r] = (jg0 + r <= ig) ? pacc[r] : 0.f;
            u32x2 pk; pk.x = att::cvtpk(pv[0], pv[1]); pk.y = att::cvtpk(pv[2], pv[3]);
            *(u32x2*)(lds + OFF_P + ig * PS + jg0 * 2) = pk; }
        else if (w == 3) { if (lane < 32) *(u32x4*)(lds + OFF_P + (lane >> 1) * PS + 32 + 16 * (lane & 1)) = (u32x4){0u, 0u, 0u, 0u}; }
        { s16x4 vl[4], vh[4], kl[2], kh[2];
#pragma unroll
          for (int u = 0; u < 4; ++u) { const int ad = ldsb + OFF_V + (8 * g + q4) * VS + (16 * u + 4 * p4) * 2; vl[u] = trr(ad); vh[u] = trr(ad + 4 * VS); }
#pragma unroll
          for (int i = 0; i < 2; ++i) { const int ad = ldsb + OFF_K + (8 * g + q4) * QS + (32 * w + 16 * i + 4 * p4) * 2; kl[i] = trr(ad); kh[i] = trr(ad + 4 * QS); }
          asm volatile("s_waitcnt lgkmcnt(0)" ::: "memory"); __builtin_amdgcn_sched_barrier(0);
          const float gl = exp2f(lg2 * (float)len);
#pragma unroll
          for (int i = 0; i < 2; ++i)
#pragma unroll
              for (int u = 0; u < 4; ++u) { S[i][u] = __builtin_amdgcn_mfma_f32_16x16x32_bf16(cat(kl[i], kh[i]), cat(vl[u], vh[u]), S[i][u], 0, 0, 0); S[i][u] *= gl; } }
        __syncthreads();
        { const int dt = w & 3, it = w >> 2; f32x4 o = {0.f, 0.f, 0.f, 0.f};
          { const int ad = ldsb + OFF_V + (8 * g + q4) * VS + (16 * dt + 4 * p4) * 2; const s16x4 lo = trr(ad), hi = trr(ad + 4 * VS);
            const bf16x8 Bp = *(const bf16x8*)(lds + OFF_P + (16 * it + c15) * PS + (8 * g) * 2);
            asm volatile("s_waitcnt lgkmcnt(0)" ::: "memory"); __builtin_amdgcn_sched_barrier(0);
            o = __builtin_amdgcn_mfma_f32_16x16x32_bf16(cat(lo, hi), Bp, o, 0, 0, 0); }
#pragma unroll
          for (int s = 0; s < 8; ++s) { const bf16x8 A = *(const bf16x8*)(lds + OFF_ST + (16 * dt + c15) * QS + (32 * s + 8 * g) * 2), B = *(const bf16x8*)(lds + OFF_Q + (16 * it + c15) * QS + (32 * s + 8 * g) * 2);
              o = __builtin_amdgcn_mfma_f32_16x16x32_bf16(A, B, o, 0, 0, 0); }
          const int i = 16 * it + c15; float ss = o[0] * o[0] + o[1] * o[1] + o[2] * o[2] + o[3] * o[3];
          ss += __shfl_xor(ss, 16); ss += __shfl_xor(ss, 32);
          if (g == 0) ((float*)(lds + OFF_SS))[i * 4 + dt] = ss;
          if (i < len) { const size_t ci = (size_t)(tok0 + i) * 2048 + h * 512 + sl * 64 + 16 * dt + 4 * g; const u32x2 gg = gg_pre;
              u32x2 pk; pk.x = att::cvtpk(o[0] * __uint_as_float(gg.x << 16), o[1] * __uint_as_float(gg.x & 0xffff0000u)); pk.y = att::cvtpk(o[2] * __uint_as_float(gg.y << 16), o[3] * __uint_as_float(gg.y & 0xffff0000u));
              *(u32x2*)(a.OG + ci) = pk; } }
        __syncthreads();
        if (tid < len) { const float* sp = (const float*)(lds + OFF_SS) + tid * 4; a.ssret[(size_t)(tok0 + tid) * 32 + h * 8 + sl] = (sp[0] + sp[1]) + (sp[2] + sp[3]); }
    }
    float* so = a.out + (size_t)O_R_P + ((size_t)b * H_RET + h) * (DK_RET * DV_RET) + sl * 64;
#pragma unroll
    for (int i = 0; i < 2; ++i)
#pragma unroll
        for (int u = 0; u < 4; ++u)
#pragma unroll
            for (int r = 0; r < 4; ++r) so[(size_t)(32 * w + 16 * i + 4 * g + r) * DV_RET + 16 * u + c15] = S[i][u][r];
    __syncthreads();
#undef RET_LOAD
}
}
namespace epi {
using f32x4 = pg8::f32x4; using u32x4 = pg8::u32x4; typedef unsigned u32x2 __attribute__((ext_vector_type(2)));
__device__ __forceinline__ unsigned pk(float lo, float hi) { return pg8::cvt_pk_bf16(lo, hi); }
__device__ __forceinline__ u32x4 pack8(const f32x4& a, const f32x4& b) { u32x4 w; w.x = pk(a[0], a[1]); w.y = pk(a[2], a[3]); w.z = pk(b[0], b[1]); w.w = pk(b[2], b[3]); return w; }
__device__ __forceinline__ float bflo(unsigned w) { return __uint_as_float(w << 16); }
__device__ __forceinline__ float bfhi(unsigned w) { return __uint_as_float(w & 0xffff0000u); }
__device__ __forceinline__ f32x4 silu4(f32x4 x) { f32x4 o;
#pragma unroll
    for (int j = 0; j < 4; ++j) o[j] = x[j] * __builtin_amdgcn_rcpf(1.0f + __expf(-x[j])); return o; }
__device__ __forceinline__ f32x4 sigm4(f32x4 x) { f32x4 o;
#pragma unroll
    for (int j = 0; j < 4; ++j) o[j] = __builtin_amdgcn_rcpf(1.0f + __expf(-x[j])); return o; }

struct Epi1 {
    static constexpr bool PERM = true, AFTER_DRAIN = false;
    const float* rstd0; const float2* rope; const float *ikw, *ikb;
    bf16_t *Rq, *Rk, *Rv, *G, *Aq, *Vb, *Iq, *Ikb, *Gates; float* Iw; float* out; int gz0;
    template <int TY> __device__ __forceinline__ void run(const f32x4 (&acc)[2][2][4][2], int pm, int wr, int wc, int fr, int fq, bf16_t* dbase, int ld, float* fbase, float* fbase_s, float post, int isv) const {
        const int cl = wc * 32 + 8 * fq;
        float rsv[8];
#pragma unroll
        for (int i = 0; i < 8; ++i) { const int row = pm * 256 + (i >> 2) * 128 + wr * 64 + (i & 3) * 16 + fr; rsv[i] = rstd0[row < T_ALL ? row : T_ALL - 1]; }
#pragma unroll
        for (int ai = 0; ai < 2; ++ai)
#pragma unroll
            for (int m = 0; m < 4; ++m) {
                const int row = pm * 256 + ai * 128 + wr * 64 + m * 16 + fr; const bool ok = row < T_ALL; const int rowc = ok ? row : T_ALL - 1;
                const float rs = rsv[ai * 4 + m];
                f32x4 v[2][2];
#pragma unroll
                for (int bj = 0; bj < 2; ++bj)
#pragma unroll
                    for (int n = 0; n < 2; ++n) v[bj][n] = acc[ai][bj][m][n] * rs;
                if constexpr (TY == 0) {
                    bf16_t* dst = dbase + (size_t)rowc * 1024 + cl;
                    const float4* rp = (const float4*)(rope + (size_t)row_pos(rowc) * 128 + cl);
                    float4 rv[4];
#pragma unroll
                    for (int q = 0; q < 4; ++q) rv[q] = rp[q];
                    asm volatile("s_waitcnt vmcnt(0)" ::: "memory");
                    f32x4 o1[2], o2[2];
#pragma unroll
                    for (int n = 0; n < 2; ++n) { const float4 cs0 = rv[2 * n], cs1 = rv[2 * n + 1]; const float c[4] = {cs0.x, cs0.z, cs1.x, cs1.z}, s[4] = {cs0.y, cs0.w, cs1.y, cs1.w};
#pragma unroll
                        for (int j = 0; j < 4; ++j) { o1[n][j] = (v[0][n][j] * c[j] - v[1][n][j] * s[j]) * post; o2[n][j] = (v[0][n][j] * s[j] + v[1][n][j] * c[j]) * post; } }
                    if (ok) { *(u32x4*)dst = pack8(o1[0], o1[1]); *(u32x4*)(dst + 128) = pack8(o2[0], o2[1]); }
                } else if constexpr (TY == 1 || TY == 2 || TY == 3) {
                    bf16_t* dst = dbase + (size_t)rowc * ld + cl;
                    if constexpr (TY == 2) { v[0][0] = silu4(v[0][0]); v[0][1] = silu4(v[0][1]); v[1][0] = silu4(v[1][0]); v[1][1] = silu4(v[1][1]); }
                    if constexpr (TY == 3) { v[0][0] = sigm4(v[0][0]); v[0][1] = sigm4(v[0][1]); v[1][0] = sigm4(v[1][0]); v[1][1] = sigm4(v[1][1]); }
                    if (ok) { *(u32x4*)dst = pack8(v[0][0], v[0][1]); *(u32x4*)(dst + 128) = pack8(v[1][0], v[1][1]); }
                } else if constexpr (TY == 4) {
                    float* dst = (rowc < T_PROMPT ? fbase + (size_t)rowc * 256 : fbase_s + (size_t)(rowc - T_PROMPT) * 256) + cl;
                    if (ok) { *(f32x4*)dst = v[0][0]; *(f32x4*)(dst + 4) = v[0][1]; *(f32x4*)(dst + 128) = v[1][0]; *(f32x4*)(dst + 132) = v[1][1];
                        if (isv) { bf16_t* vb = Vb + (size_t)rowc * 256 + cl; *(u32x4*)vb = pack8(v[0][0], v[0][1]); *(u32x4*)(vb + 128) = pack8(v[1][0], v[1][1]); } }
                } else {
                    if (wc == 0) {
                        float s = 0.f;
#pragma unroll
                        for (int bj = 0; bj < 2; ++bj)
#pragma unroll
                            for (int n = 0; n < 2; ++n) s += (v[bj][n][0] + v[bj][n][1]) + (v[bj][n][2] + v[bj][n][3]);
                        s += __shfl_xor(s, 16); s += __shfl_xor(s, 32);
                        const float mu = s * (1.0f / 64.0f); float q = 0.f;
#pragma unroll
                        for (int bj = 0; bj < 2; ++bj)
#pragma unroll
                            for (int n = 0; n < 2; ++n) { const f32x4 d = v[bj][n] - mu; q += (d[0] * d[0] + d[1] * d[1]) + (d[2] * d[2] + d[3] * d[3]); }
                        q += __shfl_xor(q, 16); q += __shfl_xor(q, 32);
                        const float rn = rsqrtf(q * (1.0f / 64.0f) + NORM_EPS);
                        float* ko = out + (rowc < T_PROMPT ? (size_t)O_KI_P + (size_t)rowc * 64 : (size_t)O_KI_S + (size_t)(rowc - T_PROMPT) * 64);
#pragma unroll
                        for (int bj = 0; bj < 2; ++bj) { const int e0 = 32 * bj + 8 * fq; f32x4 y[2];
#pragma unroll
                            for (int n = 0; n < 2; ++n) { const f32x4 wv = *(const f32x4*)(ikw + e0 + 4 * n), bv = *(const f32x4*)(ikb + e0 + 4 * n); y[n] = (v[bj][n] - mu) * rn * wv + bv; }
                            if (ok) { *(f32x4*)(ko + e0) = y[0]; *(f32x4*)(ko + e0 + 4) = y[1]; *(u32x4*)(Ikb + (size_t)rowc * 64 + e0) = pack8(y[0], y[1]); } }
                    } else if (wc == 1 && fq == 0) {
                        if (ok) { *(f32x4*)(Iw + (size_t)rowc * 8) = v[0][0] * IDX_SCALE; *(f32x4*)(Iw + (size_t)rowc * 8 + 4) = v[0][1] * IDX_SCALE; }
                    }
                }
            }
    }
    __device__ __forceinline__ void operator()(const f32x4 (&acc)[2][2][4][2], const pg8::Unit& u, int wr, int wc, int fr_in, int fq_in) const {
        int fr = fr_in, fq = fq_in; asm volatile("" : "+v"(fr), "+v"(fq));
        const int pn = u.pn + gz0, pm = u.pm;
        if (pn < 4)        run<0>(acc, pm, wr, wc, fr, fq, Rq + pn * 256, 1024, nullptr, nullptr, 1.0f, 0);
        else if (pn < 8)   run<0>(acc, pm, wr, wc, fr, fq, Rk + (pn - 4) * 256, 1024, nullptr, nullptr, 0.0625f, 0);
        else if (pn < 16)  run<1>(acc, pm, wr, wc, fr, fq, Rv + (pn - 8) * 256, 2048, nullptr, nullptr, 1.0f, 0);
        else if (pn < 24)  run<2>(acc, pm, wr, wc, fr, fq, G + (pn - 16) * 256, 2048, nullptr, nullptr, 1.0f, 0);
        else if (pn < 28)  run<1>(acc, pm, wr, wc, fr, fq, Aq + (pn - 24) * 256, 1024, nullptr, nullptr, 1.0f, 0);
        else if (pn == 28) run<4>(acc, pm, wr, wc, fr, fq, nullptr, 0, out + O_K_P, out + O_K_S, 1.0f, 0);
        else if (pn == 29) run<4>(acc, pm, wr, wc, fr, fq, nullptr, 0, out + O_V_P, out + O_V_S, 1.0f, 1);
        else if (pn < 32)  run<1>(acc, pm, wr, wc, fr, fq, Iq + (pn - 30) * 256, 512, nullptr, nullptr, 1.0f, 0);
        else if (pn == 32) run<5>(acc, pm, wr, wc, fr, fq, nullptr, 0, nullptr, nullptr, 1.0f, 0);
        else               run<3>(acc, pm, wr, wc, fr, fq, Gates + (pn - 33 + gz0) * 256, 2048, nullptr, nullptr, 1.0f, 0);
    }
};
struct EpiRet {
    static constexpr bool PERM = false, AFTER_DRAIN = false;
    float* M1;
    __device__ __forceinline__ void operator()(const f32x4 (&acc)[2][2][4][2], const pg8::Unit& u, int wr, int wc, int fr_in, int fq_in) const {
        int fr = fr_in, fq = fq_in; asm volatile("" : "+v"(fr), "+v"(fq));
#pragma unroll
        for (int ai = 0; ai < 2; ++ai)
#pragma unroll
            for (int m = 0; m < 4; ++m) { const int row = u.pm * 256 + ai * 128 + wr * 64 + m * 16 + fr;
#pragma unroll
                for (int bj = 0; bj < 2; ++bj)
#pragma unroll
                    for (int n = 0; n < 2; ++n) *(f32x4*)(M1 + (size_t)row * 1024 + u.pn * 256 + bj * 128 + wc * 32 + 16 * n + 4 * fq) = acc[ai][bj][m][n]; }
    }
};
struct EpiDsa {
    static constexpr bool PERM = false, AFTER_DRAIN = false;
    const bf16_t* Gates; const float* M1; bf16_t* Mg;
    __device__ __forceinline__ void operator()(const f32x4 (&acc)[2][2][4][2], const pg8::Unit& u, int wr, int wc, int fr_in, int fq_in) const {
        int fr = fr_in, fq = fq_in; asm volatile("" : "+v"(fr), "+v"(fq));
#pragma unroll
        for (int ai = 0; ai < 2; ++ai)
#pragma unroll
            for (int mp = 0; mp < 2; ++mp) {
                u32x2 gr[2][2][2], gd[2][2][2]; f32x4 mv[2][2][2];
#pragma unroll
                for (int mm = 0; mm < 2; ++mm) { const int row = u.pm * 256 + ai * 128 + wr * 64 + (2 * mp + mm) * 16 + fr;
#pragma unroll
                    for (int bj = 0; bj < 2; ++bj)
#pragma unroll
                        for (int n = 0; n < 2; ++n) { const int col = u.pn * 256 + bj * 128 + wc * 32 + 16 * n + 4 * fq;
                            gr[mm][bj][n] = *(const u32x2*)(Gates + (size_t)row * 2048 + col); gd[mm][bj][n] = *(const u32x2*)(Gates + (size_t)row * 2048 + 1024 + col); mv[mm][bj][n] = *(const f32x4*)(M1 + (size_t)row * 1024 + col); } }
#pragma unroll
                for (int mm = 0; mm < 2; ++mm) { const int m = 2 * mp + mm, row = u.pm * 256 + ai * 128 + wr * 64 + m * 16 + fr;
#pragma unroll
                    for (int bj = 0; bj < 2; ++bj)
#pragma unroll
                        for (int n = 0; n < 2; ++n) { const int col = u.pn * 256 + bj * 128 + wc * 32 + 16 * n + 4 * fq;
                            const f32x4 g1 = {bflo(gr[mm][bj][n].x), bfhi(gr[mm][bj][n].x), bflo(gr[mm][bj][n].y), bfhi(gr[mm][bj][n].y)}, g2 = {bflo(gd[mm][bj][n].x), bfhi(gd[mm][bj][n].x), bflo(gd[mm][bj][n].y), bfhi(gd[mm][bj][n].y)};
                            const f32x4 r = mv[mm][bj][n] * g1 + acc[ai][bj][m][n] * g2;
                            u32x2 w; w.x = pk(r[0], r[1]); w.y = pk(r[2], r[3]); *(u32x2*)(Mg + (size_t)row * 1024 + col) = w; } } }
    }
};
struct EpiOut {
    static constexpr bool PERM = false, AFTER_DRAIN = false;
    const float *xp, *xs, *meta; float* H2; bf16_t* A2; float* ss2;
    __device__ __forceinline__ void operator()(const f32x4 (&acc)[2][2][4][2], const pg8::Unit& u, int wr, int wc, int fr_in, int fq_in) const {
        int fr = fr_in, fq = fq_in; asm volatile("" : "+v"(fr), "+v"(fq));
#pragma unroll
        for (int ai = 0; ai < 2; ++ai) {
            f32x4 hv[4][2][2];
#pragma unroll
            for (int m = 0; m < 4; ++m) { const int row = u.pm * 256 + ai * 128 + wr * 64 + m * 16 + fr; const float* h = h_row_ptr(row < T_ALL ? row : 0, xp, xs, meta);
#pragma unroll
                for (int bj = 0; bj < 2; ++bj)
#pragma unroll
                    for (int n = 0; n < 2; ++n) hv[m][bj][n] = *(const f32x4*)(h + u.pn * 256 + bj * 128 + wc * 32 + 16 * n + 4 * fq); }
#pragma unroll
            for (int m = 0; m < 4; ++m) { const int row = u.pm * 256 + ai * 128 + wr * 64 + m * 16 + fr; const bool ok = row < T_ALL; float ss = 0.f;
#pragma unroll
                for (int bj = 0; bj < 2; ++bj)
#pragma unroll
                    for (int n = 0; n < 2; ++n) { const int col = u.pn * 256 + bj * 128 + wc * 32 + 16 * n + 4 * fq; f32x4 r = acc[ai][bj][m][n]; if (ok) r += hv[m][bj][n];
                        *(f32x4*)(H2 + (size_t)row * 1024 + col) = r; u32x2 w; w.x = pk(r[0], r[1]); w.y = pk(r[2], r[3]); *(u32x2*)(A2 + (size_t)row * 1024 + col) = w;
                        ss += (r[0] * r[0] + r[1] * r[1]) + (r[2] * r[2] + r[3] * r[3]); }
                ss += __shfl_xor(ss, 16); ss += __shfl_xor(ss, 32);
                if (fq == 0) atomicAdd(ss2 + row, ss); } }
    }
};
struct EpiFfi {
    static constexpr bool PERM = true, AFTER_DRAIN = false;
    const float* ss2; bf16_t* Hid;
    __device__ __forceinline__ void operator()(const f32x4 (&acc)[2][2][4][2], const pg8::Unit& u, int wr, int wc, int fr_in, int fq_in) const {
        int fr = fr_in, fq = fq_in; asm volatile("" : "+v"(fr), "+v"(fq));
        float sv[8];
#pragma unroll
        for (int i = 0; i < 8; ++i) sv[i] = ss2[u.pm * 256 + (i >> 2) * 128 + wr * 64 + (i & 3) * 16 + fr];
#pragma unroll
        for (int ai = 0; ai < 2; ++ai)
#pragma unroll
            for (int m = 0; m < 4; ++m) { const int row = u.pm * 256 + ai * 128 + wr * 64 + m * 16 + fr;
                const float rs = rsqrtf(sv[ai * 4 + m] * (1.0f / 1024.0f) + NORM_EPS);
                f32x4 hv[2];
#pragma unroll
                for (int n = 0; n < 2; ++n) hv[n] = silu4(acc[ai][0][m][n] * rs) * (acc[ai][1][m][n] * rs);
                *(u32x4*)(Hid + (size_t)row * D_FF + u.pn * 128 + wc * 32 + 8 * fq) = pack8(hv[0], hv[1]); }
    }
};
struct EpiFfo {
    static constexpr bool PERM = false, AFTER_DRAIN = false;
    const float* H2; float* out;
    __device__ __forceinline__ void operator()(const f32x4 (&acc)[2][2][4][2], const pg8::Unit& u, int wr, int wc, int fr_in, int fq_in) const {
        int fr = fr_in, fq = fq_in; asm volatile("" : "+v"(fr), "+v"(fq));
#pragma unroll
        for (int ai = 0; ai < 2; ++ai) {
            f32x4 hv[4][2][2];
#pragma unroll
            for (int m = 0; m < 4; ++m) { const int row = u.pm * 256 + ai * 128 + wr * 64 + m * 16 + fr;
#pragma unroll
                for (int bj = 0; bj < 2; ++bj)
#pragma unroll
                    for (int n = 0; n < 2; ++n) hv[m][bj][n] = *(const f32x4*)(H2 + (size_t)row * 1024 + u.pn * 256 + bj * 128 + wc * 32 + 16 * n + 4 * fq); }
#pragma unroll
            for (int m = 0; m < 4; ++m) { const int row = u.pm * 256 + ai * 128 + wr * 64 + m * 16 + fr; float* dst = nullptr;
                if (row < T_PROMPT) { const int b = row / LP, l = row % LP; if (l >= N_META) dst = out + O_Y_P + ((size_t)b * SEQ + (l - N_META)) * 1024; }
                else if (row < T_ALL) dst = out + O_Y_S + (size_t)(row - T_PROMPT) * 1024;
                if (dst) {
#pragma unroll
                    for (int bj = 0; bj < 2; ++bj)
#pragma unroll
                        for (int n = 0; n < 2; ++n) *(f32x4*)(dst + u.pn * 256 + bj * 128 + wc * 32 + 16 * n + 4 * fq) = hv[m][bj][n] + acc[ai][bj][m][n]; } } }
    }
};
}
#define RETS_N_TASKS (DEC_BATCH * H_RET * 8)
__device__ __forceinline__ void ret_sample_task(const MegaArgs& a, int task, float* qk  , int lane) {
    const int sl = task & 7, h = (task >> 3) & 3, db = task >> 5, r0 = T_PROMPT + db * DEC_SEQ;
    { const int which = lane >> 5, ch = lane & 31; const bf16_t* src = (which ? a.Rk : a.Rq) + (size_t)r0 * 1024 + h * 256 + ch * 8;
#pragma unroll
      for (int i = 0; i < 8; ++i) { const uint4 v = *(const uint4*)(src + (size_t)i * 1024); const unsigned wv[4] = {v.x, v.y, v.z, v.w};
#pragma unroll
          for (int e = 0; e < 4; ++e) { qk[(ch * 8 + 2 * e) * 16 + which * 8 + i] = __uint_as_float(wv[e] << 16); qk[(ch * 8 + 2 * e + 1) * 16 + which * 8 + i] = __uint_as_float(wv[e] & 0xffff0000u); } } }
    float v[8], o[8]; const int dv = sl * 64 + lane;
#pragma unroll
    for (int i = 0; i < 8; ++i) { v[i] = bf2f(a.Rv[(size_t)(r0 + i) * 2048 + h * 512 + dv]); o[i] = 0.f; }
    const float gamma = 1.0f - exp2f(-5.0f - (float)h);
    const size_t sb = ((size_t)db * H_RET + h) * (DK_RET * DV_RET) + dv;
    const float* sin_ = a.state_ret + sb; float* sout = a.out + (size_t)O_R_S + sb;
    for (int dk0 = 0; dk0 < 256; dk0 += 32) {
        float s[32];
#pragma unroll
        for (int j = 0; j < 32; ++j) s[j] = __builtin_nontemporal_load(sin_ + (size_t)(dk0 + j) * DV_RET);
#pragma unroll
        for (int j = 0; j < 32; ++j) { const float4* c = (const float4*)(qk + (dk0 + j) * 16); const float4 q0 = c[0], q1 = c[1], k0 = c[2], k1 = c[3];
            const float qq[8] = {q0.x, q0.y, q0.z, q0.w, q1.x, q1.y, q1.z, q1.w}, kk[8] = {k0.x, k0.y, k0.z, k0.w, k1.x, k1.y, k1.z, k1.w};
#pragma unroll
            for (int i = 0; i < 8; ++i) { s[j] = fmaf(s[j], gamma, kk[i] * v[i]); o[i] = fmaf(qq[i], s[j], o[i]); }
            __builtin_nontemporal_store(s[j], sout + (size_t)(dk0 + j) * DV_RET); }
    }
#pragma unroll
    for (int i = 0; i < 8; ++i) { float ss = o[i] * o[i];
#pragma unroll
        for (int of = 32; of >= 1; of >>= 1) ss += __shfl_xor(ss, of);
        const size_t ci = (size_t)(r0 + i) * 2048 + h * 512 + dv;
        a.OG[ci] = f2bf(o[i] * bf2f(a.G[ci]));
        if (lane == 0) a.ssret[(size_t)(r0 + i) * 32 + h * 8 + sl] = ss; }
}

__device__ __forceinline__ void make_an_row(const MegaArgs& a, int r, int lane) {
    const float4* sp = (const float4*)(a.ssret + (size_t)r * 32);
    float rn[4];
#pragma unroll
    for (int h = 0; h < 4; ++h) { const float4 s0 = sp[2 * h], s1 = sp[2 * h + 1]; rn[h] = rsqrtf(((s0.x + s0.y) + (s0.z + s0.w) + (s1.x + s1.y) + (s1.z + s1.w)) * (1.0f / 512.0f) + NORM_EPS); }
#pragma unroll
    for (int h = 0; h < 4; ++h) { const uint4 v = ((const uint4*)(a.OG + (size_t)r * 2048))[h * 64 + lane]; const float f = rn[h]; uint4 o;
        o.x = pg8::cvt_pk_bf16(__uint_as_float(v.x << 16) * f, __uint_as_float(v.x & 0xffff0000u) * f); o.y = pg8::cvt_pk_bf16(__uint_as_float(v.y << 16) * f, __uint_as_float(v.y & 0xffff0000u) * f);
        o.z = pg8::cvt_pk_bf16(__uint_as_float(v.z << 16) * f, __uint_as_float(v.z & 0xffff0000u) * f); o.w = pg8::cvt_pk_bf16(__uint_as_float(v.w << 16) * f, __uint_as_float(v.w & 0xffff0000u) * f);
        ((uint4*)(a.An + (size_t)r * 2048))[h * 64 + lane] = o; }
}
__device__ __forceinline__ void knorm_row(const MegaArgs& a, int r, int lane) {
    float* kp = a.out + (r < T_PROMPT ? (size_t)O_K_P + (size_t)r * 256 : (size_t)O_K_S + (size_t)(r - T_PROMPT) * 256) + lane * 4;
    const float4 x = *(const float4*)kp; float ss = x.x * x.x + x.y * x.y + x.z * x.z + x.w * x.w;
#pragma unroll
    for (int o = 16; o >= 1; o >>= 1) ss += __shfl_xor(ss, o);
    const float rn = rsqrtf(ss * (1.0f / 128.0f) + NORM_EPS); const float4 w = *(const float4*)(a.knw + (lane & 31) * 4);
    const float4 y = make_float4(x.x * rn * w.x, x.y * rn * w.y, x.z * rn * w.z, x.w * rn * w.w);
    *(float4*)kp = y;
    uint2 o; o.x = (unsigned)f2bf(y.x) | ((unsigned)f2bf(y.y) << 16); o.y = (unsigned)f2bf(y.z) | ((unsigned)f2bf(y.w) << 16);
    *(uint2*)(a.Kb + (size_t)r * 256 + lane * 4) = o;
}
#define IDX_N_SAMPLE_TASKS (DEC_BATCH * 2)
#define IDX_N_PROMPT_TASKS (BATCH * (LP / 4))
#define IDX_N_TASKS (IDX_N_SAMPLE_TASKS + IDX_N_PROMPT_TASKS)
__device__ __forceinline__ void idx_task(const MegaArgs& a, int k, unsigned char* shm, int wave, int lane) {
    unsigned* strip = (unsigned*)(shm + (size_t)wave * idx::WAVE_LDS); unsigned* mask32 = (unsigned*)a.mask;
    if (k < IDX_N_SAMPLE_TASKS) {
        const int db = k >> 1, q0 = 4 * (k & 1);
        const int pgv = a.page_table[db * N_PAGES + (lane & 15)];
        idx::KeySrc<true> ks{a.Ikb + (size_t)(T_PROMPT + db * DEC_SEQ) * 64, a.cache_kidx, pgv};
        idx::wave_task<true>(ks, a.Iq, a.Iw, T_PROMPT + db * DEC_SEQ + q0, PAST_LEN + q0, 4, strip, mask32, lane);
    } else {
        const int pk = k - IDX_N_SAMPLE_TASKS, b = pk & 7, l0 = 4 * (LP / 4 - 1 - (pk >> 3));
        idx::KeySrc<false> ks{a.Ikb + (size_t)b * LP * 64, nullptr, 0};
        idx::wave_task<false>(ks, a.Iq, a.Iw, b * LP + l0, l0, 4, strip, mask32, lane);
    }
}
#define ATT_N_PROMPT_UNITS (BATCH * N_KV * 33)
__device__ __forceinline__ void attn_prompt_unit(const MegaArgs& a, int idx, char* lds) {
    const int qb = 32 - idx / 16, bn = idx % 16, b = bn >> 1, n = bn & 1;
    const int tok0 = b * LP + 64 * qb, nq = (LP - 64 * qb) < 64 ? (LP - 64 * qb) : 64;
    const int NT = qb + 1;
    att::KvPrompt kv{a.Kb + (size_t)b * LP * 256 + n * 128, a.Vb + (size_t)b * LP * 256 + n * 128};
    att::attn_unit<att::KvPrompt>(kv, a.Aq, a.qnw, a.mask, a.Odsa, tok0, nq, 4 * n, NT, lds);
}
__device__ __forceinline__ void attn_sample_unit(const MegaArgs& a, int u, char* lds) {
    const int db = u >> 1, n = u & 1;
    int* pages = (int*)(lds + 2 * att::SHM_V + 2 * att::SHM_K + 2048);
    __syncthreads();
    if (threadIdx.x < N_PAGES) pages[threadIdx.x] = a.page_table[db * N_PAGES + threadIdx.x];
    __syncthreads();
    att::KvSample kv{a.cache_k, a.cache_v, a.out + O_K_S + (size_t)db * DEC_SEQ * 256 + n * 128, a.out + O_V_S + (size_t)db * DEC_SEQ * 256 + n * 128, pages, n};
    att::attn_unit<att::KvSample>(kv, a.Aq, a.qnw, a.mask, a.Odsa, T_PROMPT + db * DEC_SEQ, DEC_SEQ, 4 * n, 33, lds);
}

#define LDS_TOTAL (8 * idx::WAVE_LDS + 2048)
__global__ void __launch_bounds__(512, 2) mega(MegaArgs a) {
    extern __shared__ __attribute__((aligned(16))) unsigned char shm[];
    float* lds = (float*)shm;
    volatile LAS unsigned* xbw = (volatile LAS unsigned*)(PG8_LAS unsigned char*)(shm + LDS_TOTAL - 16);
    const int tid = threadIdx.x, wave = tid >> 6, lane = tid & 63, half = tid >> 8, G = gridDim.x, bid = blockIdx.x;
    if (tid == 0) { xbw[0] = 0u; xbw[1] = 0u; xbw[2] = 0u; xbw[3] = 0u; }
    __syncthreads();
    XcdBarrier bar = xcd_barrier_post(a.bar, xbw);
    for (int jp = bid; jp < PREP_J_ROWS / 2; jp += G) prep_job(a.prep, 2 * jp + half, lds + half * (64 * 65));
    for (int j = PREP_J_ROWS + bid * 2 + half; j < PREP_N_JOBS; j += 2 * G) prep_job(a.prep, j, lds);
    for (int i = bid * 512 + tid; i < T_PAD; i += G * 512) a.rstd2[i] = 0.f;
    xcd_barrier(bar);
    { pg8::StaticOrder S; S.init(T_PAD, N1, G, bid);
      epi::Epi1 E{a.prep.rstd0, a.prep.rope, a.ikw, a.ikb, a.Rq, a.Rk, a.Rv, a.G, a.Aq, a.Vb, a.Iq, a.Ikb, a.Gates, a.Iw, a.out, 0};
      pg8::gemm_phase<epi::Epi1, pg8::StaticOrder, false>((PG8_LAS unsigned char*)shm, pg8::Gemm{a.prep.A0, a.prep.W1t, T_PAD, N1, 1024}, S, E, nullptr); }
    xcd_barrier(bar);
    for (int ord = 0; ord < 2; ++ord) {
      if ((ord ^ (bid & 1)) == 0) {
        for (int u = bid; u < BATCH * H_RET * 8; u += G) ret::unit(a, u, (char*)shm);
      } else {
      { int tl = threadIdx.x; asm volatile("" : "+v"(tl)); const int wv = __builtin_amdgcn_readfirstlane(tl >> 6), NW = 8 * G, g = wv * G + bid;
        float* strip = (float*)(shm + (size_t)wv * idx::WAVE_LDS);
        for (int step = 0; step < 6; ++step) { const int i = step >> 1;
            int ln_o = tl & 63; asm volatile("" : "+v"(ln_o)); const int ln = ln_o;
            if ((step + wv) & 1) { const int pi = i * NW + ((i & 1) ? (NW - 1 - g) : g); if (pi < IDX_N_TASKS) idx_task(a, pi, shm, wv, ln); }
            else                 { const int pr = i * NW + g; if (pr < RETS_N_TASKS) ret_sample_task(a, pr, strip, ln); } } }
        __syncthreads();
      }
    }
    { int t2 = threadIdx.x; asm volatile("" : "+v"(t2)); for (int r = bid * 8 + (t2 >> 6); r < T_ALL; r += 8 * G) knorm_row(a, r, t2 & 63); }
    xcd_barrier(bar);
    for (int ord = 0; ord < 2; ++ord) {
      if ((ord ^ (bid & 1)) == 0) {
        for (int i = 0; ; ++i) { const long p = (long)i * G + ((i & 1) ? (G - 1 - bid) : bid); if (p >= ATT_N_PROMPT_UNITS) { if ((long)i * G >= ATT_N_PROMPT_UNITS) break; else continue; } attn_prompt_unit(a, (int)p, (char*)shm); }
      } else {
        for (int u = bid; u < DEC_BATCH * N_KV; u += G) attn_sample_unit(a, u, (char*)shm);
      }
    }
    { int t2 = threadIdx.x; asm volatile("" : "+v"(t2)); for (int r = bid * 8 + (t2 >> 6); r < T_ALL; r += 8 * G) make_an_row(a, r, t2 & 63); }
    xcd_barrier(bar);
    { pg8::StaticOrder S; S.init(T_PAD, 1024, G, bid); pg8::gemm_phase<epi::EpiRet, pg8::StaticOrder, false>((PG8_LAS unsigned char*)shm, pg8::Gemm{a.An, a.prep.Wret, T_PAD, 1024, 2048}, S, epi::EpiRet{a.M1}, nullptr); }
    { pg8::StaticOrder S; S.init(T_PAD, 1024, G, bid); pg8::gemm_phase<epi::EpiDsa, pg8::StaticOrder, false>((PG8_LAS unsigned char*)shm, pg8::Gemm{a.Odsa, a.prep.Wdsa, T_PAD, 1024, 1024}, S, epi::EpiDsa{a.Gates, a.M1, a.Mg}, nullptr); }
    xcd_barrier(bar);
    { pg8::StaticOrder S; S.init(T_PAD, 1024, G, bid); pg8::gemm_phase<epi::EpiOut, pg8::StaticOrder, false>((PG8_LAS unsigned char*)shm, pg8::Gemm{a.Mg, a.prep.Wout, T_PAD, 1024, 1024}, S, epi::EpiOut{a.prep.x_prompt, a.prep.x_sample, a.prep.meta, a.H2, a.A2, a.rstd2}, nullptr); }
    xcd_barrier(bar);
    { pg8::StaticOrder S; S.init(T_PAD, NFF2, G, bid); pg8::gemm_phase<epi::EpiFfi, pg8::StaticOrder, false>((PG8_LAS unsigned char*)shm, pg8::Gemm{a.A2, a.prep.Wffi, T_PAD, NFF2, 1024}, S, epi::EpiFfi{a.rstd2, a.Hid}, nullptr); }
    xcd_barrier(bar);
    { pg8::StaticOrder S; S.init(T_PAD, 1024, G, bid); pg8::gemm_phase<epi::EpiFfo, pg8::StaticOrder, false>((PG8_LAS unsigned char*)shm, pg8::Gemm{a.Hid, a.prep.Wffo, T_PAD, 1024, 2816}, S, epi::EpiFfo{a.H2, a.out}, nullptr); }
}
extern "C" void kernel_launch(void* const* d_in, const int* in_sizes, int n_in, void* d_out, int out_size, void* d_ws, size_t ws_size, hipStream_t stream) {
    static int grid = 0;
    if (grid == 0) {
        if (n_in != 20 || out_size != OUT_TOTAL || ws_size < WS_END_B1 || ws_size < WS_END_B2) { fprintf(stderr, "kernel_launch: unexpected shapes (n_in %d out %d ws %zu need %llu)\n", n_in, out_size, ws_size, (unsigned long long)WS_END_B1); grid = -1; return; }
        int dev = 0, cus = 0, per_cu = 0;
        if (hipGetDevice(&dev) != hipSuccess || hipDeviceGetAttribute(&cus, hipDeviceAttributeMultiprocessorCount, dev) != hipSuccess) { grid = -1; return; }
        if (hipFuncSetAttribute((const void*)mega, hipFuncAttributeMaxDynamicSharedMemorySize, LDS_TOTAL) != hipSuccess) { fprintf(stderr, "kernel_launch: hipFuncSetAttribute failed\n"); grid = -1; return; }
        if (hipOccupancyMaxActiveBlocksPerMultiprocessor(&per_cu, (const void*)mega, 512, LDS_TOTAL) != hipSuccess || per_cu < 1) { fprintf(stderr, "kernel_launch: occupancy query says %d blocks per CU\n", per_cu); grid = -1; return; }
        grid = cus;
    }
    if (grid < 0) return;
    char* ws = (char*)d_ws;
    MegaArgs a{};
    a.prep.x_prompt = (const float*)d_in[0]; a.prep.x_sample = (const float*)d_in[1]; a.prep.meta = (const float*)d_in[7]; a.prep.norm_mix_w = (const float*)d_in[8]; a.prep.w_in = (const float*)d_in[9];
    a.prep.w_ret = (const float*)d_in[10]; a.prep.w_dsa = (const float*)d_in[15]; a.prep.w_out = (const float*)d_in[16]; a.prep.norm_ffn_w = (const float*)d_in[17]; a.prep.w_ffi = (const float*)d_in[18]; a.prep.w_ffo = (const float*)d_in[19];
    a.prep.W1t = (bf16_t*)(ws + WS_W1T); a.prep.Wret = (bf16_t*)(ws + WS_WRET); a.prep.Wdsa = (bf16_t*)(ws + WS_WDSA); a.prep.Wout = (bf16_t*)(ws + WS_WOUT); a.prep.Wffi = (bf16_t*)(ws + WS_WFFI); a.prep.Wffo = (bf16_t*)(ws + WS_WFFO);
    a.prep.A0 = (bf16_t*)(ws + WS_A0); a.prep.rstd0 = (float*)(ws + WS_RSTD0); a.prep.rope = (float2*)(ws + WS_ROPE);
    a.cache_k = (const float*)d_in[2]; a.cache_v = (const float*)d_in[3]; a.cache_kidx = (const float*)d_in[4]; a.state_ret = (const float*)d_in[5]; a.page_table = (const int*)d_in[6];
    a.qnw = (const float*)d_in[11]; a.knw = (const float*)d_in[12]; a.ikw = (const float*)d_in[13]; a.ikb = (const float*)d_in[14];
    a.Rq = (bf16_t*)(ws + WS_RQ); a.Rk = (bf16_t*)(ws + WS_RK); a.Rv = (bf16_t*)(ws + WS_RV); a.G = (bf16_t*)(ws + WS_G); a.Aq = (bf16_t*)(ws + WS_AQ); a.Kb = (bf16_t*)(ws + WS_KB); a.Vb = (bf16_t*)(ws + WS_VB);
    a.Iq = (bf16_t*)(ws + WS_IQ); a.Ikb = (bf16_t*)(ws + WS_IKB); a.Gates = (bf16_t*)(ws + WS_GATES); a.OG = (bf16_t*)(ws + WS_OG); a.An = (bf16_t*)(ws + WS_AN); a.Odsa = (bf16_t*)(ws + WS_ODSA); a.Mg = (bf16_t*)(ws + WS_MG);
    a.A2 = (bf16_t*)(ws + WS_A2); a.Hid = (bf16_t*)(ws + WS_HID);
    a.Iw = (float*)(ws + WS_IW); a.ssret = (float*)(ws + WS_SSRET); a.rstd2 = (float*)(ws + WS_RSTD2); a.Z = (float*)(ws + WS_Z); a.M1 = (float*)(ws + WS_M1); a.M2 = (float*)(ws + WS_M2); a.H2 = (float*)(ws + WS_H2); a.Zf = (float*)(ws + WS_ZF);
    a.out = (float*)d_out; a.mask = (u64*)(ws + WS_MASK); a.bar = (unsigned*)(ws + WS_CTL);
    if (hipMemsetAsync(ws + WS_CTL, 0, 65536, stream) != hipSuccess) return;
    hipLaunchKernelGGL(mega, dim3(grid), dim3(512), LDS_TOTAL, stream, a);
}
```

```cpp
#include <hip/hip_runtime.h>
#include <stdint.h>
#include <stdio.h>

#define D_MODEL 1024
#define BATCH 8
#define SEQ 2048
#define N_META 16
#define LP (N_META + SEQ)
#define DEC_BATCH 128
#define DEC_SEQ 8
#define PAST_LEN 2048
#define PAGE_SIZE 128
#define N_PAGES 16
#define H_RET 4
#define DK_RET 256
#define DV_RET 512
#define N_HEADS 8
#define N_KV 2
#define D_HEAD 128
#define N_IDXH 8
#define D_IDX 64
#define TOPK 256
#define D_FF 2816
#define IN_COLS 10312
#define NORM_EPS 1e-6f
#define IDX_SCALE 0.04419417382415922f
#define T_PROMPT (BATCH * LP)
#define T_SAMPLE (DEC_BATCH * DEC_SEQ)
#define T_ALL (T_PROMPT + T_SAMPLE)
#define T_PAD 17664
#define N1 10496
#define NFF2 5632
#define MASK_WORDS 34
#define SAMPLE_L (PAST_LEN + DEC_SEQ)

#define O_Y_P   0
#define O_Y_S   16777216
#define O_K_P   17825792
#define O_V_P   22052864
#define O_KI_P  26279936
#define O_R_P   27336704
#define O_K_S   31531008
#define O_V_S   31793152
#define O_KI_S  32055296
#define O_R_S   32120832
#define OUT_TOTAL 99229696

typedef unsigned short bf16_t;
typedef unsigned long long u64;

__device__ __forceinline__ bf16_t f2bf(float f) { unsigned u = __float_as_uint(f); u += 0x7FFFu + ((u >> 16) & 1u); return (bf16_t)(u >> 16); }
__device__ __forceinline__ float bf2f(bf16_t b) { return __uint_as_float(((unsigned)b) << 16); }
__device__ __forceinline__ float silu_f(float x) { return x / (1.0f + __expf(-x)); }
__device__ __forceinline__ float sigmoid_f(float x) { return 1.0f / (1.0f + __expf(-x)); }

__device__ __forceinline__ int row_pos(int r) { return r < T_PROMPT ? (r % LP) : (PAST_LEN + ((r - T_PROMPT) & (DEC_SEQ - 1))); }

#define WS_CTL      0ull
#define WS_W1T      (WS_CTL + 65536ull)
#define WS_WRET     (WS_W1T + (u64)N1 * 1024 * 2)
#define WS_WDSA     (WS_WRET + 1024ull * 2048 * 2)
#define WS_WOUT     (WS_WDSA + 1024ull * 1024 * 2)
#define WS_WFFI     (WS_WOUT + 1024ull * 1024 * 2)
#define WS_WFFO     (WS_WFFI + (u64)NFF2 * 1024 * 2)
#define WS_ROPE     (WS_WFFO + 1024ull * 2816 * 2)
#define WS_RSTD0    (WS_ROPE + (u64)LP * 128 * 8)
#define WS_A0       (WS_RSTD0 + (u64)T_PAD * 4)
#define WS_RQ       (WS_A0 + (u64)T_PAD * 1024 * 2)
#define WS_RK       (WS_RQ + (u64)T_PAD * 1024 * 2)
#define WS_RV       (WS_RK + (u64)T_PAD * 1024 * 2)
#define WS_G        (WS_RV + (u64)T_PAD * 2048 * 2)
#define WS_AQ       (WS_G + (u64)T_PAD * 2048 * 2)
#define WS_KB       (WS_AQ + (u64)T_PAD * 1024 * 2)
#define WS_VB       (WS_KB + (u64)T_PAD * 256 * 2)
#define WS_IQ       (WS_VB + (u64)T_PAD * 256 * 2)
#define WS_IKB      (WS_IQ + (u64)T_PAD * 512 * 2)
#define WS_IW       (WS_IKB + (u64)T_PAD * 64 * 2)
#define WS_GATES    (WS_IW + (u64)T_PAD * 8 * 4)
#define WS_MASK     (WS_GATES + (u64)T_PAD * 2048 * 2)
#define WS_SSRET    (WS_MASK + (u64)T_PAD * MASK_WORDS * 8)
#define WS_RSTD2    (WS_SSRET + (u64)T_PAD * 32 * 4)
#define WS_REGION_B (((WS_RSTD2 + (u64)T_PAD * 16 * 4) + 4095ull) & ~4095ull)
#define WS_Z        WS_REGION_B
#define WS_H2       WS_REGION_B
#define WS_A2       (WS_H2 + (u64)T_PAD * 1024 * 4)
#define WS_HID      (WS_A2 + (u64)T_PAD * 1024 * 2)
#define WS_MG       (WS_HID + (u64)T_PAD * 2816 * 2)
#define WS_OG       (WS_MG + (u64)T_PAD * 1024 * 2)
#define WS_AN       (WS_OG + (u64)T_PAD * 2048 * 2)
#define WS_ODSA     (WS_AN + (u64)T_PAD * 2048 * 2)
#define WS_M1       (WS_ODSA + (u64)T_PAD * 1024 * 2)
#define WS_M2       (WS_M1 + (u64)T_PAD * 1024 * 4)
#define WS_ZF       WS_OG
#define WS_END_B1   (WS_Z + (u64)T_PAD * N1 * 4)
#define WS_END_B2   (WS_ZF + (u64)T_PAD * NFF2 * 4)
namespace pg8 {
#define PG8_LAS __attribute__((address_space(3)))
typedef unsigned short bf16_t;
typedef short bf16x8 __attribute__((ext_vector_type(8)));
typedef float f32x4 __attribute__((ext_vector_type(4)));
typedef unsigned u32x4 __attribute__((ext_vector_type(4)));
constexpr int BM = 256, BK = 64, HALF = 128, HTB = HALF * BK * 2  , STAGE_BYTES = 8 * HTB, NXCD = 8, WGM = 8;

__host__ __device__ __forceinline__ int lds_byte(int r, int c) { const int st = (r >> 4) * 2 + (c >> 5), rr = r & 15, cc = c & 31, ob = rr * 64 + cc * 2; return st * 1024 + (ob ^ (((ob >> 9) & 1) << 5)); }
__host__ __device__ __forceinline__ void stage_rc(int b, int& R, int& C) { const int st = b / 1024, sb = b % 1024, swz = sb ^ (((sb >> 9) & 1) << 5); R = (st >> 1) * 16 + swz / 64; C = (st & 1) * 32 + (swz % 64) / 2; }
__host__ __device__ __forceinline__ int perm32(int rho) { const int n = rho >> 4, i = rho & 15; return 8 * (i >> 2) + 4 * n + (i & 3); }

struct Unit { int pm, pn; };
struct Gemm { const bf16_t* A; const bf16_t* Bt; int M, N, K; };

struct StaticOrder {
    int nM, nN, nwg, G, c;
    __host__ __device__ void init(int M, int N, int G_, int c_) { nM = M / BM; nN = N / BM; nwg = nM * nN; G = G_; c = c_; }
    __host__ __device__ bool next(int i, Unit& u) const {
        const long L = (long)i * G + c; if (L >= nwg) return false;
        int wgid = (int)L; { const int q = nwg / NXCD, r = nwg % NXCD, xcd = wgid % NXCD, off = wgid / NXCD; wgid = (xcd < r ? xcd * (q + 1) : r * (q + 1) + (xcd - r) * q) + off; }
        const int nig = WGM * nN, gid = wgid / nig, fm = gid * WGM, gsz = (nM - fm) < WGM ? (nM - fm) : WGM;
        u.pm = fm + ((wgid % nig) % gsz); u.pn = (wgid % nig) / gsz; return true;
    }
    __device__ __forceinline__ void a_ready(const Unit&) const {}
    __device__ __forceinline__ void done(const Unit&) const {}
};
struct CountedOrder : StaticOrder {
    const unsigned* ready; unsigned need; unsigned* tmo;
    __device__ __forceinline__ void a_ready(const Unit& u) const {
        if (threadIdx.x < 64) {
            const unsigned long long t0 = __builtin_amdgcn_s_memrealtime(); unsigned polls = 0;
            while ((unsigned)__builtin_amdgcn_readfirstlane(__hip_atomic_load(ready + 64 * u.pm, __ATOMIC_RELAXED, __HIP_MEMORY_SCOPE_AGENT)) < need) {
                if ((++polls & 255u) == 0u && __builtin_amdgcn_readfirstlane(__hip_atomic_load(tmo, __ATOMIC_RELAXED, __HIP_MEMORY_SCOPE_AGENT)) != 0u) break;
                if (__builtin_amdgcn_s_memrealtime() - t0 > 2000000ull) {
                    if (threadIdx.x == 0) { unsigned expect = 0u; __hip_atomic_compare_exchange_strong(tmo + 1, &expect, 0x600u | (unsigned)(u.pm & 0xff), __ATOMIC_RELAXED, __ATOMIC_RELAXED, __HIP_MEMORY_SCOPE_AGENT); __hip_atomic_store(tmo, 1u, __ATOMIC_RELAXED, __HIP_MEMORY_SCOPE_AGENT); }
                    break; }
                __builtin_amdgcn_s_sleep(2); }
            __builtin_amdgcn_fence(__ATOMIC_ACQUIRE, "agent");
            asm volatile("s_waitcnt vmcnt(0)" ::: "memory");
        }
#if !defined(BROKEN_HOOK_NO_BARRIER)
        asm volatile("" ::: "memory"); __builtin_amdgcn_s_barrier(); asm volatile("" ::: "memory");
#endif
    }
};

typedef float f32x2c __attribute__((ext_vector_type(2))); typedef __bf16 bf16x2c __attribute__((ext_vector_type(2)));
__device__ __forceinline__ unsigned cvt_pk_bf16(float lo, float hi) { const f32x2c v = {lo, hi}; return __builtin_bit_cast(unsigned, __builtin_convertvector(v, bf16x2c)); }
typedef float f32x2 __attribute__((ext_vector_type(2)));
__device__ __forceinline__ f32x2 gelu_pk(f32x2 v) {
    const f32x2 av = __builtin_elementwise_abs(v), d = av * 0.2316418882f + 1.0f;
    f32x2 t; t.x = __builtin_amdgcn_rcpf(d.x); t.y = __builtin_amdgcn_rcpf(d.y);
    f32x2 q = t * 0.5307027145f + (-0.7265760135f); q = q * t + 0.7107068705f; q = q * t + (-0.142248368f); q = q * t + 0.127414796f; q = q * t;
    const f32x2 s = (v * v) * (-0.72134752044f);
    f32x2 e; e.x = __builtin_amdgcn_exp2f(s.x); e.y = __builtin_amdgcn_exp2f(s.y);
    const f32x2 m = v * (q * e), r = v - m;
    f32x2 o; o.x = v.x < 0.f ? m.x : r.x; o.y = v.y < 0.f ? m.y : r.y; return o;
}

struct EpiF32 {
    static constexpr bool PERM = false, AFTER_DRAIN = false;
    float* C; int ldc; const float* bias;
    __device__ __forceinline__ void operator()(const f32x4 (&acc)[2][2][4][2], const Unit& u, int wr, int wc, int fr, int fq) const {
        const int row0 = u.pm * BM + wr * 64 + fr, col0 = u.pn * BM + wc * 32 + 4 * fq;
        f32x4 bv[2][2];
#pragma unroll
        for (int bj = 0; bj < 2; ++bj)
#pragma unroll
            for (int n = 0; n < 2; ++n) bv[bj][n] = bias ? *(const f32x4*)(bias + col0 + bj * HALF + n * 16) : (f32x4){0.f, 0.f, 0.f, 0.f};
#pragma unroll
        for (int ai = 0; ai < 2; ++ai)
#pragma unroll
            for (int m = 0; m < 4; ++m) { float* rowp = C + (size_t)(row0 + ai * HALF + m * 16) * ldc + col0;
#pragma unroll
                for (int bj = 0; bj < 2; ++bj)
#pragma unroll
                    for (int n = 0; n < 2; ++n) *(f32x4*)(rowp + bj * HALF + n * 16) = acc[ai][bj][m][n] + bv[bj][n]; }
    }
};
template <int ACT  > struct EpiBf16 {
    static constexpr bool PERM = true, AFTER_DRAIN = false;
    bf16_t* O; int ldc; const float* bias; int split_cols; size_t split_stride;
    __device__ __forceinline__ void operator()(const f32x4 (&acc)[2][2][4][2], const Unit& u, int wr, int wc, int fr, int fq) const {
        const int row0 = u.pm * BM + wr * 64 + fr; int colt = u.pn * BM; bf16_t* base = O;
        if (split_cols) { const int t = colt / split_cols; base += (size_t)t * split_stride; colt -= t * split_cols; }
        const int col0 = colt + wc * 32 + 8 * fq, bcol0 = u.pn * BM + wc * 32 + 8 * fq;
        f32x4 bv[2][2];
#pragma unroll
        for (int bj = 0; bj < 2; ++bj)
#pragma unroll
            for (int n = 0; n < 2; ++n) bv[bj][n] = bias ? *(const f32x4*)(bias + bcol0 + bj * HALF + 4 * n) : (f32x4){0.f, 0.f, 0.f, 0.f};
#pragma unroll
        for (int ai = 0; ai < 2; ++ai)
#pragma unroll
            for (int m = 0; m < 4; ++m) { bf16_t* rowp = base + (size_t)(row0 + ai * HALF + m * 16) * ldc + col0;
#pragma unroll
                for (int bj = 0; bj < 2; ++bj) { f32x4 v0 = acc[ai][bj][m][0] + bv[bj][0], v1 = acc[ai][bj][m][1] + bv[bj][1];
                    if (ACT == 1) { f32x2 a = gelu_pk((f32x2){v0[0], v0[1]}), b = gelu_pk((f32x2){v0[2], v0[3]}), c = gelu_pk((f32x2){v1[0], v1[1]}), d = gelu_pk((f32x2){v1[2], v1[3]});
                        v0 = (f32x4){a.x, a.y, b.x, b.y}; v1 = (f32x4){c.x, c.y, d.x, d.y}; }
                    if (ACT == 2) {
#pragma unroll
                        for (int j = 0; j < 4; ++j) { v0[j] = 0.5f * v0[j] * (1.0f + erff(v0[j] * 0.70710678f)); v1[j] = 0.5f * v1[j] * (1.0f + erff(v1[j] * 0.70710678f)); } }
                    u32x4 w; w.x = cvt_pk_bf16(v0[0], v0[1]); w.y = cvt_pk_bf16(v0[2], v0[3]); w.z = cvt_pk_bf16(v1[0], v1[1]); w.w = cvt_pk_bf16(v1[2], v1[3]);
                    *(u32x4*)(rowp + bj * HALF) = w; } }
    }
};
template <class Epi, class Sched, bool STAMP = false>
__device__ __forceinline__ void gemm_phase(PG8_LAS unsigned char* lds, const Gemm g, const Sched& S, const Epi& E, unsigned long long* stamps) {
    int tid_l = threadIdx.x; asm volatile("" : "+v"(tid_l));
    const int tid = tid_l, wid = __builtin_amdgcn_readfirstlane(tid >> 6), lane = tid & 63, wr = wid >> 2, wc = wid & 3, fr = lane & 15, fq = lane >> 4;
    const int K = g.K, nt = K / BK;
    int ts_lo = 0, ts_hi = 0, nts = 0; const unsigned long long rt_entry = STAMP ? (unsigned long long)wall_clock64() : 0ull;
#define PG8_STAMP() do { if (STAMP && wid == 0 && nts < 64) { const unsigned long long _c = (unsigned long long)clock64(); \
        ts_lo = (lane == nts) ? (int)(unsigned)_c : ts_lo; ts_hi = (lane == nts) ? (int)(unsigned)(_c >> 32) : ts_hi; ++nts; } } while (0)
    PG8_STAMP();
    unsigned voffA[2], voffB[2];
#pragma unroll
    for (int i = 0; i < 2; ++i) { int R, C; stage_rc(tid * 16 + i * 8192, R, C); const int Rb = Epi::PERM ? ((R & ~31) + perm32(R & 31)) : R;
        voffA[i] = (unsigned)(R * K + C) * 2u; voffB[i] = (unsigned)(Rb * K + C) * 2u; }
    const size_t kstep = (size_t)(BK * 2);
    const size_t hstep = (size_t)HALF * K * 2;
    const size_t tstep = 2 * hstep;
    const unsigned ldsw = (unsigned)wid * 1024u;
    const int aoff = lds_byte(wr * 64 + fr, fq * 8), boff = lds_byte(wc * 32 + fr, fq * 8);
#define PG8_SA(b, h) (((b) * 2 + (h)) * HTB)
#define PG8_SB(b, h) ((4 + (b) * 2 + (h)) * HTB)
#define PG8_STAGE(bufoff, gbase, voff) do { _Pragma("unroll") for (int _i = 0; _i < 2; ++_i) \
        __builtin_amdgcn_global_load_lds((const unsigned*)((const char*)(gbase) + (voff)[_i]), (PG8_LAS unsigned*)(lds + (bufoff) + ldsw + _i * 8192), 16, 0, 0); } while (0)
#define PG8_LDA(dst, b, h) do { _Pragma("unroll") for (int m = 0; m < 4; ++m) _Pragma("unroll") for (int k = 0; k < 2; ++k) dst[m][k] = *(const PG8_LAS bf16x8*)(lds + PG8_SA(b, h) + aoff + m * 2048 + k * 1024); } while (0)
#define PG8_LDB(dst, b, h) do { _Pragma("unroll") for (int n = 0; n < 2; ++n) _Pragma("unroll") for (int k = 0; k < 2; ++k) dst[n][k] = *(const PG8_LAS bf16x8*)(lds + PG8_SB(b, h) + boff + n * 2048 + k * 1024); } while (0)
#define PG8_MMA(ai, bj, At, Bt) do { __builtin_amdgcn_s_setprio(1); _Pragma("unroll") for (int m = 0; m < 4; ++m) _Pragma("unroll") for (int n = 0; n < 2; ++n) _Pragma("unroll") for (int k = 0; k < 2; ++k) \
        acc[ai][bj][m][n] = __builtin_amdgcn_mfma_f32_16x16x32_bf16(Bt[n][k], At[m][k], acc[ai][bj][m][n], 0, 0, 0); __builtin_amdgcn_s_setprio(0); } while (0)
#define PG8_WAIT_V(n) asm volatile("s_waitcnt vmcnt(" #n ")" ::: "memory")
#define PG8_WAIT_L(n) asm volatile("s_waitcnt lgkmcnt(" #n ")" ::: "memory")
#define PG8_BAR __builtin_amdgcn_s_barrier()
#define PG8_SCHED __builtin_amdgcn_sched_barrier(0)
    Unit cur, nxt; int ui = 0;
    if (!S.next(0, cur)) return;
    f32x4 acc[2][2][4][2];
#pragma unroll
    for (int a = 0; a < 2; ++a)
#pragma unroll
        for (int b = 0; b < 2; ++b)
#pragma unroll
            for (int m = 0; m < 4; ++m)
#pragma unroll
                for (int n = 0; n < 2; ++n) acc[a][b][m][n] = (f32x4){0.f, 0.f, 0.f, 0.f};
    bf16x8 At[4][2], B0[2][2], B1[2][2];
    const char* cA = (const char*)g.A + (size_t)cur.pm * tstep; const char* cB = (const char*)g.Bt + (size_t)cur.pn * tstep;
    S.a_ready(cur);
    PG8_STAGE(PG8_SB(0, 0), cB, voffB); PG8_STAGE(PG8_SA(0, 0), cA, voffA); PG8_STAGE(PG8_SB(0, 1), cB + hstep, voffB); PG8_STAGE(PG8_SA(0, 1), cA + hstep, voffA);
    if (wr == 1) PG8_BAR;
    PG8_WAIT_V(4); PG8_BAR;
    PG8_STAGE(PG8_SB(1, 0), cB + kstep, voffB); PG8_STAGE(PG8_SA(1, 0), cA + kstep, voffA); PG8_STAGE(PG8_SB(1, 1), cB + hstep + kstep, voffB);
    PG8_WAIT_V(6); PG8_BAR;
    PG8_STAMP();
    for (;;) {
        const bool has_next = S.next(ui + 1, nxt);
        const char* nA = has_next ? (const char*)g.A + (size_t)nxt.pm * tstep : cA; const char* nB = has_next ? (const char*)g.Bt + (size_t)nxt.pn * tstep : cB;
        for (int t = 0; t < nt; t += 2) {
            const bool last = (t == nt - 2);
            const char* a1 = cA + (size_t)(t + 1) * kstep;
            const char* a2 = last ? nA : cA + (size_t)(t + 2) * kstep; const char* b2 = last ? nB : cB + (size_t)(t + 2) * kstep;
            const char* a3 = a2 + kstep; const char* b3 = b2 + kstep;
            if (last && has_next) S.a_ready(nxt);
            PG8_LDB(B0, 0, 0); PG8_SCHED; PG8_LDA(At, 0, 0); PG8_STAGE(PG8_SA(1, 1), a1 + hstep, voffA);
            PG8_WAIT_L(8); PG8_BAR; PG8_WAIT_L(0); PG8_MMA(0, 0, At, B0); PG8_BAR; PG8_SCHED;
            PG8_LDB(B1, 0, 1); PG8_STAGE(PG8_SB(0, 0), b2, voffB);
            PG8_BAR; PG8_WAIT_L(0); PG8_MMA(0, 1, At, B1); PG8_BAR;
            PG8_LDA(At, 0, 1); PG8_STAGE(PG8_SA(0, 0), a2, voffA);
            PG8_BAR; PG8_WAIT_L(0); PG8_MMA(1, 0, At, B0); PG8_BAR; PG8_SCHED;
            PG8_STAGE(PG8_SB(0, 1), b2 + hstep, voffB);
            PG8_WAIT_V(6); PG8_BAR; PG8_MMA(1, 1, At, B1); PG8_BAR;
            PG8_LDB(B0, 1, 0); PG8_SCHED; PG8_LDA(At, 1, 0); PG8_STAGE(PG8_SA(0, 1), a2 + hstep, voffA);
            PG8_WAIT_L(8); PG8_BAR; PG8_WAIT_L(0); PG8_MMA(0, 0, At, B0); PG8_BAR; PG8_SCHED;
            PG8_LDB(B1, 1, 1); PG8_STAGE(PG8_SB(1, 0), b3, voffB);
            PG8_BAR; PG8_WAIT_L(0); PG8_MMA(0, 1, At, B1); PG8_BAR;
            PG8_LDA(At, 1, 1); PG8_STAGE(PG8_SA(1, 0), a3, voffA);
            PG8_BAR; PG8_WAIT_L(0); PG8_MMA(1, 0, At, B0); PG8_BAR; PG8_SCHED;
            PG8_STAGE(PG8_SB(1, 1), b3 + hstep, voffB);
            PG8_WAIT_V(6); PG8_BAR; PG8_MMA(1, 1, At, B1); PG8_BAR;
        }
        PG8_STAMP();
        if constexpr (!Epi::AFTER_DRAIN) { E(acc, cur, wr, wc, fr, fq); S.done(cur); }
        PG8_STAMP();
        if (!has_next) break;
#pragma unroll
        for (int a = 0; a < 2; ++a)
#pragma unroll
            for (int b = 0; b < 2; ++b)
#pragma unroll
                for (int m = 0; m < 4; ++m)
#pragma unroll
                    for (int n = 0; n < 2; ++n) acc[a][b][m][n] = (f32x4){0.f, 0.f, 0.f, 0.f};
        cur = nxt; cA = nA; cB = nB; ++ui;
    }
    PG8_WAIT_V(0);
    if (wr == 0) PG8_BAR;
    PG8_BAR;
    if constexpr (Epi::AFTER_DRAIN) { E.fused(acc, cur, wr, wc, fr, fq, lds, wid, lane); S.done(cur); }
    PG8_STAMP();
    if (STAMP && wid == 0) { stamps[lane] = lane < nts ? (((unsigned long long)(unsigned)ts_hi << 32) | (unsigned)ts_lo) : 0ull;
        if (lane == 62) stamps[62] = rt_entry; if (lane == 63) stamps[63] = (unsigned long long)wall_clock64(); }
#undef PG8_STAMP
#undef PG8_SA
#undef PG8_SB
#undef PG8_STAGE
#undef PG8_LDA
#undef PG8_LDB
#undef PG8_MMA
#undef PG8_WAIT_V
#undef PG8_WAIT_L
#undef PG8_BAR
#undef PG8_SCHED
}
}
#define XB_TMO      128
#define XB_XCNT(j)  (256  + 64 * (j))
#define XB_XSUB(j)  (1280 + 64 * (j))
#define XB_XGEN(j)  (2304 + 64 * (j))
#define XB_TOP      3328
#define XB_TOPGEN   3392
#define XCD_BAR_WORDS 3456
#define XB_SPIN_CAP (1u << 18)
#define LAS __attribute__((address_space(3)))

__device__ __forceinline__ unsigned xb_ld(unsigned* p)              { return __hip_atomic_load(p, __ATOMIC_RELAXED, __HIP_MEMORY_SCOPE_AGENT); }
__device__ __forceinline__ unsigned xb_add(unsigned* p, unsigned v) { return __hip_atomic_fetch_add(p, v, __ATOMIC_RELAXED, __HIP_MEMORY_SCOPE_AGENT); }
__device__ __forceinline__ unsigned xb_xcc_id() { return (unsigned)__builtin_amdgcn_s_getreg((3 << 11) | 20) & 0xFu; }
#define XB_SPIN(cond, bar) do { unsigned _sp = 0; while (cond) { __builtin_amdgcn_s_sleep(1); \
    if ((++_sp & 255u) == 0u) { if (xb_ld(&(bar)[XB_TMO])) break; if (_sp > XB_SPIN_CAP) { atomicAdd(&(bar)[XB_TMO], 1u); break; } } } } while (0)

struct XcdBarrier {
    unsigned* bar; unsigned x;
    volatile LAS unsigned* st;
};

__device__ __forceinline__ XcdBarrier xcd_barrier_post(unsigned* bar, volatile LAS unsigned* st) {
    XcdBarrier b; b.bar = bar; b.x = xb_xcc_id(); b.st = st;
    if (threadIdx.x == 0) (void)xb_add(&bar[XB_XCNT(b.x)], 1u);
    return b;
}
__device__ __forceinline__ void xcd_barrier_complete(unsigned* bar, unsigned x, unsigned& nloc, unsigned& nx) {
    const unsigned G = gridDim.x * gridDim.y * gridDim.z;
    unsigned sum, cnt, mine, sp = 0u;
    for (;;) {
        sum = 0u; cnt = 0u; mine = 0u;
#pragma unroll
        for (unsigned j = 0; j < 16; ++j) { const unsigned c = xb_ld(&bar[XB_XCNT(j)]); sum += c; cnt += (c > 0u) ? 1u : 0u; mine = (j == x) ? c : mine; }
        if (sum == G) break;
        __builtin_amdgcn_s_sleep(1);
        if ((++sp & 255u) == 0u) { if (xb_ld(&bar[XB_TMO])) break; if (sp > XB_SPIN_CAP) { atomicAdd(&bar[XB_TMO], 1u); break; } }
    }
    nloc = mine > 0u ? mine : 1u; nx = cnt > 0u ? cnt : 1u;
}

__device__ __forceinline__ void xcd_barrier(const XcdBarrier& b) {
    asm volatile("s_waitcnt vmcnt(0)" ::: "memory");
    __syncthreads();
    if (threadIdx.x == 0) {
        unsigned* bar = b.bar;
        __builtin_amdgcn_s_waitcnt(0);
        unsigned nloc = b.st[0], nx = b.st[1];
        if (nloc == 0u) { xcd_barrier_complete(bar, b.x, nloc, nx); b.st[0] = nloc; b.st[1] = nx; }
        const unsigned old = xb_add(&bar[XB_XSUB(b.x)], 1u);
        const unsigned gen = old / nloc;
        if (old + 1u == (gen + 1u) * nloc) {
            __builtin_amdgcn_fence(__ATOMIC_RELEASE, "agent");
            asm volatile("s_waitcnt vmcnt(0)" ::: "memory");
            const unsigned og = xb_add(&bar[XB_TOP], 1u);
            const unsigned tg = og / nx;
            if (og + 1u == (tg + 1u) * nx) xb_add(&bar[XB_TOPGEN], 1u);
            else XB_SPIN(xb_ld(&bar[XB_TOPGEN]) == tg, bar);
            __builtin_amdgcn_fence(__ATOMIC_ACQUIRE, "agent");
            xb_add(&bar[XB_XGEN(b.x)], 1u);
            asm volatile("s_waitcnt vmcnt(0)" ::: "memory");
        } else {
            XB_SPIN(xb_ld(&bar[XB_XGEN(b.x)]) == gen, bar);
            __builtin_amdgcn_fence(__ATOMIC_ACQUIRE, "agent");
            asm volatile("s_waitcnt vmcnt(0)" ::: "memory");
        }
    }
    __syncthreads();
}
__host__ __device__ __forceinline__ int ikiw_src(int c) {
    if (c < 32) return 8192 + c;
    if (c < 40) return 8256 + (c - 32);
    if (c >= 128 && c < 160) return 8192 + 32 + (c - 128);
    return -1;
}
__host__ __device__ __forceinline__ int ik_tilecol(int e) { return e < 32 ? e : 128 + (e - 32); }
__device__ __forceinline__ int src_col(int mode, int n) {
    if (mode == 0) return n;
    if (mode == 1) { if (n < 8192) return n; if (n < 8448) return ikiw_src(n - 8192); return 8264 + (n - 8448); }
    const int pn = n >> 8, c = n & 255; return c < 128 ? pn * 128 + c : D_FF + pn * 128 + (c - 128);
}
__device__ __forceinline__ void prep_weight_tile(const float* __restrict__ w, int ldw, const float* __restrict__ scale, bf16_t* __restrict__ Wt, int K, int mode, int tile, float* lds  ) {
    const int ktiles = K / 64, nt = tile / ktiles, kt = tile % ktiles, tid = threadIdx.x & 255;
    const int n0 = nt * 64, k0 = kt * 64;
    {   const int nn = tid & 63, kk0 = tid >> 6; const int sc = src_col(mode, n0 + nn); float v[16];
#pragma unroll
        for (int i = 0; i < 16; ++i) { const int kk = kk0 + i * 4; v[i] = sc >= 0 ? w[(size_t)(k0 + kk) * ldw + sc] : 0.f; }
        if (scale) {
#pragma unroll
            for (int i = 0; i < 16; ++i) v[i] *= scale[k0 + kk0 + i * 4]; }
#pragma unroll
        for (int i = 0; i < 16; ++i) lds[(kk0 + i * 4) * 65 + nn] = v[i]; }
    __syncthreads();
    {   const int kp = tid & 31, nn0 = tid >> 5;
#pragma unroll
        for (int i = 0; i < 8; ++i) { const int nn = nn0 + i * 8; ((unsigned*)(Wt + (size_t)(n0 + nn) * K + k0))[kp] = (unsigned)f2bf(lds[(2 * kp) * 65 + nn]) | ((unsigned)f2bf(lds[(2 * kp + 1) * 65 + nn]) << 16); } }
    __syncthreads();
}
__device__ __forceinline__ const float* h_row_ptr(int r, const float* xp, const float* xs, const float* meta) {
    if (r < T_PROMPT) { const int b = r / LP, l = r % LP; return l < N_META ? meta + (size_t)l * D_MODEL : xp + ((size_t)b * SEQ + (l - N_META)) * D_MODEL; }
    return xs + (size_t)(r - T_PROMPT) * D_MODEL;
}
__device__ __forceinline__ void prep_row(int r, const float* xp, const float* xs, const float* meta, bf16_t* A0, float* rstd0, int lane) {
    if (r >= T_ALL) { for (int i = lane; i < D_MODEL / 2; i += 64) ((unsigned*)(A0 + (size_t)r * D_MODEL))[i] = 0u; if (lane == 0) rstd0[r] = 0.f; return; }
    const float4* src = (const float4*)h_row_ptr(r, xp, xs, meta); float ss = 0.f;
#pragma unroll
    for (int i = 0; i < 4; ++i) { const float4 v = src[lane + i * 64]; ss += v.x * v.x + v.y * v.y + v.z * v.z + v.w * v.w;
        uint2 o; o.x = (unsigned)f2bf(v.x) | ((unsigned)f2bf(v.y) << 16); o.y = (unsigned)f2bf(v.z) | ((unsigned)f2bf(v.w) << 16);
        ((uint2*)(A0 + (size_t)r * D_MODEL))[lane + i * 64] = o; }
#pragma unroll
    for (int o = 32; o >= 1; o >>= 1) ss += __shfl_xor(ss, o);
    if (lane == 0) rstd0[r] = rsqrtf(ss * (1.0f / D_MODEL) + NORM_EPS);
}
__device__ __forceinline__ void rope_entry(int idx, float2* tab) {
    const int pos = idx >> 7, i = idx & 127;
    const float inv = exp2f(-(float)i * (13.287712379549449f / 128.0f));
    const float angf = (float)pos * inv; const double a = (double)angf;
    const double kq = rint(a * 0.63661977236758134308);
    double r = fma(-kq, 1.57079632679489655800e+00, a); r = fma(-kq, 6.12323399573676603587e-17, r);
    const double r2 = r * r;
    const double sp = r * (1.0 + r2 * (-1.0 / 6 + r2 * (1.0 / 120 + r2 * (-1.0 / 5040 + r2 * (1.0 / 362880 + r2 * (-1.0 / 39916800 + r2 * (1.0 / 6227020800.0)))))));
    const double cp = 1.0 + r2 * (-0.5 + r2 * (1.0 / 24 + r2 * (-1.0 / 720 + r2 * (1.0 / 40320 + r2 * (-1.0 / 3628800 + r2 * (1.0 / 479001600 + r2 * (-1.0 / 87178291200.0)))))));
    const int q = ((int)kq) & 3;
    const double sv = (q == 0) ? sp : (q == 1) ? cp : (q == 2) ? -sp : -cp;
    const double cv = (q == 0) ? cp : (q == 1) ? -sp : (q == 2) ? -cp : sp;
    tab[idx] = make_float2((float)cv, (float)sv);
}

struct PrepArgs {
    const float *x_prompt, *x_sample, *meta, *norm_mix_w, *w_in, *w_ret, *w_dsa, *w_out, *norm_ffn_w, *w_ffi, *w_ffo;
    bf16_t *W1t, *Wret, *Wdsa, *Wout, *Wffi, *Wffo, *A0; float* rstd0; float2* rope;
};
#define PREP_J_W1   0
#define PREP_N_W1   ((N1 / 64) * (1024 / 64))
#define PREP_J_WRET (PREP_J_W1 + PREP_N_W1)
#define PREP_N_WRET ((1024 / 64) * (2048 / 64))
#define PREP_J_WDSA (PREP_J_WRET + PREP_N_WRET)
#define PREP_N_WDSA ((1024 / 64) * (1024 / 64))
#define PREP_J_WOUT (PREP_J_WDSA + PREP_N_WDSA)
#define PREP_N_WOUT ((1024 / 64) * (1024 / 64))
#define PREP_J_WFFI (PREP_J_WOUT + PREP_N_WOUT)
#define PREP_N_WFFI ((NFF2 / 64) * (1024 / 64))
#define PREP_J_WFFO (PREP_J_WFFI + PREP_N_WFFI)
#define PREP_N_WFFO ((1024 / 64) * (2816 / 64))
#define PREP_J_ROWS (PREP_J_WFFO + PREP_N_WFFO)
#define PREP_N_ROWS (T_PAD / 4)
#define PREP_J_ROPE (PREP_J_ROWS + PREP_N_ROWS)
#define PREP_N_ROPE ((LP * 128) / 256)
#define PREP_N_JOBS (PREP_J_ROPE + PREP_N_ROPE)
__device__ __forceinline__ void prep_job(const PrepArgs& a, int job, float* lds) {
    if (job < PREP_J_WRET)      prep_weight_tile(a.w_in, IN_COLS, a.norm_mix_w, a.W1t, 1024, 1, job - PREP_J_W1, lds);
    else if (job < PREP_J_WDSA) prep_weight_tile(a.w_ret, 1024, nullptr, a.Wret, 2048, 0, job - PREP_J_WRET, lds);
    else if (job < PREP_J_WOUT) prep_weight_tile(a.w_dsa, 1024, nullptr, a.Wdsa, 1024, 0, job - PREP_J_WDSA, lds);
    else if (job < PREP_J_WFFI) prep_weight_tile(a.w_out, 1024, nullptr, a.Wout, 1024, 0, job - PREP_J_WOUT, lds);
    else if (job < PREP_J_WFFO) prep_weight_tile(a.w_ffi, 2 * D_FF, a.norm_ffn_w, a.Wffi, 1024, 2, job - PREP_J_WFFI, lds);
    else if (job < PREP_J_ROWS) prep_weight_tile(a.w_ffo, 1024, nullptr, a.Wffo, 2816, 0, job - PREP_J_WFFO, lds);
    else if (job < PREP_J_ROPE) prep_row((job - PREP_J_ROWS) * 4 + ((threadIdx.x & 255) >> 6), a.x_prompt, a.x_sample, a.meta, a.A0, a.rstd0, threadIdx.x & 63);
    else rope_entry((job - PREP_J_ROPE) * 256 + (threadIdx.x & 255), a.rope);
}
namespace att {
using bf16x8 = __attribute__((ext_vector_type(8))) short;
using s16x4  = __attribute__((ext_vector_type(4))) short;
using f32x16 = __attribute__((ext_vector_type(16))) float;
using f32x8  = __attribute__((ext_vector_type(8))) float;
using u32x4  = __attribute__((ext_vector_type(4))) unsigned;
constexpr float SCALE = 0.088388347648318440f;
constexpr float THR = 8.f;
constexpr float NEG = -3.0e38f;
constexpr int SHM_V = 64 * 128 * 2, SHM_K = 64 * 128 * 2;
#define ATT_KSWZ(row, colB) ((row) * 256 + ((colB) ^ (((row) & 7) << 4)))
#define ATT_SBAR() __builtin_amdgcn_sched_barrier(0)
__device__ __forceinline__ int crow(int r, int hi) { return (r & 3) + 8 * (r >> 2) + 4 * hi; }
__device__ __forceinline__ unsigned cvtpk(float lo, float hi) { return pg8::cvt_pk_bf16(lo, hi); }
__device__ __forceinline__ bf16x8 tobf(f32x8 x) { u32x4 w = {cvtpk(x[0], x[1]), cvtpk(x[2], x[3]), cvtpk(x[4], x[5]), cvtpk(x[6], x[7])}; return *reinterpret_cast<bf16x8*>(&w); }
__device__ __forceinline__ bf16x8 tobf(bf16x8 x) { return x; }

__device__ __forceinline__ void apply_mask(f32x16& p0, f32x16& p1, u64 mk, int hi) {
    const unsigned lo = (unsigned)mk >> (4 * hi), hw = (unsigned)(mk >> 32) >> (4 * hi);
#pragma unroll
    for (int r = 0; r < 16; ++r) { const unsigned bit = 1u << ((r & 3) + 8 * (r >> 2)); p0[r] = (lo & bit) ? p0[r] : NEG; p1[r] = (hw & bit) ? p1[r] : NEG; }
}
__device__ __forceinline__ void partialSM(f32x16& p0, f32x16& p1, float& m_reg, float& mn, float& alpha) {
    constexpr float C = SCALE * 1.4426950408889634f;
    float pmax = p0[0];
#pragma unroll
    for (int r = 1; r < 16; ++r) pmax = fmaxf(pmax, p0[r]);
#pragma unroll
    for (int r = 0; r < 16; ++r) pmax = fmaxf(pmax, p1[r]);
    { auto rr = __builtin_amdgcn_permlane32_swap(__float_as_uint(pmax), __float_as_uint(pmax), false, false);
      pmax = fmaxf(__uint_as_float(rr[0]), __uint_as_float(rr[1])); }
    if (__builtin_expect(__all(pmax - m_reg <= THR / SCALE), 1)) { mn = m_reg; alpha = 1.f; }
    else { mn = fmaxf(m_reg, pmax); alpha = __builtin_amdgcn_exp2f((m_reg - mn) * C); m_reg = mn; }
    const float mnC = -mn * C;
#pragma unroll
    for (int r = 0; r < 16; ++r) p0[r] = fmaf(p0[r], C, mnC);
#pragma unroll
    for (int r = 0; r < 16; ++r) p1[r] = fmaf(p1[r], C, mnC);
#pragma unroll
    for (int r = 0; r < 16; ++r) p0[r] = __builtin_amdgcn_exp2f(p0[r]);
}
__device__ __forceinline__ void finishSM(f32x16& p0, f32x16& p1, float alpha, float& l_reg, bf16x8& pa0, bf16x8& pa1, bf16x8& pa2, bf16x8& pa3) {
#pragma unroll
    for (int r = 0; r < 16; ++r) p1[r] = __builtin_amdgcn_exp2f(p1[r]);
    float ps = 0;
#pragma unroll
    for (int r = 0; r < 16; ++r) ps += p0[r];
#pragma unroll
    for (int r = 0; r < 16; ++r) ps += p1[r];
    { auto rr = __builtin_amdgcn_permlane32_swap(__float_as_uint(ps), __float_as_uint(ps), false, false);
      ps = __uint_as_float(rr[0]) + __uint_as_float(rr[1]); }
    l_reg = l_reg * alpha + ps;
#define ATT_PK4(P, BASE, OUT) do { unsigned a0 = cvtpk(P[BASE + 0], P[BASE + 1]), a1 = cvtpk(P[BASE + 2], P[BASE + 3]);   \
    unsigned b0 = cvtpk(P[BASE + 4], P[BASE + 5]), b1 = cvtpk(P[BASE + 6], P[BASE + 7]);                              \
    auto r0 = __builtin_amdgcn_permlane32_swap(a0, b0, false, false); auto r1 = __builtin_amdgcn_permlane32_swap(a1, b1, false, false); \
    u32x4 w = {r0[0], r1[0], r0[1], r1[1]}; OUT = *reinterpret_cast<bf16x8*>(&w); } while (0)
    ATT_PK4(p0, 0, pa0); ATT_PK4(p0, 8, pa1); ATT_PK4(p1, 0, pa2); ATT_PK4(p1, 8, pa3);
#undef ATT_PK4
}
__device__ __forceinline__ void qkt(f32x16& p0, f32x16& p1, const char* Ks, const bf16x8* qr, int r32, int hi) {
    p0 = f32x16{}; p1 = f32x16{};
#pragma unroll
    for (int d0 = 0; d0 < 8; ++d0) { const int cb = (d0 * 16 + hi * 8) * 2;
        const bf16x8 b0 = *reinterpret_cast<const bf16x8*>(Ks + ATT_KSWZ(r32, cb));
        const bf16x8 b1 = *reinterpret_cast<const bf16x8*>(Ks + ATT_KSWZ(32 + r32, cb));
        p0 = __builtin_amdgcn_mfma_f32_32x32x16_bf16(b0, qr[d0], p0, 0, 0, 0);
        p1 = __builtin_amdgcn_mfma_f32_32x32x16_bf16(b1, qr[d0], p1, 0, 0, 0); }
}
__device__ __forceinline__ int v_st(int k, int c) { const int kk = (k & ~0xC) | ((k & 4) << 1) | ((k & 8) >> 1); return ((kk >> 3) * 4 + (c >> 5)) * 512 + ((kk & 7) * 32 + (c & 31)) * 2; }
__device__ __forceinline__ int v_rd_base(int lane) { return ((lane & 3) << 3) | (((lane >> 2) & 3) << 6) | (((lane >> 4) & 1) << 5) | (((lane >> 5) & 1) << 8); }
constexpr int v_rd_off(int d0, int ks, int half) { return d0 * 512 + ks * 4096 + half * 2048; }
template <int OFF> __device__ __forceinline__ s16x4 tr_read(int vb) { s16x4 r; asm volatile("ds_read_b64_tr_b16 %0, %1 offset:%2" : "=&v"(r) : "v"(vb), "i"(OFF) : "memory"); return r; }
template <int D0> __device__ __forceinline__ void pv_one(f32x16& od, int vb, bf16x8 pa0, bf16x8 pa1, bf16x8 pa2, bf16x8 pa3) {
    const s16x4 l0 = tr_read<v_rd_off(D0, 0, 0)>(vb), h0 = tr_read<v_rd_off(D0, 0, 1)>(vb), l1 = tr_read<v_rd_off(D0, 1, 0)>(vb), h1 = tr_read<v_rd_off(D0, 1, 1)>(vb);
    const s16x4 l2 = tr_read<v_rd_off(D0, 2, 0)>(vb), h2 = tr_read<v_rd_off(D0, 2, 1)>(vb), l3 = tr_read<v_rd_off(D0, 3, 0)>(vb), h3 = tr_read<v_rd_off(D0, 3, 1)>(vb);
    asm volatile("s_waitcnt lgkmcnt(0)" ::: "memory"); ATT_SBAR();
#define ATT_PK(L, H) (bf16x8){L[0], L[1], L[2], L[3], H[0], H[1], H[2], H[3]}
    od = __builtin_amdgcn_mfma_f32_32x32x16_bf16(pa0, ATT_PK(l0, h0), od, 0, 0, 0);
    od = __builtin_amdgcn_mfma_f32_32x32x16_bf16(pa1, ATT_PK(l1, h1), od, 0, 0, 0);
    od = __builtin_amdgcn_mfma_f32_32x32x16_bf16(pa2, ATT_PK(l2, h2), od, 0, 0, 0);
    od = __builtin_amdgcn_mfma_f32_32x32x16_bf16(pa3, ATT_PK(l3, h3), od, 0, 0, 0);
#undef ATT_PK
}
__device__ __forceinline__ void pv_d0(f32x16* o, int vb, bf16x8 pa0, bf16x8 pa1, bf16x8 pa2, bf16x8 pa3) {
    pv_one<0>(o[0], vb, pa0, pa1, pa2, pa3); pv_one<1>(o[1], vb, pa0, pa1, pa2, pa3); pv_one<2>(o[2], vb, pa0, pa1, pa2, pa3); pv_one<3>(o[3], vb, pa0, pa1, pa2, pa3);
}

struct KvPrompt {
    using T = bf16x8; const bf16_t* K; const bf16_t* V;
    __device__ __forceinline__ T ldk(int key, int col) const { return *reinterpret_cast<const bf16x8*>(K + (size_t)key * 256 + col); }
    __device__ __forceinline__ T ldv(int key, int col) const { return *reinterpret_cast<const bf16x8*>(V + (size_t)key * 256 + col); }
};
struct KvSample {
    using T = f32x8; const float* ck; const float* cv; const float* kn; const float* vn; const int* pages  ; int n;
    __device__ __forceinline__ size_t roff(int key) const { return (((size_t)pages[key >> 7] * PAGE_SIZE + (key & 127)) * N_KV + n) * 128; }
    __device__ __forceinline__ T ldk(int key, int col) const { const float* p = key < PAST_LEN ? ck + roff(key) : kn + (size_t)min(key - PAST_LEN, DEC_SEQ - 1) * 256; return *reinterpret_cast<const f32x8*>(p + col); }
    __device__ __forceinline__ T ldv(int key, int col) const { const float* p = key < PAST_LEN ? cv + roff(key) : vn + (size_t)min(key - PAST_LEN, DEC_SEQ - 1) * 256; return *reinterpret_cast<const f32x8*>(p + col); }
};

template <class KV>
__device__ __forceinline__ void attn_unit(const KV kv, const bf16_t* __restrict__ Aq, const float* __restrict__ qnw, const u64* __restrict__ mask, bf16_t* __restrict__ Odsa, int tok0, int nq_valid, int hd0, int NT, char* lds) {
    int tid_l = threadIdx.x; asm volatile("" : "+v"(tid_l));
    const int tid = tid_l, wid = tid >> 6, lane = tid & 63, r32 = lane & 31, hi = lane >> 5;
    char* V_lds = lds; char* K_lds = lds + 2 * SHM_V;
    float* wsx = (float*)(lds + 2 * SHM_V + 2 * SHM_K) + wid * 64; float* li_l = wsx; float* al_l = wsx + 32;
    float m_reg = -1e30f, l_reg = 0; f32x16 o[4] = {}; bf16x8 qr[8];
    const int mytok = tok0 + 8 * wid + (r32 >> 2);
    { const bf16_t* Qw = Aq + (size_t)mytok * 1024 + (hd0 + (r32 & 3)) * 128 + hi * 8;
#pragma unroll
      for (int d0 = 0; d0 < 8; ++d0) qr[d0] = *reinterpret_cast<const bf16x8*>(Qw + d0 * 16);
      float ssq = 0.f;
#pragma unroll
      for (int d0 = 0; d0 < 8; ++d0) { const u32x4 w = *reinterpret_cast<const u32x4*>(&qr[d0]);
#pragma unroll
          for (int j = 0; j < 4; ++j) { const float lo = __uint_as_float(w[j] << 16), hh = __uint_as_float(w[j] & 0xffff0000u); ssq += lo * lo + hh * hh; } }
      ssq += __shfl_xor(ssq, 32);
      const float rn = rsqrtf(ssq * (1.0f / 128.0f) + NORM_EPS);
#pragma unroll
      for (int d0 = 0; d0 < 8; ++d0) { const u32x4 w = *reinterpret_cast<const u32x4*>(&qr[d0]); const float4 g0 = *(const float4*)(qnw + d0 * 16 + hi * 8), g1 = *(const float4*)(qnw + d0 * 16 + hi * 8 + 4);
          u32x4 o; o[0] = cvtpk(__uint_as_float(w[0] << 16) * rn * g0.x, __uint_as_float(w[0] & 0xffff0000u) * rn * g0.y); o[1] = cvtpk(__uint_as_float(w[1] << 16) * rn * g0.z, __uint_as_float(w[1] & 0xffff0000u) * rn * g0.w);
          o[2] = cvtpk(__uint_as_float(w[2] << 16) * rn * g1.x, __uint_as_float(w[2] & 0xffff0000u) * rn * g1.y); o[3] = cvtpk(__uint_as_float(w[3] << 16) * rn * g1.z, __uint_as_float(w[3] & 0xffff0000u) * rn * g1.w);
          qr[d0] = *reinterpret_cast<const bf16x8*>(&o); } }
    const u64* mrow = mask + (size_t)mytok * MASK_WORDS;
    const int sr = tid >> 4, sc = (tid & 15) * 8, vst0 = v_st(sr, sc), vst1 = v_st(32 + sr, sc);
    const int vbase = (int)(uintptr_t)(PG8_LAS char*)V_lds + v_rd_base(lane);
    typename KV::T vs0, vs1, ks0, ks1;
#define ATT_SLOAD(k0) do { vs0 = kv.ldv((k0) + sr, sc); vs1 = kv.ldv((k0) + 32 + sr, sc); ks0 = kv.ldk((k0) + sr, sc); ks1 = kv.ldk((k0) + 32 + sr, sc); } while (0)
#define ATT_SWRITE(b) do { *(bf16x8*)(V_lds + (b) * SHM_V + vst0) = tobf(vs0); *(bf16x8*)(V_lds + (b) * SHM_V + vst1) = tobf(vs1); const int kc = sc * 2; \
    *(bf16x8*)(K_lds + (b) * SHM_K + ATT_KSWZ(sr, kc)) = tobf(ks0); *(bf16x8*)(K_lds + (b) * SHM_K + ATT_KSWZ(32 + sr, kc)) = tobf(ks1); } while (0)
    __syncthreads();
    ATT_SLOAD(0); ATT_SWRITE(0); __syncthreads();
    u64 mk_next = mrow[0];
    for (int j = 0; j < NT; ++j) {
        const int b = j & 1;
        const u64 mk = mk_next; mk_next = mrow[j + 1 < NT ? j + 1 : j];
        if (j + 1 < NT) ATT_SLOAD((j + 1) * 64);
        f32x16 p0, p1; float mn, alpha; bf16x8 pa0, pa1, pa2, pa3;
        ATT_SBAR(); qkt(p0, p1, K_lds + b * SHM_K, qr, r32, hi); apply_mask(p0, p1, mk, hi);
        partialSM(p0, p1, m_reg, mn, alpha);
        if (__any(alpha < 1.f)) { if (hi == 0) al_l[r32] = alpha; asm volatile("s_waitcnt lgkmcnt(0)" ::: "memory");
#pragma unroll
            for (int d = 0; d < 4; ++d)
#pragma unroll
                for (int r = 0; r < 16; ++r) o[d][r] *= al_l[crow(r, hi)]; }
        finishSM(p0, p1, alpha, l_reg, pa0, pa1, pa2, pa3); ATT_SBAR();
        pv_d0(o, vbase + b * SHM_V, pa0, pa1, pa2, pa3);
        if (j + 1 < NT) ATT_SWRITE(b ^ 1);
        __syncthreads();
    }
    if (hi == 0) li_l[r32] = l_reg; asm volatile("s_waitcnt lgkmcnt(0)" ::: "memory");
#pragma unroll
    for (int r = 0; r < 16; ++r) { const int orow = crow(r, hi); const float rli = __builtin_amdgcn_rcpf(li_l[orow]);
        const int q = 8 * wid + (orow >> 2);
        if (q < nq_valid) { bf16_t* Ow = Odsa + (size_t)(tok0 + q) * 1024 + (hd0 + (orow & 3)) * 128 + r32;
#pragma unroll
            for (int d0 = 0; d0 < 4; ++d0) Ow[d0 * 32] = f2bf(o[d0][r] * rli); } }
#undef ATT_SLOAD
#undef ATT_SWRITE
}
}
namespace idx {
using bf16x8 = __attribute__((ext_vector_type(8))) short;
using f32x16 = __attribute__((ext_vector_type(16))) float;
using f32x8  = __attribute__((ext_vector_type(8))) float;
constexpr int NTILE = 65;
constexpr int WAVE_LDS = NTILE * 64 * 4;
__device__ __forceinline__ unsigned ord_of(float f) { const unsigned u = __float_as_uint(f); return (u & 0x80000000u) ? ~u : (u | 0x80000000u); }
__device__ __forceinline__ int half_sum(int v) {
    v += __builtin_amdgcn_mov_dpp(v, 0xB1, 0xF, 0xF, true);
    v += __builtin_amdgcn_mov_dpp(v, 0x4E, 0xF, 0xF, true);
    v += __builtin_amdgcn_mov_dpp(v, 0x141, 0xF, 0xF, true);
    v += __builtin_amdgcn_mov_dpp(v, 0x140, 0xF, 0xF, true);
    v += __shfl_xor(v, 16);
    return v;
}
template <bool SAMPLE> struct KeySrc {
    const bf16_t* ikb; const float* ck; int pgv;
    struct Raw { f32x8 f[SAMPLE ? 4 : 1]; bf16x8 h[SAMPLE ? 1 : 4]; };
    __device__ __forceinline__ void load(int t, int c, int hi, Raw& R) const {
        if constexpr (!SAMPLE) { const bf16_t* p = ikb + (size_t)(32 * t + c) * 64 + hi * 8;
#pragma unroll
            for (int s = 0; s < 4; ++s) R.h[s] = *reinterpret_cast<const bf16x8*>(p + 16 * s); }
        else { const int tc = t < 64 ? t : 63; const int page = __builtin_amdgcn_readlane(pgv, tc >> 2);
            const float* p = ck + ((size_t)page * PAGE_SIZE + ((32 * tc) & 127) + c) * 64 + hi * 8;
            if (t >= 64) {
                const bf16_t* q = ikb + (size_t)(c < DEC_SEQ ? c : DEC_SEQ - 1) * 64 + hi * 8;
#pragma unroll
                for (int s = 0; s < 4; ++s) { const att::u32x4 w = *reinterpret_cast<const att::u32x4*>(q + 16 * s);
#pragma unroll
                    for (int e = 0; e < 4; ++e) { R.f[s][2 * e] = __uint_as_float(w[e] << 16); R.f[s][2 * e + 1] = __uint_as_float(w[e] & 0xffff0000u); } } }
            else {
#pragma unroll
                for (int s = 0; s < 4; ++s) R.f[s] = *reinterpret_cast<const f32x8*>(p + 16 * s); } }
    }
    __device__ __forceinline__ void cvt(const Raw& R, bf16x8 (&B)[4]) const {
#pragma unroll
        for (int s = 0; s < 4; ++s) { if constexpr (SAMPLE) B[s] = att::tobf(R.f[s]); else B[s] = R.h[s]; }
    }
};
template <int A_> __device__ __forceinline__ float head_sum(const f32x16& acc, const float (&w)[8]) {
    float s = 0.f;
#pragma unroll
    for (int h = 0; h < 8; ++h) s = fmaf(w[h], fmaxf(acc[8 * A_ + h], 0.f), s);
    return s;
}
template <bool SAMPLE, int A_>
__device__ __forceinline__ void pass(const KeySrc<SAMPLE>& ks, const bf16x8 (&A)[4], const float* Iw, int tokbase, int pos0, int nvalid, int ntiles, unsigned* strip, unsigned* mask32, int lane) {
    const int c = lane & 31, hi = lane >> 5, myq = 2 * hi + A_, mypos = pos0 + myq; const bool qvalid = myq < nvalid;
    float w[8];
    { const float* wp = Iw + (size_t)(tokbase + (qvalid ? myq : nvalid - 1)) * 8;
#pragma unroll
      for (int h = 0; h < 8; ++h) w[h] = wp[h]; }
    typename KeySrc<SAMPLE>::Raw R0, R1, R2, R3; bf16x8 B[4];
    ks.load(0, c, hi, R0); if (1 < ntiles) ks.load(1, c, hi, R1); if (2 < ntiles) ks.load(2, c, hi, R2); if (3 < ntiles) ks.load(3, c, hi, R3);
#define IDX_TILE(t_, R_) do { ks.cvt(R_, B); if ((t_) + 4 < ntiles) ks.load((t_) + 4, c, hi, R_); f32x16 acc = {}; \
        _Pragma("unroll") for (int s_ = 0; s_ < 4; ++s_) acc = __builtin_amdgcn_mfma_f32_32x32x16_bf16(A[s_], B[s_], acc, 0, 0, 0); \
        const float sc_ = head_sum<A_>(acc, w); strip[(t_) * 64 + lane] = (32 * (t_) + c <= mypos) ? ord_of(sc_) : 0u; } while (0)
    for (int t = 0; t < ntiles; t += 4) { IDX_TILE(t, R0); if (t + 1 < ntiles) IDX_TILE(t + 1, R1); if (t + 2 < ntiles) IDX_TILE(t + 2, R2); if (t + 3 < ntiles) IDX_TILE(t + 3, R3); }
#undef IDX_TILE
    unsigned x[NTILE];
#pragma unroll
    for (int t = 0; t < NTILE; ++t) x[t] = (t < ntiles) ? strip[t * 64 + lane] : 0u;
    unsigned tau = 0u; int r_ties = 0;
    if (__any(mypos + 1 > TOPK)) {
        unsigned* hist = strip + hi * 320;
        unsigned prefix = 0u; int need = TOPK;
#pragma unroll 1
        for (int ps = 0; ps < 4; ++ps) {
            const int sh = 24 - 8 * ps;
#pragma unroll
            for (int k = 0; k < 9; ++k) hist[c + 32 * k] = 0u;
#pragma unroll
            for (int t = 0; t < NTILE; ++t) { const unsigned xv = x[t]; const bool match = xv != 0u && (ps == 0 || (xv >> (sh + 8)) == prefix);
                atomicAdd(&hist[match ? ((xv >> sh) & 255u) : (256u + (unsigned)c)], 1u); }
            unsigned h[8]; unsigned sum = 0;
#pragma unroll
            for (int k = 0; k < 8; ++k) { h[k] = hist[8 * c + k]; sum += h[k]; }
            int sfx = (int)sum;
#pragma unroll
            for (int d = 1; d < 32; d <<= 1) { const int tt = __shfl_down(sfx, d, 32); if (c + d < 32) sfx += tt; }
            const u64 bm = __ballot(sfx >= need); const unsigned mh = hi ? (unsigned)(bm >> 32) : (unsigned)bm;
            const int lc = mh ? 31 - __clz((int)mh) : 0;
            const int above = __shfl(sfx, lc < 31 ? lc + 1 : 31, 32);
            const int need2 = need - (lc < 31 ? above : 0);
            int bsel = 0, nsel = need2, cacc = 0; bool found = false;
#pragma unroll
            for (int k = 7; k >= 0; --k) { if (!found && cacc + (int)h[k] >= need2) { bsel = 8 * c + k; nsel = need2 - cacc; found = true; } cacc += (int)h[k]; }
            bsel = __shfl(bsel, lc, 32); need = __shfl(nsel, lc, 32);
            prefix = (prefix << 8) | (unsigned)bsel;
        }
        tau = prefix; r_ties = need;
    }
    if (mypos + 1 <= TOPK) { tau = 0u; r_ties = 0; }
    int eq_before = 0; unsigned* mrow = mask32 + (size_t)(tokbase + myq) * (2 * MASK_WORDS);
#pragma unroll
    for (int t = 0; t < NTILE; ++t) {
        const bool eq = x[t] == tau, gt = x[t] > tau;
        const u64 eqm = __ballot(eq); const unsigned my_eqm = hi ? (unsigned)(eqm >> 32) : (unsigned)eqm;
        const int rank = eq_before + __popc(my_eqm & ((1u << c) - 1u));
        const bool sel = gt || (eq && rank < r_ties);
        eq_before += __popc(my_eqm);
        const u64 sm = __ballot(sel); const unsigned my_sm = hi ? (unsigned)(sm >> 32) : (unsigned)sm;
        if (c == 0 && qvalid) mrow[t] = my_sm;
    }
    if (c < 2 * MASK_WORDS - NTILE && qvalid) mrow[NTILE + c] = 0u;
}
template <bool SAMPLE>
__device__ __forceinline__ void wave_task(const KeySrc<SAMPLE>& ks, const bf16_t* Iq, const float* Iw, int tokbase, int pos0, int nvalid, unsigned* strip, unsigned* mask32, int lane) {
    const int c = lane & 31, hi = lane >> 5;
    const int aq_ = 2 * ((c >> 2) & 1) + (c >> 4), ah = 4 * ((c >> 3) & 1) + (c & 3);
    bf16x8 A[4];
    { const bf16_t* ap = Iq + (size_t)(tokbase + (aq_ < nvalid ? aq_ : nvalid - 1)) * 512 + ah * 64 + hi * 8;
#pragma unroll
      for (int s = 0; s < 4; ++s) A[s] = *reinterpret_cast<const bf16x8*>(ap + 16 * s); }
    const int pmax = pos0 + nvalid - 1; int ntiles = (pmax + 32) >> 5; if (ntiles > NTILE) ntiles = NTILE;
    pass<SAMPLE, 0>(ks, A, Iw, tokbase, pos0, nvalid, ntiles, strip, mask32, lane);
    pass<SAMPLE, 1>(ks, A, Iw, tokbase, pos0, nvalid, ntiles, strip, mask32, lane);
}
}
struct MegaArgs {
    PrepArgs prep;
    const float *cache_k, *cache_v, *cache_kidx, *state_ret; const int* page_table;
    const float *qnw, *knw, *ikw, *ikb;
    bf16_t *Rq, *Rk, *Rv, *G, *Aq, *Kb, *Vb, *Iq, *Ikb, *Gates, *OG, *An, *Odsa, *Mg, *A2, *Hid;
    float *Iw, *ssret, *rstd2, *Z, *M1, *M2, *H2, *Zf, *out;
    u64* mask; unsigned* bar;
};

namespace ret {
using bf16x8 = __attribute__((ext_vector_type(8))) short;
using s16x4  = __attribute__((ext_vector_type(4))) short;
using f32x4  = __attribute__((ext_vector_type(4))) float;
using u32x4  = __attribute__((ext_vector_type(4))) unsigned;
using u32x2  = __attribute__((ext_vector_type(2))) unsigned;
constexpr int QS = 528, VS = 144, PS = 80;
constexpr int OFF_Q = 0, OFF_K = OFF_Q + 32 * QS, OFF_V = OFF_K + 32 * QS, OFF_P = OFF_V + 32 * VS, OFF_ST = OFF_P + 32 * PS, OFF_SS = OFF_ST + 64 * QS, LDS_BYTES = OFF_SS + 32 * 4 * 4;
__device__ __forceinline__ s16x4 trr(int addr) { s16x4 r; asm volatile("ds_read_b64_tr_b16 %0, %1" : "=&v"(r) : "v"(addr) : "memory"); return r; }
__device__ __forceinline__ bf16x8 cat(s16x4 l, s16x4 h) { return (bf16x8){l[0], l[1], l[2], l[3], h[0], h[1], h[2], h[3]}; }
__device__ __forceinline__ u32x4 scale8(u32x4 v, float f) {
    u32x4 o;
#pragma unroll
    for (int i = 0; i < 4; ++i) o[i] = att::cvtpk(__uint_as_float(v[i] << 16) * f, __uint_as_float(v[i] & 0xffff0000u) * f);
    return o;
}
__device__ __forceinline__ void unit(const MegaArgs& a, int unit8, char* lds) {
    int tid_l = threadIdx.x; asm volatile("" : "+v"(tid_l));
    const int tid = tid_l, w = __builtin_amdgcn_readfirstlane(tid >> 6), lane = tid & 63, g = lane >> 4, c15 = lane & 15, q4 = c15 >> 2, p4 = c15 & 3;
    const int bh = unit8 >> 3, sl = unit8 & 7, b = bh >> 2, h = bh & 3;
    const int ldsb = (int)(uintptr_t)(PG8_LAS char*)lds;
    const float lg2 = log2f(1.0f - exp2f(-5.0f - (float)h));
    const int st_tok = tid >> 4, st_seg = tid & 15;
    const float fq = exp2f(lg2 * (float)(st_tok + 1)), fk = exp2f(-lg2 * (float)(st_tok + 1));
    f32x4 S[2][4];
#pragma unroll
    for (int i = 0; i < 2; ++i)
#pragma unroll
        for (int u = 0; u < 4; ++u) S[i][u] = (f32x4){0.f, 0.f, 0.f, 0.f};
    u32x4 rq0, rq1, rk0, rk1; u32x2 rv;
#define RET_LOAD(tok0_, len_) do { const bool ok_ = st_tok < (len_); const size_t r_ = (size_t)((tok0_) + (ok_ ? st_tok : 0)); \
        const u32x4* qp_ = (const u32x4*)(a.Rq + r_ * 1024 + h * 256 + st_seg * 16); const u32x4* kp_ = (const u32x4*)(a.Rk + r_ * 1024 + h * 256 + st_seg * 16); \
        rq0 = qp_[0]; rq1 = qp_[1]; rk0 = kp_[0]; rk1 = kp_[1]; rv = *(const u32x2*)(a.Rv + r_ * 2048 + h * 512 + sl * 64 + st_seg * 4); \
        if (!ok_) { rq0 = rq1 = rk0 = rk1 = (u32x4){0u, 0u, 0u, 0u}; rv = (u32x2){0u, 0u}; } } while (0)
    const int row0 = b * LP;
    RET_LOAD(row0, 16);
    __syncthreads();
    for (int c = 0; c < 65; ++c) {
        const int len = c == 0 ? 16 : 32, tok0 = c == 0 ? row0 : row0 + 16 + 32 * (c - 1);
        *(u32x4*)(lds + OFF_Q + st_tok * QS + st_seg * 32) = scale8(rq0, fq); *(u32x4*)(lds + OFF_Q + st_tok * QS + st_seg * 32 + 16) = scale8(rq1, fq);
        *(u32x4*)(lds + OFF_K + st_tok * QS + st_seg * 32) = scale8(rk0, fk); *(u32x4*)(lds + OFF_K + st_tok * QS + st_seg * 32 + 16) = scale8(rk1, fk);
        *(u32x2*)(lds + OFF_V + st_tok * VS + st_seg * 8) = rv;
#pragma unroll
        for (int i = 0; i < 2; ++i)
#pragma unroll
            for (int u = 0; u < 4; ++u) { u32x2 pk; pk.x = att::cvtpk(S[i][u][0], S[i][u][1]); pk.y = att::cvtpk(S[i][u][2], S[i][u][3]);
                *(u32x2*)(lds + OFF_ST + (16 * u + c15) * QS + (32 * w + 16 * i + 4 * g) * 2) = pk; }
        __syncthreads();
        if (c + 1 < 65) RET_LOAD(row0 + 16 + 32 * c, 32);
        u32x2 gg_pre;
        { const int dt_ = w & 3, it_ = w >> 2, i_ = 16 * it_ + c15; const size_t ci_ = (size_t)(tok0 + (i_ < len ? i_ : 0)) * 2048 + h * 512 + sl * 64 + 16 * dt_ + 4 * g; gg_pre = *(const u32x2*)(a.G + ci_); }
        if (w < 3) { const int jt = w >> 1, it = (w + 1) >> 1; f32x4 pacc = {0.f, 0.f, 0.f, 0.f};
#pragma unroll
            for (int s = 0; s < 8; ++s) { const bf16x8 A = *(const bf16x8*)(lds + OFF_K + (16 * jt + c15) * QS + (32 * s + 8 * g) * 2), B = *(const bf16x8*)(lds + OFF_Q + (16 * it + c15) * QS + (32 * s + 8 * g) * 2);
                pacc = __builtin_amdgcn_mfma_f32_16x16x32_bf16(A, B, pacc, 0, 0, 0); }
            const int ig = 16 * it + c15, jg0 = 16 * jt + 4 * g; float pv[4];
#pragma unroll
            for (int r = 0; r < 4; ++r) pv[r] = (jg0 + r <= ig) ? pacc[r] : 0.f;
            u32x2 pk; pk.x = att::cvtpk(pv[0], pv[1]); pk.y = att::cvtpk(pv[2], pv[3]);
            *(u32x2*)(lds + OFF_P + ig * PS + jg0 * 2) = pk; }
        else if (w == 3) { if (lane < 32) *(u32x4*)(lds + OFF_P + (lane >> 1) * PS + 32 + 16 * (lane & 1)) = (u32x4){0u, 0u, 0u, 0u}; }
        { s16x4 vl[4], vh[4], kl[2], kh[2];
#pragma unroll
          for (int u = 0; u < 4; ++u) { const int ad = ldsb + OFF_V + (8 * g + q4) * VS + (16 * u + 4 * p4) * 2; vl[u] = trr(ad); vh[u] = trr(ad + 4 * VS); }
#pragma unroll
          for (int i = 0; i < 2; ++i) { const int ad = ldsb + OFF_K + (8 * g + q4) * QS + (32 * w + 16 * i + 4 * p4) * 2; kl[i] = trr(ad); kh[i] = trr(ad + 4 * QS); }
          asm volatile("s_waitcnt lgkmcnt(0)" ::: "memory"); __builtin_amdgcn_sched_barrier(0);
          const float gl = exp2f(lg2 * (float)len);
#pragma unroll
          for (int i = 0; i < 2; ++i)
#pragma unroll
              for (int u = 0; u < 4; ++u) { S[i][u] = __builtin_amdgcn_mfma_f32_16x16x32_bf16(cat(kl[i], kh[i]), cat(vl[u], vh[u]), S[i][u], 0, 0, 0); S[i][u] *= gl; } }
        __syncthreads();
        { const int dt = w & 3, it = w >> 2; f32x4 o = {0.f, 0.f, 0.f, 0.f};
          { const int ad = ldsb + OFF_V + (8 * g + q4) * VS + (16 * dt + 4 * p4) * 2; const s16x4 lo = trr(ad), hi = trr(ad + 4 * VS);
            const bf16x8 Bp = *(const bf16x8*)(lds + OFF_P + (16 * it + c15) * PS + (8 * g) * 2);
            asm volatile("s_waitcnt lgkmcnt(0)" ::: "memory"); __builtin_amdgcn_sched_barrier(0);
            o = __builtin_amdgcn_mfma_f32_16x16x32_bf16(cat(lo, hi), Bp, o, 0, 0, 0); }
#pragma unroll
          for (int s = 0; s < 8; ++s) { const bf16x8 A = *(const bf16x8*)(lds + OFF_ST + (16 * dt + c15) * QS + (32 * s + 8 * g) * 2), B = *(const bf16x8*)(lds + OFF_Q + (16 * it + c15) * QS + (32 * s + 8 * g) * 2);
              o = __builtin_amdgcn_mfma_f32_16x16x32_bf16(A, B, o, 0, 0, 0); }
          const int i = 16 * it + c15; float ss = o[0] * o[0] + o[1] * o[1] + o[2] * o[2] + o[3] * o[3];
          ss += __shfl_xor(ss, 16); ss += __shfl_xor(ss, 32);
          if (g == 0) ((float*)(lds + OFF_SS))[i * 4 + dt] = ss;
          if (i < len) { const size_t ci = (size_t)(tok0 + i) * 2048 + h * 512 + sl * 64 + 16 * dt + 4 * g; const u32x2 gg = gg_pre;
              u32x2 pk; pk.x = att::cvtpk(o[0] * __uint_as_float(gg.x << 16), o[1] * __uint_as_float(gg.x & 0xffff0000u)); pk.y = att::cvtpk(o[2] * __uint_as_float(gg.y << 16), o[3] * __uint_as_float(gg.y & 0xffff0000u));
              *(u32x2*)(a.OG + ci) = pk; } }
        __syncthreads();
        if (tid < len) { const float* sp = (const float*)(lds + OFF_SS) + tid * 4; a.ssret[(size_t)(tok0 + tid) * 32 + h * 8 + sl] = (sp[0] + sp[1]) + (sp[2] + sp[3]); }
    }
    float* so = a.out + (size_t)O_R_P + ((size_t)b * H_RET + h) * (DK_RET * DV_RET) + sl * 64;
#pragma unroll
    for (int i = 0; i < 2; ++i)
#pragma unroll
        for (int u = 0; u < 4; ++u)
#pragma unroll
            for (int r = 0; r < 4; ++r) so[(size_t)(32 * w + 16 * i + 4 * g + r) * DV_RET + 16 * u + c15] = S[i][u][r];
    __syncthreads();
#undef RET_LOAD
}
}
namespace epi {
using f32x4 = pg8::f32x4; using u32x4 = pg8::u32x4; typedef unsigned u32x2 __attribute__((ext_vector_type(2)));
__device__ __forceinline__ unsigned pk(float lo, float hi) { return pg8::cvt_pk_bf16(lo, hi); }
__device__ __forceinline__ u32x4 pack8(const f32x4& a, const f32x4& b) { u32x4 w; w.x = pk(a[0], a[1]); w.y = pk(a[2], a[3]); w.z = pk(b[0], b[1]); w.w = pk(b[2], b[3]); return w; }
__device__ __forceinline__ float bflo(unsigned w) { return __uint_as_float(w << 16); }
__device__ __forceinline__ float bfhi(unsigned w) { return __uint_as_float(w & 0xffff0000u); }
__device__ __forceinline__ f32x4 silu4(f32x4 x) { f32x4 o;
#pragma unroll
    for (int j = 0; j < 4; ++j) o[j] = x[j] * __builtin_amdgcn_rcpf(1.0f + __expf(-x[j])); return o; }
__device__ __forceinline__ f32x4 sigm4(f32x4 x) { f32x4 o;
#pragma unroll
    for (int j = 0; j < 4; ++j) o[j] = __builtin_amdgcn_rcpf(1.0f + __expf(-x[j])); return o; }

struct Epi1 {
    static constexpr bool PERM = true, AFTER_DRAIN = false;
    const float* rstd0; const float2* rope; const float *ikw, *ikb;
    bf16_t *Rq, *Rk, *Rv, *G, *Aq, *Vb, *Iq, *Ikb, *Gates; float* Iw; float* out; int gz0;
    template <int TY> __device__ __forceinline__ void run(const f32x4 (&acc)[2][2][4][2], int pm, int wr, int wc, int fr, int fq, bf16_t* dbase, int ld, float* fbase, float* fbase_s, float post, int isv) const {
        const int cl = wc * 32 + 8 * fq;
        float rsv[8];
#pragma unroll
        for (int i = 0; i < 8; ++i) { const int row = pm * 256 + (i >> 2) * 128 + wr * 64 + (i & 3) * 16 + fr; rsv[i] = rstd0[row < T_ALL ? row : T_ALL - 1]; }
#pragma unroll
        for (int ai = 0; ai < 2; ++ai)
#pragma unroll
            for (int m = 0; m < 4; ++m) {
                const int row = pm * 256 + ai * 128 + wr * 64 + m * 16 + fr; const bool ok = row < T_ALL; const int rowc = ok ? row : T_ALL - 1;
                const float rs = rsv[ai * 4 + m];
                f32x4 v[2][2];
#pragma unroll
                for (int bj = 0; bj < 2; ++bj)
#pragma unroll
                    for (int n = 0; n < 2; ++n) v[bj][n] = acc[ai][bj][m][n] * rs;
                if constexpr (TY == 0) {
                    bf16_t* dst = dbase + (size_t)rowc * 1024 + cl;
                    const float4* rp = (const float4*)(rope + (size_t)row_pos(rowc) * 128 + cl);
                    float4 rv[4];
#pragma unroll
                    for (int q = 0; q < 4; ++q) rv[q] = rp[q];
                    asm volatile("s_waitcnt vmcnt(0)" ::: "memory");
                    f32x4 o1[2], o2[2];
#pragma unroll
                    for (int n = 0; n < 2; ++n) { const float4 cs0 = rv[2 * n], cs1 = rv[2 * n + 1]; const float c[4] = {cs0.x, cs0.z, cs1.x, cs1.z}, s[4] = {cs0.y, cs0.w, cs1.y, cs1.w};
#pragma unroll
                        for (int j = 0; j < 4; ++j) { o1[n][j] = (v[0][n][j] * c[j] - v[1][n][j] * s[j]) * post; o2[n][j] = (v[0][n][j] * s[j] + v[1][n][j] * c[j]) * post; } }
                    if (ok) { *(u32x4*)dst = pack8(o1[0], o1[1]); *(u32x4*)(dst + 128) = pack8(o2[0], o2[1]); }
                } else if constexpr (TY == 1 || TY == 2 || TY == 3) {
                    bf16_t* dst = dbase + (size_t)rowc * ld + cl;
                    if constexpr (TY == 2) { v[0][0] = silu4(v[0][0]); v[0][1] = silu4(v[0][1]); v[1][0] = silu4(v[1][0]); v[1][1] = silu4(v[1][1]); }
                    if constexpr (TY == 3) { v[0][0] = sigm4(v[0][0]); v[0][1] = sigm4(v[0][1]); v[1][0] = sigm4(v[1][0]); v[1][1] = sigm4(v[1][1]); }
                    if (ok) { *(u32x4*)dst = pack8(v[0][0], v[0][1]); *(u32x4*)(dst + 128) = pack8(v[1][0], v[1][1]); }
                } else if constexpr (TY == 4) {
                    float* dst = (rowc < T_PROMPT ? fbase + (size_t)rowc * 256 : fbase_s + (size_t)(rowc - T_PROMPT) * 256) + cl;
                    if (ok) { *(f32x4*)dst = v[0][0]; *(f32x4*)(dst + 4) = v[0][1]; *(f32x4*)(dst + 128) = v[1][0]; *(f32x4*)(dst + 132) = v[1][1];
                        if (isv) { bf16_t* vb = Vb + (size_t)rowc * 256 + cl; *(u32x4*)vb = pack8(v[0][0], v[0][1]); *(u32x4*)(vb + 128) = pack8(v[1][0], v[1][1]); } }
                } else {
                    if (wc == 0) {
                        float s = 0.f;
#pragma unroll
                        for (int bj = 0; bj < 2; ++bj)
#pragma unroll
                            for (int n = 0; n < 2; ++n) s += (v[bj][n][0] + v[bj][n][1]) + (v[bj][n][2] + v[bj][n][3]);
                        s += __shfl_xor(s, 16); s += __shfl_xor(s, 32);
                        const float mu = s * (1.0f / 64.0f); float q = 0.f;
#pragma unroll
                        for (int bj = 0; bj < 2; ++bj)
#pragma unroll
                            for (int n = 0; n < 2; ++n) { const f32x4 d = v[bj][n] - mu; q += (d[0] * d[0] + d[1] * d[1]) + (d[2] * d[2] + d[3] * d[3]); }
                        q += __shfl_xor(q, 16); q += __shfl_xor(q, 32);
                        const float rn = rsqrtf(q * (1.0f / 64.0f) + NORM_EPS);
                        float* ko = out + (rowc < T_PROMPT ? (size_t)O_KI_P + (size_t)rowc * 64 : (size_t)O_KI_S + (size_t)(rowc - T_PROMPT) * 64);
#pragma unroll
                        for (int bj = 0; bj < 2; ++bj) { const int e0 = 32 * bj + 8 * fq; f32x4 y[2];
#pragma unroll
                            for (int n = 0; n < 2; ++n) { const f32x4 wv = *(const f32x4*)(ikw + e0 + 4 * n), bv = *(const f32x4*)(ikb + e0 + 4 * n); y[n] = (v[bj][n] - mu) * rn * wv + bv; }
                            if (ok) { *(f32x4*)(ko + e0) = y[0]; *(f32x4*)(ko + e0 + 4) = y[1]; *(u32x4*)(Ikb + (size_t)rowc * 64 + e0) = pack8(y[0], y[1]); } }
                    } else if (wc == 1 && fq == 0) {
                        if (ok) { *(f32x4*)(Iw + (size_t)rowc * 8) = v[0][0] * IDX_SCALE; *(f32x4*)(Iw + (size_t)rowc * 8 + 4) = v[0][1] * IDX_SCALE; }
                    }
                }
            }
    }
    __device__ __forceinline__ void operator()(const f32x4 (&acc)[2][2][4][2], const pg8::Unit& u, int wr, int wc, int fr_in, int fq_in) const {
        int fr = fr_in, fq = fq_in; asm volatile("" : "+v"(fr), "+v"(fq));
        const int pn = u.pn + gz0, pm = u.pm;
        if (pn < 4)        run<0>(acc, pm, wr, wc, fr, fq, Rq + pn * 256, 1024, nullptr, nullptr, 1.0f, 0);
        else if (pn < 8)   run<0>(acc, pm, wr, wc, fr, fq, Rk + (pn - 4) * 256, 1024, nullptr, nullptr, 0.0625f, 0);
        else if (pn < 16)  run<1>(acc, pm, wr, wc, fr, fq, Rv + (pn - 8) * 256, 2048, nullptr, nullptr, 1.0f, 0);
        else if (pn < 24)  run<2>(acc, pm, wr, wc, fr, fq, G + (pn - 16) * 256, 2048, nullptr, nullptr, 1.0f, 0);
        else if (pn < 28)  run<1>(acc, pm, wr, wc, fr, fq, Aq + (pn - 24) * 256, 1024, nullptr, nullptr, 1.0f, 0);
        else if (pn == 28) run<4>(acc, pm, wr, wc, fr, fq, nullptr, 0, out + O_K_P, out + O_K_S, 1.0f, 0);
        else if (pn == 29) run<4>(acc, pm, wr, wc, fr, fq, nullptr, 0, out + O_V_P, out + O_V_S, 1.0f, 1);
        else if (pn < 32)  run<1>(acc, pm, wr, wc, fr, fq, Iq + (pn - 30) * 256, 512, nullptr, nullptr, 1.0f, 0);
        else if (pn == 32) run<5>(acc, pm, wr, wc, fr, fq, nullptr, 0, nullptr, nullptr, 1.0f, 0);
        else               run<3>(acc, pm, wr, wc, fr, fq, Gates + (pn - 33 + gz0) * 256, 2048, nullptr, nullptr, 1.0f, 0);
    }
};
struct EpiRet {
    static constexpr bool PERM = false, AFTER_DRAIN = false;
    float* M1;
    __device__ __forceinline__ void operator()(const f32x4 (&acc)[2][2][4][2], const pg8::Unit& u, int wr, int wc, int fr_in, int fq_in) const {
        int fr = fr_in, fq = fq_in; asm volatile("" : "+v"(fr), "+v"(fq));
#pragma unroll
        for (int ai = 0; ai < 2; ++ai)
#pragma unroll
            for (int m = 0; m < 4; ++m) { const int row = u.pm * 256 + ai * 128 + wr * 64 + m * 16 + fr;
#pragma unroll
                for (int bj = 0; bj < 2; ++bj)
#pragma unroll
                    for (int n = 0; n < 2; ++n) *(f32x4*)(M1 + (size_t)row * 1024 + u.pn * 256 + bj * 128 + wc * 32 + 16 * n + 4 * fq) = acc[ai][bj][m][n]; }
    }
};
struct EpiDsa {
    static constexpr bool PERM = false, AFTER_DRAIN = false;
    const bf16_t* Gates; const float* M1; bf16_t* Mg;
    __device__ __forceinline__ void operator()(const f32x4 (&acc)[2][2][4][2], const pg8::Unit& u, int wr, int wc, int fr_in, int fq_in) const {
        int fr = fr_in, fq = fq_in; asm volatile("" : "+v"(fr), "+v"(fq));
#pragma unroll
        for (int ai = 0; ai < 2; ++ai)
#pragma unroll
            for (int mp = 0; mp < 2; ++mp) {
                u32x2 gr[2][2][2], gd[2][2][2]; f32x4 mv[2][2][2];
#pragma unroll
                for (int mm = 0; mm < 2; ++mm) { const int row = u.pm * 256 + ai * 128 + wr * 64 + (2 * mp + mm) * 16 + fr;
#pragma unroll
                    for (int bj = 0; bj < 2; ++bj)
#pragma unroll
                        for (int n = 0; n < 2; ++n) { const int col = u.pn * 256 + bj * 128 + wc * 32 + 16 * n + 4 * fq;
                            gr[mm][bj][n] = *(const u32x2*)(Gates + (size_t)row * 2048 + col); gd[mm][bj][n] = *(const u32x2*)(Gates + (size_t)row * 2048 + 1024 + col); mv[mm][bj][n] = *(const f32x4*)(M1 + (size_t)row * 1024 + col); } }
#pragma unroll
                for (int mm = 0; mm < 2; ++mm) { const int m = 2 * mp + mm, row = u.pm * 256 + ai * 128 + wr * 64 + m * 16 + fr;
#pragma unroll
                    for (int bj = 0; bj < 2; ++bj)
#pragma unroll
                        for (int n = 0; n < 2; ++n) { const int col = u.pn * 256 + bj * 128 + wc * 32 + 16 * n + 4 * fq;
                            const f32x4 g1 = {bflo(gr[mm][bj][n].x), bfhi(gr[mm][bj][n].x), bflo(gr[mm][bj][n].y), bfhi(gr[mm][bj][n].y)}, g2 = {bflo(gd[mm][bj][n].x), bfhi(gd[mm][bj][n].x), bflo(gd[mm][bj][n].y), bfhi(gd[mm][bj][n].y)};
                            const f32x4 r = mv[mm][bj][n] * g1 + acc[ai][bj][m][n] * g2;
                            u32x2 w; w.x = pk(r[0], r[1]); w.y = pk(r[2], r[3]); *(u32x2*)(Mg + (size_t)row * 1024 + col) = w; } } }
    }
};
struct EpiOut {
    static constexpr bool PERM = false, AFTER_DRAIN = false;
    const float *xp, *xs, *meta; float* H2; bf16_t* A2; float* ss2;
    __device__ __forceinline__ void operator()(const f32x4 (&acc)[2][2][4][2], const pg8::Unit& u, int wr, int wc, int fr_in, int fq_in) const {
        int fr = fr_in, fq = fq_in; asm volatile("" : "+v"(fr), "+v"(fq));
#pragma unroll
        for (int ai = 0; ai < 2; ++ai) {
            f32x4 hv[4][2][2];
#pragma unroll
            for (int m = 0; m < 4; ++m) { const int row = u.pm * 256 + ai * 128 + wr * 64 + m * 16 + fr; const float* h = h_row_ptr(row < T_ALL ? row : 0, xp, xs, meta);
#pragma unroll
                for (int bj = 0; bj < 2; ++bj)
#pragma unroll
                    for (int n = 0; n < 2; ++n) hv[m][bj][n] = *(const f32x4*)(h + u.pn * 256 + bj * 128 + wc * 32 + 16 * n + 4 * fq); }
#pragma unroll
            for (int m = 0; m < 4; ++m) { const int row = u.pm * 256 + ai * 128 + wr * 64 + m * 16 + fr; const bool ok = row < T_ALL; float ss = 0.f;
#pragma unroll
                for (int bj = 0; bj < 2; ++bj)
#pragma unroll
                    for (int n = 0; n < 2; ++n) { const int col = u.pn * 256 + bj * 128 + wc * 32 + 16 * n + 4 * fq; f32x4 r = acc[ai][bj][m][n]; if (ok) r += hv[m][bj][n];
                        *(f32x4*)(H2 + (size_t)row * 1024 + col) = r; u32x2 w; w.x = pk(r[0], r[1]); w.y = pk(r[2], r[3]); *(u32x2*)(A2 + (size_t)row * 1024 + col) = w;
                        ss += (r[0] * r[0] + r[1] * r[1]) + (r[2] * r[2] + r[3] * r[3]); }
                ss += __shfl_xor(ss, 16); ss += __shfl_xor(ss, 32);
                if (fq == 0) atomicAdd(ss2 + row, ss); } }
    }
};
struct EpiFfi {
    static constexpr bool PERM = true, AFTER_DRAIN = false;
    const float* ss2; bf16_t* Hid;
    __device__ __forceinline__ void operator()(const f32x4 (&acc)[2][2][4][2], const pg8::Unit& u, int wr, int wc, int fr_in, int fq_in) const {
        int fr = fr_in, fq = fq_in; asm volatile("" : "+v"(fr), "+v"(fq));
        float sv[8];
#pragma unroll
        for (int i = 0; i < 8; ++i) sv[i] = ss2[u.pm * 256 + (i >> 2) * 128 + wr * 64 + (i & 3) * 16 + fr];
#pragma unroll
        for (int ai = 0; ai < 2; ++ai)
#pragma unroll
            for (int m = 0; m < 4; ++m) { const int row = u.pm * 256 + ai * 128 + wr * 64 + m * 16 + fr;
                const float rs = rsqrtf(sv[ai * 4 + m] * (1.0f / 1024.0f) + NORM_EPS);
                f32x4 hv[2];
#pragma unroll
                for (int n = 0; n < 2; ++n) hv[n] = silu4(acc[ai][0][m][n] * rs) * (acc[ai][1][m][n] * rs);
                *(u32x4*)(Hid + (size_t)row * D_FF + u.pn * 128 + wc * 32 + 8 * fq) = pack8(hv[0], hv[1]); }
    }
};
struct EpiFfo {
    static constexpr bool PERM = false, AFTER_DRAIN = false;
    const float* H2; float* out;
    __device__ __forceinline__ void operator()(const f32x4 (&acc)[2][2][4][2], const pg8::Unit& u, int wr, int wc, int fr_in, int fq_in) const {
        int fr = fr_in, fq = fq_in; asm volatile("" : "+v"(fr), "+v"(fq));
#pragma unroll
        for (int ai = 0; ai < 2; ++ai) {
            f32x4 hv[4][2][2];
#pragma unroll
            for (int m = 0; m < 4; ++m) { const int row = u.pm * 256 + ai * 128 + wr * 64 + m * 16 + fr;
#pragma unroll
                for (int bj = 0; bj < 2; ++bj)
#pragma unroll
                    for (int n = 0; n < 2; ++n) hv[m][bj][n] = *(const f32x4*)(H2 + (size_t)row * 1024 + u.pn * 256 + bj * 128 + wc * 32 + 16 * n + 4 * fq); }
#pragma unroll
            for (int m = 0; m < 4; ++m) { const int row = u.pm * 256 + ai * 128 + wr * 64 + m * 16 + fr; float* dst = nullptr;
                if (row < T_PROMPT) { const int b = row / LP, l = row % LP; if (l >= N_META) dst = out + O_Y_P + ((size_t)b * SEQ + (l - N_META)) * 1024; }
                else if (row < T_ALL) dst = out + O_Y_S + (size_t)(row - T_PROMPT) * 1024;
                if (dst) {
#pragma unroll
                    for (int bj = 0; bj < 2; ++bj)
#pragma unroll
                        for (int n = 0; n < 2; ++n) *(f32x4*)(dst + u.pn * 256 + bj * 128 + wc * 32 + 16 * n + 4 * fq) = hv[m][bj][n] + acc[ai][bj][m][n]; } } }
    }
};
}
#define RETS_N_TASKS (DEC_BATCH * H_RET * 8)
__device__ __forceinline__ void ret_sample_task(const MegaArgs& a, int task, float* qk  , int lane) {
    const int sl = task & 7, h = (task >> 3) & 3, db = task >> 5, r0 = T_PROMPT + db * DEC_SEQ;
    { const int which = lane >> 5, ch = lane & 31; const bf16_t* src = (which ? a.Rk : a.Rq) + (size_t)r0 * 1024 + h * 256 + ch * 8;
#pragma unroll
      for (int i = 0; i < 8; ++i) { const uint4 v = *(const uint4*)(src + (size_t)i * 1024); const unsigned wv[4] = {v.x, v.y, v.z, v.w};
#pragma unroll
          for (int e = 0; e < 4; ++e) { qk[(ch * 8 + 2 * e) * 16 + which * 8 + i] = __uint_as_float(wv[e] << 16); qk[(ch * 8 + 2 * e + 1) * 16 + which * 8 + i] = __uint_as_float(wv[e] & 0xffff0000u); } } }
    float v[8], o[8]; const int dv = sl * 64 + lane;
#pragma unroll
    for (int i = 0; i < 8; ++i) { v[i] = bf2f(a.Rv[(size_t)(r0 + i) * 2048 + h * 512 + dv]); o[i] = 0.f; }
    const float gamma = 1.0f - exp2f(-5.0f - (float)h);
    const size_t sb = ((size_t)db * H_RET + h) * (DK_RET * DV_RET) + dv;
    const float* sin_ = a.state_ret + sb; float* sout = a.out + (size_t)O_R_S + sb;
    for (int dk0 = 0; dk0 < 256; dk0 += 32) {
        float s[32];
#pragma unroll
        for (int j = 0; j < 32; ++j) s[j] = __builtin_nontemporal_load(sin_ + (size_t)(dk0 + j) * DV_RET);
#pragma unroll
        for (int j = 0; j < 32; ++j) { const float4* c = (const float4*)(qk + (dk0 + j) * 16); const float4 q0 = c[0], q1 = c[1], k0 = c[2], k1 = c[3];
            const float qq[8] = {q0.x, q0.y, q0.z, q0.w, q1.x, q1.y, q1.z, q1.w}, kk[8] = {k0.x, k0.y, k0.z, k0.w, k1.x, k1.y, k1.z, k1.w};
#pragma unroll
            for (int i = 0; i < 8; ++i) { s[j] = fmaf(s[j], gamma, kk[i] * v[i]); o[i] = fmaf(qq[i], s[j], o[i]); }
            __builtin_nontemporal_store(s[j], sout + (size_t)(dk0 + j) * DV_RET); }
    }
#pragma unroll
    for (int i = 0; i < 8; ++i) { float ss = o[i] * o[i];
#pragma unroll
        for (int of = 32; of >= 1; of >>= 1) ss += __shfl_xor(ss, of);
        const size_t ci = (size_t)(r0 + i) * 2048 + h * 512 + dv;
        a.OG[ci] = f2bf(o[i] * bf2f(a.G[ci]));
        if (lane == 0) a.ssret[(size_t)(r0 + i) * 32 + h * 8 + sl] = ss; }
}

__device__ __forceinline__ void make_an_row(const MegaArgs& a, int r, int lane) {
    const float4* sp = (const float4*)(a.ssret + (size_t)r * 32);
    float rn[4];
#pragma unroll
    for (int h = 0; h < 4; ++h) { const float4 s0 = sp[2 * h], s1 = sp[2 * h + 1]; rn[h] = rsqrtf(((s0.x + s0.y) + (s0.z + s0.w) + (s1.x + s1.y) + (s1.z + s1.w)) * (1.0f / 512.0f) + NORM_EPS); }
#pragma unroll
    for (int h = 0; h < 4; ++h) { const uint4 v = ((const uint4*)(a.OG + (size_t)r * 2048))[h * 64 + lane]; const float f = rn[h]; uint4 o;
        o.x = pg8::cvt_pk_bf16(__uint_as_float(v.x << 16) * f, __uint_as_float(v.x & 0xffff0000u) * f); o.y = pg8::cvt_pk_bf16(__uint_as_float(v.y << 16) * f, __uint_as_float(v.y & 0xffff0000u) * f);
        o.z = pg8::cvt_pk_bf16(__uint_as_float(v.z << 16) * f, __uint_as_float(v.z & 0xffff0000u) * f); o.w = pg8::cvt_pk_bf16(__uint_as_float(v.w << 16) * f, __uint_as_float(v.w & 0xffff0000u) * f);
        ((uint4*)(a.An + (size_t)r * 2048))[h * 64 + lane] = o; }
}
__device__ __forceinline__ void knorm_row(const MegaArgs& a, int r, int lane) {
    float* kp = a.out + (r < T_PROMPT ? (size_t)O_K_P + (size_t)r * 256 : (size_t)O_K_S + (size_t)(r - T_PROMPT) * 256) + lane * 4;
    const float4 x = *(const float4*)kp; float ss = x.x * x.x + x.y * x.y + x.z * x.z + x.w * x.w;
#pragma unroll
    for (int o = 16; o >= 1; o >>= 1) ss += __shfl_xor(ss, o);
    const float rn = rsqrtf(ss * (1.0f / 128.0f) + NORM_EPS); const float4 w = *(const float4*)(a.knw + (lane & 31) * 4);
    const float4 y = make_float4(x.x * rn * w.x, x.y * rn * w.y, x.z * rn * w.z, x.w * rn * w.w);
    *(float4*)kp = y;
    uint2 o; o.x = (unsigned)f2bf(y.x) | ((unsigned)f2bf(y.y) << 16); o.y = (unsigned)f2bf(y.z) | ((unsigned)f2bf(y.w) << 16);
    *(uint2*)(a.Kb + (size_t)r * 256 + lane * 4) = o;
}
#define IDX_N_SAMPLE_TASKS (DEC_BATCH * 2)
#define IDX_N_PROMPT_TASKS (BATCH * (LP / 4))
#define IDX_N_TASKS (IDX_N_SAMPLE_TASKS + IDX_N_PROMPT_TASKS)
__device__ __forceinline__ void idx_task(const MegaArgs& a, int k, unsigned char* shm, int wave, int lane) {
    unsigned* strip = (unsigned*)(shm + (size_t)wave * idx::WAVE_LDS); unsigned* mask32 = (unsigned*)a.mask;
    if (k < IDX_N_SAMPLE_TASKS) {
        const int db = k >> 1, q0 = 4 * (k & 1);
        const int pgv = a.page_table[db * N_PAGES + (lane & 15)];
        idx::KeySrc<true> ks{a.Ikb + (size_t)(T_PROMPT + db * DEC_SEQ) * 64, a.cache_kidx, pgv};
        idx::wave_task<true>(ks, a.Iq, a.Iw, T_PROMPT + db * DEC_SEQ + q0, PAST_LEN + q0, 4, strip, mask32, lane);
    } else {
        const int pk = k - IDX_N_SAMPLE_TASKS, b = pk & 7, l0 = 4 * (LP / 4 - 1 - (pk >> 3));
        idx::KeySrc<false> ks{a.Ikb + (size_t)b * LP * 64, nullptr, 0};
        idx::wave_task<false>(ks, a.Iq, a.Iw, b * LP + l0, l0, 4, strip, mask32, lane);
    }
}
#define ATT_N_PROMPT_UNITS (BATCH * N_KV * 33)
__device__ __forceinline__ void attn_prompt_unit(const MegaArgs& a, int idx, char* lds) {
    const int qb = 32 - idx / 16, bn = idx % 16, b = bn >> 1, n = bn & 1;
    const int tok0 = b * LP + 64 * qb, nq = (LP - 64 * qb) < 64 ? (LP - 64 * qb) : 64;
    const int NT = qb + 1;
    att::KvPrompt kv{a.Kb + (size_t)b * LP * 256 + n * 128, a.Vb + (size_t)b * LP * 256 + n * 128};
    att::attn_unit<att::KvPrompt>(kv, a.Aq, a.qnw, a.mask, a.Odsa, tok0, nq, 4 * n, NT, lds);
}
__device__ __forceinline__ void attn_sample_unit(const MegaArgs& a, int u, char* lds) {
    const int db = u >> 1, n = u & 1;
    int* pages = (int*)(lds + 2 * att::SHM_V + 2 * att::SHM_K + 2048);
    __syncthreads();
    if (threadIdx.x < N_PAGES) pages[threadIdx.x] = a.page_table[db * N_PAGES + threadIdx.x];
    __syncthreads();
    att::KvSample kv{a.cache_k, a.cache_v, a.out + O_K_S + (size_t)db * DEC_SEQ * 256 + n * 128, a.out + O_V_S + (size_t)db * DEC_SEQ * 256 + n * 128, pages, n};
    att::attn_unit<att::KvSample>(kv, a.Aq, a.qnw, a.mask, a.Odsa, T_PROMPT + db * DEC_SEQ, DEC_SEQ, 4 * n, 33, lds);
}

#define LDS_TOTAL (8 * idx::WAVE_LDS + 2048)
__global__ void __launch_bounds__(512, 2) mega(MegaArgs a) {
    extern __shared__ __attribute__((aligned(16))) unsigned char shm[];
    float* lds = (float*)shm;
    volatile LAS unsigned* xbw = (volatile LAS unsigned*)(PG8_LAS unsigned char*)(shm + LDS_TOTAL - 16);
    const int tid = threadIdx.x, wave = tid >> 6, lane = tid & 63, half = tid >> 8, G = gridDim.x, bid = blockIdx.x;
    if (tid == 0) { xbw[0] = 0u; xbw[1] = 0u; xbw[2] = 0u; xbw[3] = 0u; }
    __syncthreads();
    XcdBarrier bar = xcd_barrier_post(a.bar, xbw);
    for (int jp = bid; jp < PREP_J_ROWS / 2; jp += G) prep_job(a.prep, 2 * jp + half, lds + half * (64 * 65));
    for (int j = PREP_J_ROWS + bid * 2 + half; j < PREP_N_JOBS; j += 2 * G) prep_job(a.prep, j, lds);
    for (int i = bid * 512 + tid; i < T_PAD; i += G * 512) a.rstd2[i] = 0.f;
    xcd_barrier(bar);
    { pg8::StaticOrder S; S.init(T_PAD, N1, G, bid);
      epi::Epi1 E{a.prep.rstd0, a.prep.rope, a.ikw, a.ikb, a.Rq, a.Rk, a.Rv, a.G, a.Aq, a.Vb, a.Iq, a.Ikb, a.Gates, a.Iw, a.out, 0};
      pg8::gemm_phase<epi::Epi1, pg8::StaticOrder, false>((PG8_LAS unsigned char*)shm, pg8::Gemm{a.prep.A0, a.prep.W1t, T_PAD, N1, 1024}, S, E, nullptr); }
    xcd_barrier(bar);
    for (int ord = 0; ord < 2; ++ord) {
      if ((ord ^ (bid & 1)) == 0) {
        for (int u = bid; u < BATCH * H_RET * 8; u += G) ret::unit(a, u, (char*)shm);
      } else {
      { int tl = threadIdx.x; asm volatile("" : "+v"(tl)); const int wv = __builtin_amdgcn_readfirstlane(tl >> 6), NW = 8 * G, g = wv * G + bid;
        float* strip = (float*)(shm + (size_t)wv * idx::WAVE_LDS);
        for (int step = 0; step < 6; ++step) { const int i = step >> 1;
            int ln_o = tl & 63; asm volatile("" : "+v"(ln_o)); const int ln = ln_o;
            if ((step + wv) & 1) { const int pi = i * NW + ((i & 1) ? (NW - 1 - g) : g); if (pi < IDX_N_TASKS) idx_task(a, pi, shm, wv, ln); }
            else                 { const int pr = i * NW + g; if (pr < RETS_N_TASKS) ret_sample_task(a, pr, strip, ln); } } }
        __syncthreads();
      }
    }
    { int t2 = threadIdx.x; asm volatile("" : "+v"(t2)); for (int r = bid * 8 + (t2 >> 6); r < T_ALL; r += 8 * G) knorm_row(a, r, t2 & 63); }
    xcd_barrier(bar);
    for (int ord = 0; ord < 2; ++ord) {
      if ((ord ^ (bid & 1)) == 0) {
        for (int i = 0; ; ++i) { const long p = (long)i * G + ((i & 1) ? (G - 1 - bid) : bid); if (p >= ATT_N_PROMPT_UNITS) { if ((long)i * G >= ATT_N_PROMPT_UNITS) break; else continue; } attn_prompt_unit(a, (int)p, (char*)shm); }
      } else {
        for (int u = bid; u < DEC_BATCH * N_KV; u += G) attn_sample_unit(a, u, (char*)shm);
      }
    }
    { int t2 = threadIdx.x; asm volatile("" : "+v"(t2)); for (int r = bid * 8 + (t2 >> 6); r < T_ALL; r += 8 * G) make_an_row(a, r, t2 & 63); }
    xcd_barrier(bar);
    { pg8::StaticOrder S; S.init(T_PAD, 1024, G, bid); pg8::gemm_phase<epi::EpiRet, pg8::StaticOrder, false>((PG8_LAS unsigned char*)shm, pg8::Gemm{a.An, a.prep.Wret, T_PAD, 1024, 2048}, S, epi::EpiRet{a.M1}, nullptr); }
    { pg8::StaticOrder S; S.init(T_PAD, 1024, G, bid); pg8::gemm_phase<epi::EpiDsa, pg8::StaticOrder, false>((PG8_LAS unsigned char*)shm, pg8::Gemm{a.Odsa, a.prep.Wdsa, T_PAD, 1024, 1024}, S, epi::EpiDsa{a.Gates, a.M1, a.Mg}, nullptr); }
    xcd_barrier(bar);
    { pg8::StaticOrder S; S.init(T_PAD, 1024, G, bid); pg8::gemm_phase<epi::EpiOut, pg8::StaticOrder, false>((PG8_LAS unsigned char*)shm, pg8::Gemm{a.Mg, a.prep.Wout, T_PAD, 1024, 1024}, S, epi::EpiOut{a.prep.x_prompt, a.prep.x_sample, a.prep.meta, a.H2, a.A2, a.rstd2}, nullptr); }
    xcd_barrier(bar);
    { pg8::StaticOrder S; S.init(T_PAD, NFF2, G, bid); pg8::gemm_phase<epi::EpiFfi, pg8::StaticOrder, false>((PG8_LAS unsigned char*)shm, pg8::Gemm{a.A2, a.prep.Wffi, T_PAD, NFF2, 1024}, S, epi::EpiFfi{a.rstd2, a.Hid}, nullptr); }
    xcd_barrier(bar);
    { pg8::StaticOrder S; S.init(T_PAD, 1024, G, bid); pg8::gemm_phase<epi::EpiFfo, pg8::StaticOrder, false>((PG8_LAS unsigned char*)shm, pg8::Gemm{a.Hid, a.prep.Wffo, T_PAD, 1024, 2816}, S, epi::EpiFfo{a.H2, a.out}, nullptr); }
}
extern "C" void kernel_launch(void* const* d_in, const int* in_sizes, int n_in, void* d_out, int out_size, void* d_ws, size_t ws_size, hipStream_t stream) {
    static int grid = 0;
    if (grid == 0) {
        if (n_in != 20 || out_size != OUT_TOTAL || ws_size < WS_END_B1 || ws_size < WS_END_B2) { fprintf(stderr, "kernel_launch: unexpected shapes (n_in %d out %d ws %zu need %llu)\n", n_in, out_size, ws_size, (unsigned long long)WS_END_B1); grid = -1; return; }
        int dev = 0, cus = 0, per_cu = 0;
        if (hipGetDevice(&dev) != hipSuccess || hipDeviceGetAttribute(&cus, hipDeviceAttributeMultiprocessorCount, dev) != hipSuccess) { grid = -1; return; }
        if (hipFuncSetAttribute((const void*)mega, hipFuncAttributeMaxDynamicSharedMemorySize, LDS_TOTAL) != hipSuccess) { fprintf(stderr, "kernel_launch: hipFuncSetAttribute failed\n"); grid = -1; return; }
        if (hipOccupancyMaxActiveBlocksPerMultiprocessor(&per_cu, (const void*)mega, 512, LDS_TOTAL) != hipSuccess || per_cu < 1) { fprintf(stderr, "kernel_launch: occupancy query says %d blocks per CU\n", per_cu); grid = -1; return; }
        grid = cus;
    }
    if (grid < 0) return;
    char* ws = (char*)d_ws;
    MegaArgs a{};
    a.prep.x_prompt = (const float*)d_in[0]; a.prep.x_sample = (const float*)d_in[1]; a.prep.meta = (const float*)d_in[7]; a.prep.norm_mix_w = (const float*)d_in[8]; a.prep.w_in = (const float*)d_in[9];
    a.prep.w_ret = (const float*)d_in[10]; a.prep.w_dsa = (const float*)d_in[15]; a.prep.w_out = (const float*)d_in[16]; a.prep.norm_ffn_w = (const float*)d_in[17]; a.prep.w_ffi = (const float*)d_in[18]; a.prep.w_ffo = (const float*)d_in[19];
    a.prep.W1t = (bf16_t*)(ws + WS_W1T); a.prep.Wret = (bf16_t*)(ws + WS_WRET); a.prep.Wdsa = (bf16_t*)(ws + WS_WDSA); a.prep.Wout = (bf16_t*)(ws + WS_WOUT); a.prep.Wffi = (bf16_t*)(ws + WS_WFFI); a.prep.Wffo = (bf16_t*)(ws + WS_WFFO);
    a.prep.A0 = (bf16_t*)(ws + WS_A0); a.prep.rstd0 = (float*)(ws + WS_RSTD0); a.prep.rope = (float2*)(ws + WS_ROPE);
    a.cache_k = (const float*)d_in[2]; a.cache_v = (const float*)d_in[3]; a.cache_kidx = (const float*)d_in[4]; a.state_ret = (const float*)d_in[5]; a.page_table = (const int*)d_in[6];
    a.qnw = (const float*)d_in[11]; a.knw = (const float*)d_in[12]; a.ikw = (const float*)d_in[13]; a.ikb = (const float*)d_in[14];
    a.Rq = (bf16_t*)(ws + WS_RQ); a.Rk = (bf16_t*)(ws + WS_RK); a.Rv = (bf16_t*)(ws + WS_RV); a.G = (bf16_t*)(ws + WS_G); a.Aq = (bf16_t*)(ws + WS_AQ); a.Kb = (bf16_t*)(ws + WS_KB); a.Vb = (bf16_t*)(ws + WS_VB);
    a.Iq = (bf16_t*)(ws + WS_IQ); a.Ikb = (bf16_t*)(ws + WS_IKB); a.Gates = (bf16_t*)(ws + WS_GATES); a.OG = (bf16_t*)(ws + WS_OG); a.An = (bf16_t*)(ws + WS_AN); a.Odsa = (bf16_t*)(ws + WS_ODSA); a.Mg = (bf16_t*)(ws + WS_MG);
    a.A2 = (bf16_t*)(ws + WS_A2); a.Hid = (bf16_t*)(ws + WS_HID);
    a.Iw = (float*)(ws + WS_IW); a.ssret = (float*)(ws + WS_SSRET); a.rstd2 = (float*)(ws + WS_RSTD2); a.Z = (float*)(ws + WS_Z); a.M1 = (float*)(ws + WS_M1); a.M2 = (float*)(ws + WS_M2); a.H2 = (float*)(ws + WS_H2); a.Zf = (float*)(ws + WS_ZF);
    a.out = (float*)d_out; a.mask = (u64*)(ws + WS_MASK); a.bar = (unsigned*)(ws + WS_CTL);
    if (hipMemsetAsync(ws + WS_CTL, 0, 65536, stream) != hipSuccess) return;
    hipLaunchKernelGGL(mega, dim3(grid), dim3(512), LDS_TOTAL, stream, a);
}
```
